# Optimizing an MI355X kernel written in HIP

```python
import jax, jax.numpy as jnp
from jax import lax
import numpy as np

D_MODEL = 1024
BATCH = 16
SEQ = 2048
DEPTH = 1

CHUNK = 64
LEFT_CHUNKS = 8
BAND = LEFT_CHUNKS + 1
N_MEM = 256

D_MIX = D_MODEL
ATT_HEADS = 8
ATT_HEAD_DIM = 64
D_ATT = ATT_HEADS * ATT_HEAD_DIM
CONV_GROUPS = 8
CONV_GROUP_DIM = 64
D_CONV = CONV_GROUPS * CONV_GROUP_DIM
CONV_W = 3
MAX_REL = 256
N_REL = 2 * MAX_REL + 1
D_IN_PROJ = 3 * D_ATT + 3 * D_CONV

X_HEADS = 4
X_HEAD_DIM = 128
D_X = X_HEADS * X_HEAD_DIM

N_EXPERTS = 32
TOP_K = 4
D_FF = D_MODEL
SWIGLU_LIMIT = 7.0
SWIGLU_ALPHA = 1.702
EXPERT_BLOCK = 128

EPS = 1e-6
NEG_INF = -1e30

kernel_name = "hybrid_chunk_attn_shortconv_memxattn_moe"


def _rmsnorm(x, g):
    xf = x.astype(jnp.float32)
    y = xf * lax.rsqrt(jnp.mean(xf * xf, axis=-1, keepdims=True) + EPS)
    return (y * g.astype(jnp.float32)).astype(x.dtype)


def _rel_bias_band(rel_bias):
    qi = np.arange(CHUNK)[:, None] + LEFT_CHUNKS * CHUNK
    kk = np.arange(BAND * CHUNK)[None, :]
    idx = np.clip(qi - kk, -MAX_REL, MAX_REL) + MAX_REL
    return rel_bias[:, idx]


def _chunk_attention(q, k, v, q_g, k_g, rel_bias):
    B, S = q.shape[0], q.shape[1]
    nc = S // CHUNK
    q = _rmsnorm(q, q_g).reshape(B, nc, CHUNK, ATT_HEADS, ATT_HEAD_DIM)
    k = _rmsnorm(k, k_g).reshape(B, nc, CHUNK, ATT_HEADS, ATT_HEAD_DIM)
    v = v.reshape(B, nc, CHUNK, ATT_HEADS, ATT_HEAD_DIM)
    pad = ((0, 0), (LEFT_CHUNKS, 0), (0, 0), (0, 0), (0, 0))
    kp, vp = jnp.pad(k, pad), jnp.pad(v, pad)
    k_band = jnp.concatenate([kp[:, i:i + nc] for i in range(BAND)], axis=2)
    v_band = jnp.concatenate([vp[:, i:i + nc] for i in range(BAND)], axis=2)
    scale = ATT_HEAD_DIM ** -0.5
    s = jnp.einsum('bcqhd,bckhd->bhcqk', q, k_band,
                   preferred_element_type=jnp.float32) * scale
    s = s + _rel_bias_band(rel_bias).astype(jnp.float32)[None, :, None]
    key_chunk = (jnp.arange(nc)[:, None] - LEFT_CHUNKS
                 + (jnp.arange(BAND * CHUNK)[None, :] // CHUNK))
    s = jnp.where((key_chunk >= 0)[None, None, :, None, :], s, NEG_INF)
    p = jax.nn.softmax(s, axis=-1).astype(v.dtype)
    o = jnp.einsum('bhcqk,bckhd->bcqhd', p, v_band)
    return o.reshape(B, S, D_ATT)


def _short_conv(bg, cg, xv, conv_w):
    S = xv.shape[1]
    u = jnp.pad(cg * xv, ((0, 0), (CONV_W - 1, 0), (0, 0)))
    conv = conv_w[0] * u[:, 0:S] + conv_w[1] * u[:, 1:S + 1] + conv_w[2] * u[:, 2:S + 2]
    return bg * conv


def _memory_xattn(h, mem, norm_mem_g, w_xq, w_xkv, xq_g, xk_g, w_xo):
    B, S, _ = h.shape
    hm = _rmsnorm(mem, norm_mem_g)
    q = (h @ w_xq).reshape(B, S, X_HEADS, X_HEAD_DIM)
    k, v = jnp.split(hm @ w_xkv, 2, axis=-1)
    k = k.reshape(B, N_MEM, X_HEADS, X_HEAD_DIM)
    v = v.reshape(B, N_MEM, X_HEADS, X_HEAD_DIM)
    q, k = _rmsnorm(q, xq_g), _rmsnorm(k, xk_g)
    s = jnp.einsum('bshd,bmhd->bhsm', q, k,
                   preferred_element_type=jnp.float32) * (X_HEAD_DIM ** -0.5)
    p = jax.nn.softmax(s, axis=-1).astype(v.dtype)
    o = jnp.einsum('bhsm,bmhd->bshd', p, v).reshape(B, S, D_X)
    return o @ w_xo


def _clamped_swiglu(gu):
    g = jnp.minimum(gu[..., ::2], SWIGLU_LIMIT)
    lin = jnp.clip(gu[..., 1::2], -SWIGLU_LIMIT, SWIGLU_LIMIT)
    return g * jax.nn.sigmoid(SWIGLU_ALPHA * g) * (lin + 1.0)


def _moe(h, w_router, b_router, w_gate_up, b_gate_up, w_down, b_down):
    B, S, D = h.shape
    n_tok = B * S
    hf = h.reshape(n_tok, D)
    logits = (hf @ w_router).astype(jnp.float32) + b_router.astype(jnp.float32)
    top_val, top_idx = lax.top_k(logits, TOP_K)
    gates = jax.nn.softmax(top_val, axis=-1)
    n_assign = n_tok * TOP_K
    expert_ids = top_idx.reshape(-1)
    token_ids = jnp.arange(n_assign, dtype=jnp.int32) // TOP_K
    order = jnp.argsort(expert_ids)
    sorted_e = expert_ids[order]
    sorted_tok = token_ids[order]
    sorted_gate = gates.reshape(-1)[order]
    counts = jnp.bincount(expert_ids, length=N_EXPERTS)
    padded = (counts + EXPERT_BLOCK - 1) // EXPERT_BLOCK * EXPERT_BLOCK
    start = jnp.cumsum(counts) - counts
    pend = jnp.cumsum(padded)
    pstart = pend - padded
    dest = pstart[sorted_e] + (jnp.arange(n_assign, dtype=jnp.int32) - start[sorted_e])
    n_pad = n_assign + N_EXPERTS * EXPERT_BLOCK
    n_blocks = n_pad // EXPERT_BLOCK
    tok_pad = jnp.zeros((n_pad,), jnp.int32).at[dest].set(sorted_tok)
    block_e = jnp.searchsorted(pend, jnp.arange(n_blocks) * EXPERT_BLOCK, side='right')
    block_e = jnp.minimum(block_e, N_EXPERTS - 1).astype(jnp.int32)

    def expert_block(args):
        tok, e = args
        xb = hf[tok]
        act = _clamped_swiglu(xb @ w_gate_up[e] + b_gate_up[e])
        return act @ w_down[e] + b_down[e]

    y_pad = lax.map(expert_block, (tok_pad.reshape(n_blocks, EXPERT_BLOCK), block_e))
    y_sorted = y_pad.reshape(n_pad, D)[dest].astype(jnp.float32)
    out = jnp.zeros((n_tok, D), jnp.float32).at[sorted_tok].add(sorted_gate[:, None] * y_sorted)
    return out.astype(h.dtype).reshape(B, S, D)


def setup_inputs(seed: int = 0) -> dict:
    key = jax.random.key(seed)
    ks = jax.random.split(key, 26)
    f32 = jnp.float32

    def nrm(k, shape, scale):
        return jax.random.normal(k, shape, f32) * scale

    def gain(k, shape):
        return 1.0 + 0.1 * jax.random.normal(k, shape, f32)

    L = DEPTH
    return {
        "x": nrm(ks[0], (BATCH, SEQ, D_MODEL), 1.0),
        "mem": nrm(ks[1], (BATCH, N_MEM, D_MODEL), 1.0),
        "norm_mix_g": gain(ks[2], (L, D_MODEL)),
        "w_in": nrm(ks[3], (L, D_MODEL, D_IN_PROJ), D_MODEL ** -0.5),
        "q_norm_g": gain(ks[4], (L, ATT_HEAD_DIM)),
        "k_norm_g": gain(ks[5], (L, ATT_HEAD_DIM)),
        "rel_bias": nrm(ks[6], (L, ATT_HEADS, N_REL), 0.5),
        "conv_w": nrm(ks[7], (L, CONV_W, D_CONV), 0.5),
        "out_norm_a_g": gain(ks[8], (L, D_ATT)),
        "out_norm_b_g": gain(ks[9], (L, D_CONV)),
        "w_out": nrm(ks[10], (L, D_MIX, D_MODEL), D_MIX ** -0.5),
        "norm_xattn_g": gain(ks[11], (L, D_MODEL)),
        "norm_mem_g": gain(ks[12], (L, D_MODEL)),
        "w_xq": nrm(ks[13], (L, D_MODEL, D_X), D_MODEL ** -0.5),
        "w_xkv": nrm(ks[14], (L, D_MODEL, 2 * D_X), D_MODEL ** -0.5),
        "xq_norm_g": gain(ks[15], (L, X_HEAD_DIM)),
        "xk_norm_g": gain(ks[16], (L, X_HEAD_DIM)),
        "w_xo": nrm(ks[17], (L, D_X, D_MODEL), D_X ** -0.5),
        "norm_ffn_g": gain(ks[18], (L, D_MODEL)),
        "w_router": nrm(ks[19], (L, D_MODEL, N_EXPERTS), D_MODEL ** -0.5),
        "b_router": nrm(ks[20], (L, N_EXPERTS), 0.01),
        "w_gate_up": nrm(ks[21], (L, N_EXPERTS, D_MODEL, 2 * D_FF), D_MODEL ** -0.5),
        "b_gate_up": nrm(ks[22], (L, N_EXPERTS, 2 * D_FF), 0.02),
        "w_down": nrm(ks[23], (L, N_EXPERTS, D_FF, D_MODEL), D_FF ** -0.5),
        "b_down": nrm(ks[24], (L, N_EXPERTS, D_MODEL), 0.02),
    }


def reference(x, mem, norm_mix_g, w_in, q_norm_g, k_norm_g, rel_bias, conv_w,
              out_norm_a_g, out_norm_b_g, w_out, norm_xattn_g, norm_mem_g,
              w_xq, w_xkv, xq_norm_g, xk_norm_g, w_xo, norm_ffn_g,
              w_router, b_router, w_gate_up, b_gate_up, w_down, b_down):
    B, S, _ = x.shape
    splits = [D_ATT, 2 * D_ATT, 3 * D_ATT, 3 * D_ATT + D_CONV, 3 * D_ATT + 2 * D_CONV]
    for l in range(DEPTH):
        h = _rmsnorm(x, norm_mix_g[l])
        proj = h @ w_in[l]
        q, k, v, bg, cg, xv = jnp.split(proj, splits, axis=-1)
        shp = (B, S, ATT_HEADS, ATT_HEAD_DIM)
        y_a = _chunk_attention(q.reshape(shp), k.reshape(shp), v.reshape(shp),
                               q_norm_g[l], k_norm_g[l], rel_bias[l])
        y_b = _short_conv(bg, cg, xv, conv_w[l])
        y = jnp.concatenate([_rmsnorm(y_a, out_norm_a_g[l]),
                             _rmsnorm(y_b, out_norm_b_g[l])], axis=-1)
        x = x + y @ w_out[l]
        x = x + _memory_xattn(_rmsnorm(x, norm_xattn_g[l]), mem, norm_mem_g[l],
                              w_xq[l], w_xkv[l], xq_norm_g[l], xk_norm_g[l], w_xo[l])
        x = x + _moe(_rmsnorm(x, norm_ffn_g[l]), w_router[l], b_router[l],
                     w_gate_up[l], b_gate_up[l], w_down[l], b_down[l])
    return x
```

```cpp
#include <hip/hip_runtime.h>
#include <stdint.h>
#include <stdio.h>

typedef unsigned short bf16_t;
typedef short bf16x8 __attribute__((ext_vector_type(8)));
typedef float f32x4 __attribute__((ext_vector_type(4)));

constexpr int DM = 1024, BATCH = 16, SEQ = 2048, MTOK = BATCH * SEQ;
constexpr int CHUNK = 64, LEFT = 8, NMEM = 256, MMEM = BATCH * NMEM;
constexpr int DATT = 512, DCONV = 512, NPROJ = 3072;
constexpr int XH = 4, XHD = 128, DX = 512;
constexpr int NE = 32, TOPK = 4, DFF = 1024;
constexpr int NREL = 513, MAXREL = 256;
constexpr int NASSIGN = MTOK * TOPK;
constexpr int MAXSLOT = NASSIGN + NE * 256;
constexpr float EPS = 1e-6f;

constexpr size_t MiB = 1u << 20;
constexpr size_t WS_CTL = 0;
constexpr size_t WS_WIN = 1 * MiB, WS_WOUT = 7 * MiB, WS_WXQ = 9 * MiB, WS_WXKV = 10 * MiB, WS_WXO = 12 * MiB, WS_WGU = 13 * MiB, WS_WDN = 141 * MiB;
constexpr size_t WS_HB = 205 * MiB, WS_HMB = 269 * MiB;
constexpr size_t WS_LIST = 277 * MiB, WS_GATE = 281 * MiB, WS_SLOTTK = 282 * MiB, WS_SLOTSRC = 283 * MiB, WS_BLKE = 284 * MiB;
constexpr size_t WS_PROJ = 285 * MiB, WS_KVMEM = 477 * MiB, WS_YA = 485 * MiB, WS_YB = 549 * MiB, WS_X1 = 613 * MiB, WS_QX = 741 * MiB, WS_OX = 773 * MiB;
constexpr size_t WS_ACT = 285 * MiB, WS_YBUF = 557 * MiB, WS_END = 813 * MiB;
constexpr int CW_CNT = 0, CW_NBLK = 64, CW_PSTART = 128;

__device__ __forceinline__ unsigned f2bf(float f) { unsigned u = __builtin_bit_cast(unsigned, f); return (u + 0x7fffu + ((u >> 16) & 1u)) >> 16; }
__device__ __forceinline__ float bf2f(bf16_t b) { return __builtin_bit_cast(float, ((unsigned)b) << 16); }
__device__ __forceinline__ float wave_sum(float v) {
#pragma unroll
    for (int o = 1; o < 64; o <<= 1) v += __shfl_xor(v, o);
    return v;
}

__global__ __launch_bounds__(256) void k_transpose(const float* __restrict__ W, bf16_t* __restrict__ Wt, int K, int N) {
    __shared__ float t[32][33];
    const size_t boff = (size_t)blockIdx.z * K * N;
    const int k0 = blockIdx.y * 32, n0 = blockIdx.x * 32, tx = threadIdx.x & 31, ty = threadIdx.x >> 5;
#pragma unroll
    for (int i = 0; i < 4; ++i) t[ty + 8 * i][tx] = W[boff + (size_t)(k0 + ty + 8 * i) * N + n0 + tx];
    __syncthreads();
#pragma unroll
    for (int i = 0; i < 4; ++i) Wt[boff + (size_t)(n0 + ty + 8 * i) * K + k0 + tx] = (bf16_t)f2bf(t[tx][ty + 8 * i]);
}

__global__ __launch_bounds__(256) void k_rmsnorm(const float* __restrict__ x, const float* __restrict__ g, bf16_t* __restrict__ out, int M) {
    const int row = blockIdx.x * 4 + (threadIdx.x >> 6), lane = threadIdx.x & 63;
    if (row >= M) return;
    const f32x4* xr = (const f32x4*)(x + (size_t)row * DM) + lane;
    f32x4 v[4]; float s = 0.f;
#pragma unroll
    for (int j = 0; j < 4; ++j) { v[j] = xr[64 * j]; s += v[j].x * v[j].x + v[j].y * v[j].y + v[j].z * v[j].z + v[j].w * v[j].w; }
    const float rstd = 1.0f / sqrtf(wave_sum(s) * (1.0f / DM) + EPS);
    const f32x4* gr = (const f32x4*)g + lane;
    unsigned long long* o8 = (unsigned long long*)(out + (size_t)row * DM) + lane;
#pragma unroll
    for (int j = 0; j < 4; ++j) { const f32x4 gg = gr[64 * j];
        const unsigned lo = f2bf(v[j].x * rstd * gg.x) | (f2bf(v[j].y * rstd * gg.y) << 16), hi = f2bf(v[j].z * rstd * gg.z) | (f2bf(v[j].w * rstd * gg.w) << 16);
        o8[64 * j] = (unsigned long long)lo | ((unsigned long long)hi << 32); }
}

template <class Epi>
__global__ __launch_bounds__(256) void k_gemm(const bf16_t* __restrict__ A, const int* __restrict__ arow,
                                              const bf16_t* __restrict__ Bt, size_t b_estride, const int* __restrict__ blk_e, const unsigned* __restrict__ nblk256,
                                              int lda, int K, Epi E) {
    __shared__ __attribute__((aligned(16))) bf16_t As[128][40];
    __shared__ __attribute__((aligned(16))) bf16_t Bs[128][40];
    const int tid = threadIdx.x, lane = tid & 63, wid = tid >> 6, wm = wid >> 1, wn = wid & 1;
    const int row0 = blockIdx.y * 128, col0 = blockIdx.x * 128;
    if (nblk256 && row0 >= (int)(*nblk256) * 256) return;
    const int e = blk_e ? blk_e[row0 >> 8] : 0;
    const bf16_t* Bte = Bt + (size_t)e * b_estride;
    const int lr0 = tid >> 2, lr1 = (tid + 256) >> 2, lc = (tid & 3) * 8;
    const int sr0 = arow ? arow[row0 + lr0] : row0 + lr0, sr1 = arow ? arow[row0 + lr1] : row0 + lr1;
    const bf16_t* ap0 = A + (size_t)sr0 * lda + lc; const bf16_t* ap1 = A + (size_t)sr1 * lda + lc;
    const bf16_t* bp0 = Bte + (size_t)(col0 + lr0) * K + lc; const bf16_t* bp1 = Bte + (size_t)(col0 + lr1) * K + lc;
    f32x4 acc[4][4];
#pragma unroll
    for (int i = 0; i < 4; ++i)
#pragma unroll
        for (int j = 0; j < 4; ++j) acc[i][j] = (f32x4){0.f, 0.f, 0.f, 0.f};
    for (int k0 = 0; k0 < K; k0 += 32) {
        const uint4 va0 = *(const uint4*)(ap0 + k0), va1 = *(const uint4*)(ap1 + k0), vb0 = *(const uint4*)(bp0 + k0), vb1 = *(const uint4*)(bp1 + k0);
        __syncthreads();
        *(uint4*)&As[lr0][lc] = va0; *(uint4*)&As[lr1][lc] = va1; *(uint4*)&Bs[lr0][lc] = vb0; *(uint4*)&Bs[lr1][lc] = vb1;
        __syncthreads();
        bf16x8 af[4], bfr[4];
#pragma unroll
        for (int i = 0; i < 4; ++i) af[i] = *(const bf16x8*)&As[wm * 64 + i * 16 + (lane & 15)][8 * (lane >> 4)];
#pragma unroll
        for (int j = 0; j < 4; ++j) bfr[j] = *(const bf16x8*)&Bs[wn * 64 + j * 16 + (lane & 15)][8 * (lane >> 4)];
#pragma unroll
        for (int i = 0; i < 4; ++i)
#pragma unroll
            for (int j = 0; j < 4; ++j) acc[i][j] = __builtin_amdgcn_mfma_f32_16x16x32_bf16(af[i], bfr[j], acc[i][j], 0, 0, 0);
    }
#pragma unroll
    for (int i = 0; i < 4; ++i)
#pragma unroll
        for (int j = 0; j < 4; ++j)
#pragma unroll
            for (int r = 0; r < 4; ++r) E(row0 + wm * 64 + i * 16 + 4 * (lane >> 4) + r, col0 + wn * 64 + j * 16 + (lane & 15), acc[i][j][r], e);
}

struct EpiStoreBf16 { bf16_t* O; int ldo; int pad;
    __device__ __forceinline__ void operator()(int row, int col, float v, int) const { O[(size_t)row * ldo + col] = (bf16_t)f2bf(v); } };
struct EpiResF32 { const float* base; float* O; int ldo; int pad;
    __device__ __forceinline__ void operator()(int row, int col, float v, int) const { const size_t i = (size_t)row * ldo + col; O[i] = base[i] + v; } };
struct EpiSwiglu { bf16_t* act; const float* bias;
    __device__ __forceinline__ void operator()(int row, int col, float v, int e) const {
        v += bias[(size_t)e * 2 * DFF + col];
        const float o = __shfl_xor(v, 1);
        if ((col & 1) == 0) { const float g = fminf(v, 7.0f), lin = fminf(fmaxf(o, -7.0f), 7.0f);
            const float a = g * (1.0f / (1.0f + __expf(-1.702f * g))) * (lin + 1.0f);
            act[(size_t)row * DFF + (col >> 1)] = (bf16_t)f2bf(a); } } };
struct EpiDown { bf16_t* ybuf; const float* bias; const int* slot_tk; const float* gate;
    __device__ __forceinline__ void operator()(int row, int col, float v, int e) const {
        const int tk = slot_tk[row];
        if (tk >= 0) ybuf[(size_t)tk * DM + col] = (bf16_t)f2bf(gate[tk] * (v + bias[(size_t)e * DM + col])); } };

template <int HD>
__global__ __launch_bounds__(256) void k_headnorm(bf16_t* __restrict__ p, const float* __restrict__ g, int ld, int M, int nheads, float scale) {
    const long item = (long)blockIdx.x * 4 + (threadIdx.x >> 6); const int lane = threadIdx.x & 63;
    if (item >= (long)M * nheads) return;
    const int row = (int)(item / nheads), h = (int)(item % nheads);
    bf16_t* q = p + (size_t)row * ld + h * HD;
    constexpr int PER = HD / 64;
    float v[PER]; float s = 0.f;
#pragma unroll
    for (int j = 0; j < PER; ++j) { v[j] = bf2f(q[lane * PER + j]); s += v[j] * v[j]; }
    const float rstd = 1.0f / sqrtf(wave_sum(s) * (1.0f / HD) + EPS);
#pragma unroll
    for (int j = 0; j < PER; ++j) q[lane * PER + j] = (bf16_t)f2bf(v[j] * rstd * g[lane * PER + j] * scale);
}

__global__ __launch_bounds__(64) void k_chunk_attn(const bf16_t* __restrict__ proj, const float* __restrict__ rel_bias, float* __restrict__ ya) {
    __shared__ float Ks[64][65];
    __shared__ float Vs[64][65];
    const int c = blockIdx.x, h = blockIdx.y, b = blockIdx.z, t = threadIdx.x;
    const size_t rowq = (size_t)b * SEQ + c * CHUNK + t;
    float q[64], o[64];
    { const bf16_t* qp = proj + rowq * NPROJ + h * 64;
#pragma unroll
      for (int d = 0; d < 64; ++d) { q[d] = bf2f(qp[d]); o[d] = 0.f; } }
    float m = -1e30f, l = 0.f;
    const float* rb = rel_bias + (size_t)h * NREL;
    const int kc0 = c - LEFT < 0 ? 0 : c - LEFT;
    for (int kc = kc0; kc <= c; ++kc) {
        __syncthreads();
        { const size_t rowk = (size_t)b * SEQ + kc * CHUNK + t;
          const bf16_t* kp = proj + rowk * NPROJ + DATT + h * 64; const bf16_t* vp = proj + rowk * NPROJ + 2 * DATT + h * 64;
#pragma unroll
          for (int d = 0; d < 64; ++d) { Ks[t][d] = bf2f(kp[d]); Vs[t][d] = bf2f(vp[d]); } }
        __syncthreads();
        for (int j = 0; j < 64; ++j) {
            float s = 0.f;
#pragma unroll
            for (int d = 0; d < 64; ++d) s += q[d] * Ks[j][d];
            int rel = (c * CHUNK + t) - (kc * CHUNK + j); rel = rel < -MAXREL ? -MAXREL : (rel > MAXREL ? MAXREL : rel);
            s += rb[rel + MAXREL];
            const float mn = fmaxf(m, s), f = __expf(m - mn), p = __expf(s - mn);
            l = l * f + p; m = mn;
#pragma unroll
            for (int d = 0; d < 64; ++d) o[d] = o[d] * f + p * Vs[j][d];
        }
    }
    const float il = 1.0f / l;
    float* op = ya + rowq * DATT + h * 64;
#pragma unroll
    for (int d = 0; d < 64; ++d) op[d] = o[d] * il;
}

__global__ __launch_bounds__(256) void k_conv_norm(const bf16_t* __restrict__ proj, const float* __restrict__ ya, const float* __restrict__ conv_w,
                                                   const float* __restrict__ ga, const float* __restrict__ gb, bf16_t* __restrict__ yb) {
    const int row = blockIdx.x * 4 + (threadIdx.x >> 6), lane = threadIdx.x & 63;
    const int s = row % SEQ;
    float a[8], cv[8]; float sa = 0.f, sb = 0.f;
    const float* yap = ya + (size_t)row * DATT + lane * 8;
#pragma unroll
    for (int j = 0; j < 8; ++j) { a[j] = yap[j]; sa += a[j] * a[j]; }
#pragma unroll
    for (int j = 0; j < 8; ++j) {
        const int ch = lane * 8 + j; float acc = 0.f;
#pragma unroll
        for (int tap = 0; tap < 3; ++tap) { const int ds = 2 - tap;
            if (s - ds >= 0) { const bf16_t* pr = proj + (size_t)(row - ds) * NPROJ;
                const float u = bf2f(pr[3 * DATT + DCONV + ch]) * bf2f(pr[3 * DATT + 2 * DCONV + ch]);
                acc += conv_w[tap * DCONV + ch] * u; } }
        cv[j] = bf2f(proj[(size_t)row * NPROJ + 3 * DATT + ch]) * acc; sb += cv[j] * cv[j];
    }
    const float ra = 1.0f / sqrtf(wave_sum(sa) * (1.0f / DATT) + EPS), rb = 1.0f / sqrtf(wave_sum(sb) * (1.0f / DCONV) + EPS);
    bf16_t* o = yb + (size_t)row * DM;
#pragma unroll
    for (int j = 0; j < 8; ++j) { const int ch = lane * 8 + j; o[ch] = (bf16_t)f2bf(a[j] * ra * ga[ch]); o[DATT + ch] = (bf16_t)f2bf(cv[j] * rb * gb[ch]); }
}

__global__ __launch_bounds__(64) void k_xattn(const bf16_t* __restrict__ qx, const bf16_t* __restrict__ kvmem, bf16_t* __restrict__ ox) {
    __shared__ float Ks[32][129];
    __shared__ float Vs[32][129];
    const int qt = blockIdx.x, h = blockIdx.y, b = blockIdx.z, t = threadIdx.x, qi = t & 31, half = t >> 5;
    const size_t rowq = (size_t)b * SEQ + qt * 32 + qi;
    float q[64], o[64];
    { const bf16_t* qp = qx + rowq * DX + h * XHD + half * 64;
#pragma unroll
      for (int d = 0; d < 64; ++d) { q[d] = bf2f(qp[d]); o[d] = 0.f; } }
    float m = -1e30f, l = 0.f;
    for (int kt = 0; kt < NMEM / 32; ++kt) {
        __syncthreads();
        { const size_t rowk = (size_t)b * NMEM + kt * 32 + qi;
          const bf16_t* kp = kvmem + rowk * (2 * DX) + h * XHD + half * 64; const bf16_t* vp = kvmem + rowk * (2 * DX) + DX + h * XHD + half * 64;
#pragma unroll
          for (int d = 0; d < 64; ++d) { Ks[qi][half * 64 + d] = bf2f(kp[d]); Vs[qi][half * 64 + d] = bf2f(vp[d]); } }
        __syncthreads();
        for (int j = 0; j < 32; ++j) {
            float s = 0.f;
#pragma unroll
            for (int d = 0; d < 64; ++d) s += q[d] * Ks[j][half * 64 + d];
            s += __shfl_xor(s, 32);
            const float mn = fmaxf(m, s), f = __expf(m - mn), p = __expf(s - mn);
            l = l * f + p; m = mn;
#pragma unroll
            for (int d = 0; d < 64; ++d) o[d] = o[d] * f + p * Vs[j][half * 64 + d];
        }
    }
    const float il = 1.0f / l;
    bf16_t* op = ox + rowq * DX + h * XHD + half * 64;
#pragma unroll
    for (int d = 0; d < 64; ++d) op[d] = (bf16_t)f2bf(o[d] * il);
}

__global__ __launch_bounds__(256) void k_route(const float* __restrict__ x2, const float* __restrict__ g, const float* __restrict__ wr, const float* __restrict__ br,
                                               unsigned* __restrict__ cnt, int* __restrict__ list, float* __restrict__ gate) {
    __shared__ float xs[4][DM];
    const int w = threadIdx.x >> 6, lane = threadIdx.x & 63, tok = blockIdx.x * 4 + w;
    { const f32x4* xr = (const f32x4*)(x2 + (size_t)tok * DM) + lane; const f32x4* gr = (const f32x4*)g + lane;
      f32x4 v[4]; float s = 0.f;
#pragma unroll
      for (int j = 0; j < 4; ++j) { v[j] = xr[64 * j]; s += v[j].x * v[j].x + v[j].y * v[j].y + v[j].z * v[j].z + v[j].w * v[j].w; }
      const float rstd = 1.0f / sqrtf(wave_sum(s) * (1.0f / DM) + EPS);
#pragma unroll
      for (int j = 0; j < 4; ++j) { const f32x4 gg = gr[64 * j]; float* d = &xs[w][(lane + 64 * j) * 4];
          d[0] = v[j].x * rstd * gg.x; d[1] = v[j].y * rstd * gg.y; d[2] = v[j].z * rstd * gg.z; d[3] = v[j].w * rstd * gg.w; } }
    __syncthreads();
    const int e = lane & 31, half = lane >> 5;
    float s = 0.f;
    for (int k = half * 512; k < half * 512 + 512; ++k) s += xs[w][k] * wr[(size_t)k * NE + e];
    s += __shfl_xor(s, 32);
    float logit = s + br[e];
    float tv[4]; int ti[4];
#pragma unroll
    for (int r = 0; r < 4; ++r) {
        float bv = logit; int bi = e;
#pragma unroll
        for (int o = 1; o < 32; o <<= 1) { const float ov = __shfl_xor(bv, o); const int oi = __shfl_xor(bi, o);
            if (ov > bv || (ov == bv && oi < bi)) { bv = ov; bi = oi; } }
        tv[r] = bv; ti[r] = bi; if (e == bi) logit = -3.0e38f;
    }
    const float e1 = __expf(tv[1] - tv[0]), e2 = __expf(tv[2] - tv[0]), e3 = __expf(tv[3] - tv[0]); const float inv = 1.0f / (1.0f + e1 + e2 + e3);
    if (lane < 4) { const int ek = lane == 0 ? ti[0] : lane == 1 ? ti[1] : lane == 2 ? ti[2] : ti[3];
        const float gk = (lane == 0 ? 1.0f : lane == 1 ? e1 : lane == 2 ? e2 : e3) * inv;
        const unsigned pos = atomicAdd(&cnt[ek], 1u);
        list[(size_t)ek * MTOK + pos] = tok * 4 + lane; gate[tok * 4 + lane] = gk; }
}
__global__ __launch_bounds__(64) void k_plan(unsigned* __restrict__ ctl, int* __restrict__ blk_e) {
    const int lane = threadIdx.x; const unsigned c = lane < NE ? ctl[CW_CNT + lane] : 0u; const unsigned nb = (c + 255u) >> 8;
    unsigned inc = nb;
#pragma unroll
    for (int o = 1; o < 64; o <<= 1) { const unsigned t = __shfl_up(inc, o); if (lane >= o) inc += t; }
    const unsigned start = inc - nb;
    if (lane < NE) { ctl[CW_PSTART + lane] = start; for (unsigned b = 0; b < nb; ++b) blk_e[start + b] = lane; }
    if (lane == 63) ctl[CW_NBLK] = inc;
}
__global__ __launch_bounds__(256) void k_fill(const unsigned* __restrict__ ctl, const int* __restrict__ list, int* __restrict__ slot_tk, int* __restrict__ slot_src) {
    const int e = blockIdx.y, j = blockIdx.x * 256 + threadIdx.x; const unsigned c = ctl[CW_CNT + e], nb = (c + 255u) >> 8, start = ctl[CW_PSTART + e];
    if ((unsigned)j >= nb * 256u) return;
    const int tk = (unsigned)j < c ? list[(size_t)e * MTOK + j] : -1;
    slot_tk[start * 256 + j] = tk; slot_src[start * 256 + j] = tk >= 0 ? (tk >> 2) : 0;
}
__global__ __launch_bounds__(256) void k_combine(float* __restrict__ out, const bf16_t* __restrict__ ybuf) {
    const size_t i = ((size_t)blockIdx.x * 256 + threadIdx.x) * 4;
    const size_t tok = i / DM, col = i % DM;
    f32x4 v = *(const f32x4*)(out + i);
#pragma unroll
    for (int k = 0; k < 4; ++k) { const uint2 y = *(const uint2*)(ybuf + (tok * 4 + k) * DM + col);
        v.x += bf2f((bf16_t)(y.x & 0xffff)); v.y += bf2f((bf16_t)(y.x >> 16)); v.z += bf2f((bf16_t)(y.y & 0xffff)); v.w += bf2f((bf16_t)(y.y >> 16)); }
    *(f32x4*)(out + i) = v;
}

extern "C" void kernel_launch(void* const* d_in, const int* in_sizes, int n_in, void* d_out, int out_size, void* d_ws, size_t ws_size, hipStream_t stream) {
    if (n_in != 25 || ws_size < WS_END || out_size != MTOK * DM) { fprintf(stderr, "kernel_launch: unexpected problem (n_in %d ws %zu out %d)\n", n_in, ws_size, out_size); return; }
    const float* x = (const float*)d_in[0]; const float* mem = (const float*)d_in[1]; const float* norm_mix_g = (const float*)d_in[2]; const float* w_in = (const float*)d_in[3];
    const float* q_norm_g = (const float*)d_in[4]; const float* k_norm_g = (const float*)d_in[5]; const float* rel_bias = (const float*)d_in[6]; const float* conv_w = (const float*)d_in[7];
    const float* out_norm_a_g = (const float*)d_in[8]; const float* out_norm_b_g = (const float*)d_in[9]; const float* w_out = (const float*)d_in[10]; const float* norm_xattn_g = (const float*)d_in[11];
    const float* norm_mem_g = (const float*)d_in[12]; const float* w_xq = (const float*)d_in[13]; const float* w_xkv = (const float*)d_in[14]; const float* xq_norm_g = (const float*)d_in[15];
    const float* xk_norm_g = (const float*)d_in[16]; const float* w_xo = (const float*)d_in[17]; const float* norm_ffn_g = (const float*)d_in[18]; const float* w_router = (const float*)d_in[19];
    const float* b_router = (const float*)d_in[20]; const float* w_gate_up = (const float*)d_in[21]; const float* b_gate_up = (const float*)d_in[22]; const float* w_down = (const float*)d_in[23];
    const float* b_down = (const float*)d_in[24];
    unsigned char* ws = (unsigned char*)d_ws; float* out = (float*)d_out;
    unsigned* ctl = (unsigned*)(ws + WS_CTL);
    bf16_t *Win = (bf16_t*)(ws + WS_WIN), *Wout = (bf16_t*)(ws + WS_WOUT), *Wxq = (bf16_t*)(ws + WS_WXQ), *Wxkv = (bf16_t*)(ws + WS_WXKV), *Wxo = (bf16_t*)(ws + WS_WXO), *Wgu = (bf16_t*)(ws + WS_WGU), *Wdn = (bf16_t*)(ws + WS_WDN);
    bf16_t *hb = (bf16_t*)(ws + WS_HB), *hmb = (bf16_t*)(ws + WS_HMB), *proj = (bf16_t*)(ws + WS_PROJ), *kvmem = (bf16_t*)(ws + WS_KVMEM), *yb = (bf16_t*)(ws + WS_YB), *qx = (bf16_t*)(ws + WS_QX), *ox = (bf16_t*)(ws + WS_OX);
    bf16_t *act = (bf16_t*)(ws + WS_ACT), *ybuf = (bf16_t*)(ws + WS_YBUF);
    float *ya = (float*)(ws + WS_YA), *x1 = (float*)(ws + WS_X1), *gate = (float*)(ws + WS_GATE);
    int *list = (int*)(ws + WS_LIST), *slot_tk = (int*)(ws + WS_SLOTTK), *slot_src = (int*)(ws + WS_SLOTSRC), *blk_e = (int*)(ws + WS_BLKE);

    (void)hipMemsetAsync(ctl, 0, 4096, stream);
    hipLaunchKernelGGL(k_transpose, dim3(NPROJ / 32, DM / 32, 1), dim3(256), 0, stream, w_in, Win, DM, NPROJ);
    hipLaunchKernelGGL(k_transpose, dim3(DM / 32, DM / 32, 1), dim3(256), 0, stream, w_out, Wout, DM, DM);
    hipLaunchKernelGGL(k_transpose, dim3(DX / 32, DM / 32, 1), dim3(256), 0, stream, w_xq, Wxq, DM, DX);
    hipLaunchKernelGGL(k_transpose, dim3(2 * DX / 32, DM / 32, 1), dim3(256), 0, stream, w_xkv, Wxkv, DM, 2 * DX);
    hipLaunchKernelGGL(k_transpose, dim3(DM / 32, DX / 32, 1), dim3(256), 0, stream, w_xo, Wxo, DX, DM);
    hipLaunchKernelGGL(k_transpose, dim3(2 * DFF / 32, DM / 32, NE), dim3(256), 0, stream, w_gate_up, Wgu, DM, 2 * DFF);
    hipLaunchKernelGGL(k_transpose, dim3(DM / 32, DFF / 32, NE), dim3(256), 0, stream, w_down, Wdn, DFF, DM);
    hipLaunchKernelGGL(k_rmsnorm, dim3(MTOK / 4), dim3(256), 0, stream, x, norm_mix_g, hb, MTOK);
    hipLaunchKernelGGL(k_rmsnorm, dim3(MMEM / 4), dim3(256), 0, stream, mem, norm_mem_g, hmb, MMEM);
    hipLaunchKernelGGL((k_gemm<EpiStoreBf16>), dim3(NPROJ / 128, MTOK / 128), dim3(256), 0, stream, (const bf16_t*)hb, (const int*)nullptr, (const bf16_t*)Win, (size_t)0, (const int*)nullptr, (const unsigned*)nullptr, DM, DM, EpiStoreBf16{proj, NPROJ, 0});
    hipLaunchKernelGGL((k_gemm<EpiStoreBf16>), dim3(2 * DX / 128, MMEM / 128), dim3(256), 0, stream, (const bf16_t*)hmb, (const int*)nullptr, (const bf16_t*)Wxkv, (size_t)0, (const int*)nullptr, (const unsigned*)nullptr, DM, DM, EpiStoreBf16{kvmem, 2 * DX, 0});
    hipLaunchKernelGGL((k_headnorm<64>), dim3(MTOK * 8 / 4), dim3(256), 0, stream, proj, q_norm_g, NPROJ, MTOK, 8, 0.125f);
    hipLaunchKernelGGL((k_headnorm<64>), dim3(MTOK * 8 / 4), dim3(256), 0, stream, proj + DATT, k_norm_g, NPROJ, MTOK, 8, 1.0f);
    hipLaunchKernelGGL((k_headnorm<128>), dim3(MMEM * 4 / 4), dim3(256), 0, stream, kvmem, xk_norm_g, 2 * DX, MMEM, 4, 1.0f);
    hipLaunchKernelGGL(k_chunk_attn, dim3(SEQ / CHUNK, 8, BATCH), dim3(64), 0, stream, (const bf16_t*)proj, rel_bias, ya);
    hipLaunchKernelGGL(k_conv_norm, dim3(MTOK / 4), dim3(256), 0, stream, (const bf16_t*)proj, (const float*)ya, conv_w, out_norm_a_g, out_norm_b_g, yb);
    hipLaunchKernelGGL((k_gemm<EpiResF32>), dim3(DM / 128, MTOK / 128), dim3(256), 0, stream, (const bf16_t*)yb, (const int*)nullptr, (const bf16_t*)Wout, (size_t)0, (const int*)nullptr, (const unsigned*)nullptr, DM, DM, EpiResF32{x, x1, DM, 0});
    hipLaunchKernelGGL(k_rmsnorm, dim3(MTOK / 4), dim3(256), 0, stream, (const float*)x1, norm_xattn_g, hb, MTOK);
    hipLaunchKernelGGL((k_gemm<EpiStoreBf16>), dim3(DX / 128, MTOK / 128), dim3(256), 0, stream, (const bf16_t*)hb, (const int*)nullptr, (const bf16_t*)Wxq, (size_t)0, (const int*)nullptr, (const unsigned*)nullptr, DM, DM, EpiStoreBf16{qx, DX, 0});
    hipLaunchKernelGGL((k_headnorm<128>), dim3(MTOK * 4 / 4), dim3(256), 0, stream, qx, xq_norm_g, DX, MTOK, 4, 0.08838834764831845f);
    hipLaunchKernelGGL(k_xattn, dim3(SEQ / 32, XH, BATCH), dim3(64), 0, stream, (const bf16_t*)qx, (const bf16_t*)kvmem, ox);
    hipLaunchKernelGGL((k_gemm<EpiResF32>), dim3(DM / 128, MTOK / 128), dim3(256), 0, stream, (const bf16_t*)ox, (const int*)nullptr, (const bf16_t*)Wxo, (size_t)0, (const int*)nullptr, (const unsigned*)nullptr, DX, DX, EpiResF32{x1, out, DM, 0});
    hipLaunchKernelGGL(k_rmsnorm, dim3(MTOK / 4), dim3(256), 0, stream, (const float*)out, norm_ffn_g, hb, MTOK);
    hipLaunchKernelGGL(k_route, dim3(MTOK / 4), dim3(256), 0, stream, (const float*)out, norm_ffn_g, w_router, b_router, ctl + CW_CNT, list, gate);
    hipLaunchKernelGGL(k_plan, dim3(1), dim3(64), 0, stream, ctl, blk_e);
    hipLaunchKernelGGL(k_fill, dim3(MTOK / 256, NE), dim3(256), 0, stream, (const unsigned*)ctl, (const int*)list, slot_tk, slot_src);
    hipLaunchKernelGGL((k_gemm<EpiSwiglu>), dim3(2 * DFF / 128, MAXSLOT / 128), dim3(256), 0, stream, (const bf16_t*)hb, (const int*)slot_src, (const bf16_t*)Wgu, (size_t)2 * DFF * DM, (const int*)blk_e, (const unsigned*)(ctl + CW_NBLK), DM, DM, EpiSwiglu{act, b_gate_up});
    hipLaunchKernelGGL((k_gemm<EpiDown>), dim3(DM / 128, MAXSLOT / 128), dim3(256), 0, stream, (const bf16_t*)act, (const int*)nullptr, (const bf16_t*)Wdn, (size_t)DM * DFF, (const int*)blk_e, (const unsigned*)(ctl + CW_NBLK), DFF, DFF, EpiDown{ybuf, b_down, slot_tk, gate});
    hipLaunchKernelGGL(k_combine, dim3(MTOK * DM / 4 / 256), dim3(256), 0, stream, out, (const bf16_t*)ybuf);
}
```

```cpp
#include <hip/hip_runtime.h>
#include <stdint.h>
#include <stdio.h>

#define LAS __attribute__((address_space(3)))
#define GAS __attribute__((address_space(1)))
typedef unsigned short bf16_t;
typedef short bf16x8 __attribute__((ext_vector_type(8)));
typedef float f32x4 __attribute__((ext_vector_type(4)));
typedef float f32x16 __attribute__((ext_vector_type(16)));
typedef unsigned u32x4 __attribute__((ext_vector_type(4)));
typedef unsigned u32x2 __attribute__((ext_vector_type(2)));

constexpr int DM = 1024, BATCH = 16, SEQ = 2048, MTOK = BATCH * SEQ;
constexpr int CHUNK = 64, LEFT = 8, NMEM = 256, MMEM = BATCH * NMEM;
constexpr int DATT = 512, DCONV = 512, NPROJ = 3072;
constexpr int XH = 4, XHD = 128, DX = 512;
constexpr int NE = 32, TOPK = 4, DFF = 1024;
constexpr int NREL = 513, MAXREL = 256;
constexpr int NASSIGN = MTOK * TOPK;
constexpr int MAXSLOT = NASSIGN + NE * 256;
constexpr float EPS = 1e-6f;
constexpr float LOG2E = 1.4426950408889634f;

constexpr size_t MiB = 1u << 20;
constexpr size_t WS_CTL = 0, CTL_ZERO_BYTES = 256 * 1024;
constexpr size_t WS_WIN = 1 * MiB, WS_WOUT = 7 * MiB, WS_WXQ = 9 * MiB, WS_WXKV = 10 * MiB, WS_WXO = 12 * MiB, WS_WGU = 13 * MiB, WS_WDN = 141 * MiB;
constexpr size_t WS_HB = 205 * MiB, WS_HMB = 269 * MiB;
constexpr size_t WS_LIST = 277 * MiB, WS_GATE = 281 * MiB, WS_SLOTTK = 282 * MiB, WS_SLOTSRC = 283 * MiB, WS_BLKE = 284 * MiB;
constexpr size_t WS_PROJ = 285 * MiB, WS_KVMEM = 477 * MiB, WS_YA = 485 * MiB, WS_YB = 549 * MiB, WS_X1 = 613 * MiB, WS_QX = 741 * MiB, WS_OX = 773 * MiB;
constexpr size_t WS_ACT = 285 * MiB, WS_YBUF = 557 * MiB;
constexpr size_t WS_SQ1 = 813 * MiB, WS_SQ2 = 815 * MiB, WS_RSTD2 = 817 * MiB, WS_WRT = 818 * MiB, WS_END = 819 * MiB;
constexpr int CW_CNT = 0, CW_NBLK = 64, CW_PSTART = 128;
constexpr int CW_BAR = 4096;

__device__ __forceinline__ unsigned f2bf(float f) { unsigned u = __builtin_bit_cast(unsigned, f); return (u + 0x7fffu + ((u >> 16) & 1u)) >> 16; }
__device__ __forceinline__ float bf2f(bf16_t b) { return __builtin_bit_cast(float, ((unsigned)b) << 16); }
__device__ __forceinline__ unsigned pk2(float lo, float hi) { return f2bf(lo) | (f2bf(hi) << 16); }
__device__ __forceinline__ float bflo(unsigned w) { return __builtin_bit_cast(float, w << 16); }
__device__ __forceinline__ float bfhi(unsigned w) { return __builtin_bit_cast(float, w & 0xffff0000u); }
__device__ __forceinline__ float wave_sum(float v) {
#pragma unroll
    for (int o = 1; o < 64; o <<= 1) v += __shfl_xor(v, o);
    return v;
}
__device__ __forceinline__ unsigned cvt_pk_bf16(float lo, float hi) { unsigned r; asm volatile("v_cvt_pk_bf16_f32 %0, %1, %2" : "=v"(r) : "v"(lo), "v"(hi)); return r; }

namespace pg8 {
constexpr int BM = 256, BK = 64, HALF = 128, HTB = HALF * BK * 2  , STAGE_BYTES = 8 * HTB, NXCD = 8, WGM = 8;
__host__ __device__ __forceinline__ int lds_byte(int r, int c) { const int st = (r >> 4) * 2 + (c >> 5), rr = r & 15, cc = c & 31, ob = rr * 64 + cc * 2; return st * 1024 + (ob ^ (((ob >> 9) & 1) << 5)); }
__host__ __device__ __forceinline__ void stage_rc(int b, int& R, int& C) { const int st = b / 1024, sb = b % 1024, swz = sb ^ (((sb >> 9) & 1) << 5); R = (st >> 1) * 16 + swz / 64; C = (st & 1) * 32 + (swz % 64) / 2; }
__host__ __device__ __forceinline__ int perm32(int rho) { const int n = rho >> 4, i = rho & 15; return 8 * (i >> 2) + 4 * n + (i & 3); }

struct Unit { int pm, pn, e, rbl; };

__device__ __forceinline__ bool static_order(int nM, int nN, int G, int c, int i, int& pm, int& pn) {
    const int nwg = nM * nN; const long L = (long)i * G + c; if (L >= nwg) return false;
    int wgid = (int)L; { const int q = nwg / NXCD, r = nwg % NXCD, xcd = wgid % NXCD, off = wgid / NXCD; wgid = (xcd < r ? xcd * (q + 1) : r * (q + 1) + (xcd - r) * q) + off; }
    const int nig = WGM * nN, gid = wgid / nig, fm = gid * WGM, gsz = (nM - fm) < WGM ? (nM - fm) : WGM;
    pm = fm + ((wgid % nig) % gsz); pn = (wgid % nig) / gsz; return true;
}
struct DenseSched {
    const char* A; const char* Bt; int K, nM, nN, G, c;
    __device__ __forceinline__ void init(const void* A_, const void* Bt_, int M, int N, int K_, int G_, int c_) { A = (const char*)A_; Bt = (const char*)Bt_; K = K_; nM = M / BM; nN = N / BM; G = G_; c = c_; }
    __device__ __forceinline__ bool next(int i, Unit& u) const { u.e = 0; u.rbl = 0; return static_order(nM, nN, G, c, i, u.pm, u.pn); }
    __device__ __forceinline__ const char* a_base(const Unit& u) const { return A + (size_t)u.pm * BM * K * 2; }
    __device__ __forceinline__ const char* b_base(const Unit& u) const { return Bt + (size_t)u.pn * BM * K * 2; }
    __device__ __forceinline__ void issue_rows(const Unit&, LAS unsigned char*, int, int) const {}
    __device__ __forceinline__ void read_rows(const Unit&, const LAS unsigned char*, int, unsigned (&)[4]) const {}
};

template <class Epi, class Sched, int MODE>
__device__ __forceinline__ void gemm_phase(LAS unsigned char* lds, LAS unsigned char* ldsidx, const Sched& S, const Epi& E) {
    const int tid = threadIdx.x, wid = __builtin_amdgcn_readfirstlane(tid >> 6), lane = tid & 63, wr = wid >> 2, wc = wid & 3, fr = lane & 15, fq = lane >> 4;
    const int K = S.K, nt = K / BK;
    int R0, C0; stage_rc(tid * 16, R0, C0);
    const int Rb = (R0 & ~31) + perm32(R0 & 31);
    const unsigned voffB0 = (unsigned)(Rb * K + C0) * 2u, voffB1 = voffB0 + (unsigned)(64 * K) * 2u;
    const size_t kstep = (size_t)(BK * 2);
    const size_t hstep = (size_t)HALF * K * 2;
    const unsigned ldsw = (unsigned)wid * 1024u;
    const int aoff = lds_byte(wr * 64 + fr, fq * 8), boff = lds_byte(wc * 32 + fr, fq * 8);
#define PG8_SA(b, h) (((b) * 2 + (h)) * HTB)
#define PG8_SB(b, h) ((4 + (b) * 2 + (h)) * HTB)
#define PG8_STAGE(bufoff, gbase, o0, o1) do { \
        __builtin_amdgcn_global_load_lds((const unsigned*)((const char*)(gbase) + (o0)), (LAS unsigned*)(lds + (bufoff) + ldsw), 16, 0, 0); \
        __builtin_amdgcn_global_load_lds((const unsigned*)((const char*)(gbase) + (o1)), (LAS unsigned*)(lds + (bufoff) + ldsw + 8192), 16, 0, 0); } while (0)
#define PG8_LDA(dst, b, h) do { _Pragma("unroll") for (int m = 0; m < 4; ++m) _Pragma("unroll") for (int k = 0; k < 2; ++k) dst[m][k] = *(const LAS bf16x8*)(lds + PG8_SA(b, h) + aoff + m * 2048 + k * 1024); } while (0)
#define PG8_LDB(dst, b, h) do { _Pragma("unroll") for (int n = 0; n < 2; ++n) _Pragma("unroll") for (int k = 0; k < 2; ++k) dst[n][k] = *(const LAS bf16x8*)(lds + PG8_SB(b, h) + boff + n * 2048 + k * 1024); } while (0)
#define PG8_MMA(ai, bj, At, Bt) do { __builtin_amdgcn_s_setprio(1); _Pragma("unroll") for (int m = 0; m < 4; ++m) _Pragma("unroll") for (int n = 0; n < 2; ++n) _Pragma("unroll") for (int k = 0; k < 2; ++k) \
        acc[ai][bj][m][n] = __builtin_amdgcn_mfma_f32_16x16x32_bf16(Bt[n][k], At[m][k], acc[ai][bj][m][n], 0, 0, 0); __builtin_amdgcn_s_setprio(0); } while (0)
#define PG8_WAIT_V(n) asm volatile("s_waitcnt vmcnt(" #n ")" ::: "memory")
#define PG8_WAIT_L(n) asm volatile("s_waitcnt lgkmcnt(" #n ")" ::: "memory")
#define PG8_BAR __builtin_amdgcn_s_barrier()
#define PG8_SCHED __builtin_amdgcn_sched_barrier(0)
    Unit cur, nxt; int ui = 0, ib = 0;
    if (!S.next(0, cur)) return;
    unsigned vc[4], vn[4];
    constexpr bool GATHER = (MODE == 2);
    if constexpr (MODE >= 1) { S.issue_rows(cur, ldsidx, wid, lane); asm volatile("s_waitcnt vmcnt(0)" ::: "memory"); __builtin_amdgcn_s_barrier(); asm volatile("" ::: "memory"); }
    if constexpr (GATHER) { S.read_rows(cur, ldsidx, R0, vc); _Pragma("unroll") for (int q = 0; q < 4; ++q) vc[q] += (unsigned)C0 * 2u; }
    else { _Pragma("unroll") for (int q = 0; q < 4; ++q) vc[q] = (unsigned)((R0 + 64 * q) * K + C0) * 2u; }
#pragma unroll
    for (int q = 0; q < 4; ++q) vn[q] = vc[q];
    f32x4 acc[2][2][4][2];
#pragma unroll
    for (int a = 0; a < 2; ++a)
#pragma unroll
        for (int b = 0; b < 2; ++b)
#pragma unroll
            for (int m = 0; m < 4; ++m)
#pragma unroll
                for (int n = 0; n < 2; ++n) acc[a][b][m][n] = (f32x4){0.f, 0.f, 0.f, 0.f};
    bf16x8 At[4][2], B0[2][2], B1[2][2];
    const char* cA = S.a_base(cur); const char* cB = S.b_base(cur);
    PG8_STAGE(PG8_SB(0, 0), cB, voffB0, voffB1); PG8_STAGE(PG8_SB(0, 1), cB + hstep, voffB0, voffB1); PG8_STAGE(PG8_SA(0, 0), cA, vc[0], vc[1]); PG8_STAGE(PG8_SA(0, 1), cA, vc[2], vc[3]);
    if (wr == 1) PG8_BAR;
    PG8_WAIT_V(2); PG8_BAR;
    PG8_STAGE(PG8_SB(1, 0), cB + kstep, voffB0, voffB1); PG8_STAGE(PG8_SA(1, 0), cA + kstep, vc[0], vc[1]); PG8_STAGE(PG8_SB(1, 1), cB + hstep + kstep, voffB0, voffB1);
    PG8_WAIT_V(6); PG8_BAR;
    for (;;) {
        const bool has_next = S.next(ui + 1, nxt);
        if constexpr (MODE >= 1) { if (has_next) S.issue_rows(nxt, ldsidx + (ib == 2 ? 0 : ib + 1) * 1024, wid, lane); }
        const char* nA = has_next ? S.a_base(nxt) : cA; const char* nB = has_next ? S.b_base(nxt) : cB;
        for (int t = 0; t < nt; t += 2) {
            const bool last = (t == nt - 2);
            const char* a1 = cA + (size_t)(t + 1) * kstep;
            const char* a2 = last ? nA : cA + (size_t)(t + 2) * kstep; const char* b2 = last ? nB : cB + (size_t)(t + 2) * kstep;
            const char* a3 = a2 + kstep; const char* b3 = b2 + kstep;
            unsigned w0 = vc[0], w1 = vc[1], w2 = vc[2], w3 = vc[3];
            if constexpr (GATHER) { if (last && has_next) { S.read_rows(nxt, ldsidx + (ib == 2 ? 0 : ib + 1) * 1024, R0, vn); _Pragma("unroll") for (int q = 0; q < 4; ++q) vn[q] += (unsigned)C0 * 2u;
                w0 = vn[0]; w1 = vn[1]; w2 = vn[2]; w3 = vn[3]; } }
            PG8_LDB(B0, 0, 0); PG8_LDB(B1, 0, 1); PG8_SCHED; PG8_LDA(At, 0, 0); PG8_STAGE(PG8_SA(1, 1), a1, vc[2], vc[3]);
            PG8_WAIT_V(8); PG8_WAIT_L(0); PG8_BAR; PG8_MMA(0, 0, At, B0); PG8_MMA(0, 1, At, B1); PG8_BAR; PG8_SCHED;
            PG8_LDA(At, 0, 1); PG8_STAGE(PG8_SB(0, 0), b2, voffB0, voffB1); PG8_STAGE(PG8_SB(0, 1), b2 + hstep, voffB0, voffB1); PG8_STAGE(PG8_SA(0, 0), a2, w0, w1);
            PG8_WAIT_V(8); PG8_WAIT_L(0); PG8_BAR; PG8_MMA(1, 0, At, B0); PG8_MMA(1, 1, At, B1); PG8_BAR; PG8_SCHED;
            PG8_LDB(B0, 1, 0); PG8_LDB(B1, 1, 1); PG8_SCHED; PG8_LDA(At, 1, 0); PG8_STAGE(PG8_SA(0, 1), a2, w2, w3);
            PG8_WAIT_V(8); PG8_WAIT_L(0); PG8_BAR; PG8_MMA(0, 0, At, B0); PG8_MMA(0, 1, At, B1); PG8_BAR; PG8_SCHED;
            PG8_LDA(At, 1, 1); PG8_STAGE(PG8_SB(1, 0), b3, voffB0, voffB1); PG8_STAGE(PG8_SB(1, 1), b3 + hstep, voffB0, voffB1); PG8_STAGE(PG8_SA(1, 0), a3, w0, w1);
            PG8_WAIT_V(8); PG8_WAIT_L(0); PG8_BAR; PG8_MMA(1, 0, At, B0); PG8_MMA(1, 1, At, B1); PG8_BAR; PG8_SCHED;
        }
        if (wr == 0) PG8_BAR;
        E(acc, cur, wr, wc, fr, fq, (const LAS unsigned char*)(ldsidx + ib * 1024));
        if (!has_next) break;
#pragma unroll
        for (int a = 0; a < 2; ++a)
#pragma unroll
            for (int b = 0; b < 2; ++b)
#pragma unroll
                for (int m = 0; m < 4; ++m)
#pragma unroll
                    for (int n = 0; n < 2; ++n) acc[a][b][m][n] = (f32x4){0.f, 0.f, 0.f, 0.f};
        cur = nxt; cA = nA; cB = nB; ++ui; ib = (ib == 2 ? 0 : ib + 1);
#pragma unroll
        for (int q = 0; q < 4; ++q) vc[q] = vn[q];
        if (wr == 1) PG8_BAR;
    }
    PG8_WAIT_V(0);
    PG8_BAR;
#undef PG8_SA
#undef PG8_SB
#undef PG8_STAGE
#undef PG8_LDA
#undef PG8_LDB
#undef PG8_MMA
#undef PG8_WAIT_V
#undef PG8_WAIT_L
#undef PG8_BAR
#undef PG8_SCHED
}
}

#define XB_TMO      128
#define XB_XCNT(j)  (256  + 64 * (j))
#define XB_XSUB(j)  (1280 + 64 * (j))
#define XB_XGEN(j)  (2304 + 64 * (j))
#define XB_TOP      3328
#define XB_TOPGEN   3392
#define XCD_BAR_WORDS 3456
#define XB_SPIN_CAP (1u << 18)

__device__ __forceinline__ unsigned xb_ld(unsigned* p)              { return __hip_atomic_load(p, __ATOMIC_RELAXED, __HIP_MEMORY_SCOPE_AGENT); }
__device__ __forceinline__ unsigned xb_add(unsigned* p, unsigned v) { return __hip_atomic_fetch_add(p, v, __ATOMIC_RELAXED, __HIP_MEMORY_SCOPE_AGENT); }
__device__ __forceinline__ unsigned xb_xcc_id() { return (unsigned)__builtin_amdgcn_s_getreg((3 << 11) | 20) & 0xFu; }
#define XB_SPIN(cond, bar) do { unsigned _sp = 0; while (cond) { __builtin_amdgcn_s_sleep(1); \
    if ((++_sp & 255u) == 0u) { if (xb_ld(&(bar)[XB_TMO])) break; if (_sp > XB_SPIN_CAP) { atomicAdd(&(bar)[XB_TMO], 1u); break; } } } } while (0)

struct XcdBarrier {
    unsigned* bar; unsigned x;
    volatile LAS unsigned* st;
};
__device__ __forceinline__ XcdBarrier xcd_barrier_post(unsigned* bar, volatile LAS unsigned* st) {
    XcdBarrier b; b.bar = bar; b.x = xb_xcc_id(); b.st = st;
    if (threadIdx.x == 0) (void)xb_add(&bar[XB_XCNT(b.x)], 1u);
    return b;
}
__device__ __forceinline__ void xcd_barrier_complete(unsigned* bar, unsigned x, unsigned& nloc, unsigned& nx) {
    const unsigned G = gridDim.x * gridDim.y * gridDim.z;
    unsigned sum, cnt, mine, sp = 0u;
    for (;;) {
        sum = 0u; cnt = 0u; mine = 0u;
#pragma unroll
        for (unsigned j = 0; j < 16; ++j) { const unsigned c = xb_ld(&bar[XB_XCNT(j)]); sum += c; cnt += (c > 0u) ? 1u : 0u; mine = (j == x) ? c : mine; }
        if (sum == G) break;
        __builtin_amdgcn_s_sleep(1);
        if ((++sp & 255u) == 0u) { if (xb_ld(&bar[XB_TMO])) break; if (sp > XB_SPIN_CAP) { atomicAdd(&bar[XB_TMO], 1u); break; } }
    }
    nloc = mine > 0u ? mine : 1u; nx = cnt > 0u ? cnt : 1u;
}
__device__ __forceinline__ void xcd_barrier(const XcdBarrier& b) {
    asm volatile("s_waitcnt vmcnt(0)" ::: "memory");
    __syncthreads();
    if (threadIdx.x == 0) {
        unsigned* bar = b.bar;
        __builtin_amdgcn_s_waitcnt(0);
        unsigned nloc = b.st[0], nx = b.st[1];
        if (nloc == 0u) { xcd_barrier_complete(bar, b.x, nloc, nx); b.st[0] = nloc; b.st[1] = nx; }
        const unsigned old = xb_add(&bar[XB_XSUB(b.x)], 1u);
        const unsigned gen = old / nloc;
        if (old + 1u == (gen + 1u) * nloc) {
            __builtin_amdgcn_fence(__ATOMIC_RELEASE, "agent");
            asm volatile("s_waitcnt vmcnt(0)" ::: "memory");
            const unsigned og = xb_add(&bar[XB_TOP], 1u);
            const unsigned tg = og / nx;
            if (og + 1u == (tg + 1u) * nx) xb_add(&bar[XB_TOPGEN], 1u);
            else XB_SPIN(xb_ld(&bar[XB_TOPGEN]) == tg, bar);
            __builtin_amdgcn_fence(__ATOMIC_ACQUIRE, "agent");
            xb_add(&bar[XB_XGEN(b.x)], 1u);
            asm volatile("s_waitcnt vmcnt(0)" ::: "memory");
        } else {
            XB_SPIN(xb_ld(&bar[XB_XGEN(b.x)]) == gen, bar);
            __builtin_amdgcn_fence(__ATOMIC_ACQUIRE, "agent");
            asm volatile("s_waitcnt vmcnt(0)" ::: "memory");
        }
    }
    __syncthreads();
}

constexpr int NWAVES = 8;
constexpr int RING_OFF = 0, RING_BYTES = 139264;
constexpr int LDSCTL_OFF = RING_BYTES, MISC_OFF = LDSCTL_OFF + 320;
constexpr int MOE_OFF = LDSCTL_OFF + 512;
constexpr int IDX_OFF = LDSCTL_OFF + 1024;
constexpr int TBL_OFF = LDSCTL_OFF + 4096;
constexpr int SSQ_OFF = LDSCTL_OFF + 16384;
constexpr int LDS_BYTES = RING_BYTES + 20480;
static_assert(TBL_OFF + 8 * 384 * 4 <= SSQ_OFF && SSQ_OFF + 4096 <= LDS_BYTES && LDS_BYTES <= 160 * 1024, "LDS map");

struct Args { const float* in[25]; float* out; unsigned char* ws; int ph_lo, ph_hi, li, pad; };
enum { I_X = 0, I_MEM, I_NORM_MIX_G, I_W_IN, I_Q_G, I_K_G, I_REL_BIAS, I_CONV_W, I_ONA_G, I_ONB_G, I_W_OUT, I_NORM_X_G, I_NORM_MEM_G, I_W_XQ, I_W_XKV, I_XQ_G, I_XK_G, I_W_XO,
       I_NORM_FFN_G, I_W_ROUTER, I_B_ROUTER, I_W_GU, I_B_GU, I_W_DN, I_B_DN };

struct Frame {
    LAS unsigned char* lds; int tid, lane, wave, vcu, G;
};

__device__ __forceinline__ void p0_transpose_item(const float* __restrict__ W, int ldw, int K, bf16_t* __restrict__ WT, int k0, int scol0, int cstride, int drow0, const float* __restrict__ g, LAS float* scr, int lane) {
#pragma unroll 8
    for (int i = 0; i < 32; ++i) { const int kk = 2 * i + (lane >> 5); float v = W[(size_t)(k0 + kk) * ldw + scol0 + (lane & 31) * cstride]; if (g) v *= g[k0 + kk]; scr[kk * 33 + (lane & 31)] = v; }
    asm volatile("s_waitcnt lgkmcnt(0)" ::: "memory");
    const int c = lane & 7;
#pragma unroll
    for (int j = 0; j < 4; ++j) { const int n = (lane >> 3) + 8 * j; const LAS float* s = scr + (8 * c) * 33 + n;
        u32x4 o; o.x = pk2(s[0 * 33], s[1 * 33]); o.y = pk2(s[2 * 33], s[3 * 33]); o.z = pk2(s[4 * 33], s[5 * 33]); o.w = pk2(s[6 * 33], s[7 * 33]);
        *(u32x4*)(WT + (size_t)(drow0 + n) * K + k0 + 8 * c) = o; }
    asm volatile("s_waitcnt lgkmcnt(0)" ::: "memory");
}
__device__ __forceinline__ void rms_row_to_bf16(const float* __restrict__ xrow, const float* __restrict__ g, bf16_t* __restrict__ orow, int lane) {
    const f32x4* xr = (const f32x4*)xrow + lane; const f32x4* gr = (const f32x4*)g + lane;
    f32x4 v[4]; float s = 0.f;
#pragma unroll
    for (int j = 0; j < 4; ++j) { v[j] = xr[64 * j]; s += (v[j].x * v[j].x + v[j].y * v[j].y) + (v[j].z * v[j].z + v[j].w * v[j].w); }
    const float rstd = 1.0f / sqrtf(wave_sum(s) * (1.0f / DM) + EPS);
    u32x2* o8 = (u32x2*)orow + lane;
#pragma unroll
    for (int j = 0; j < 4; ++j) { const f32x4 gg = gr[64 * j]; u32x2 o; o.x = pk2(v[j].x * rstd * gg.x, v[j].y * rstd * gg.y); o.y = pk2(v[j].z * rstd * gg.z, v[j].w * rstd * gg.w); o8[64 * j] = o; }
}

using pg8::Unit;
struct EpiProj { bf16_t* O; const float* qg; const float* kg; float qscale; int pad;
    __device__ __forceinline__ void operator()(const f32x4 (&acc)[2][2][4][2], const Unit& u, int wr, int wc, int fr, int fq, const LAS unsigned char*) const {
        const int row0 = u.pm * 256 + wr * 64 + fr, colb = u.pn * 256 + wc * 64 + 8 * fq;
        const int mode = u.pn < 2 ? 1 : (u.pn < 4 ? 2 : 0);
        f32x4 gv[2][2];
        if (mode) { const float* gp = (mode == 1 ? qg : kg) + 8 * fq; const float sc = mode == 1 ? qscale : 1.0f;
#pragma unroll
            for (int bj = 0; bj < 2; ++bj)
#pragma unroll
                for (int n = 0; n < 2; ++n) gv[bj][n] = *(const f32x4*)(gp + 32 * bj + 4 * n) * sc; }
#pragma unroll
        for (int ai = 0; ai < 2; ++ai)
#pragma unroll
            for (int m = 0; m < 4; ++m) {
                f32x4 v[2][2];
#pragma unroll
                for (int bj = 0; bj < 2; ++bj)
#pragma unroll
                    for (int n = 0; n < 2; ++n) v[bj][n] = acc[ai][bj][m][n];
                if (mode) { float ss = 0.f;
#pragma unroll
                    for (int bj = 0; bj < 2; ++bj)
#pragma unroll
                        for (int n = 0; n < 2; ++n) ss += (v[bj][n].x * v[bj][n].x + v[bj][n].y * v[bj][n].y) + (v[bj][n].z * v[bj][n].z + v[bj][n].w * v[bj][n].w);
                    ss += __shfl_xor(ss, 16); ss += __shfl_xor(ss, 32);
                    const float rstd = 1.0f / sqrtf(ss * (1.0f / 64.0f) + EPS);
#pragma unroll
                    for (int bj = 0; bj < 2; ++bj)
#pragma unroll
                        for (int n = 0; n < 2; ++n) v[bj][n] = v[bj][n] * rstd * gv[bj][n]; }
                bf16_t* rowp = O + (size_t)(row0 + ai * 128 + m * 16) * NPROJ + colb;
#pragma unroll
                for (int bj = 0; bj < 2; ++bj) { u32x4 w; w.x = cvt_pk_bf16(v[bj][0].x, v[bj][0].y); w.y = cvt_pk_bf16(v[bj][0].z, v[bj][0].w); w.z = cvt_pk_bf16(v[bj][1].x, v[bj][1].y); w.w = cvt_pk_bf16(v[bj][1].z, v[bj][1].w);
                    *(u32x4*)(rowp + 32 * bj) = w; }
            }
    }
};
struct EpiBf16 { bf16_t* O; int ldo; int pad;
    __device__ __forceinline__ void operator()(const f32x4 (&acc)[2][2][4][2], const Unit& u, int wr, int wc, int fr, int fq, const LAS unsigned char*) const {
        const int row0 = u.pm * 256 + wr * 64 + fr, col0 = u.pn * 256 + wc * 32 + 8 * fq;
#pragma unroll
        for (int ai = 0; ai < 2; ++ai)
#pragma unroll
            for (int m = 0; m < 4; ++m) { bf16_t* rowp = O + (size_t)(row0 + ai * 128 + m * 16) * ldo + col0;
#pragma unroll
                for (int bj = 0; bj < 2; ++bj) { const f32x4 v0 = acc[ai][bj][m][0], v1 = acc[ai][bj][m][1];
                    u32x4 w; w.x = cvt_pk_bf16(v0.x, v0.y); w.y = cvt_pk_bf16(v0.z, v0.w); w.z = cvt_pk_bf16(v1.x, v1.y); w.w = cvt_pk_bf16(v1.z, v1.w);
                    *(u32x4*)(rowp + bj * 128) = w; } }
    }
};
struct EpiRes { const float* base; float* out; bf16_t* outb; float* sq;
    __device__ __forceinline__ void operator()(const f32x4 (&acc)[2][2][4][2], const Unit& u, int wr, int wc, int fr, int fq, const LAS unsigned char*) const {
        const int row0 = u.pm * 256 + wr * 64 + fr, col0 = u.pn * 256 + wc * 32 + 8 * fq;
#pragma unroll
        for (int ai = 0; ai < 2; ++ai)
#pragma unroll
            for (int m = 0; m < 4; ++m) { const int row = row0 + ai * 128 + m * 16; const size_t off = (size_t)row * DM + col0; float ss = 0.f;
#pragma unroll
                for (int bj = 0; bj < 2; ++bj) { const f32x4 b0 = *(const f32x4*)(base + off + bj * 128), b1 = *(const f32x4*)(base + off + bj * 128 + 4);
                    const f32x4 v0 = acc[ai][bj][m][0] + b0, v1 = acc[ai][bj][m][1] + b1;
                    *(f32x4*)(out + off + bj * 128) = v0; *(f32x4*)(out + off + bj * 128 + 4) = v1;
                    u32x4 w; w.x = cvt_pk_bf16(v0.x, v0.y); w.y = cvt_pk_bf16(v0.z, v0.w); w.z = cvt_pk_bf16(v1.x, v1.y); w.w = cvt_pk_bf16(v1.z, v1.w);
                    *(u32x4*)(outb + off + bj * 128) = w;
                    ss += (v0.x * v0.x + v0.y * v0.y) + (v0.z * v0.z + v0.w * v0.w) + (v1.x * v1.x + v1.y * v1.y) + (v1.z * v1.z + v1.w * v1.w); }
                ss += __shfl_xor(ss, 16); ss += __shfl_xor(ss, 32);
                if (fq == 0) sq[((size_t)u.pn * MTOK + row) * 4 + wc] = ss; }
    }
};
struct EpiRstdBf16 { bf16_t* O; const float* sq; int ldo; int pad;
    __device__ __forceinline__ void operator()(const f32x4 (&acc)[2][2][4][2], const Unit& u, int wr, int wc, int fr, int fq, const LAS unsigned char*) const {
        const int row0 = u.pm * 256 + wr * 64 + fr, col0 = u.pn * 256 + wc * 32 + 8 * fq;
#pragma unroll
        for (int ai = 0; ai < 2; ++ai)
#pragma unroll
            for (int m = 0; m < 4; ++m) { const int row = row0 + ai * 128 + m * 16; float s = 0.f;
#pragma unroll
                for (int t = 0; t < 4; ++t) { const f32x4 p = *(const f32x4*)(sq + ((size_t)t * MTOK + row) * 4); s += (p.x + p.y) + (p.z + p.w); }
                const float rstd = 1.0f / sqrtf(s * (1.0f / DM) + EPS);
                bf16_t* rowp = O + (size_t)row * ldo + col0;
#pragma unroll
                for (int bj = 0; bj < 2; ++bj) { const f32x4 v0 = acc[ai][bj][m][0] * rstd, v1 = acc[ai][bj][m][1] * rstd;
                    u32x4 w; w.x = cvt_pk_bf16(v0.x, v0.y); w.y = cvt_pk_bf16(v0.z, v0.w); w.z = cvt_pk_bf16(v1.x, v1.y); w.w = cvt_pk_bf16(v1.z, v1.w);
                    *(u32x4*)(rowp + bj * 128) = w; } }
    }
};
constexpr int LSTRIDE = MTOK;
struct MoeSched {
    const char* A; const char* Bt; size_t estride; const int* list; const LAS unsigned* tab; int K, nN, nblk, G, c, gather;
    __device__ __forceinline__ bool next(int i, Unit& u) const {
        if (!pg8::static_order(nblk, nN, G, c, i, u.pm, u.pn)) return false;
        int e = 0; while (e < NE - 1 && (int)tab[32 + e + 1] <= u.pm) ++e;
        e = __builtin_amdgcn_readfirstlane(e); u.e = e; u.rbl = u.pm - (int)__builtin_amdgcn_readfirstlane(tab[32 + e]); return true;
    }
    __device__ __forceinline__ const char* a_base(const Unit& u) const { return gather ? A : A + (size_t)u.pm * 256 * K * 2; }
    __device__ __forceinline__ const char* b_base(const Unit& u) const { return Bt + (size_t)u.e * estride + (size_t)u.pn * 256 * K * 2; }
    __device__ __forceinline__ void issue_rows(const Unit& u, LAS unsigned char* buf, int wid, int lane) const {
        if (wid < 4) __builtin_amdgcn_global_load_lds((const unsigned*)(list + (size_t)u.e * LSTRIDE + u.rbl * 256 + wid * 64 + lane), (LAS unsigned*)(buf + wid * 256), 4, 0, 0);
    }
    __device__ __forceinline__ void read_rows(const Unit& u, const LAS unsigned char* buf, int R0, unsigned (&off)[4]) const {
        const int cnt = (int)tab[u.e] - u.rbl * 256;
#pragma unroll
        for (int q = 0; q < 4; ++q) { const int j = R0 + 64 * q; const int v = ((const LAS int*)buf)[j]; const int tok = (j < cnt) ? (v >> 2) : 0; off[q] = (unsigned)tok * (unsigned)(K * 2); }
    }
};
struct EpiSwiglu2 { bf16_t* act; const float* bias; const float* rstd2; const LAS unsigned* tab;
    __device__ __forceinline__ void operator()(const f32x4 (&acc)[2][2][4][2], const Unit& u, int wr, int wc, int fr, int fq, const LAS unsigned char* idx) const {
        const int cnt = (int)tab[u.e] - u.rbl * 256, c0 = u.pn * 128 + wc * 32 + 8 * fq;
        const float* bp = bias + (size_t)u.e * 2 * DFF + 2 * c0; f32x4 bb[4];
#pragma unroll
        for (int i = 0; i < 4; ++i) bb[i] = *(const f32x4*)(bp + 4 * i);
#pragma unroll
        for (int ai = 0; ai < 2; ++ai)
#pragma unroll
            for (int m = 0; m < 4; ++m) { const int j = ai * 128 + wr * 64 + m * 16 + fr; const int v = ((const LAS int*)idx)[j]; const int tok = (j < cnt) ? (v >> 2) : 0; const float rs = rstd2[tok];
                float o[8];
#pragma unroll
                for (int n = 0; n < 2; ++n)
#pragma unroll
                    for (int k = 0; k < 4; ++k) { const int cc = 4 * n + k; const float bg = bb[cc >> 1][(cc & 1) * 2], bl = bb[cc >> 1][(cc & 1) * 2 + 1];
                        const float g = fminf(acc[ai][0][m][n][k] * rs + bg, 7.0f), l = fminf(fmaxf(acc[ai][1][m][n][k] * rs + bl, -7.0f), 7.0f);
                        o[cc] = g * __builtin_amdgcn_rcpf(1.0f + __builtin_amdgcn_exp2f(-1.702f * LOG2E * g)) * (l + 1.0f); }
                u32x4 w; w.x = cvt_pk_bf16(o[0], o[1]); w.y = cvt_pk_bf16(o[2], o[3]); w.z = cvt_pk_bf16(o[4], o[5]); w.w = cvt_pk_bf16(o[6], o[7]);
                *(u32x4*)(act + (size_t)(u.pm * 256 + j) * DFF + c0) = w; }
    }
};
struct EpiDown2 { bf16_t* ybuf; const float* bias; const float* gate; const LAS unsigned* tab;
    __device__ __forceinline__ void operator()(const f32x4 (&acc)[2][2][4][2], const Unit& u, int wr, int wc, int fr, int fq, const LAS unsigned char* idx) const {
        const int cnt = (int)tab[u.e] - u.rbl * 256, col0 = u.pn * 256 + wc * 32 + 8 * fq;
        const float* bp = bias + (size_t)u.e * DM + col0; f32x4 bb[2][2];
#pragma unroll
        for (int bj = 0; bj < 2; ++bj)
#pragma unroll
            for (int n = 0; n < 2; ++n) bb[bj][n] = *(const f32x4*)(bp + bj * 128 + 4 * n);
#pragma unroll
        for (int ai = 0; ai < 2; ++ai)
#pragma unroll
            for (int m = 0; m < 4; ++m) { const int j = ai * 128 + wr * 64 + m * 16 + fr;
                if (j < cnt) { const int tk = ((const LAS int*)idx)[j]; const float g = gate[tk]; bf16_t* rowp = ybuf + (size_t)tk * DM + col0;
#pragma unroll
                    for (int bj = 0; bj < 2; ++bj) { const f32x4 v0 = (acc[ai][bj][m][0] + bb[bj][0]) * g, v1 = (acc[ai][bj][m][1] + bb[bj][1]) * g;
                        u32x4 w; w.x = cvt_pk_bf16(v0.x, v0.y); w.y = cvt_pk_bf16(v0.z, v0.w); w.z = cvt_pk_bf16(v1.x, v1.y); w.w = cvt_pk_bf16(v1.z, v1.w);
                        *(u32x4*)(rowp + bj * 128) = w; } } }
    }
};
__device__ __forceinline__ void moe_tables(const unsigned* gcnt, LAS unsigned* tab, int tid) {
    if (tid < 64) { const unsigned c = tid < NE ? gcnt[tid] : 0u; const unsigned nb = (c + 255u) >> 8; unsigned inc = nb;
#pragma unroll
        for (int o = 1; o < 64; o <<= 1) { const unsigned t = __shfl_up(inc, o); if (tid >= o) inc += t; }
        if (tid < NE) { tab[tid] = c; tab[32 + tid] = inc - nb; } if (tid == NE) tab[32 + NE] = inc - nb; }
    __syncthreads();
}
__device__ __forceinline__ void p7_route(const Frame& F, const bf16_t* __restrict__ hb, const bf16_t* __restrict__ Wrt, const float* __restrict__ sq2, const float* __restrict__ br,
                                         unsigned* gcnt, int* __restrict__ list, float* __restrict__ gate, float* __restrict__ rstd2) {
    LAS unsigned* lcnt = (LAS unsigned*)(F.lds + RING_OFF); LAS unsigned* lbase = lcnt + 32;
    const int lane = F.lane, tcol = lane & 15, kq = lane >> 4;
    for (int round = blockIdx.x; round < MTOK / 128; round += F.G) {
        if (F.tid < 32) lcnt[F.tid] = 0u;
        __syncthreads();
        const int tok = round * 128 + F.wave * 16 + tcol;
        const bf16_t* xp = hb + (size_t)tok * DM + 8 * kq; const bf16_t* w0p = Wrt + (size_t)tcol * DM + 8 * kq; const bf16_t* w1p = w0p + 16 * DM;
        f32x4 a0 = {0.f, 0.f, 0.f, 0.f}, a1 = {0.f, 0.f, 0.f, 0.f};
#pragma unroll 8
        for (int ks = 0; ks < 32; ++ks) { const bf16x8 b = *(const bf16x8*)(xp + 32 * ks), w0 = *(const bf16x8*)(w0p + 32 * ks), w1 = *(const bf16x8*)(w1p + 32 * ks);
            a0 = __builtin_amdgcn_mfma_f32_16x16x32_bf16(w0, b, a0, 0, 0, 0); a1 = __builtin_amdgcn_mfma_f32_16x16x32_bf16(w1, b, a1, 0, 0, 0); }
        float s = 0.f;
#pragma unroll
        for (int t = 0; t < 4; ++t) { const f32x4 p = *(const f32x4*)(sq2 + ((size_t)t * MTOK + tok) * 4); s += (p.x + p.y) + (p.z + p.w); }
        const float rstd = 1.0f / sqrtf(s * (1.0f / DM) + EPS);
        float v[8]; int id[8];
#pragma unroll
        for (int r = 0; r < 4; ++r) { id[r] = 4 * kq + r; id[4 + r] = 16 + 4 * kq + r; v[r] = a0[r] * rstd + br[4 * kq + r]; v[4 + r] = a1[r] * rstd + br[16 + 4 * kq + r]; }
        float tv[4]; int ti[4];
#pragma unroll
        for (int r = 0; r < 4; ++r) { float bv = v[0]; int bi = id[0];
#pragma unroll
            for (int j = 1; j < 8; ++j) if (v[j] > bv) { bv = v[j]; bi = id[j]; }
#pragma unroll
            for (int o = 16; o < 64; o <<= 1) { const float ov = __shfl_xor(bv, o); const int oi = __shfl_xor(bi, o); if (ov > bv || (ov == bv && oi < bi)) { bv = ov; bi = oi; } }
            tv[r] = bv; ti[r] = bi;
#pragma unroll
            for (int j = 0; j < 8; ++j) if (id[j] == bi) v[j] = -3.0e38f; }
        const float e1 = __expf(tv[1] - tv[0]), e2 = __expf(tv[2] - tv[0]), e3 = __expf(tv[3] - tv[0]); const float inv = 1.0f / (1.0f + e1 + e2 + e3);
        unsigned lp[4];
        if (kq == 0) {
#pragma unroll
            for (int k = 0; k < 4; ++k) lp[k] = __hip_atomic_fetch_add(lcnt + ti[k], 1u, __ATOMIC_RELAXED, __HIP_MEMORY_SCOPE_WORKGROUP); }
        __syncthreads();
        if (F.tid < 32) { const unsigned c = lcnt[F.tid]; lbase[F.tid] = c ? __hip_atomic_fetch_add(gcnt + F.tid, c, __ATOMIC_RELAXED, __HIP_MEMORY_SCOPE_AGENT) : 0u; }
        __syncthreads();
        if (kq == 0) { const float gk[4] = {inv, e1 * inv, e2 * inv, e3 * inv};
#pragma unroll
            for (int k = 0; k < 4; ++k) { const unsigned pos = lbase[ti[k]] + lp[k]; list[(size_t)ti[k] * LSTRIDE + pos] = tok * 4 + k; gate[tok * 4 + k] = gk[k]; }
            rstd2[tok] = rstd; }
        __syncthreads();
    }
}
__device__ __forceinline__ void p10_combine(const Frame& F, float* __restrict__ out, const bf16_t* __restrict__ ybuf) {
    const size_t n8 = (size_t)MTOK * DM / 8;
    for (size_t i = (size_t)blockIdx.x * (NWAVES * 64) + F.tid; i < n8; i += (size_t)F.G * (NWAVES * 64)) {
        const size_t tok = i / (DM / 8), c8 = i % (DM / 8);
        f32x4 v0 = *(const f32x4*)(out + i * 8), v1 = *(const f32x4*)(out + i * 8 + 4);
#pragma unroll
        for (int k = 0; k < 4; ++k) { const u32x4 y = *(const u32x4*)(ybuf + (tok * 4 + k) * DM + c8 * 8);
            v0.x += bflo(y.x); v0.y += bfhi(y.x); v0.z += bflo(y.y); v0.w += bfhi(y.y); v1.x += bflo(y.z); v1.y += bfhi(y.z); v1.z += bflo(y.w); v1.w += bfhi(y.w); }
        *(f32x4*)(out + i * 8) = v0; *(f32x4*)(out + i * 8 + 4) = v1;
    }
}
typedef short v4i16_t __attribute__((ext_vector_type(4)));
__device__ __forceinline__ v4i16_t lds_tr16(const LAS unsigned char* p) { return __builtin_amdgcn_ds_read_tr16_b64_v4i16((LAS v4i16_t*)p); }
__device__ __forceinline__ bf16x8 cat8(v4i16_t a, v4i16_t b) { return (bf16x8){a[0], a[1], a[2], a[3], b[0], b[1], b[2], b[3]}; }
__device__ __forceinline__ int koff16(int rho) { return (rho & 3) + 8 * (rho >> 2); }

__device__ __forceinline__ void p2_attn(const Frame& F, const bf16_t* __restrict__ proj, const float* __restrict__ rel_bias, const float* __restrict__ conv_w,
                                        const float* __restrict__ ga, const float* __restrict__ gb, bf16_t* __restrict__ yb, bf16_t* __restrict__ kvmem, const float* __restrict__ xk_g) {
    LAS float* tbl = (LAS float*)(F.lds + TBL_OFF);
    for (int i = F.tid; i < 8 * 384; i += NWAVES * 64) { const int h = i / 384, j = i % 384; int rel = 319 - j; rel = rel < -MAXREL ? -MAXREL : (rel > MAXREL ? MAXREL : rel); tbl[i] = rel_bias[h * NREL + rel + MAXREL] * LOG2E; }
    __syncthreads();
    const int lane = F.lane, h = F.wave, r = lane & 31, hi = lane >> 5;
    LAS unsigned char* wbuf = F.lds + RING_OFF + h * 16384;
    LAS float* ssq = (LAS float*)(F.lds + SSQ_OFF);
    const LAS float* tblh = tbl + h * 384;
    const float far_bias = rel_bias[h * NREL + 2 * MAXREL] * LOG2E;
    unsigned kso[4], vso[4];
#pragma unroll
    for (int i = 0; i < 4; ++i) { const int key = 8 * i + (lane >> 3), cp = lane & 7;
        kso[i] = (unsigned)(key * NPROJ + (cp ^ ((key >> 1) & 7)) * 8) * 2u; vso[i] = (unsigned)(key * NPROJ + DATT + (cp ^ (((key >> 1) & 1) << 2)) * 8) * 2u; }
    int kaddr[4];
#pragma unroll
    for (int s = 0; s < 4; ++s) kaddr[s] = r * 128 + (((2 * s + hi) ^ ((r >> 1) & 7)) * 16);
    const int G1 = (lane >> 4) & 1, tq = (lane & 15) >> 2, tp = lane & 3;
    int vaddr[2];
#pragma unroll
    for (int db = 0; db < 2; ++db) vaddr[db] = 4096 + (4 * hi + tq) * 128 + (((4 * db + 2 * G1 + (tp >> 1)) ^ (((tq >> 1) & 1) << 2)) * 16) + (tp & 1) * 8;
#define P2_DMA(T_, buf_) do { const char* kp_ = (const char*)(proj + ((size_t)b * SEQ + 32 * (T_)) * NPROJ + DATT + h * 64); \
        _Pragma("unroll") for (int i_ = 0; i_ < 4; ++i_) __builtin_amdgcn_global_load_lds((const unsigned*)(kp_ + kso[i_]), (LAS unsigned*)(wbuf + (buf_) * 8192 + i_ * 1024), 16, 0, 0); \
        _Pragma("unroll") for (int i_ = 0; i_ < 4; ++i_) __builtin_amdgcn_global_load_lds((const unsigned*)(kp_ + vso[i_]), (LAS unsigned*)(wbuf + (buf_) * 8192 + 4096 + i_ * 1024), 16, 0, 0); } while (0)
    const int upw = (512 + F.G - 1) / F.G;
    for (int ui = 0; ui < upw; ++ui) {
        const int unit = F.vcu * upw + ui; if (unit >= BATCH * (SEQ / CHUNK)) break;
        const int b = unit / (SEQ / CHUNK), c = unit % (SEQ / CHUNK); const size_t row0 = (size_t)b * SEQ + c * CHUNK;
        const int T0 = 2 * (c - LEFT < 0 ? 0 : c - LEFT), T1 = 2 * c + 1;
        P2_DMA(T0, 0);
        bf16x8 qf[2][4];
#pragma unroll
        for (int qb = 0; qb < 2; ++qb)
#pragma unroll
            for (int s = 0; s < 4; ++s) qf[qb][s] = *(const bf16x8*)(proj + (row0 + 32 * qb + r) * NPROJ + h * 64 + 16 * s + 8 * hi);
        f32x16 o[2][2];
#pragma unroll
        for (int db = 0; db < 2; ++db)
#pragma unroll
            for (int qb = 0; qb < 2; ++qb)
#pragma unroll
                for (int i = 0; i < 16; ++i) o[db][qb][i] = 0.f;
        float mrun[2] = {-1e30f, -1e30f}, lrun[2] = {0.f, 0.f};
        for (int T = T0; T <= T1; ++T) {
            const int pb = (T - T0) & 1; const LAS unsigned char* Ks = wbuf + pb * 8192;
            if (T < T1) { P2_DMA(T + 1, pb ^ 1); asm volatile("s_waitcnt vmcnt(8)" ::: "memory"); }
            else asm volatile("s_waitcnt vmcnt(0)" ::: "memory");
            f32x16 sacc[2];
#pragma unroll
            for (int qb = 0; qb < 2; ++qb)
#pragma unroll
                for (int i = 0; i < 16; ++i) sacc[qb][i] = 0.f;
#pragma unroll
            for (int s = 0; s < 4; ++s) { const bf16x8 kf = *(const LAS bf16x8*)(Ks + kaddr[s]);
                sacc[0] = __builtin_amdgcn_mfma_f32_32x32x16_bf16(kf, qf[0][s], sacc[0], 0, 0, 0); sacc[1] = __builtin_amdgcn_mfma_f32_32x32x16_bf16(kf, qf[1][s], sacc[1], 0, 0, 0); }
            if ((T >> 1) >= c - 4) {
#pragma unroll
                for (int qb = 0; qb < 2; ++qb) { const LAS float* tp0 = tblh + (319 - 64 * c - 32 * qb - r + 32 * T + 4 * hi);
#pragma unroll
                    for (int i = 0; i < 16; ++i) sacc[qb][i] += tp0[koff16(i)]; }
            } else {
#pragma unroll
                for (int qb = 0; qb < 2; ++qb)
#pragma unroll
                    for (int i = 0; i < 16; ++i) sacc[qb][i] += far_bias;
            }
            bf16x8 pf[2][2];
#pragma unroll
            for (int qb = 0; qb < 2; ++qb) {
                float mx = sacc[qb][0];
#pragma unroll
                for (int i = 1; i < 16; ++i) mx = fmaxf(mx, sacc[qb][i]);
                mx = fmaxf(mx, __shfl_xor(mx, 32));
                const float mn = fmaxf(mrun[qb], mx), f = __builtin_amdgcn_exp2f(mrun[qb] - mn); mrun[qb] = mn;
                float ls = 0.f; float p[16];
#pragma unroll
                for (int i = 0; i < 16; ++i) { p[i] = __builtin_amdgcn_exp2f(sacc[qb][i] - mn); ls += p[i]; }
                lrun[qb] = lrun[qb] * f + ls;
#pragma unroll
                for (int i = 0; i < 16; ++i) { o[0][qb][i] *= f; o[1][qb][i] *= f; }
#pragma unroll
                for (int ks = 0; ks < 2; ++ks) { u32x4 w; w.x = cvt_pk_bf16(p[8 * ks + 0], p[8 * ks + 1]); w.y = cvt_pk_bf16(p[8 * ks + 2], p[8 * ks + 3]); w.z = cvt_pk_bf16(p[8 * ks + 4], p[8 * ks + 5]); w.w = cvt_pk_bf16(p[8 * ks + 6], p[8 * ks + 7]);
                    pf[qb][ks] = __builtin_bit_cast(bf16x8, w); }
            }
#pragma unroll
            for (int db = 0; db < 2; ++db)
#pragma unroll
                for (int ks = 0; ks < 2; ++ks) {
                    const v4i16_t t0 = lds_tr16(Ks + vaddr[db] + (16 * ks) * 128), t1 = lds_tr16(Ks + vaddr[db] + (16 * ks + 8) * 128);
                    const bf16x8 vf = cat8(t0, t1);
                    o[db][0] = __builtin_amdgcn_mfma_f32_32x32x16_bf16(vf, pf[0][ks], o[db][0], 0, 0, 0); o[db][1] = __builtin_amdgcn_mfma_f32_32x32x16_bf16(vf, pf[1][ks], o[db][1], 0, 0, 0);
                }
        }

        LAS float* sq = ssq + (ui & 1) * 512;
#pragma unroll
        for (int qb = 0; qb < 2; ++qb) { const float lt = lrun[qb] + __shfl_xor(lrun[qb], 32); const float inv = 1.0f / lt; float ss = 0.f;
#pragma unroll
            for (int db = 0; db < 2; ++db)
#pragma unroll
                for (int i = 0; i < 16; ++i) { o[db][qb][i] *= inv; ss += o[db][qb][i] * o[db][qb][i]; }
            ss += __shfl_xor(ss, 32);
            if (hi == 0) sq[h * 64 + 32 * qb + r] = ss; }
        __syncthreads();
#pragma unroll
        for (int qb = 0; qb < 2; ++qb) { float tot = 0.f;
#pragma unroll
            for (int hh = 0; hh < 8; ++hh) tot += sq[hh * 64 + 32 * qb + r];
            const float rstd = 1.0f / sqrtf(tot * (1.0f / DATT) + EPS);
            bf16_t* orow = yb + (row0 + 32 * qb + r) * DM + h * 64;
#pragma unroll
            for (int db = 0; db < 2; ++db)
#pragma unroll
                for (int g4 = 0; g4 < 4; ++g4) { const int d0 = 32 * db + 8 * g4 + 4 * hi; const f32x4 gg = *(const f32x4*)(ga + h * 64 + d0);
                    u32x2 w; w.x = cvt_pk_bf16(o[db][qb][4 * g4 + 0] * rstd * gg.x, o[db][qb][4 * g4 + 1] * rstd * gg.y); w.y = cvt_pk_bf16(o[db][qb][4 * g4 + 2] * rstd * gg.z, o[db][qb][4 * g4 + 3] * rstd * gg.w);
                    *(u32x2*)(orow + d0) = w; } }
        { const int ch0 = 8 * lane; float cw[3][8], gbv[8];
#pragma unroll
          for (int t = 0; t < 3; ++t) { const f32x4 a = *(const f32x4*)(conv_w + t * DCONV + ch0), bq = *(const f32x4*)(conv_w + t * DCONV + ch0 + 4);
              cw[t][0] = a.x; cw[t][1] = a.y; cw[t][2] = a.z; cw[t][3] = a.w; cw[t][4] = bq.x; cw[t][5] = bq.y; cw[t][6] = bq.z; cw[t][7] = bq.w; }
          { const f32x4 a = *(const f32x4*)(gb + ch0), bq = *(const f32x4*)(gb + ch0 + 4); gbv[0] = a.x; gbv[1] = a.y; gbv[2] = a.z; gbv[3] = a.w; gbv[4] = bq.x; gbv[5] = bq.y; gbv[6] = bq.z; gbv[7] = bq.w; }
          const size_t tfirst = row0 + 8 * h; const int sfirst = c * CHUNK + 8 * h;
          float u1[8], u2[8];
#pragma unroll
          for (int j = 0; j < 8; ++j) { u1[j] = 0.f; u2[j] = 0.f; }
          if (sfirst >= 1) { const u32x4 cg = *(const u32x4*)(proj + (tfirst - 1) * NPROJ + 3 * DATT + DCONV + ch0), xv = *(const u32x4*)(proj + (tfirst - 1) * NPROJ + 3 * DATT + 2 * DCONV + ch0);
              u1[0] = bflo(cg.x) * bflo(xv.x); u1[1] = bfhi(cg.x) * bfhi(xv.x); u1[2] = bflo(cg.y) * bflo(xv.y); u1[3] = bfhi(cg.y) * bfhi(xv.y); u1[4] = bflo(cg.z) * bflo(xv.z); u1[5] = bfhi(cg.z) * bfhi(xv.z); u1[6] = bflo(cg.w) * bflo(xv.w); u1[7] = bfhi(cg.w) * bfhi(xv.w); }
          if (sfirst >= 2) { const u32x4 cg = *(const u32x4*)(proj + (tfirst - 2) * NPROJ + 3 * DATT + DCONV + ch0), xv = *(const u32x4*)(proj + (tfirst - 2) * NPROJ + 3 * DATT + 2 * DCONV + ch0);
              u2[0] = bflo(cg.x) * bflo(xv.x); u2[1] = bfhi(cg.x) * bfhi(xv.x); u2[2] = bflo(cg.y) * bflo(xv.y); u2[3] = bfhi(cg.y) * bfhi(xv.y); u2[4] = bflo(cg.z) * bflo(xv.z); u2[5] = bfhi(cg.z) * bfhi(xv.z); u2[6] = bflo(cg.w) * bflo(xv.w); u2[7] = bfhi(cg.w) * bfhi(xv.w); }
#pragma unroll
          for (int i = 0; i < 8; ++i) { const bf16_t* pr = proj + (tfirst + i) * NPROJ + 3 * DATT + ch0;
              const u32x4 bg = *(const u32x4*)pr, cg = *(const u32x4*)(pr + DCONV), xv = *(const u32x4*)(pr + 2 * DCONV);
              float u0[8], bgf[8], y[8];
              u0[0] = bflo(cg.x) * bflo(xv.x); u0[1] = bfhi(cg.x) * bfhi(xv.x); u0[2] = bflo(cg.y) * bflo(xv.y); u0[3] = bfhi(cg.y) * bfhi(xv.y); u0[4] = bflo(cg.z) * bflo(xv.z); u0[5] = bfhi(cg.z) * bfhi(xv.z); u0[6] = bflo(cg.w) * bflo(xv.w); u0[7] = bfhi(cg.w) * bfhi(xv.w);
              bgf[0] = bflo(bg.x); bgf[1] = bfhi(bg.x); bgf[2] = bflo(bg.y); bgf[3] = bfhi(bg.y); bgf[4] = bflo(bg.z); bgf[5] = bfhi(bg.z); bgf[6] = bflo(bg.w); bgf[7] = bfhi(bg.w);
              float ss = 0.f;
#pragma unroll
              for (int j = 0; j < 8; ++j) { y[j] = bgf[j] * (cw[0][j] * u2[j] + cw[1][j] * u1[j] + cw[2][j] * u0[j]); ss += y[j] * y[j]; u2[j] = u1[j]; u1[j] = u0[j]; }
              const float rstd = 1.0f / sqrtf(wave_sum(ss) * (1.0f / DCONV) + EPS);
              u32x4 w; w.x = cvt_pk_bf16(y[0] * rstd * gbv[0], y[1] * rstd * gbv[1]); w.y = cvt_pk_bf16(y[2] * rstd * gbv[2], y[3] * rstd * gbv[3]); w.z = cvt_pk_bf16(y[4] * rstd * gbv[4], y[5] * rstd * gbv[5]); w.w = cvt_pk_bf16(y[6] * rstd * gbv[6], y[7] * rstd * gbv[7]);
              *(u32x4*)(yb + (tfirst + i) * DM + DATT + ch0) = w; } }
        { bf16_t* kp = kvmem + (size_t)(8 * unit + h) * (2 * DX) + 8 * lane; const u32x4 kv = *(const u32x4*)kp;
          float v[8] = {bflo(kv.x), bfhi(kv.x), bflo(kv.y), bfhi(kv.y), bflo(kv.z), bfhi(kv.z), bflo(kv.w), bfhi(kv.w)}; float ss = 0.f;
#pragma unroll
          for (int j = 0; j < 8; ++j) ss += v[j] * v[j];
          ss += __shfl_xor(ss, 1); ss += __shfl_xor(ss, 2); ss += __shfl_xor(ss, 4); ss += __shfl_xor(ss, 8);
          const float rstd = 1.0f / sqrtf(ss * (1.0f / XHD) + EPS); const float* gp = xk_g + ((8 * lane) & (XHD - 1)); const f32x4 g0 = *(const f32x4*)gp, g1 = *(const f32x4*)(gp + 4);
          u32x4 w; w.x = cvt_pk_bf16(v[0] * rstd * g0.x, v[1] * rstd * g0.y); w.y = cvt_pk_bf16(v[2] * rstd * g0.z, v[3] * rstd * g0.w); w.z = cvt_pk_bf16(v[4] * rstd * g1.x, v[5] * rstd * g1.y); w.w = cvt_pk_bf16(v[6] * rstd * g1.z, v[7] * rstd * g1.w);
          *(u32x4*)kp = w; }
    }
    __syncthreads();
}
__device__ __forceinline__ void p5_xattn(const Frame& F, const bf16_t* __restrict__ qx, const bf16_t* __restrict__ kvmem, const float* __restrict__ xq_g, bf16_t* __restrict__ ox) {
    const int lane = F.lane, r = lane & 31, hi = lane >> 5;
    LAS unsigned char* Kl = F.lds + RING_OFF; LAS unsigned char* Vl = Kl + 256 * 272;
    const int G1 = (lane >> 4) & 1, tq = (lane & 15) >> 2, tp = lane & 3;
    const float XS = 0.08838834764831845f * LOG2E;
    const int upw = (512 + F.G - 1) / F.G; int cur_bh = -1;
    for (int ui = 0; ui < upw; ++ui) {
        const int unit = F.vcu * upw + ui; if (unit >= BATCH * XH * 8) break;
        const int bh = unit >> 3, qt = unit & 7, b = bh >> 2, h = bh & 3;
        if (bh != cur_bh) {
            __syncthreads();
            const bf16_t* src = kvmem + (size_t)b * NMEM * (2 * DX) + h * XHD;
#pragma unroll
            for (int i = 0; i < 8; ++i) { const int ci = F.tid + 512 * i, key = ci >> 4, ch = ci & 15;
                const u32x4 kv = *(const u32x4*)(src + (size_t)key * (2 * DX) + ch * 8), vv = *(const u32x4*)(src + (size_t)key * (2 * DX) + DX + ch * 8);
                *(LAS u32x4*)(Kl + key * 272 + ch * 16) = kv; *(LAS u32x4*)(Vl + key * 256 + ((ch ^ ((key & 3) << 2)) * 16)) = vv; }
            __syncthreads();
            cur_bh = bh;
        }
        const size_t qrow = (size_t)b * SEQ + qt * 256 + F.wave * 32 + r;
        bf16x8 qf[8];
        { u32x4 raw[8]; float ss = 0.f;
#pragma unroll
          for (int s = 0; s < 8; ++s) { raw[s] = *(const u32x4*)(qx + qrow * DX + h * XHD + 16 * s + 8 * hi);
              const float a0 = bflo(raw[s].x), a1 = bfhi(raw[s].x), a2 = bflo(raw[s].y), a3 = bfhi(raw[s].y), a4 = bflo(raw[s].z), a5 = bfhi(raw[s].z), a6 = bflo(raw[s].w), a7 = bfhi(raw[s].w);
              ss += (a0 * a0 + a1 * a1) + (a2 * a2 + a3 * a3) + (a4 * a4 + a5 * a5) + (a6 * a6 + a7 * a7); }
          ss += __shfl_xor(ss, 32);
          const float rs = XS / sqrtf(ss * (1.0f / XHD) + EPS);
#pragma unroll
          for (int s = 0; s < 8; ++s) { const f32x4 g0 = *(const f32x4*)(xq_g + 16 * s + 8 * hi), g1 = *(const f32x4*)(xq_g + 16 * s + 8 * hi + 4);
              u32x4 w; w.x = cvt_pk_bf16(bflo(raw[s].x) * rs * g0.x, bfhi(raw[s].x) * rs * g0.y); w.y = cvt_pk_bf16(bflo(raw[s].y) * rs * g0.z, bfhi(raw[s].y) * rs * g0.w);
              w.z = cvt_pk_bf16(bflo(raw[s].z) * rs * g1.x, bfhi(raw[s].z) * rs * g1.y); w.w = cvt_pk_bf16(bflo(raw[s].w) * rs * g1.z, bfhi(raw[s].w) * rs * g1.w);
              qf[s] = __builtin_bit_cast(bf16x8, w); } }
        f32x16 o[4];
#pragma unroll
        for (int db = 0; db < 4; ++db)
#pragma unroll
            for (int i = 0; i < 16; ++i) o[db][i] = 0.f;
        float mrun = -1e30f, lrun = 0.f;
        const LAS unsigned char* kbase = Kl + r * 272 + hi * 16;
        const LAS unsigned char* vbase[4];
#pragma unroll
        for (int db = 0; db < 4; ++db) vbase[db] = Vl + (4 * hi + tq) * 256 + ((4 * (db ^ tq) + 2 * G1 + (tp >> 1)) * 16) + (tp & 1) * 8;
#pragma unroll 1
        for (int t = 0; t < 4; ++t) {
            f32x16 sacc[2];
#pragma unroll
            for (int kb = 0; kb < 2; ++kb) {
#pragma unroll
                for (int i = 0; i < 16; ++i) sacc[kb][i] = 0.f;
#pragma unroll
                for (int s = 0; s < 8; ++s) { const bf16x8 kf = *(const LAS bf16x8*)(kbase + (64 * t + 32 * kb) * 272 + 32 * s);
                    sacc[kb] = __builtin_amdgcn_mfma_f32_32x32x16_bf16(kf, qf[s], sacc[kb], 0, 0, 0); } }
            float mx = sacc[0][0];
#pragma unroll
            for (int i = 1; i < 16; ++i) mx = fmaxf(mx, sacc[0][i]);
#pragma unroll
            for (int i = 0; i < 16; ++i) mx = fmaxf(mx, sacc[1][i]);
            mx = fmaxf(mx, __shfl_xor(mx, 32));
            const float mn = fmaxf(mrun, mx), f = __builtin_amdgcn_exp2f(mrun - mn); mrun = mn;
            float ls = 0.f; bf16x8 pf[2][2];
#pragma unroll
            for (int kb = 0; kb < 2; ++kb) { float p[16];
#pragma unroll
                for (int i = 0; i < 16; ++i) { p[i] = __builtin_amdgcn_exp2f(sacc[kb][i] - mn); ls += p[i]; }
#pragma unroll
                for (int ks = 0; ks < 2; ++ks) { u32x4 w; w.x = cvt_pk_bf16(p[8 * ks + 0], p[8 * ks + 1]); w.y = cvt_pk_bf16(p[8 * ks + 2], p[8 * ks + 3]); w.z = cvt_pk_bf16(p[8 * ks + 4], p[8 * ks + 5]); w.w = cvt_pk_bf16(p[8 * ks + 6], p[8 * ks + 7]);
                    pf[kb][ks] = __builtin_bit_cast(bf16x8, w); } }
            lrun = lrun * f + ls;
#pragma unroll
            for (int db = 0; db < 4; ++db)
#pragma unroll
                for (int i = 0; i < 16; ++i) o[db][i] *= f;
#pragma unroll
            for (int db = 0; db < 4; ++db)
#pragma unroll
                for (int kb = 0; kb < 2; ++kb)
#pragma unroll
                    for (int ks = 0; ks < 2; ++ks) { const int ko = (64 * t + 32 * kb + 16 * ks) * 256;
                        const v4i16_t t0 = lds_tr16(vbase[db] + ko), t1 = lds_tr16(vbase[db] + ko + 8 * 256);
                        o[db] = __builtin_amdgcn_mfma_f32_32x32x16_bf16(cat8(t0, t1), pf[kb][ks], o[db], 0, 0, 0); }
        }
        const float lt = lrun + __shfl_xor(lrun, 32); const float inv = 1.0f / lt;
        bf16_t* orow = ox + qrow * DX + h * XHD;
#pragma unroll
        for (int db = 0; db < 4; ++db)
#pragma unroll
            for (int g4 = 0; g4 < 4; ++g4) { const int d0 = 32 * db + 8 * g4 + 4 * hi;
                u32x2 w; w.x = cvt_pk_bf16(o[db][4 * g4 + 0] * inv, o[db][4 * g4 + 1] * inv); w.y = cvt_pk_bf16(o[db][4 * g4 + 2] * inv, o[db][4 * g4 + 3] * inv);
                *(u32x2*)(orow + d0) = w; }
    }
    __syncthreads();
}
__global__ __launch_bounds__(256) void k_transpose(const float* __restrict__ W, bf16_t* __restrict__ Wt, int K, int N) {
    __shared__ float t[32][33];
    const size_t boff = (size_t)blockIdx.z * K * N;
    const int k0 = blockIdx.y * 32, n0 = blockIdx.x * 32, tx = threadIdx.x & 31, ty = threadIdx.x >> 5;
#pragma unroll
    for (int i = 0; i < 4; ++i) t[ty + 8 * i][tx] = W[boff + (size_t)(k0 + ty + 8 * i) * N + n0 + tx];
    __syncthreads();
#pragma unroll
    for (int i = 0; i < 4; ++i) Wt[boff + (size_t)(n0 + ty + 8 * i) * K + k0 + tx] = (bf16_t)f2bf(t[tx][ty + 8 * i]);
}

__global__ __launch_bounds__(256) void k_rmsnorm(const float* __restrict__ x, const float* __restrict__ g, bf16_t* __restrict__ out, int M) {
    const int row = blockIdx.x * 4 + (threadIdx.x >> 6), lane = threadIdx.x & 63;
    if (row >= M) return;
    const f32x4* xr = (const f32x4*)(x + (size_t)row * DM) + lane;
    f32x4 v[4]; float s = 0.f;
#pragma unroll
    for (int j = 0; j < 4; ++j) { v[j] = xr[64 * j]; s += v[j].x * v[j].x + v[j].y * v[j].y + v[j].z * v[j].z + v[j].w * v[j].w; }
    const float rstd = 1.0f / sqrtf(wave_sum(s) * (1.0f / DM) + EPS);
    const f32x4* gr = (const f32x4*)g + lane;
    unsigned long long* o8 = (unsigned long long*)(out + (size_t)row * DM) + lane;
#pragma unroll
    for (int j = 0; j < 4; ++j) { const f32x4 gg = gr[64 * j];
        const unsigned lo = f2bf(v[j].x * rstd * gg.x) | (f2bf(v[j].y * rstd * gg.y) << 16), hi = f2bf(v[j].z * rstd * gg.z) | (f2bf(v[j].w * rstd * gg.w) << 16);
        o8[64 * j] = (unsigned long long)lo | ((unsigned long long)hi << 32); }
}

template <class Epi>
__global__ __launch_bounds__(256) void k_gemm(const bf16_t* __restrict__ A, const int* __restrict__ arow,
                                              const bf16_t* __restrict__ Bt, size_t b_estride, const int* __restrict__ blk_e, const unsigned* __restrict__ nblk256,
                                              int lda, int K, Epi E) {
    __shared__ __attribute__((aligned(16))) bf16_t As[128][40];
    __shared__ __attribute__((aligned(16))) bf16_t Bs[128][40];
    const int tid = threadIdx.x, lane = tid & 63, wid = tid >> 6, wm = wid >> 1, wn = wid & 1;
    const int row0 = blockIdx.y * 128, col0 = blockIdx.x * 128;
    if (nblk256 && row0 >= (int)(*nblk256) * 256) return;
    const int e = blk_e ? blk_e[row0 >> 8] : 0;
    const bf16_t* Bte = Bt + (size_t)e * b_estride;
    const int lr0 = tid >> 2, lr1 = (tid + 256) >> 2, lc = (tid & 3) * 8;
    const int sr0 = arow ? arow[row0 + lr0] : row0 + lr0, sr1 = arow ? arow[row0 + lr1] : row0 + lr1;
    const bf16_t* ap0 = A + (size_t)sr0 * lda + lc; const bf16_t* ap1 = A + (size_t)sr1 * lda + lc;
    const bf16_t* bp0 = Bte + (size_t)(col0 + lr0) * K + lc; const bf16_t* bp1 = Bte + (size_t)(col0 + lr1) * K + lc;
    f32x4 acc[4][4];
#pragma unroll
    for (int i = 0; i < 4; ++i)
#pragma unroll
        for (int j = 0; j < 4; ++j) acc[i][j] = (f32x4){0.f, 0.f, 0.f, 0.f};
    for (int k0 = 0; k0 < K; k0 += 32) {
        const uint4 va0 = *(const uint4*)(ap0 + k0), va1 = *(const uint4*)(ap1 + k0), vb0 = *(const uint4*)(bp0 + k0), vb1 = *(const uint4*)(bp1 + k0);
        __syncthreads();
        *(uint4*)&As[lr0][lc] = va0; *(uint4*)&As[lr1][lc] = va1; *(uint4*)&Bs[lr0][lc] = vb0; *(uint4*)&Bs[lr1][lc] = vb1;
        __syncthreads();
        bf16x8 af[4], bfr[4];
#pragma unroll
        for (int i = 0; i < 4; ++i) af[i] = *(const bf16x8*)&As[wm * 64 + i * 16 + (lane & 15)][8 * (lane >> 4)];
#pragma unroll
        for (int j = 0; j < 4; ++j) bfr[j] = *(const bf16x8*)&Bs[wn * 64 + j * 16 + (lane & 15)][8 * (lane >> 4)];
#pragma unroll
        for (int i = 0; i < 4; ++i)
#pragma unroll
            for (int j = 0; j < 4; ++j) acc[i][j] = __builtin_amdgcn_mfma_f32_16x16x32_bf16(af[i], bfr[j], acc[i][j], 0, 0, 0);
    }
#pragma unroll
    for (int i = 0; i < 4; ++i)
#pragma unroll
        for (int j = 0; j < 4; ++j)
#pragma unroll
            for (int r = 0; r < 4; ++r) E(row0 + wm * 64 + i * 16 + 4 * (lane >> 4) + r, col0 + wn * 64 + j * 16 + (lane & 15), acc[i][j][r], e);
}

struct EpiStoreBf16 { bf16_t* O; int ldo; int pad;
    __device__ __forceinline__ void operator()(int row, int col, float v, int) const { O[(size_t)row * ldo + col] = (bf16_t)f2bf(v); } };
struct EpiResF32 { const float* base; float* O; int ldo; int pad;
    __device__ __forceinline__ void operator()(int row, int col, float v, int) const { const size_t i = (size_t)row * ldo + col; O[i] = base[i] + v; } };
struct EpiSwiglu { bf16_t* act; const float* bias;
    __device__ __forceinline__ void operator()(int row, int col, float v, int e) const {
        v += bias[(size_t)e * 2 * DFF + col];
        const float o = __shfl_xor(v, 1);
        if ((col & 1) == 0) { const float g = fminf(v, 7.0f), lin = fminf(fmaxf(o, -7.0f), 7.0f);
            const float a = g * (1.0f / (1.0f + __expf(-1.702f * g))) * (lin + 1.0f);
            act[(size_t)row * DFF + (col >> 1)] = (bf16_t)f2bf(a); } } };
struct EpiDown { bf16_t* ybuf; const float* bias; const int* slot_tk; const float* gate;
    __device__ __forceinline__ void operator()(int row, int col, float v, int e) const {
        const int tk = slot_tk[row];
        if (tk >= 0) ybuf[(size_t)tk * DM + col] = (bf16_t)f2bf(gate[tk] * (v + bias[(size_t)e * DM + col])); } };

template <int HD>
__global__ __launch_bounds__(256) void k_headnorm(bf16_t* __restrict__ p, const float* __restrict__ g, int ld, int M, int nheads, float scale) {
    const long item = (long)blockIdx.x * 4 + (threadIdx.x >> 6); const int lane = threadIdx.x & 63;
    if (item >= (long)M * nheads) return;
    const int row = (int)(item / nheads), h = (int)(item % nheads);
    bf16_t* q = p + (size_t)row * ld + h * HD;
    constexpr int PER = HD / 64;
    float v[PER]; float s = 0.f;
#pragma unroll
    for (int j = 0; j < PER; ++j) { v[j] = bf2f(q[lane * PER + j]); s += v[j] * v[j]; }
    const float rstd = 1.0f / sqrtf(wave_sum(s) * (1.0f / HD) + EPS);
#pragma unroll
    for (int j = 0; j < PER; ++j) q[lane * PER + j] = (bf16_t)f2bf(v[j] * rstd * g[lane * PER + j] * scale);
}

__global__ __launch_bounds__(64) void k_chunk_attn(const bf16_t* __restrict__ proj, const float* __restrict__ rel_bias, float* __restrict__ ya) {
    __shared__ float Ks[64][65];
    __shared__ float Vs[64][65];
    const int c = blockIdx.x, h = blockIdx.y, b = blockIdx.z, t = threadIdx.x;
    const size_t rowq = (size_t)b * SEQ + c * CHUNK + t;
    float q[64], o[64];
    { const bf16_t* qp = proj + rowq * NPROJ + h * 64;
#pragma unroll
      for (int d = 0; d < 64; ++d) { q[d] = bf2f(qp[d]); o[d] = 0.f; } }
    float m = -1e30f, l = 0.f;
    const float* rb = rel_bias + (size_t)h * NREL;
    const int kc0 = c - LEFT < 0 ? 0 : c - LEFT;
    for (int kc = kc0; kc <= c; ++kc) {
        __syncthreads();
        { const size_t rowk = (size_t)b * SEQ + kc * CHUNK + t;
          const bf16_t* kp = proj + rowk * NPROJ + DATT + h * 64; const bf16_t* vp = proj + rowk * NPROJ + 2 * DATT + h * 64;
#pragma unroll
          for (int d = 0; d < 64; ++d) { Ks[t][d] = bf2f(kp[d]); Vs[t][d] = bf2f(vp[d]); } }
        __syncthreads();
        for (int j = 0; j < 64; ++j) {
            float s = 0.f;
#pragma unroll
            for (int d = 0; d < 64; ++d) s += q[d] * Ks[j][d];
            int rel = (c * CHUNK + t) - (kc * CHUNK + j); rel = rel < -MAXREL ? -MAXREL : (rel > MAXREL ? MAXREL : rel);
            s += rb[rel + MAXREL];
            const float mn = fmaxf(m, s), f = __expf(m - mn), p = __expf(s - mn);
            l = l * f + p; m = mn;
#pragma unroll
            for (int d = 0; d < 64; ++d) o[d] = o[d] * f + p * Vs[j][d];
        }
    }
    const float il = 1.0f / l;
    float* op = ya + rowq * DATT + h * 64;
#pragma unroll
    for (int d = 0; d < 64; ++d) op[d] = o[d] * il;
}

__global__ __launch_bounds__(256) void k_conv_norm(const bf16_t* __restrict__ proj, const float* __restrict__ ya, const float* __restrict__ conv_w,
                                                   const float* __restrict__ ga, const float* __restrict__ gb, bf16_t* __restrict__ yb) {
    const int row = blockIdx.x * 4 + (threadIdx.x >> 6), lane = threadIdx.x & 63;
    const int s = row % SEQ;
    float a[8], cv[8]; float sa = 0.f, sb = 0.f;
    const float* yap = ya + (size_t)row * DATT + lane * 8;
#pragma unroll
    for (int j = 0; j < 8; ++j) { a[j] = yap[j]; sa += a[j] * a[j]; }
#pragma unroll
    for (int j = 0; j < 8; ++j) {
        const int ch = lane * 8 + j; float acc = 0.f;
#pragma unroll
        for (int tap = 0; tap < 3; ++tap) { const int ds = 2 - tap;
            if (s - ds >= 0) { const bf16_t* pr = proj + (size_t)(row - ds) * NPROJ;
                const float u = bf2f(pr[3 * DATT + DCONV + ch]) * bf2f(pr[3 * DATT + 2 * DCONV + ch]);
                acc += conv_w[tap * DCONV + ch] * u; } }
        cv[j] = bf2f(proj[(size_t)row * NPROJ + 3 * DATT + ch]) * acc; sb += cv[j] * cv[j];
    }
    const float ra = 1.0f / sqrtf(wave_sum(sa) * (1.0f / DATT) + EPS), rb = 1.0f / sqrtf(wave_sum(sb) * (1.0f / DCONV) + EPS);
    bf16_t* o = yb + (size_t)row * DM;
#pragma unroll
    for (int j = 0; j < 8; ++j) { const int ch = lane * 8 + j; o[ch] = (bf16_t)f2bf(a[j] * ra * ga[ch]); o[DATT + ch] = (bf16_t)f2bf(cv[j] * rb * gb[ch]); }
}

__global__ __launch_bounds__(64) void k_xattn(const bf16_t* __restrict__ qx, const bf16_t* __restrict__ kvmem, bf16_t* __restrict__ ox) {
    __shared__ float Ks[32][129];
    __shared__ float Vs[32][129];
    const int qt = blockIdx.x, h = blockIdx.y, b = blockIdx.z, t = threadIdx.x, qi = t & 31, half = t >> 5;
    const size_t rowq = (size_t)b * SEQ + qt * 32 + qi;
    float q[64], o[64];
    { const bf16_t* qp = qx + rowq * DX + h * XHD + half * 64;
#pragma unroll
      for (int d = 0; d < 64; ++d) { q[d] = bf2f(qp[d]); o[d] = 0.f; } }
    float m = -1e30f, l = 0.f;
    for (int kt = 0; kt < NMEM / 32; ++kt) {
        __syncthreads();
        { const size_t rowk = (size_t)b * NMEM + kt * 32 + qi;
          const bf16_t* kp = kvmem + rowk * (2 * DX) + h * XHD + half * 64; const bf16_t* vp = kvmem + rowk * (2 * DX) + DX + h * XHD + half * 64;
#pragma unroll
          for (int d = 0; d < 64; ++d) { Ks[qi][half * 64 + d] = bf2f(kp[d]); Vs[qi][half * 64 + d] = bf2f(vp[d]); } }
        __syncthreads();
        for (int j = 0; j < 32; ++j) {
            float s = 0.f;
#pragma unroll
            for (int d = 0; d < 64; ++d) s += q[d] * Ks[j][half * 64 + d];
            s += __shfl_xor(s, 32);
            const float mn = fmaxf(m, s), f = __expf(m - mn), p = __expf(s - mn);
            l = l * f + p; m = mn;
#pragma unroll
            for (int d = 0; d < 64; ++d) o[d] = o[d] * f + p * Vs[j][half * 64 + d];
        }
    }
    const float il = 1.0f / l;
    bf16_t* op = ox + rowq * DX + h * XHD + half * 64;
#pragma unroll
    for (int d = 0; d < 64; ++d) op[d] = (bf16_t)f2bf(o[d] * il);
}

__global__ __launch_bounds__(256) void k_route(const float* __restrict__ x2, const float* __restrict__ g, const float* __restrict__ wr, const float* __restrict__ br,
                                               unsigned* __restrict__ cnt, int* __restrict__ list, float* __restrict__ gate) {
    __shared__ float xs[4][DM];
    const int w = threadIdx.x >> 6, lane = threadIdx.x & 63, tok = blockIdx.x * 4 + w;
    { const f32x4* xr = (const f32x4*)(x2 + (size_t)tok * DM) + lane; const f32x4* gr = (const f32x4*)g + lane;
      f32x4 v[4]; float s = 0.f;
#pragma unroll
      for (int j = 0; j < 4; ++j) { v[j] = xr[64 * j]; s += v[j].x * v[j].x + v[j].y * v[j].y + v[j].z * v[j].z + v[j].w * v[j].w; }
      const float rstd = 1.0f / sqrtf(wave_sum(s) * (1.0f / DM) + EPS);
#pragma unroll
      for (int j = 0; j < 4; ++j) { const f32x4 gg = gr[64 * j]; float* d = &xs[w][(lane + 64 * j) * 4];
          d[0] = v[j].x * rstd * gg.x; d[1] = v[j].y * rstd * gg.y; d[2] = v[j].z * rstd * gg.z; d[3] = v[j].w * rstd * gg.w; } }
    __syncthreads();
    const int e = lane & 31, half = lane >> 5;
    float s = 0.f;
    for (int k = half * 512; k < half * 512 + 512; ++k) s += xs[w][k] * wr[(size_t)k * NE + e];
    s += __shfl_xor(s, 32);
    float logit = s + br[e];
    float tv[4]; int ti[4];
#pragma unroll
    for (int r = 0; r < 4; ++r) {
        float bv = logit; int bi = e;
#pragma unroll
        for (int o = 1; o < 32; o <<= 1) { const float ov = __shfl_xor(bv, o); const int oi = __shfl_xor(bi, o);
            if (ov > bv || (ov == bv && oi < bi)) { bv = ov; bi = oi; } }
        tv[r] = bv; ti[r] = bi; if (e == bi) logit = -3.0e38f;
    }
    const float e1 = __expf(tv[1] - tv[0]), e2 = __expf(tv[2] - tv[0]), e3 = __expf(tv[3] - tv[0]); const float inv = 1.0f / (1.0f + e1 + e2 + e3);
    if (lane < 4) { const int ek = lane == 0 ? ti[0] : lane == 1 ? ti[1] : lane == 2 ? ti[2] : ti[3];
        const float gk = (lane == 0 ? 1.0f : lane == 1 ? e1 : lane == 2 ? e2 : e3) * inv;
        const unsigned pos = atomicAdd(&cnt[ek], 1u);
        list[(size_t)ek * MTOK + pos] = tok * 4 + lane; gate[tok * 4 + lane] = gk; }
}
__global__ __launch_bounds__(64) void k_plan(unsigned* __restrict__ ctl, int* __restrict__ blk_e) {
    const int lane = threadIdx.x; const unsigned c = lane < NE ? ctl[CW_CNT + lane] : 0u; const unsigned nb = (c + 255u) >> 8;
    unsigned inc = nb;
#pragma unroll
    for (int o = 1; o < 64; o <<= 1) { const unsigned t = __shfl_up(inc, o); if (lane >= o) inc += t; }
    const unsigned start = inc - nb;
    if (lane < NE) { ctl[CW_PSTART + lane] = start; for (unsigned b = 0; b < nb; ++b) blk_e[start + b] = lane; }
    if (lane == 63) ctl[CW_NBLK] = inc;
}
__global__ __launch_bounds__(256) void k_fill(const unsigned* __restrict__ ctl, const int* __restrict__ list, int* __restrict__ slot_tk, int* __restrict__ slot_src) {
    const int e = blockIdx.y, j = blockIdx.x * 256 + threadIdx.x; const unsigned c = ctl[CW_CNT + e], nb = (c + 255u) >> 8, start = ctl[CW_PSTART + e];
    if ((unsigned)j >= nb * 256u) return;
    const int tk = (unsigned)j < c ? list[(size_t)e * MTOK + j] : -1;
    slot_tk[start * 256 + j] = tk; slot_src[start * 256 + j] = tk >= 0 ? (tk >> 2) : 0;
}
__global__ __launch_bounds__(256) void k_combine(float* __restrict__ out, const bf16_t* __restrict__ ybuf) {
    const size_t i = ((size_t)blockIdx.x * 256 + threadIdx.x) * 4;
    const size_t tok = i / DM, col = i % DM;
    f32x4 v = *(const f32x4*)(out + i);
#pragma unroll
    for (int k = 0; k < 4; ++k) { const uint2 y = *(const uint2*)(ybuf + (tok * 4 + k) * DM + col);
        v.x += bf2f((bf16_t)(y.x & 0xffff)); v.y += bf2f((bf16_t)(y.x >> 16)); v.z += bf2f((bf16_t)(y.y & 0xffff)); v.w += bf2f((bf16_t)(y.y >> 16)); }
    *(f32x4*)(out + i) = v;
}


#ifndef QSCALE_V
#define QSCALE_V (0.125f * LOG2E)
#endif
__global__ void __launch_bounds__(NWAVES * 64, 2) mk_fwd(Args args) {
    extern __shared__ __attribute__((aligned(16))) unsigned char lds_raw[];
    Frame F; F.lds = (LAS unsigned char*)lds_raw; F.tid = threadIdx.x; F.lane = F.tid & 63; F.wave = __builtin_amdgcn_readfirstlane(F.tid >> 6); F.G = gridDim.x;
    { const int bx = blockIdx.x; F.vcu = (F.G % 8 == 0) ? (bx % 8) * (F.G / 8) + bx / 8 : bx; }
    unsigned char* ws = args.ws; unsigned* ctl = (unsigned*)(ws + WS_CTL);
    for (int u = F.tid; u < (LDS_BYTES - LDSCTL_OFF) / 4; u += NWAVES * 64) ((LAS unsigned*)(F.lds + LDSCTL_OFF))[u] = 0u;
    __syncthreads();
    volatile LAS unsigned* MISC = (volatile LAS unsigned*)(F.lds + MISC_OFF);
    XcdBarrier bar = xcd_barrier_post(ctl + CW_BAR + args.li * XCD_BAR_WORDS, MISC + 8);
    const int lo = args.ph_lo, hi = args.ph_hi;
#define IN(k) (lo <= (k) && (k) < hi)
#define BOTH(k) (IN(k) && IN((k) + 1))
    bf16_t *Win = (bf16_t*)(ws + WS_WIN), *Wxkv = (bf16_t*)(ws + WS_WXKV), *Wout = (bf16_t*)(ws + WS_WOUT), *Wxq = (bf16_t*)(ws + WS_WXQ), *Wxo = (bf16_t*)(ws + WS_WXO);
    bf16_t *yb = (bf16_t*)(ws + WS_YB), *qx = (bf16_t*)(ws + WS_QX), *ox = (bf16_t*)(ws + WS_OX);
    float *x1 = (float*)(ws + WS_X1), *sq1 = (float*)(ws + WS_SQ1), *sq2 = (float*)(ws + WS_SQ2), *rstd2 = (float*)(ws + WS_RSTD2), *gate = (float*)(ws + WS_GATE);
    bf16_t *Wrt = (bf16_t*)(ws + WS_WRT), *Wgu = (bf16_t*)(ws + WS_WGU), *Wdn = (bf16_t*)(ws + WS_WDN), *act = (bf16_t*)(ws + WS_ACT), *ybuf = (bf16_t*)(ws + WS_YBUF);
    int* list = (int*)(ws + WS_LIST); LAS unsigned* mtab = (LAS unsigned*)(F.lds + MOE_OFF);
    bf16_t *hb = (bf16_t*)(ws + WS_HB), *hmb = (bf16_t*)(ws + WS_HMB), *proj = (bf16_t*)(ws + WS_PROJ), *kvmem = (bf16_t*)(ws + WS_KVMEM);
    const int gw = F.vcu * NWAVES + F.wave, NGW = F.G * NWAVES;

    if (IN(0)) {
        LAS float* scr = (LAS float*)(F.lds + RING_OFF + F.wave * 16384);
        constexpr int IT_IN = (DM / 64) * (NPROJ / 32), IT_XKV = (DM / 64) * (2 * DX / 32), IT_OUT = (DM / 64) * (DM / 32), IT_XQ = (DM / 64) * (DX / 32), IT_XO = (DX / 64) * (DM / 32), IT_RT = DM / 64, IT_GU = NE * (DM / 64) * (2 * DFF / 32), IT_DN = NE * (DFF / 64) * (DM / 32);
        for (int it = gw; it < IT_IN + IT_XKV + IT_OUT + IT_XQ + IT_XO + IT_RT + IT_GU + IT_DN; it += NGW) {
            int r = it;
            if (r < IT_IN) { const int kb = r / (NPROJ / 32), nb = r % (NPROJ / 32); const int pn = nb >> 3, bj = (nb >> 2) & 1, wc = nb & 3;
                p0_transpose_item(args.in[I_W_IN], NPROJ, DM, Win, 64 * kb, 256 * pn + 64 * wc + 32 * bj, 1, 32 * nb, nullptr, scr, F.lane); continue; }
            r -= IT_IN;
            if (r < IT_XKV) { const int kb = r / (2 * DX / 32), nb = r % (2 * DX / 32);
                p0_transpose_item(args.in[I_W_XKV], 2 * DX, DM, Wxkv, 64 * kb, 32 * nb, 1, 32 * nb, nullptr, scr, F.lane); continue; }
            r -= IT_XKV;
            if (r < IT_OUT) { const int kb = r / (DM / 32), nb = r % (DM / 32);
                p0_transpose_item(args.in[I_W_OUT], DM, DM, Wout, 64 * kb, 32 * nb, 1, 32 * nb, nullptr, scr, F.lane); continue; }
            r -= IT_OUT;
            if (r < IT_XQ) { const int kb = r / (DX / 32), nb = r % (DX / 32);
                p0_transpose_item(args.in[I_W_XQ], DX, DM, Wxq, 64 * kb, 32 * nb, 1, 32 * nb, args.in[I_NORM_X_G], scr, F.lane); continue; }
            r -= IT_XQ;
            if (r < IT_XO) { const int kb = r / (DM / 32), nb = r % (DM / 32);
                p0_transpose_item(args.in[I_W_XO], DM, DX, Wxo, 64 * kb, 32 * nb, 1, 32 * nb, nullptr, scr, F.lane); continue; }
            r -= IT_XO;
            if (r < IT_RT) { p0_transpose_item(args.in[I_W_ROUTER], NE, DM, Wrt, 64 * r, 0, 1, 0, args.in[I_NORM_FFN_G], scr, F.lane); continue; }
            r -= IT_RT;
            if (r < IT_GU) { constexpr int PER_E = (DM / 64) * (2 * DFF / 32); const int e = r / PER_E, rr = r % PER_E, kb = rr / (2 * DFF / 32), nb = rr % (2 * DFF / 32);
                const int pn = nb >> 3, bj = (nb >> 2) & 1, cg = nb & 3;
                p0_transpose_item(args.in[I_W_GU] + (size_t)e * DM * 2 * DFF, 2 * DFF, DM, Wgu + (size_t)e * 2 * DFF * DM, 64 * kb, 2 * (128 * pn + 32 * cg) + bj, 2, 32 * nb, args.in[I_NORM_FFN_G], scr, F.lane); continue; }
            r -= IT_GU;
            { constexpr int PER_E = (DFF / 64) * (DM / 32); const int e = r / PER_E, rr = r % PER_E, kb = rr / (DM / 32), nb = rr % (DM / 32);
                p0_transpose_item(args.in[I_W_DN] + (size_t)e * DFF * DM, DM, DFF, Wdn + (size_t)e * DM * DFF, 64 * kb, 32 * nb, 1, 32 * nb, nullptr, scr, F.lane); }
        }
        for (int m = gw; m < MTOK; m += NGW) rms_row_to_bf16(args.in[I_X] + (size_t)m * DM, args.in[I_NORM_MIX_G], hb + (size_t)m * DM, F.lane);
        for (int m = gw; m < MMEM; m += NGW) rms_row_to_bf16(args.in[I_MEM] + (size_t)m * DM, args.in[I_NORM_MEM_G], hmb + (size_t)m * DM, F.lane);
        if (BOTH(0)) xcd_barrier(bar);
    }
    if (IN(1)) {
        { pg8::DenseSched S; S.init(hb, Win, MTOK, NPROJ, DM, F.G, (int)blockIdx.x); EpiProj E{proj, args.in[I_Q_G], args.in[I_K_G], QSCALE_V, 0};
          pg8::gemm_phase<EpiProj, pg8::DenseSched, 0>(F.lds + RING_OFF, F.lds + IDX_OFF, S, E); }
        { pg8::DenseSched S; S.init(hmb, Wxkv, MMEM, 2 * DX, DM, F.G, (int)blockIdx.x); EpiBf16 E{kvmem, 2 * DX, 0};
          pg8::gemm_phase<EpiBf16, pg8::DenseSched, 0>(F.lds + RING_OFF, F.lds + IDX_OFF, S, E); }
        if (BOTH(1)) xcd_barrier(bar);
    }
    if (IN(2)) {
        p2_attn(F, proj, args.in[I_REL_BIAS], args.in[I_CONV_W], args.in[I_ONA_G], args.in[I_ONB_G], yb, kvmem, args.in[I_XK_G]);
        if (BOTH(2)) xcd_barrier(bar);
    }
    if (IN(3)) {
        pg8::DenseSched S; S.init(yb, Wout, MTOK, DM, DM, F.G, (int)blockIdx.x); EpiRes E{args.in[I_X], x1, hb, sq1};
        pg8::gemm_phase<EpiRes, pg8::DenseSched, 0>(F.lds + RING_OFF, F.lds + IDX_OFF, S, E);
        if (BOTH(3)) xcd_barrier(bar);
    }
    if (IN(4)) {
        pg8::DenseSched S; S.init(hb, Wxq, MTOK, DX, DM, F.G, (int)blockIdx.x); EpiRstdBf16 E{qx, sq1, DX, 0};
        pg8::gemm_phase<EpiRstdBf16, pg8::DenseSched, 0>(F.lds + RING_OFF, F.lds + IDX_OFF, S, E);
        if (BOTH(4)) xcd_barrier(bar);
    }
    if (IN(5)) {
        p5_xattn(F, qx, kvmem, args.in[I_XQ_G], ox);
        if (BOTH(5)) xcd_barrier(bar);
    }
    if (IN(6)) {
        pg8::DenseSched S; S.init(ox, Wxo, MTOK, DM, DX, F.G, (int)blockIdx.x); EpiRes E{x1, args.out, hb, sq2};
        pg8::gemm_phase<EpiRes, pg8::DenseSched, 0>(F.lds + RING_OFF, F.lds + IDX_OFF, S, E);
        if (BOTH(6)) xcd_barrier(bar);
    }
    if (IN(7)) {
        p7_route(F, hb, Wrt, sq2, args.in[I_B_ROUTER], ctl + CW_CNT, list, gate, rstd2);
        if (BOTH(7)) xcd_barrier(bar);
    }
    if (IN(8)) {
        moe_tables(ctl + CW_CNT, mtab, F.tid);
        MoeSched S{(const char*)hb, (const char*)Wgu, (size_t)2 * DFF * DM * 2, list, mtab, DM, 2 * DFF / 256, (int)mtab[32 + NE], F.G, (int)blockIdx.x, 1};
        EpiSwiglu2 E{act, args.in[I_B_GU], rstd2, mtab};
        pg8::gemm_phase<EpiSwiglu2, MoeSched, 2>(F.lds + RING_OFF, F.lds + IDX_OFF, S, E);
        if (BOTH(8)) xcd_barrier(bar);
    }
    if (IN(9)) {
        moe_tables(ctl + CW_CNT, mtab, F.tid);
        MoeSched S{(const char*)act, (const char*)Wdn, (size_t)DM * DFF * 2, list, mtab, DFF, DM / 256, (int)mtab[32 + NE], F.G, (int)blockIdx.x, 0};
        EpiDown2 E{ybuf, args.in[I_B_DN], gate, mtab};
        pg8::gemm_phase<EpiDown2, MoeSched, 1>(F.lds + RING_OFF, F.lds + IDX_OFF, S, E);
        if (BOTH(9)) xcd_barrier(bar);
    }
    if (IN(10)) p10_combine(F, args.out, ybuf);
#undef IN
#undef BOTH
}

static int g_grid = 0;
static void launch_mk(Args& a, int lo, int hi, int li, hipStream_t stream) {
    a.ph_lo = lo; a.ph_hi = hi; a.li = li; a.pad = 0;
    hipLaunchKernelGGL(mk_fwd, dim3(g_grid), dim3(NWAVES * 64), LDS_BYTES, stream, a);
}
extern "C" void kernel_launch(void* const* d_in, const int* in_sizes, int n_in, void* d_out, int out_size, void* d_ws, size_t ws_size, hipStream_t stream) {
    if (n_in != 25 || ws_size < WS_END || out_size != MTOK * DM) { fprintf(stderr, "kernel_launch: unexpected problem (n_in %d ws %zu out %d)\n", n_in, ws_size, out_size); return; }
    if (g_grid == 0) {
        int dev = 0, cus = 0;
        if (hipGetDevice(&dev) != hipSuccess || hipDeviceGetAttribute(&cus, hipDeviceAttributeMultiprocessorCount, dev) != hipSuccess) { g_grid = -1; return; }
        if (hipFuncSetAttribute((const void*)mk_fwd, hipFuncAttributeMaxDynamicSharedMemorySize, LDS_BYTES) != hipSuccess) { g_grid = -1; return; }
        int per_cu = 0; (void)hipOccupancyMaxActiveBlocksPerMultiprocessor(&per_cu, (const void*)mk_fwd, NWAVES * 64, LDS_BYTES); (void)hipGetLastError();
        g_grid = (per_cu >= 1) ? cus : -1;
    }
    if (g_grid < 0) return;
    const float* x = (const float*)d_in[0]; const float* rel_bias = (const float*)d_in[6]; const float* conv_w = (const float*)d_in[7];
    const float* out_norm_a_g = (const float*)d_in[8]; const float* out_norm_b_g = (const float*)d_in[9]; const float* w_out = (const float*)d_in[10]; const float* norm_xattn_g = (const float*)d_in[11];
    const float* w_xq = (const float*)d_in[13]; const float* xq_norm_g = (const float*)d_in[15];
    const float* xk_norm_g = (const float*)d_in[16]; const float* w_xo = (const float*)d_in[17]; const float* norm_ffn_g = (const float*)d_in[18]; const float* w_router = (const float*)d_in[19];
    const float* b_router = (const float*)d_in[20]; const float* w_gate_up = (const float*)d_in[21]; const float* b_gate_up = (const float*)d_in[22]; const float* w_down = (const float*)d_in[23];
    const float* b_down = (const float*)d_in[24];
    unsigned char* ws = (unsigned char*)d_ws; float* out = (float*)d_out;
    unsigned* ctl = (unsigned*)(ws + WS_CTL);
    bf16_t *Wout = (bf16_t*)(ws + WS_WOUT), *Wxq = (bf16_t*)(ws + WS_WXQ), *Wxo = (bf16_t*)(ws + WS_WXO), *Wgu = (bf16_t*)(ws + WS_WGU), *Wdn = (bf16_t*)(ws + WS_WDN);
    bf16_t *hb = (bf16_t*)(ws + WS_HB), *proj = (bf16_t*)(ws + WS_PROJ), *kvmem = (bf16_t*)(ws + WS_KVMEM), *yb = (bf16_t*)(ws + WS_YB), *qx = (bf16_t*)(ws + WS_QX), *ox = (bf16_t*)(ws + WS_OX);
    bf16_t *act = (bf16_t*)(ws + WS_ACT), *ybuf = (bf16_t*)(ws + WS_YBUF);
    float *ya = (float*)(ws + WS_YA), *x1 = (float*)(ws + WS_X1), *gate = (float*)(ws + WS_GATE);
    int *list = (int*)(ws + WS_LIST), *slot_tk = (int*)(ws + WS_SLOTTK), *slot_src = (int*)(ws + WS_SLOTSRC), *blk_e = (int*)(ws + WS_BLKE);

    (void)hipMemsetAsync(ctl, 0, CTL_ZERO_BYTES, stream);
    Args a{}; for (int i = 0; i < 25; ++i) a.in[i] = (const float*)d_in[i]; a.out = out; a.ws = ws;
    launch_mk(a, 0, 11, 0, stream);
}
```

```cpp
#include <hip/hip_runtime.h>
#include <stdint.h>
#include <stdio.h>

#define LAS __attribute__((address_space(3)))
#define GAS __attribute__((address_space(1)))
typedef unsigned short bf16_t;
typedef short bf16x8 __attribute__((ext_vector_type(8)));
typedef float f32x4 __attribute__((ext_vector_type(4)));
typedef float f32x16 __attribute__((ext_vector_type(16)));
typedef unsigned u32x4 __attribute__((ext_vector_type(4)));
typedef unsigned u32x2 __attribute__((ext_vector_type(2)));

constexpr int DM = 1024, BATCH = 16, SEQ = 2048, MTOK = BATCH * SEQ;
constexpr int CHUNK = 64, LEFT = 8, NMEM = 256, MMEM = BATCH * NMEM;
constexpr int DATT = 512, DCONV = 512, NPROJ = 3072;
constexpr int XH = 4, XHD = 128, DX = 512;
constexpr int NE = 32, TOPK = 4, DFF = 1024;
constexpr int NREL = 513, MAXREL = 256;
constexpr int NASSIGN = MTOK * TOPK;
constexpr int MAXSLOT = NASSIGN + NE * 256;
constexpr float EPS = 1e-6f;
constexpr float LOG2E = 1.4426950408889634f;

constexpr size_t MiB = 1u << 20;
constexpr size_t WS_CTL = 0, CTL_ZERO_BYTES = 256 * 1024;
constexpr size_t WS_WIN = 1 * MiB, WS_WOUT = 7 * MiB, WS_WXQ = 9 * MiB, WS_WXKV = 10 * MiB, WS_WXO = 12 * MiB, WS_WGU = 13 * MiB, WS_WDN = 141 * MiB;
constexpr size_t WS_HB = 205 * MiB, WS_HMB = 269 * MiB;
constexpr size_t WS_LIST = 277 * MiB, WS_GATE = 281 * MiB, WS_SLOTTK = 282 * MiB, WS_SLOTSRC = 283 * MiB, WS_BLKE = 284 * MiB;
constexpr size_t WS_PROJ = 285 * MiB, WS_KVMEM = 477 * MiB, WS_YA = 485 * MiB, WS_YB = 549 * MiB, WS_X1 = 613 * MiB, WS_QX = 741 * MiB, WS_OX = 773 * MiB;
constexpr size_t WS_ACT = 285 * MiB, WS_YBUF = 557 * MiB;
constexpr size_t WS_SQ1 = 813 * MiB, WS_SQ2 = 815 * MiB, WS_RSTD2 = 817 * MiB, WS_WRT = 818 * MiB, WS_END = 819 * MiB;
constexpr int CW_CNT = 0, CW_NBLK = 64, CW_PSTART = 128;
constexpr int CW_BAR = 4096;

__device__ __forceinline__ unsigned f2bf(float f) { unsigned u = __builtin_bit_cast(unsigned, f); return (u + 0x7fffu + ((u >> 16) & 1u)) >> 16; }
__device__ __forceinline__ float bf2f(bf16_t b) { return __builtin_bit_cast(float, ((unsigned)b) << 16); }
__device__ __forceinline__ unsigned pk2(float lo, float hi) { return f2bf(lo) | (f2bf(hi) << 16); }
__device__ __forceinline__ float bflo(unsigned w) { return __builtin_bit_cast(float, w << 16); }
__device__ __forceinline__ float bfhi(unsigned w) { return __builtin_bit_cast(float, w & 0xffff0000u); }
__device__ __forceinline__ float wave_sum(float v) {
#pragma unroll
    for (int o = 1; o < 64; o <<= 1) v += __shfl_xor(v, o);
    return v;
}
__device__ __forceinline__ unsigned cvt_pk_bf16(float lo, float hi) { unsigned r; asm volatile("v_cvt_pk_bf16_f32 %0, %1, %2" : "=v"(r) : "v"(lo), "v"(hi)); return r; }

namespace pg8 {
constexpr int BM = 256, BK = 64, HALF = 128, HTB = HALF * BK * 2  , STAGE_BYTES = 8 * HTB, NXCD = 8, WGM = 8;
__host__ __device__ __forceinline__ int lds_byte(int r, int c) { const int st = (r >> 4) * 2 + (c >> 5), rr = r & 15, cc = c & 31, ob = rr * 64 + cc * 2; return st * 1024 + (ob ^ (((ob >> 9) & 1) << 5)); }
__host__ __device__ __forceinline__ void stage_rc(int b, int& R, int& C) { const int st = b / 1024, sb = b % 1024, swz = sb ^ (((sb >> 9) & 1) << 5); R = (st >> 1) * 16 + swz / 64; C = (st & 1) * 32 + (swz % 64) / 2; }
__host__ __device__ __forceinline__ int perm32(int rho) { const int n = rho >> 4, i = rho & 15; return 8 * (i >> 2) + 4 * n + (i & 3); }

struct Unit { int pm, pn, e, rbl; };

__device__ __forceinline__ bool static_order(int nM, int nN, int G, int c, int i, int& pm, int& pn) {
    const int nwg = nM * nN; const long L = (long)i * G + c; if (L >= nwg) return false;
    int wgid = (int)L; { const int q = nwg / NXCD, r = nwg % NXCD, xcd = wgid % NXCD, off = wgid / NXCD; wgid = (xcd < r ? xcd * (q + 1) : r * (q + 1) + (xcd - r) * q) + off; }
    const int nig = WGM * nN, gid = wgid / nig, fm = gid * WGM, gsz = (nM - fm) < WGM ? (nM - fm) : WGM;
    pm = fm + ((wgid % nig) % gsz); pn = (wgid % nig) / gsz; return true;
}
struct DenseSched {
    const char* A; const char* Bt; int K, nM, nN, G, c;
    __device__ __forceinline__ void init(const void* A_, const void* Bt_, int M, int N, int K_, int G_, int c_) { A = (const char*)A_; Bt = (const char*)Bt_; K = K_; nM = M / BM; nN = N / BM; G = G_; c = c_; }
    __device__ __forceinline__ bool next(int i, Unit& u) const { u.e = 0; u.rbl = 0; return static_order(nM, nN, G, c, i, u.pm, u.pn); }
    __device__ __forceinline__ const char* a_base(const Unit& u) const { return A + (size_t)u.pm * BM * K * 2; }
    __device__ __forceinline__ const char* b_base(const Unit& u) const { return Bt + (size_t)u.pn * BM * K * 2; }
    __device__ __forceinline__ void issue_rows(const Unit&, LAS unsigned char*, int, int) const {}
    __device__ __forceinline__ void read_rows(const Unit&, const LAS unsigned char*, int, unsigned (&)[4]) const {}
};

template <class Epi, class Sched, int MODE>
__device__ __forceinline__ void gemm_phase(LAS unsigned char* lds, LAS unsigned char* ldsidx, const Sched& S, const Epi& E) {
    const int tid = threadIdx.x, wid = __builtin_amdgcn_readfirstlane(tid >> 6), lane = tid & 63, wr = wid >> 2, wc = wid & 3, fr = lane & 15, fq = lane >> 4;
    const int K = S.K, nt = K / BK;
    int R0, C0; stage_rc(tid * 16, R0, C0);
    const int Rb = (R0 & ~31) + perm32(R0 & 31);
    const unsigned voffB0 = (unsigned)(Rb * K + C0) * 2u, voffB1 = voffB0 + (unsigned)(64 * K) * 2u;
    const size_t kstep = (size_t)(BK * 2);
    const size_t hstep = (size_t)HALF * K * 2;
    const unsigned ldsw = (unsigned)wid * 1024u;
    const int aoff = lds_byte(wr * 64 + fr, fq * 8), boff = lds_byte(wc * 32 + fr, fq * 8);
#define PG8_SA(b, h) (((b) * 2 + (h)) * HTB)
#define PG8_SB(b, h) ((4 + (b) * 2 + (h)) * HTB)
#define PG8_STAGE(bufoff, gbase, o0, o1) do { \
        __builtin_amdgcn_global_load_lds((const unsigned*)((const char*)(gbase) + (o0)), (LAS unsigned*)(lds + (bufoff) + ldsw), 16, 0, 0); \
        __builtin_amdgcn_global_load_lds((const unsigned*)((const char*)(gbase) + (o1)), (LAS unsigned*)(lds + (bufoff) + ldsw + 8192), 16, 0, 0); } while (0)
#define PG8_LDA(dst, b, h) do { _Pragma("unroll") for (int m = 0; m < 4; ++m) _Pragma("unroll") for (int k = 0; k < 2; ++k) dst[m][k] = *(const LAS bf16x8*)(lds + PG8_SA(b, h) + aoff + m * 2048 + k * 1024); } while (0)
#define PG8_LDB(dst, b, h) do { _Pragma("unroll") for (int n = 0; n < 2; ++n) _Pragma("unroll") for (int k = 0; k < 2; ++k) dst[n][k] = *(const LAS bf16x8*)(lds + PG8_SB(b, h) + boff + n * 2048 + k * 1024); } while (0)
#define PG8_MMA(ai, bj, At, Bt) do { __builtin_amdgcn_s_setprio(1); _Pragma("unroll") for (int m = 0; m < 4; ++m) _Pragma("unroll") for (int n = 0; n < 2; ++n) _Pragma("unroll") for (int k = 0; k < 2; ++k) \
        acc[ai][bj][m][n] = __builtin_amdgcn_mfma_f32_16x16x32_bf16(Bt[n][k], At[m][k], acc[ai][bj][m][n], 0, 0, 0); __builtin_amdgcn_s_setprio(0); } while (0)
#define PG8_WAIT_V(n) asm volatile("s_waitcnt vmcnt(" #n ")" ::: "memory")
#define PG8_WAIT_L(n) asm volatile("s_waitcnt lgkmcnt(" #n ")" ::: "memory")
#define PG8_BAR __builtin_amdgcn_s_barrier()
#define PG8_SCHED __builtin_amdgcn_sched_barrier(0)
    Unit cur, nxt; int ui = 0, ib = 0;
    if (!S.next(0, cur)) return;
    unsigned vc[4], vn[4];
    constexpr bool GATHER = (MODE == 2);
    if constexpr (MODE >= 1) { S.issue_rows(cur, ldsidx, wid, lane); asm volatile("s_waitcnt vmcnt(0)" ::: "memory"); __builtin_amdgcn_s_barrier(); asm volatile("" ::: "memory"); }
    if constexpr (GATHER) { S.read_rows(cur, ldsidx, R0, vc); _Pragma("unroll") for (int q = 0; q < 4; ++q) vc[q] += (unsigned)C0 * 2u; }
    else { _Pragma("unroll") for (int q = 0; q < 4; ++q) vc[q] = (unsigned)((R0 + 64 * q) * K + C0) * 2u; }
#pragma unroll
    for (int q = 0; q < 4; ++q) vn[q] = vc[q];
    f32x4 acc[2][2][4][2];
#pragma unroll
    for (int a = 0; a < 2; ++a)
#pragma unroll
        for (int b = 0; b < 2; ++b)
#pragma unroll
            for (int m = 0; m < 4; ++m)
#pragma unroll
                for (int n = 0; n < 2; ++n) acc[a][b][m][n] = (f32x4){0.f, 0.f, 0.f, 0.f};
    bf16x8 At[4][2], B0[2][2], B1[2][2];
    const char* cA = S.a_base(cur); const char* cB = S.b_base(cur);
    PG8_STAGE(PG8_SB(0, 0), cB, voffB0, voffB1); PG8_STAGE(PG8_SB(0, 1), cB + hstep, voffB0, voffB1); PG8_STAGE(PG8_SA(0, 0), cA, vc[0], vc[1]); PG8_STAGE(PG8_SA(0, 1), cA, vc[2], vc[3]);
    if (wr == 1) PG8_BAR;
    PG8_WAIT_V(2); PG8_BAR;
    PG8_STAGE(PG8_SB(1, 0), cB + kstep, voffB0, voffB1); PG8_STAGE(PG8_SA(1, 0), cA + kstep, vc[0], vc[1]); PG8_STAGE(PG8_SB(1, 1), cB + hstep + kstep, voffB0, voffB1);
    PG8_WAIT_V(6); PG8_BAR;
    for (;;) {
        const bool has_next = S.next(ui + 1, nxt);
        if constexpr (MODE >= 1) { if (has_next) S.issue_rows(nxt, ldsidx + (ib == 2 ? 0 : ib + 1) * 1024, wid, lane); }
        const char* nA = has_next ? S.a_base(nxt) : cA; const char* nB = has_next ? S.b_base(nxt) : cB;
        for (int t = 0; t < nt; t += 2) {
            const bool last = (t == nt - 2);
            const char* a1 = cA + (size_t)(t + 1) * kstep;
            const char* a2 = last ? nA : cA + (size_t)(t + 2) * kstep; const char* b2 = last ? nB : cB + (size_t)(t + 2) * kstep;
            const char* a3 = a2 + kstep; const char* b3 = b2 + kstep;
            unsigned w0 = vc[0], w1 = vc[1], w2 = vc[2], w3 = vc[3];
            if constexpr (GATHER) { if (last && has_next) { S.read_rows(nxt, ldsidx + (ib == 2 ? 0 : ib + 1) * 1024, R0, vn); _Pragma("unroll") for (int q = 0; q < 4; ++q) vn[q] += (unsigned)C0 * 2u;
                w0 = vn[0]; w1 = vn[1]; w2 = vn[2]; w3 = vn[3]; } }
            PG8_LDB(B0, 0, 0); PG8_LDB(B1, 0, 1); PG8_SCHED; PG8_LDA(At, 0, 0); PG8_STAGE(PG8_SA(1, 1), a1, vc[2], vc[3]);
            PG8_WAIT_V(8); PG8_WAIT_L(0); PG8_BAR; PG8_MMA(0, 0, At, B0); PG8_MMA(0, 1, At, B1); PG8_BAR; PG8_SCHED;
            PG8_LDA(At, 0, 1); PG8_STAGE(PG8_SB(0, 0), b2, voffB0, voffB1); PG8_STAGE(PG8_SB(0, 1), b2 + hstep, voffB0, voffB1); PG8_STAGE(PG8_SA(0, 0), a2, w0, w1);
            PG8_WAIT_V(8); PG8_WAIT_L(0); PG8_BAR; PG8_MMA(1, 0, At, B0); PG8_MMA(1, 1, At, B1); PG8_BAR; PG8_SCHED;
            PG8_LDB(B0, 1, 0); PG8_LDB(B1, 1, 1); PG8_SCHED; PG8_LDA(At, 1, 0); PG8_STAGE(PG8_SA(0, 1), a2, w2, w3);
            PG8_WAIT_V(8); PG8_WAIT_L(0); PG8_BAR; PG8_MMA(0, 0, At, B0); PG8_MMA(0, 1, At, B1); PG8_BAR; PG8_SCHED;
            PG8_LDA(At, 1, 1); PG8_STAGE(PG8_SB(1, 0), b3, voffB0, voffB1); PG8_STAGE(PG8_SB(1, 1), b3 + hstep, voffB0, voffB1); PG8_STAGE(PG8_SA(1, 0), a3, w0, w1);
            PG8_WAIT_V(8); PG8_WAIT_L(0); PG8_BAR; PG8_MMA(1, 0, At, B0); PG8_MMA(1, 1, At, B1); PG8_BAR; PG8_SCHED;
        }
        if (wr == 0) PG8_BAR;
        E(acc, cur, wr, wc, fr, fq, (const LAS unsigned char*)(ldsidx + ib * 1024));
        if (!has_next) break;
#pragma unroll
        for (int a = 0; a < 2; ++a)
#pragma unroll
            for (int b = 0; b < 2; ++b)
#pragma unroll
                for (int m = 0; m < 4; ++m)
#pragma unroll
                    for (int n = 0; n < 2; ++n) acc[a][b][m][n] = (f32x4){0.f, 0.f, 0.f, 0.f};
        cur = nxt; cA = nA; cB = nB; ++ui; ib = (ib == 2 ? 0 : ib + 1);
#pragma unroll
        for (int q = 0; q < 4; ++q) vc[q] = vn[q];
        if (wr == 1) PG8_BAR;
    }
    PG8_WAIT_V(0);
    PG8_BAR;
#undef PG8_SA
#undef PG8_SB
#undef PG8_STAGE
#undef PG8_LDA
#undef PG8_LDB
#undef PG8_MMA
#undef PG8_WAIT_V
#undef PG8_WAIT_L
#undef PG8_BAR
#undef PG8_SCHED
}
}

#define XB_TMO      128
#define XB_XCNT(j)  (256  + 64 * (j))
#define XB_XSUB(j)  (1280 + 64 * (j))
#define XB_XGEN(j)  (2304 + 64 * (j))
#define XB_TOP      3328
#define XB_TOPGEN   3392
#define XCD_BAR_WORDS 3456
#define XB_SPIN_CAP (1u << 18)

__device__ __forceinline__ unsigned xb_ld(unsigned* p)              { return __hip_atomic_load(p, __ATOMIC_RELAXED, __HIP_MEMORY_SCOPE_AGENT); }
__device__ __forceinline__ unsigned xb_add(unsigned* p, unsigned v) { return __hip_atomic_fetch_add(p, v, __ATOMIC_RELAXED, __HIP_MEMORY_SCOPE_AGENT); }
__device__ __forceinline__ unsigned xb_xcc_id() { return (unsigned)__builtin_amdgcn_s_getreg((3 << 11) | 20) & 0xFu; }
#define XB_SPIN(cond, bar) do { unsigned _sp = 0; while (cond) { __builtin_amdgcn_s_sleep(1); \
    if ((++_sp & 255u) == 0u) { if (xb_ld(&(bar)[XB_TMO])) break; if (_sp > XB_SPIN_CAP) { atomicAdd(&(bar)[XB_TMO], 1u); break; } } } } while (0)

struct XcdBarrier {
    unsigned* bar; unsigned x;
    volatile LAS unsigned* st;
};
__device__ __forceinline__ XcdBarrier xcd_barrier_post(unsigned* bar, volatile LAS unsigned* st) {
    XcdBarrier b; b.bar = bar; b.x = xb_xcc_id(); b.st = st;
    if (threadIdx.x == 0) (void)xb_add(&bar[XB_XCNT(b.x)], 1u);
    return b;
}
__device__ __forceinline__ void xcd_barrier_complete(unsigned* bar, unsigned x, unsigned& nloc, unsigned& nx) {
    const unsigned G = gridDim.x * gridDim.y * gridDim.z;
    unsigned sum, cnt, mine, sp = 0u;
    for (;;) {
        sum = 0u; cnt = 0u; mine = 0u;
#pragma unroll
        for (unsigned j = 0; j < 16; ++j) { const unsigned c = xb_ld(&bar[XB_XCNT(j)]); sum += c; cnt += (c > 0u) ? 1u : 0u; mine = (j == x) ? c : mine; }
        if (sum == G) break;
        __builtin_amdgcn_s_sleep(1);
        if ((++sp & 255u) == 0u) { if (xb_ld(&bar[XB_TMO])) break; if (sp > XB_SPIN_CAP) { atomicAdd(&bar[XB_TMO], 1u); break; } }
    }
    nloc = mine > 0u ? mine : 1u; nx = cnt > 0u ? cnt : 1u;
}
__device__ __forceinline__ void xcd_barrier(const XcdBarrier& b) {
    asm volatile("s_waitcnt vmcnt(0)" ::: "memory");
    __syncthreads();
    if (threadIdx.x == 0) {
        unsigned* bar = b.bar;
        __builtin_amdgcn_s_waitcnt(0);
        unsigned nloc = b.st[0], nx = b.st[1];
        if (nloc == 0u) { xcd_barrier_complete(bar, b.x, nloc, nx); b.st[0] = nloc; b.st[1] = nx; }
        const unsigned old = xb_add(&bar[XB_XSUB(b.x)], 1u);
        const unsigned gen = old / nloc;
        if (old + 1u == (gen + 1u) * nloc) {
            __builtin_amdgcn_fence(__ATOMIC_RELEASE, "agent");
            asm volatile("s_waitcnt vmcnt(0)" ::: "memory");
            const unsigned og = xb_add(&bar[XB_TOP], 1u);
            const unsigned tg = og / nx;
            if (og + 1u == (tg + 1u) * nx) xb_add(&bar[XB_TOPGEN], 1u);
            else XB_SPIN(xb_ld(&bar[XB_TOPGEN]) == tg, bar);
            __builtin_amdgcn_fence(__ATOMIC_ACQUIRE, "agent");
            xb_add(&bar[XB_XGEN(b.x)], 1u);
            asm volatile("s_waitcnt vmcnt(0)" ::: "memory");
        } else {
            XB_SPIN(xb_ld(&bar[XB_XGEN(b.x)]) == gen, bar);
            __builtin_amdgcn_fence(__ATOMIC_ACQUIRE, "agent");
            asm volatile("s_waitcnt vmcnt(0)" ::: "memory");
        }
    }
    __syncthreads();
}

constexpr int NWAVES = 8;
constexpr int RING_OFF = 0, RING_BYTES = 139264;
constexpr int LDSCTL_OFF = RING_BYTES, MISC_OFF = LDSCTL_OFF + 320;
constexpr int MOE_OFF = LDSCTL_OFF + 512;
constexpr int IDX_OFF = LDSCTL_OFF + 1024;
constexpr int TBL_OFF = LDSCTL_OFF + 4096;
constexpr int SSQ_OFF = LDSCTL_OFF + 16384;
constexpr int LDS_BYTES = RING_BYTES + 20480;
static_assert(TBL_OFF + 8 * 384 * 4 <= SSQ_OFF && SSQ_OFF + 4096 <= LDS_BYTES && LDS_BYTES <= 160 * 1024, "LDS map");

struct Args { const float* in[25]; float* out; unsigned char* ws; int ph_lo, ph_hi, li, pad; };
enum { I_X = 0, I_MEM, I_NORM_MIX_G, I_W_IN, I_Q_G, I_K_G, I_REL_BIAS, I_CONV_W, I_ONA_G, I_ONB_G, I_W_OUT, I_NORM_X_G, I_NORM_MEM_G, I_W_XQ, I_W_XKV, I_XQ_G, I_XK_G, I_W_XO,
       I_NORM_FFN_G, I_W_ROUTER, I_B_ROUTER, I_W_GU, I_B_GU, I_W_DN, I_B_DN };

struct Frame {
    LAS unsigned char* lds; int tid, lane, wave, vcu, G;
};

__device__ __forceinline__ void p0_transpose_item(const float* __restrict__ W, int ldw, int K, bf16_t* __restrict__ WT, int k0, int scol0, int cstride, int drow0, const float* __restrict__ g, LAS float* scr, int lane) {
#pragma unroll 8
    for (int i = 0; i < 32; ++i) { const int kk = 2 * i + (lane >> 5); float v = W[(size_t)(k0 + kk) * ldw + scol0 + (lane & 31) * cstride]; if (g) v *= g[k0 + kk]; scr[kk * 33 + (lane & 31)] = v; }
    asm volatile("s_waitcnt lgkmcnt(0)" ::: "memory");
    const int c = lane & 7;
#pragma unroll
    for (int j = 0; j < 4; ++j) { const int n = (lane >> 3) + 8 * j; const LAS float* s = scr + (8 * c) * 33 + n;
        u32x4 o; o.x = pk2(s[0 * 33], s[1 * 33]); o.y = pk2(s[2 * 33], s[3 * 33]); o.z = pk2(s[4 * 33], s[5 * 33]); o.w = pk2(s[6 * 33], s[7 * 33]);
        *(u32x4*)(WT + (size_t)(drow0 + n) * K + k0 + 8 * c) = o; }
    asm volatile("s_waitcnt lgkmcnt(0)" ::: "memory");
}
template <int MODE>
__device__ __forceinline__ void p0_transpose64(const float* __restrict__ W, int ldw, int K, bf16_t* __restrict__ WT, int k0, int n0, int drow0, const float* __restrict__ g, LAS float* scr, int lane) {
    const int krow = lane >> 4, c4 = lane & 15;
    f32x4 v[16];
#pragma unroll
    for (int i = 0; i < 16; ++i) v[i] = *(const f32x4*)(W + (size_t)(k0 + 4 * i + krow) * ldw + n0 + 4 * c4);
    if (g) {
#pragma unroll
        for (int i = 0; i < 16; ++i) v[i] = v[i] * g[k0 + 4 * i + krow]; }
#pragma unroll
    for (int i = 0; i < 16; ++i) { LAS float* d = scr + (4 * i + krow) * 65 + 4 * c4; d[0] = v[i].x; d[1] = v[i].y; d[2] = v[i].z; d[3] = v[i].w; }
    asm volatile("s_waitcnt lgkmcnt(0)" ::: "memory");
    const int kc = lane & 7;
#pragma unroll
    for (int j = 0; j < 8; ++j) { const int n = (lane >> 3) + 8 * j; const LAS float* s = scr + (8 * kc) * 65 + n;
        u32x4 o; o.x = pk2(s[0 * 65], s[1 * 65]); o.y = pk2(s[2 * 65], s[3 * 65]); o.z = pk2(s[4 * 65], s[5 * 65]); o.w = pk2(s[6 * 65], s[7 * 65]);
        const int dr = MODE == 0 ? n : (MODE == 1 ? 128 * (n >> 5) + (n & 31) : 128 * (n & 1) + (n >> 1));
        *(u32x4*)(WT + (size_t)(drow0 + dr) * K + k0 + 8 * kc) = o; }
    asm volatile("s_waitcnt lgkmcnt(0)" ::: "memory");
}
__device__ __forceinline__ void rms_row_to_bf16(const float* __restrict__ xrow, const float* __restrict__ g, bf16_t* __restrict__ orow, int lane) {
    const f32x4* xr = (const f32x4*)xrow + lane; const f32x4* gr = (const f32x4*)g + lane;
    f32x4 v[4]; float s = 0.f;
#pragma unroll
    for (int j = 0; j < 4; ++j) { v[j] = xr[64 * j]; s += (v[j].x * v[j].x + v[j].y * v[j].y) + (v[j].z * v[j].z + v[j].w * v[j].w); }
    const float rstd = 1.0f / sqrtf(wave_sum(s) * (1.0f / DM) + EPS);
    u32x2* o8 = (u32x2*)orow + lane;
#pragma unroll
    for (int j = 0; j < 4; ++j) { const f32x4 gg = gr[64 * j]; u32x2 o; o.x = pk2(v[j].x * rstd * gg.x, v[j].y * rstd * gg.y); o.y = pk2(v[j].z * rstd * gg.z, v[j].w * rstd * gg.w); o8[64 * j] = o; }
}

using pg8::Unit;
struct EpiProj { bf16_t* O; const float* qg; const float* kg; float qscale; int pad;
    __device__ __forceinline__ void operator()(const f32x4 (&acc)[2][2][4][2], const Unit& u, int wr, int wc, int fr, int fq, const LAS unsigned char*) const {
        const int row0 = u.pm * 256 + wr * 64 + fr, colb = u.pn * 256 + wc * 64 + 8 * fq;
        const int mode = u.pn < 2 ? 1 : (u.pn < 4 ? 2 : 0);
        f32x4 gv[2][2];
        if (mode) { const float* gp = (mode == 1 ? qg : kg) + 8 * fq; const float sc = mode == 1 ? qscale : 1.0f;
#pragma unroll
            for (int bj = 0; bj < 2; ++bj)
#pragma unroll
                for (int n = 0; n < 2; ++n) gv[bj][n] = *(const f32x4*)(gp + 32 * bj + 4 * n) * sc; }
#pragma unroll
        for (int ai = 0; ai < 2; ++ai)
#pragma unroll
            for (int m = 0; m < 4; ++m) {
                f32x4 v[2][2];
#pragma unroll
                for (int bj = 0; bj < 2; ++bj)
#pragma unroll
                    for (int n = 0; n < 2; ++n) v[bj][n] = acc[ai][bj][m][n];
                if (mode) { float ss = 0.f;
#pragma unroll
                    for (int bj = 0; bj < 2; ++bj)
#pragma unroll
                        for (int n = 0; n < 2; ++n) ss += (v[bj][n].x * v[bj][n].x + v[bj][n].y * v[bj][n].y) + (v[bj][n].z * v[bj][n].z + v[bj][n].w * v[bj][n].w);
                    ss += __shfl_xor(ss, 16); ss += __shfl_xor(ss, 32);
                    const float rstd = 1.0f / sqrtf(ss * (1.0f / 64.0f) + EPS);
#pragma unroll
                    for (int bj = 0; bj < 2; ++bj)
#pragma unroll
                        for (int n = 0; n < 2; ++n) v[bj][n] = v[bj][n] * rstd * gv[bj][n]; }
                bf16_t* rowp = O + (size_t)(row0 + ai * 128 + m * 16) * NPROJ + colb;
#pragma unroll
                for (int bj = 0; bj < 2; ++bj) { u32x4 w; w.x = cvt_pk_bf16(v[bj][0].x, v[bj][0].y); w.y = cvt_pk_bf16(v[bj][0].z, v[bj][0].w); w.z = cvt_pk_bf16(v[bj][1].x, v[bj][1].y); w.w = cvt_pk_bf16(v[bj][1].z, v[bj][1].w);
                    *(u32x4*)(rowp + 32 * bj) = w; }
            }
    }
};
struct EpiBf16 { bf16_t* O; int ldo; int pad;
    __device__ __forceinline__ void operator()(const f32x4 (&acc)[2][2][4][2], const Unit& u, int wr, int wc, int fr, int fq, const LAS unsigned char*) const {
        const int row0 = u.pm * 256 + wr * 64 + fr, col0 = u.pn * 256 + wc * 32 + 8 * fq;
#pragma unroll
        for (int ai = 0; ai < 2; ++ai)
#pragma unroll
            for (int m = 0; m < 4; ++m) { bf16_t* rowp = O + (size_t)(row0 + ai * 128 + m * 16) * ldo + col0;
#pragma unroll
                for (int bj = 0; bj < 2; ++bj) { const f32x4 v0 = acc[ai][bj][m][0], v1 = acc[ai][bj][m][1];
                    u32x4 w; w.x = cvt_pk_bf16(v0.x, v0.y); w.y = cvt_pk_bf16(v0.z, v0.w); w.z = cvt_pk_bf16(v1.x, v1.y); w.w = cvt_pk_bf16(v1.z, v1.w);
                    *(u32x4*)(rowp + bj * 128) = w; } }
    }
};
template <bool BASE_BF16> struct EpiRes { const void* base; bf16_t* outb; float* sq;
    __device__ __forceinline__ void operator()(const f32x4 (&acc)[2][2][4][2], const Unit& u, int wr, int wc, int fr, int fq, const LAS unsigned char*) const {
        const int row0 = u.pm * 256 + wr * 64 + fr, col0 = u.pn * 256 + wc * 32 + 8 * fq;
#pragma unroll
        for (int ai = 0; ai < 2; ++ai)
#pragma unroll
            for (int m = 0; m < 4; ++m) { const int row = row0 + ai * 128 + m * 16; const size_t off = (size_t)row * DM + col0; float ss = 0.f;
#pragma unroll
                for (int bj = 0; bj < 2; ++bj) { f32x4 b0, b1;
                    if constexpr (BASE_BF16) { const u32x4 bb = *(const u32x4*)((const bf16_t*)base + off + bj * 128); b0 = (f32x4){bflo(bb.x), bfhi(bb.x), bflo(bb.y), bfhi(bb.y)}; b1 = (f32x4){bflo(bb.z), bfhi(bb.z), bflo(bb.w), bfhi(bb.w)}; }
                    else { b0 = *(const f32x4*)((const float*)base + off + bj * 128); b1 = *(const f32x4*)((const float*)base + off + bj * 128 + 4); }
                    const f32x4 v0 = acc[ai][bj][m][0] + b0, v1 = acc[ai][bj][m][1] + b1;
                    u32x4 w; w.x = cvt_pk_bf16(v0.x, v0.y); w.y = cvt_pk_bf16(v0.z, v0.w); w.z = cvt_pk_bf16(v1.x, v1.y); w.w = cvt_pk_bf16(v1.z, v1.w);
                    *(u32x4*)(outb + off + bj * 128) = w;
                    ss += (v0.x * v0.x + v0.y * v0.y) + (v0.z * v0.z + v0.w * v0.w) + (v1.x * v1.x + v1.y * v1.y) + (v1.z * v1.z + v1.w * v1.w); }
                ss += __shfl_xor(ss, 16); ss += __shfl_xor(ss, 32);
                if (fq == 0) sq[((size_t)u.pn * MTOK + row) * 4 + wc] = ss; }
    }
};
struct EpiRstdBf16 { bf16_t* O; const float* sq; int ldo; int pad;
    __device__ __forceinline__ void operator()(const f32x4 (&acc)[2][2][4][2], const Unit& u, int wr, int wc, int fr, int fq, const LAS unsigned char*) const {
        const int row0 = u.pm * 256 + wr * 64 + fr, col0 = u.pn * 256 + wc * 32 + 8 * fq;
#pragma unroll
        for (int ai = 0; ai < 2; ++ai)
#pragma unroll
            for (int m = 0; m < 4; ++m) { const int row = row0 + ai * 128 + m * 16; float s = 0.f;
#pragma unroll
                for (int t = 0; t < 4; ++t) { const f32x4 p = *(const f32x4*)(sq + ((size_t)t * MTOK + row) * 4); s += (p.x + p.y) + (p.z + p.w); }
                const float rstd = 1.0f / sqrtf(s * (1.0f / DM) + EPS);
                bf16_t* rowp = O + (size_t)row * ldo + col0;
#pragma unroll
                for (int bj = 0; bj < 2; ++bj) { const f32x4 v0 = acc[ai][bj][m][0] * rstd, v1 = acc[ai][bj][m][1] * rstd;
                    u32x4 w; w.x = cvt_pk_bf16(v0.x, v0.y); w.y = cvt_pk_bf16(v0.z, v0.w); w.z = cvt_pk_bf16(v1.x, v1.y); w.w = cvt_pk_bf16(v1.z, v1.w);
                    *(u32x4*)(rowp + bj * 128) = w; } }
    }
};
constexpr int LSTRIDE = MTOK;
struct MoeSched {
    const char* A; const char* Bt; size_t estride; const int* list; const LAS unsigned* tab; int K, nN, nblk, G, c, gather;
    __device__ __forceinline__ bool next(int i, Unit& u) const {
        if (!pg8::static_order(nblk, nN, G, c, i, u.pm, u.pn)) return false;
        int e = 0; while (e < NE - 1 && (int)tab[32 + e + 1] <= u.pm) ++e;
        e = __builtin_amdgcn_readfirstlane(e); u.e = e; u.rbl = u.pm - (int)__builtin_amdgcn_readfirstlane(tab[32 + e]); return true;
    }
    __device__ __forceinline__ const char* a_base(const Unit& u) const { return gather ? A : A + (size_t)u.pm * 256 * K * 2; }
    __device__ __forceinline__ const char* b_base(const Unit& u) const { return Bt + (size_t)u.e * estride + (size_t)u.pn * 256 * K * 2; }
    __device__ __forceinline__ void issue_rows(const Unit& u, LAS unsigned char* buf, int wid, int lane) const {
        if (wid < 4) __builtin_amdgcn_global_load_lds((const unsigned*)(list + (size_t)u.e * LSTRIDE + u.rbl * 256 + wid * 64 + lane), (LAS unsigned*)(buf + wid * 256), 4, 0, 0);
    }
    __device__ __forceinline__ void read_rows(const Unit& u, const LAS unsigned char* buf, int R0, unsigned (&off)[4]) const {
        const int cnt = (int)tab[u.e] - u.rbl * 256;
#pragma unroll
        for (int q = 0; q < 4; ++q) { const int j = R0 + 64 * q; const int v = ((const LAS int*)buf)[j]; const int tok = (j < cnt) ? (v >> 2) : 0; off[q] = (unsigned)tok * (unsigned)(K * 2); }
    }
};
struct EpiSwiglu2 { bf16_t* act; const float* bias; const float* rstd2; const LAS unsigned* tab;
    __device__ __forceinline__ void operator()(const f32x4 (&acc)[2][2][4][2], const Unit& u, int wr, int wc, int fr, int fq, const LAS unsigned char* idx) const {
        const int cnt = (int)tab[u.e] - u.rbl * 256, c0 = u.pn * 128 + wc * 32 + 8 * fq;
        const float* bp = bias + (size_t)u.e * 2 * DFF + 2 * c0; f32x4 bb[4];
#pragma unroll
        for (int i = 0; i < 4; ++i) bb[i] = *(const f32x4*)(bp + 4 * i);
#pragma unroll
        for (int ai = 0; ai < 2; ++ai)
#pragma unroll
            for (int m = 0; m < 4; ++m) { const int j = ai * 128 + wr * 64 + m * 16 + fr; const int v = ((const LAS int*)idx)[j]; const int tok = (j < cnt) ? (v >> 2) : 0; const float rs = rstd2[tok];
                float o[8];
#pragma unroll
                for (int n = 0; n < 2; ++n)
#pragma unroll
                    for (int k = 0; k < 4; ++k) { const int cc = 4 * n + k; const float bg = bb[cc >> 1][(cc & 1) * 2], bl = bb[cc >> 1][(cc & 1) * 2 + 1];
                        const float g = fminf(acc[ai][0][m][n][k] * rs + bg, 7.0f), l = fminf(fmaxf(acc[ai][1][m][n][k] * rs + bl, -7.0f), 7.0f);
                        o[cc] = g * __builtin_amdgcn_rcpf(1.0f + __builtin_amdgcn_exp2f(-1.702f * LOG2E * g)) * (l + 1.0f); }
                u32x4 w; w.x = cvt_pk_bf16(o[0], o[1]); w.y = cvt_pk_bf16(o[2], o[3]); w.z = cvt_pk_bf16(o[4], o[5]); w.w = cvt_pk_bf16(o[6], o[7]);
                *(u32x4*)(act + (size_t)(u.pm * 256 + j) * DFF + c0) = w; }
    }
};
struct EpiDown2 { bf16_t* ybuf; const float* bias; const float* gate; const LAS unsigned* tab;
    __device__ __forceinline__ void operator()(const f32x4 (&acc)[2][2][4][2], const Unit& u, int wr, int wc, int fr, int fq, const LAS unsigned char* idx) const {
        const int cnt = (int)tab[u.e] - u.rbl * 256, col0 = u.pn * 256 + wc * 32 + 8 * fq;
        const float* bp = bias + (size_t)u.e * DM + col0; f32x4 bb[2][2];
#pragma unroll
        for (int bj = 0; bj < 2; ++bj)
#pragma unroll
            for (int n = 0; n < 2; ++n) bb[bj][n] = *(const f32x4*)(bp + bj * 128 + 4 * n);
#pragma unroll
        for (int ai = 0; ai < 2; ++ai)
#pragma unroll
            for (int m = 0; m < 4; ++m) { const int j = ai * 128 + wr * 64 + m * 16 + fr;
                if (j < cnt) { const int tk = ((const LAS int*)idx)[j]; const float g = gate[tk]; bf16_t* rowp = ybuf + (size_t)tk * DM + col0;
#pragma unroll
                    for (int bj = 0; bj < 2; ++bj) { const f32x4 v0 = (acc[ai][bj][m][0] + bb[bj][0]) * g, v1 = (acc[ai][bj][m][1] + bb[bj][1]) * g;
                        u32x4 w; w.x = cvt_pk_bf16(v0.x, v0.y); w.y = cvt_pk_bf16(v0.z, v0.w); w.z = cvt_pk_bf16(v1.x, v1.y); w.w = cvt_pk_bf16(v1.z, v1.w);
                        *(u32x4*)(rowp + bj * 128) = w; } } }
    }
};
__device__ __forceinline__ void moe_tables(const unsigned* gcnt, LAS unsigned* tab, int tid) {
    if (tid < 64) { const unsigned c = tid < NE ? gcnt[tid] : 0u; const unsigned nb = (c + 255u) >> 8; unsigned inc = nb;
#pragma unroll
        for (int o = 1; o < 64; o <<= 1) { const unsigned t = __shfl_up(inc, o); if (tid >= o) inc += t; }
        if (tid < NE) { tab[tid] = c; tab[32 + tid] = inc - nb; } if (tid == NE) tab[32 + NE] = inc - nb; }
    __syncthreads();
}
__device__ __forceinline__ void p7_route(const Frame& F, const bf16_t* __restrict__ hb, const bf16_t* __restrict__ Wrt, const float* __restrict__ sq2, const float* __restrict__ br,
                                         unsigned* gcnt, int* __restrict__ list, float* __restrict__ gate, float* __restrict__ rstd2) {
    LAS unsigned* lcnt = (LAS unsigned*)(F.lds + RING_OFF); LAS unsigned* lbase = lcnt + 32;
    const int lane = F.lane, tcol = lane & 15, kq = lane >> 4;
    for (int round = blockIdx.x; round < MTOK / 128; round += F.G) {
        if (F.tid < 32) lcnt[F.tid] = 0u;
        __syncthreads();
        const int tok = round * 128 + F.wave * 16 + tcol;
        const bf16_t* xp = hb + (size_t)tok * DM + 8 * kq; const bf16_t* w0p = Wrt + (size_t)tcol * DM + 8 * kq; const bf16_t* w1p = w0p + 16 * DM;
        f32x4 a0 = {0.f, 0.f, 0.f, 0.f}, a1 = {0.f, 0.f, 0.f, 0.f};
#pragma unroll 8
        for (int ks = 0; ks < 32; ++ks) { const bf16x8 b = *(const bf16x8*)(xp + 32 * ks), w0 = *(const bf16x8*)(w0p + 32 * ks), w1 = *(const bf16x8*)(w1p + 32 * ks);
            a0 = __builtin_amdgcn_mfma_f32_16x16x32_bf16(w0, b, a0, 0, 0, 0); a1 = __builtin_amdgcn_mfma_f32_16x16x32_bf16(w1, b, a1, 0, 0, 0); }
        float s = 0.f;
#pragma unroll
        for (int t = 0; t < 4; ++t) { const f32x4 p = *(const f32x4*)(sq2 + ((size_t)t * MTOK + tok) * 4); s += (p.x + p.y) + (p.z + p.w); }
        const float rstd = 1.0f / sqrtf(s * (1.0f / DM) + EPS);
        float v[8]; int id[8];
#pragma unroll
        for (int r = 0; r < 4; ++r) { id[r] = 4 * kq + r; id[4 + r] = 16 + 4 * kq + r; v[r] = a0[r] * rstd + br[4 * kq + r]; v[4 + r] = a1[r] * rstd + br[16 + 4 * kq + r]; }
        float tv[4]; int ti[4];
#pragma unroll
        for (int r = 0; r < 4; ++r) { float bv = v[0]; int bi = id[0];
#pragma unroll
            for (int j = 1; j < 8; ++j) if (v[j] > bv) { bv = v[j]; bi = id[j]; }
#pragma unroll
            for (int o = 16; o < 64; o <<= 1) { const float ov = __shfl_xor(bv, o); const int oi = __shfl_xor(bi, o); if (ov > bv || (ov == bv && oi < bi)) { bv = ov; bi = oi; } }
            tv[r] = bv; ti[r] = bi;
#pragma unroll
            for (int j = 0; j < 8; ++j) if (id[j] == bi) v[j] = -3.0e38f; }
        const float e1 = __expf(tv[1] - tv[0]), e2 = __expf(tv[2] - tv[0]), e3 = __expf(tv[3] - tv[0]); const float inv = 1.0f / (1.0f + e1 + e2 + e3);
        unsigned lp[4];
        if (kq == 0) {
#pragma unroll
            for (int k = 0; k < 4; ++k) lp[k] = __hip_atomic_fetch_add(lcnt + ti[k], 1u, __ATOMIC_RELAXED, __HIP_MEMORY_SCOPE_WORKGROUP); }
        __syncthreads();
        if (F.tid < 32) { const unsigned c = lcnt[F.tid]; lbase[F.tid] = c ? __hip_atomic_fetch_add(gcnt + F.tid, c, __ATOMIC_RELAXED, __HIP_MEMORY_SCOPE_AGENT) : 0u; }
        __syncthreads();
        if (kq == 0) { const float gk[4] = {inv, e1 * inv, e2 * inv, e3 * inv};
#pragma unroll
            for (int k = 0; k < 4; ++k) { const unsigned pos = lbase[ti[k]] + lp[k]; list[(size_t)ti[k] * LSTRIDE + pos] = tok * 4 + k; gate[tok * 4 + k] = gk[k]; }
            rstd2[tok] = rstd; }
        __syncthreads();
    }
}
__device__ __forceinline__ void p10_combine(const Frame& F, float* __restrict__ out, const bf16_t* __restrict__ x2b, const bf16_t* __restrict__ ybuf) {
    const size_t n8 = (size_t)MTOK * DM / 8;
    for (size_t i = (size_t)blockIdx.x * (NWAVES * 64) + F.tid; i < n8; i += (size_t)F.G * (NWAVES * 64)) {
        const size_t tok = i / (DM / 8), c8 = i % (DM / 8);
        const u32x4 xb = *(const u32x4*)(x2b + i * 8);
        f32x4 v0 = {bflo(xb.x), bfhi(xb.x), bflo(xb.y), bfhi(xb.y)}, v1 = {bflo(xb.z), bfhi(xb.z), bflo(xb.w), bfhi(xb.w)};
#pragma unroll
        for (int k = 0; k < 4; ++k) { const u32x4 y = *(const u32x4*)(ybuf + (tok * 4 + k) * DM + c8 * 8);
            v0.x += bflo(y.x); v0.y += bfhi(y.x); v0.z += bflo(y.y); v0.w += bfhi(y.y); v1.x += bflo(y.z); v1.y += bfhi(y.z); v1.z += bflo(y.w); v1.w += bfhi(y.w); }
        *(f32x4*)(out + i * 8) = v0; *(f32x4*)(out + i * 8 + 4) = v1;
    }
}
typedef short v4i16_t __attribute__((ext_vector_type(4)));
__device__ __forceinline__ v4i16_t lds_tr16(const LAS unsigned char* p) { return __builtin_amdgcn_ds_read_tr16_b64_v4i16((LAS v4i16_t*)p); }
__device__ __forceinline__ bf16x8 cat8(v4i16_t a, v4i16_t b) { return (bf16x8){a[0], a[1], a[2], a[3], b[0], b[1], b[2], b[3]}; }
__device__ __forceinline__ int koff16(int rho) { return (rho & 3) + 8 * (rho >> 2); }

__device__ __forceinline__ void p2_attn(const Frame& F, const bf16_t* __restrict__ proj, const float* __restrict__ rel_bias, const float* __restrict__ conv_w,
                                        const float* __restrict__ ga, const float* __restrict__ gb, bf16_t* __restrict__ yb, bf16_t* __restrict__ kvmem, const float* __restrict__ xk_g, bool do_kv) {
    LAS float* tbl = (LAS float*)(F.lds + TBL_OFF);
    for (int i = F.tid; i < 8 * 384; i += NWAVES * 64) { const int h = i / 384, j = i % 384; int rel = 319 - j; rel = rel < -MAXREL ? -MAXREL : (rel > MAXREL ? MAXREL : rel); tbl[i] = rel_bias[h * NREL + rel + MAXREL] * LOG2E; }
    __syncthreads();
    const int lane = F.lane, h = F.wave, r = lane & 31, hi = lane >> 5;
    LAS unsigned char* wbuf = F.lds + RING_OFF + h * 16384;
    LAS float* ssq = (LAS float*)(F.lds + SSQ_OFF);
    const LAS float* tblh = tbl + h * 384;
    const float far_bias = rel_bias[h * NREL + 2 * MAXREL] * LOG2E;
    unsigned kso[4], vso[4];
#pragma unroll
    for (int i = 0; i < 4; ++i) { const int key = 8 * i + (lane >> 3), cp = lane & 7;
        kso[i] = (unsigned)(key * NPROJ + (cp ^ ((key >> 1) & 7)) * 8) * 2u; vso[i] = (unsigned)(key * NPROJ + DATT + (cp ^ (((key >> 1) & 1) << 2)) * 8) * 2u; }
    int kaddr[4];
#pragma unroll
    for (int s = 0; s < 4; ++s) kaddr[s] = r * 128 + (((2 * s + hi) ^ ((r >> 1) & 7)) * 16);
    const int G1 = (lane >> 4) & 1, tq = (lane & 15) >> 2, tp = lane & 3;
    int vaddr[2];
#pragma unroll
    for (int db = 0; db < 2; ++db) vaddr[db] = 4096 + (4 * hi + tq) * 128 + (((4 * db + 2 * G1 + (tp >> 1)) ^ (((tq >> 1) & 1) << 2)) * 16) + (tp & 1) * 8;
#define P2_DMA(T_, buf_) do { const char* kp_ = (const char*)(proj + ((size_t)b * SEQ + 32 * (T_)) * NPROJ + DATT + h * 64); \
        _Pragma("unroll") for (int i_ = 0; i_ < 4; ++i_) __builtin_amdgcn_global_load_lds((const unsigned*)(kp_ + kso[i_]), (LAS unsigned*)(wbuf + (buf_) * 8192 + i_ * 1024), 16, 0, 0); \
        _Pragma("unroll") for (int i_ = 0; i_ < 4; ++i_) __builtin_amdgcn_global_load_lds((const unsigned*)(kp_ + vso[i_]), (LAS unsigned*)(wbuf + (buf_) * 8192 + 4096 + i_ * 1024), 16, 0, 0); } while (0)
    const int upw = (512 + F.G - 1) / F.G;
    for (int ui = 0; ui < upw; ++ui) {
        const int unit = F.vcu * upw + ui; if (unit >= BATCH * (SEQ / CHUNK)) break;
        const int b = unit / (SEQ / CHUNK), c = unit % (SEQ / CHUNK); const size_t row0 = (size_t)b * SEQ + c * CHUNK;
        const int T0 = 2 * (c - LEFT < 0 ? 0 : c - LEFT), T1 = 2 * c + 1;
        P2_DMA(T0, 0);
        bf16x8 qf[2][4];
#pragma unroll
        for (int qb = 0; qb < 2; ++qb)
#pragma unroll
            for (int s = 0; s < 4; ++s) qf[qb][s] = *(const bf16x8*)(proj + (row0 + 32 * qb + r) * NPROJ + h * 64 + 16 * s + 8 * hi);
        f32x16 o[2][2];
#pragma unroll
        for (int db = 0; db < 2; ++db)
#pragma unroll
            for (int qb = 0; qb < 2; ++qb)
#pragma unroll
                for (int i = 0; i < 16; ++i) o[db][qb][i] = 0.f;
        float mrun[2] = {-1e30f, -1e30f}, lrun[2] = {0.f, 0.f};
        for (int T = T0; T <= T1; ++T) {
            const int pb = (T - T0) & 1; const LAS unsigned char* Ks = wbuf + pb * 8192;
            if (T < T1) { P2_DMA(T + 1, pb ^ 1); asm volatile("s_waitcnt vmcnt(8)" ::: "memory"); }
            else asm volatile("s_waitcnt vmcnt(0)" ::: "memory");
            f32x16 sacc[2];
#pragma unroll
            for (int qb = 0; qb < 2; ++qb)
#pragma unroll
                for (int i = 0; i < 16; ++i) sacc[qb][i] = 0.f;
#pragma unroll
            for (int s = 0; s < 4; ++s) { const bf16x8 kf = *(const LAS bf16x8*)(Ks + kaddr[s]);
                sacc[0] = __builtin_amdgcn_mfma_f32_32x32x16_bf16(kf, qf[0][s], sacc[0], 0, 0, 0); sacc[1] = __builtin_amdgcn_mfma_f32_32x32x16_bf16(kf, qf[1][s], sacc[1], 0, 0, 0); }
            if ((T >> 1) >= c - 4) {
#pragma unroll
                for (int qb = 0; qb < 2; ++qb) { const LAS float* tp0 = tblh + (319 - 64 * c - 32 * qb - r + 32 * T + 4 * hi);
#pragma unroll
                    for (int i = 0; i < 16; ++i) sacc[qb][i] += tp0[koff16(i)]; }
            } else {
#pragma unroll
                for (int qb = 0; qb < 2; ++qb)
#pragma unroll
                    for (int i = 0; i < 16; ++i) sacc[qb][i] += far_bias;
            }
            bf16x8 pf[2][2];
#pragma unroll
            for (int qb = 0; qb < 2; ++qb) {
                float mx = sacc[qb][0];
#pragma unroll
                for (int i = 1; i < 16; ++i) mx = fmaxf(mx, sacc[qb][i]);
                mx = fmaxf(mx, __shfl_xor(mx, 32));
                const float mn = fmaxf(mrun[qb], mx), f = __builtin_amdgcn_exp2f(mrun[qb] - mn); mrun[qb] = mn;
                float ls = 0.f; float p[16];
#pragma unroll
                for (int i = 0; i < 16; ++i) { p[i] = __builtin_amdgcn_exp2f(sacc[qb][i] - mn); ls += p[i]; }
                lrun[qb] = lrun[qb] * f + ls;
#pragma unroll
                for (int i = 0; i < 16; ++i) { o[0][qb][i] *= f; o[1][qb][i] *= f; }
#pragma unroll
                for (int ks = 0; ks < 2; ++ks) { u32x4 w; w.x = cvt_pk_bf16(p[8 * ks + 0], p[8 * ks + 1]); w.y = cvt_pk_bf16(p[8 * ks + 2], p[8 * ks + 3]); w.z = cvt_pk_bf16(p[8 * ks + 4], p[8 * ks + 5]); w.w = cvt_pk_bf16(p[8 * ks + 6], p[8 * ks + 7]);
                    pf[qb][ks] = __builtin_bit_cast(bf16x8, w); }
            }
#pragma unroll
            for (int db = 0; db < 2; ++db)
#pragma unroll
                for (int ks = 0; ks < 2; ++ks) {
                    const v4i16_t t0 = lds_tr16(Ks + vaddr[db] + (16 * ks) * 128), t1 = lds_tr16(Ks + vaddr[db] + (16 * ks + 8) * 128);
                    const bf16x8 vf = cat8(t0, t1);
                    o[db][0] = __builtin_amdgcn_mfma_f32_32x32x16_bf16(vf, pf[0][ks], o[db][0], 0, 0, 0); o[db][1] = __builtin_amdgcn_mfma_f32_32x32x16_bf16(vf, pf[1][ks], o[db][1], 0, 0, 0);
                }
        }

        LAS float* sq = ssq + (ui & 1) * 512;
#pragma unroll
        for (int qb = 0; qb < 2; ++qb) { const float lt = lrun[qb] + __shfl_xor(lrun[qb], 32); const float inv = 1.0f / lt; float ss = 0.f;
#pragma unroll
            for (int db = 0; db < 2; ++db)
#pragma unroll
                for (int i = 0; i < 16; ++i) { o[db][qb][i] *= inv; ss += o[db][qb][i] * o[db][qb][i]; }
            ss += __shfl_xor(ss, 32);
            if (hi == 0) sq[h * 64 + 32 * qb + r] = ss; }
        __syncthreads();
#pragma unroll
        for (int qb = 0; qb < 2; ++qb) { float tot = 0.f;
#pragma unroll
            for (int hh = 0; hh < 8; ++hh) tot += sq[hh * 64 + 32 * qb + r];
            const float rstd = 1.0f / sqrtf(tot * (1.0f / DATT) + EPS);
            bf16_t* orow = yb + (row0 + 32 * qb + r) * DM + h * 64;
#pragma unroll
            for (int db = 0; db < 2; ++db)
#pragma unroll
                for (int g4 = 0; g4 < 4; ++g4) { const int d0 = 32 * db + 8 * g4 + 4 * hi; const f32x4 gg = *(const f32x4*)(ga + h * 64 + d0);
                    u32x2 w; w.x = cvt_pk_bf16(o[db][qb][4 * g4 + 0] * rstd * gg.x, o[db][qb][4 * g4 + 1] * rstd * gg.y); w.y = cvt_pk_bf16(o[db][qb][4 * g4 + 2] * rstd * gg.z, o[db][qb][4 * g4 + 3] * rstd * gg.w);
                    *(u32x2*)(orow + d0) = w; } }
        { const int ch0 = 8 * lane; float cw[3][8], gbv[8];
#pragma unroll
          for (int t = 0; t < 3; ++t) { const f32x4 a = *(const f32x4*)(conv_w + t * DCONV + ch0), bq = *(const f32x4*)(conv_w + t * DCONV + ch0 + 4);
              cw[t][0] = a.x; cw[t][1] = a.y; cw[t][2] = a.z; cw[t][3] = a.w; cw[t][4] = bq.x; cw[t][5] = bq.y; cw[t][6] = bq.z; cw[t][7] = bq.w; }
          { const f32x4 a = *(const f32x4*)(gb + ch0), bq = *(const f32x4*)(gb + ch0 + 4); gbv[0] = a.x; gbv[1] = a.y; gbv[2] = a.z; gbv[3] = a.w; gbv[4] = bq.x; gbv[5] = bq.y; gbv[6] = bq.z; gbv[7] = bq.w; }
          const size_t tfirst = row0 + 8 * h; const int sfirst = c * CHUNK + 8 * h;
          float u1[8], u2[8];
#pragma unroll
          for (int j = 0; j < 8; ++j) { u1[j] = 0.f; u2[j] = 0.f; }
          if (sfirst >= 1) { const u32x4 cg = *(const u32x4*)(proj + (tfirst - 1) * NPROJ + 3 * DATT + DCONV + ch0), xv = *(const u32x4*)(proj + (tfirst - 1) * NPROJ + 3 * DATT + 2 * DCONV + ch0);
              u1[0] = bflo(cg.x) * bflo(xv.x); u1[1] = bfhi(cg.x) * bfhi(xv.x); u1[2] = bflo(cg.y) * bflo(xv.y); u1[3] = bfhi(cg.y) * bfhi(xv.y); u1[4] = bflo(cg.z) * bflo(xv.z); u1[5] = bfhi(cg.z) * bfhi(xv.z); u1[6] = bflo(cg.w) * bflo(xv.w); u1[7] = bfhi(cg.w) * bfhi(xv.w); }
          if (sfirst >= 2) { const u32x4 cg = *(const u32x4*)(proj + (tfirst - 2) * NPROJ + 3 * DATT + DCONV + ch0), xv = *(const u32x4*)(proj + (tfirst - 2) * NPROJ + 3 * DATT + 2 * DCONV + ch0);
              u2[0] = bflo(cg.x) * bflo(xv.x); u2[1] = bfhi(cg.x) * bfhi(xv.x); u2[2] = bflo(cg.y) * bflo(xv.y); u2[3] = bfhi(cg.y) * bfhi(xv.y); u2[4] = bflo(cg.z) * bflo(xv.z); u2[5] = bfhi(cg.z) * bfhi(xv.z); u2[6] = bflo(cg.w) * bflo(xv.w); u2[7] = bfhi(cg.w) * bfhi(xv.w); }
#pragma unroll
          for (int i = 0; i < 8; ++i) { const bf16_t* pr = proj + (tfirst + i) * NPROJ + 3 * DATT + ch0;
              const u32x4 bg = *(const u32x4*)pr, cg = *(const u32x4*)(pr + DCONV), xv = *(const u32x4*)(pr + 2 * DCONV);
              float u0[8], bgf[8], y[8];
              u0[0] = bflo(cg.x) * bflo(xv.x); u0[1] = bfhi(cg.x) * bfhi(xv.x); u0[2] = bflo(cg.y) * bflo(xv.y); u0[3] = bfhi(cg.y) * bfhi(xv.y); u0[4] = bflo(cg.z) * bflo(xv.z); u0[5] = bfhi(cg.z) * bfhi(xv.z); u0[6] = bflo(cg.w) * bflo(xv.w); u0[7] = bfhi(cg.w) * bfhi(xv.w);
              bgf[0] = bflo(bg.x); bgf[1] = bfhi(bg.x); bgf[2] = bflo(bg.y); bgf[3] = bfhi(bg.y); bgf[4] = bflo(bg.z); bgf[5] = bfhi(bg.z); bgf[6] = bflo(bg.w); bgf[7] = bfhi(bg.w);
              float ss = 0.f;
#pragma unroll
              for (int j = 0; j < 8; ++j) { y[j] = bgf[j] * (cw[0][j] * u2[j] + cw[1][j] * u1[j] + cw[2][j] * u0[j]); ss += y[j] * y[j]; u2[j] = u1[j]; u1[j] = u0[j]; }
              const float rstd = 1.0f / sqrtf(wave_sum(ss) * (1.0f / DCONV) + EPS);
              u32x4 w; w.x = cvt_pk_bf16(y[0] * rstd * gbv[0], y[1] * rstd * gbv[1]); w.y = cvt_pk_bf16(y[2] * rstd * gbv[2], y[3] * rstd * gbv[3]); w.z = cvt_pk_bf16(y[4] * rstd * gbv[4], y[5] * rstd * gbv[5]); w.w = cvt_pk_bf16(y[6] * rstd * gbv[6], y[7] * rstd * gbv[7]);
              *(u32x4*)(yb + (tfirst + i) * DM + DATT + ch0) = w; } }
        if (do_kv) { bf16_t* kp = kvmem + (size_t)(8 * unit + h) * (2 * DX) + 8 * lane; const u32x4 kv = *(const u32x4*)kp;
          float v[8] = {bflo(kv.x), bfhi(kv.x), bflo(kv.y), bfhi(kv.y), bflo(kv.z), bfhi(kv.z), bflo(kv.w), bfhi(kv.w)}; float ss = 0.f;
#pragma unroll
          for (int j = 0; j < 8; ++j) ss += v[j] * v[j];
          ss += __shfl_xor(ss, 1); ss += __shfl_xor(ss, 2); ss += __shfl_xor(ss, 4); ss += __shfl_xor(ss, 8);
          const float rstd = 1.0f / sqrtf(ss * (1.0f / XHD) + EPS); const float* gp = xk_g + ((8 * lane) & (XHD - 1)); const f32x4 g0 = *(const f32x4*)gp, g1 = *(const f32x4*)(gp + 4);
          u32x4 w; w.x = cvt_pk_bf16(v[0] * rstd * g0.x, v[1] * rstd * g0.y); w.y = cvt_pk_bf16(v[2] * rstd * g0.z, v[3] * rstd * g0.w); w.z = cvt_pk_bf16(v[4] * rstd * g1.x, v[5] * rstd * g1.y); w.w = cvt_pk_bf16(v[6] * rstd * g1.z, v[7] * rstd * g1.w);
          *(u32x4*)kp = w; }
    }
    __syncthreads();
}
__device__ __forceinline__ void p5_xattn(const Frame& F, const bf16_t* __restrict__ qx, const bf16_t* __restrict__ kvmem, const float* __restrict__ xq_g, bf16_t* __restrict__ ox) {
    const int lane = F.lane, r = lane & 31, hi = lane >> 5;
    LAS unsigned char* Kl = F.lds + RING_OFF; LAS unsigned char* Vl = Kl + 256 * 272;
    const int G1 = (lane >> 4) & 1, tq = (lane & 15) >> 2, tp = lane & 3;
    const float XS = 0.08838834764831845f * LOG2E;
    const int upw = (512 + F.G - 1) / F.G; int cur_bh = -1;
    for (int ui = 0; ui < upw; ++ui) {
        const int unit = F.vcu * upw + ui; if (unit >= BATCH * XH * 8) break;
        const int bh = unit >> 3, qt = unit & 7, b = bh >> 2, h = bh & 3;
        if (bh != cur_bh) {
            __syncthreads();
            const bf16_t* src = kvmem + (size_t)b * NMEM * (2 * DX) + h * XHD;
#pragma unroll
            for (int i = 0; i < 8; ++i) { const int ci = F.tid + 512 * i, key = ci >> 4, ch = ci & 15;
                const u32x4 kv = *(const u32x4*)(src + (size_t)key * (2 * DX) + ch * 8), vv = *(const u32x4*)(src + (size_t)key * (2 * DX) + DX + ch * 8);
                *(LAS u32x4*)(Kl + key * 272 + ch * 16) = kv; *(LAS u32x4*)(Vl + key * 256 + ((ch ^ ((key & 3) << 2)) * 16)) = vv; }
            __syncthreads();
            cur_bh = bh;
        }
        const size_t qrow = (size_t)b * SEQ + qt * 256 + F.wave * 32 + r;
        bf16x8 qf[8];
        { u32x4 raw[8]; float ss = 0.f;
#pragma unroll
          for (int s = 0; s < 8; ++s) { raw[s] = *(const u32x4*)(qx + qrow * DX + h * XHD + 16 * s + 8 * hi);
              const float a0 = bflo(raw[s].x), a1 = bfhi(raw[s].x), a2 = bflo(raw[s].y), a3 = bfhi(raw[s].y), a4 = bflo(raw[s].z), a5 = bfhi(raw[s].z), a6 = bflo(raw[s].w), a7 = bfhi(raw[s].w);
              ss += (a0 * a0 + a1 * a1) + (a2 * a2 + a3 * a3) + (a4 * a4 + a5 * a5) + (a6 * a6 + a7 * a7); }
          ss += __shfl_xor(ss, 32);
          const float rs = XS / sqrtf(ss * (1.0f / XHD) + EPS);
#pragma unroll
          for (int s = 0; s < 8; ++s) { const f32x4 g0 = *(const f32x4*)(xq_g + 16 * s + 8 * hi), g1 = *(const f32x4*)(xq_g + 16 * s + 8 * hi + 4);
              u32x4 w; w.x = cvt_pk_bf16(bflo(raw[s].x) * rs * g0.x, bfhi(raw[s].x) * rs * g0.y); w.y = cvt_pk_bf16(bflo(raw[s].y) * rs * g0.z, bfhi(raw[s].y) * rs * g0.w);
              w.z = cvt_pk_bf16(bflo(raw[s].z) * rs * g1.x, bfhi(raw[s].z) * rs * g1.y); w.w = cvt_pk_bf16(bflo(raw[s].w) * rs * g1.z, bfhi(raw[s].w) * rs * g1.w);
              qf[s] = __builtin_bit_cast(bf16x8, w); } }
        f32x16 o[4];
#pragma unroll
        for (int db = 0; db < 4; ++db)
#pragma unroll
            for (int i = 0; i < 16; ++i) o[db][i] = 0.f;
        float mrun = -1e30f, lrun = 0.f;
        const LAS unsigned char* kbase = Kl + r * 272 + hi * 16;
        const LAS unsigned char* vbase[4];
#pragma unroll
        for (int db = 0; db < 4; ++db) vbase[db] = Vl + (4 * hi + tq) * 256 + ((4 * (db ^ tq) + 2 * G1 + (tp >> 1)) * 16) + (tp & 1) * 8;
#pragma unroll 1
        for (int t = 0; t < 4; ++t) {
            f32x16 sacc[2];
#pragma unroll
            for (int kb = 0; kb < 2; ++kb) {
#pragma unroll
                for (int i = 0; i < 16; ++i) sacc[kb][i] = 0.f;
#pragma unroll
                for (int s = 0; s < 8; ++s) { const bf16x8 kf = *(const LAS bf16x8*)(kbase + (64 * t + 32 * kb) * 272 + 32 * s);
                    sacc[kb] = __builtin_amdgcn_mfma_f32_32x32x16_bf16(kf, qf[s], sacc[kb], 0, 0, 0); } }
            float mx = sacc[0][0];
#pragma unroll
            for (int i = 1; i < 16; ++i) mx = fmaxf(mx, sacc[0][i]);
#pragma unroll
            for (int i = 0; i < 16; ++i) mx = fmaxf(mx, sacc[1][i]);
            mx = fmaxf(mx, __shfl_xor(mx, 32));
            const float mn = fmaxf(mrun, mx), f = __builtin_amdgcn_exp2f(mrun - mn); mrun = mn;
            float ls = 0.f; bf16x8 pf[2][2];
#pragma unroll
            for (int kb = 0; kb < 2; ++kb) { float p[16];
#pragma unroll
                for (int i = 0; i < 16; ++i) { p[i] = __builtin_amdgcn_exp2f(sacc[kb][i] - mn); ls += p[i]; }
#pragma unroll
                for (int ks = 0; ks < 2; ++ks) { u32x4 w; w.x = cvt_pk_bf16(p[8 * ks + 0], p[8 * ks + 1]); w.y = cvt_pk_bf16(p[8 * ks + 2], p[8 * ks + 3]); w.z = cvt_pk_bf16(p[8 * ks + 4], p[8 * ks + 5]); w.w = cvt_pk_bf16(p[8 * ks + 6], p[8 * ks + 7]);
                    pf[kb][ks] = __builtin_bit_cast(bf16x8, w); } }
            lrun = lrun * f + ls;
#pragma unroll
            for (int db = 0; db < 4; ++db)
#pragma unroll
                for (int i = 0; i < 16; ++i) o[db][i] *= f;
#pragma unroll
            for (int db = 0; db < 4; ++db)
#pragma unroll
                for (int kb = 0; kb < 2; ++kb)
#pragma unroll
                    for (int ks = 0; ks < 2; ++ks) { const int ko = (64 * t + 32 * kb + 16 * ks) * 256;
                        const v4i16_t t0 = lds_tr16(vbase[db] + ko), t1 = lds_tr16(vbase[db] + ko + 8 * 256);
                        o[db] = __builtin_amdgcn_mfma_f32_32x32x16_bf16(cat8(t0, t1), pf[kb][ks], o[db], 0, 0, 0); }
        }
        const float lt = lrun + __shfl_xor(lrun, 32); const float inv = 1.0f / lt;
        bf16_t* orow = ox + qrow * DX + h * XHD;
#pragma unroll
        for (int db = 0; db < 4; ++db)
#pragma unroll
            for (int g4 = 0; g4 < 4; ++g4) { const int d0 = 32 * db + 8 * g4 + 4 * hi;
                u32x2 w; w.x = cvt_pk_bf16(o[db][4 * g4 + 0] * inv, o[db][4 * g4 + 1] * inv); w.y = cvt_pk_bf16(o[db][4 * g4 + 2] * inv, o[db][4 * g4 + 3] * inv);
                *(u32x2*)(orow + d0) = w; }
    }
    __syncthreads();
}

#ifndef QSCALE_V
#define QSCALE_V (0.125f * LOG2E)
#endif
__global__ void __launch_bounds__(NWAVES * 64, 2) mk_fwd(Args args) {
    extern __shared__ __attribute__((aligned(16))) unsigned char lds_raw[];
    Frame F; F.lds = (LAS unsigned char*)lds_raw; F.tid = threadIdx.x; F.lane = F.tid & 63; F.wave = __builtin_amdgcn_readfirstlane(F.tid >> 6); F.G = gridDim.x;
    { const int bx = blockIdx.x; F.vcu = (F.G % 8 == 0) ? (bx % 8) * (F.G / 8) + bx / 8 : bx; }
    unsigned char* ws = args.ws; unsigned* ctl = (unsigned*)(ws + WS_CTL);
    for (int u = F.tid; u < (LDS_BYTES - LDSCTL_OFF) / 4; u += NWAVES * 64) ((LAS unsigned*)(F.lds + LDSCTL_OFF))[u] = 0u;
    __syncthreads();
    volatile LAS unsigned* MISC = (volatile LAS unsigned*)(F.lds + MISC_OFF);
    XcdBarrier bar = xcd_barrier_post(ctl + CW_BAR + args.li * XCD_BAR_WORDS, MISC + 8);
    const int lo = args.ph_lo, hi = args.ph_hi;
#define IN(k) (lo <= (k) && (k) < hi)
#define BOTH(k) (IN(k) && IN((k) + 1))
    bf16_t *Win = (bf16_t*)(ws + WS_WIN), *Wxkv = (bf16_t*)(ws + WS_WXKV), *Wout = (bf16_t*)(ws + WS_WOUT), *Wxq = (bf16_t*)(ws + WS_WXQ), *Wxo = (bf16_t*)(ws + WS_WXO);
    bf16_t *yb = (bf16_t*)(ws + WS_YB), *qx = (bf16_t*)(ws + WS_QX), *ox = (bf16_t*)(ws + WS_OX);
    float *sq1 = (float*)(ws + WS_SQ1), *sq2 = (float*)(ws + WS_SQ2), *rstd2 = (float*)(ws + WS_RSTD2), *gate = (float*)(ws + WS_GATE);
    bf16_t *Wrt = (bf16_t*)(ws + WS_WRT), *Wgu = (bf16_t*)(ws + WS_WGU), *Wdn = (bf16_t*)(ws + WS_WDN), *act = (bf16_t*)(ws + WS_ACT), *ybuf = (bf16_t*)(ws + WS_YBUF);
    int* list = (int*)(ws + WS_LIST); LAS unsigned* mtab = (LAS unsigned*)(F.lds + MOE_OFF);
    bf16_t *hb = (bf16_t*)(ws + WS_HB), *hmb = (bf16_t*)(ws + WS_HMB), *proj = (bf16_t*)(ws + WS_PROJ), *kvmem = (bf16_t*)(ws + WS_KVMEM);
    const int gw = F.vcu * NWAVES + F.wave, NGW = F.G * NWAVES;

    if (IN(0)) {
        LAS float* scr = (LAS float*)(F.lds + RING_OFF + F.wave * 17408);
        constexpr int IT_IN = (DM / 64) * (NPROJ / 64), IT_XKV = (DM / 64) * (2 * DX / 64), IT_OUT = (DM / 64) * (DM / 64), IT_XQ = (DM / 64) * (DX / 64), IT_XO = (DX / 64) * (DM / 64), IT_RT = DM / 64,
                      GU_PER_E = (DM / 64) * (2 * DFF / 64), DN_PER_E = (DFF / 64) * (DM / 64), IT_GU = NE * GU_PER_E, IT_DN = NE * DN_PER_E;
        for (int it = gw; it < IT_GU + IT_DN + IT_IN + IT_XKV + IT_OUT + IT_XQ + IT_XO + IT_RT; it += NGW) {
            int r = it;
            if (r < IT_GU) { const int e = r / GU_PER_E, rr = r % GU_PER_E, kb = rr / (2 * DFF / 64), nb = rr % (2 * DFF / 64);
                const int c0 = 32 * nb, pn = c0 >> 7;
                p0_transpose64<2>(args.in[I_W_GU] + (size_t)e * DM * 2 * DFF, 2 * DFF, DM, Wgu + (size_t)e * 2 * DFF * DM, 64 * kb, 64 * nb, 256 * pn + (c0 & 127), args.in[I_NORM_FFN_G], scr, F.lane); continue; }
            r -= IT_GU;
            if (r < IT_DN) { const int e = r / DN_PER_E, rr = r % DN_PER_E, kb = rr / (DM / 64), nb = rr % (DM / 64);
                p0_transpose64<0>(args.in[I_W_DN] + (size_t)e * DFF * DM, DM, DFF, Wdn + (size_t)e * DM * DFF, 64 * kb, 64 * nb, 64 * nb, nullptr, scr, F.lane); continue; }
            r -= IT_DN;
            if (r < IT_IN) { const int kb = r / (NPROJ / 64), nb = r % (NPROJ / 64); const int pn = nb >> 2, wc = nb & 3;
                p0_transpose64<1>(args.in[I_W_IN], NPROJ, DM, Win, 64 * kb, 64 * nb, 256 * pn + 32 * wc, nullptr, scr, F.lane); continue; }
            r -= IT_IN;
            if (r < IT_XKV) { const int kb = r / (2 * DX / 64), nb = r % (2 * DX / 64);
                p0_transpose64<0>(args.in[I_W_XKV], 2 * DX, DM, Wxkv, 64 * kb, 64 * nb, 64 * nb, nullptr, scr, F.lane); continue; }
            r -= IT_XKV;
            if (r < IT_OUT) { const int kb = r / (DM / 64), nb = r % (DM / 64);
                p0_transpose64<0>(args.in[I_W_OUT], DM, DM, Wout, 64 * kb, 64 * nb, 64 * nb, nullptr, scr, F.lane); continue; }
            r -= IT_OUT;
            if (r < IT_XQ) { const int kb = r / (DX / 64), nb = r % (DX / 64);
                p0_transpose64<0>(args.in[I_W_XQ], DX, DM, Wxq, 64 * kb, 64 * nb, 64 * nb, args.in[I_NORM_X_G], scr, F.lane); continue; }
            r -= IT_XQ;
            if (r < IT_XO) { const int kb = r / (DM / 64), nb = r % (DM / 64);
                p0_transpose64<0>(args.in[I_W_XO], DM, DX, Wxo, 64 * kb, 64 * nb, 64 * nb, nullptr, scr, F.lane); continue; }
            r -= IT_XO;
            p0_transpose_item(args.in[I_W_ROUTER], NE, DM, Wrt, 64 * r, 0, 1, 0, args.in[I_NORM_FFN_G], scr, F.lane);
        }
        for (int m = gw; m < MTOK; m += NGW) rms_row_to_bf16(args.in[I_X] + (size_t)m * DM, args.in[I_NORM_MIX_G], hb + (size_t)m * DM, F.lane);
        for (int m = gw; m < MMEM; m += NGW) rms_row_to_bf16(args.in[I_MEM] + (size_t)m * DM, args.in[I_NORM_MEM_G], hmb + (size_t)m * DM, F.lane);
        if (BOTH(0)) xcd_barrier(bar);
    }
    if (IN(1)) {
        { pg8::DenseSched S; S.init(hb, Win, MTOK, NPROJ, DM, F.G, (int)blockIdx.x); EpiProj E{proj, args.in[I_Q_G], args.in[I_K_G], QSCALE_V, 0};
          pg8::gemm_phase<EpiProj, pg8::DenseSched, 0>(F.lds + RING_OFF, F.lds + IDX_OFF, S, E); }
        { pg8::DenseSched S; S.init(hmb, Wxkv, MMEM, 2 * DX, DM, F.G, (int)blockIdx.x); EpiBf16 E{kvmem, 2 * DX, 0};
          pg8::gemm_phase<EpiBf16, pg8::DenseSched, 0>(F.lds + RING_OFF, F.lds + IDX_OFF, S, E); }
        if (BOTH(1)) xcd_barrier(bar);
    }
    if (IN(2)) {
        p2_attn(F, proj, args.in[I_REL_BIAS], args.in[I_CONV_W], args.in[I_ONA_G], args.in[I_ONB_G], yb, kvmem, args.in[I_XK_G], true);
        if (BOTH(2)) xcd_barrier(bar);
    }
    if (IN(3)) {
        pg8::DenseSched S; S.init(yb, Wout, MTOK, DM, DM, F.G, (int)blockIdx.x); EpiRes<false> E{args.in[I_X], hb, sq1};
        pg8::gemm_phase<EpiRes<false>, pg8::DenseSched, 0>(F.lds + RING_OFF, F.lds + IDX_OFF, S, E);
        if (BOTH(3)) xcd_barrier(bar);
    }
    if (IN(4)) {
        pg8::DenseSched S; S.init(hb, Wxq, MTOK, DX, DM, F.G, (int)blockIdx.x); EpiRstdBf16 E{qx, sq1, DX, 0};
        pg8::gemm_phase<EpiRstdBf16, pg8::DenseSched, 0>(F.lds + RING_OFF, F.lds + IDX_OFF, S, E);
        if (BOTH(4)) xcd_barrier(bar);
    }
    if (IN(5)) {
        p5_xattn(F, qx, kvmem, args.in[I_XQ_G], ox);
        if (BOTH(5)) xcd_barrier(bar);
    }
    if (IN(6)) {
        pg8::DenseSched S; S.init(ox, Wxo, MTOK, DM, DX, F.G, (int)blockIdx.x); EpiRes<true> E{hb, hb, sq2};
        pg8::gemm_phase<EpiRes<true>, pg8::DenseSched, 0>(F.lds + RING_OFF, F.lds + IDX_OFF, S, E);
        if (BOTH(6)) xcd_barrier(bar);
    }
    if (IN(7)) {
        p7_route(F, hb, Wrt, sq2, args.in[I_B_ROUTER], ctl + CW_CNT, list, gate, rstd2);
        if (BOTH(7)) xcd_barrier(bar);
    }
    if (IN(8)) {
        moe_tables(ctl + CW_CNT, mtab, F.tid);
        MoeSched S{(const char*)hb, (const char*)Wgu, (size_t)2 * DFF * DM * 2, list, mtab, DM, 2 * DFF / 256, (int)mtab[32 + NE], F.G, (int)blockIdx.x, 1};
        EpiSwiglu2 E{act, args.in[I_B_GU], rstd2, mtab};
        pg8::gemm_phase<EpiSwiglu2, MoeSched, 2>(F.lds + RING_OFF, F.lds + IDX_OFF, S, E);
        if (BOTH(8)) xcd_barrier(bar);
    }
    if (IN(9)) {
        moe_tables(ctl + CW_CNT, mtab, F.tid);
        MoeSched S{(const char*)act, (const char*)Wdn, (size_t)DM * DFF * 2, list, mtab, DFF, DM / 256, (int)mtab[32 + NE], F.G, (int)blockIdx.x, 0};
        EpiDown2 E{ybuf, args.in[I_B_DN], gate, mtab};
        pg8::gemm_phase<EpiDown2, MoeSched, 1>(F.lds + RING_OFF, F.lds + IDX_OFF, S, E);
        if (BOTH(9)) xcd_barrier(bar);
    }
    if (IN(10)) p10_combine(F, args.out, hb, ybuf);
#undef IN
#undef BOTH
}

static int g_grid = 0;
static void launch_mk(Args& a, int lo, int hi, int li, hipStream_t stream) {
    a.ph_lo = lo; a.ph_hi = hi; a.li = li; a.pad = 0;
    hipLaunchKernelGGL(mk_fwd, dim3(g_grid), dim3(NWAVES * 64), LDS_BYTES, stream, a);
}
extern "C" void kernel_launch(void* const* d_in, const int* in_sizes, int n_in, void* d_out, int out_size, void* d_ws, size_t ws_size, hipStream_t stream) {
    if (n_in != 25 || ws_size < WS_END || out_size != MTOK * DM) { fprintf(stderr, "kernel_launch: unexpected problem (n_in %d ws %zu out %d)\n", n_in, ws_size, out_size); return; }
    if (g_grid == 0) {
        int dev = 0, cus = 0;
        if (hipGetDevice(&dev) != hipSuccess || hipDeviceGetAttribute(&cus, hipDeviceAttributeMultiprocessorCount, dev) != hipSuccess) { g_grid = -1; return; }
        if (hipFuncSetAttribute((const void*)mk_fwd, hipFuncAttributeMaxDynamicSharedMemorySize, LDS_BYTES) != hipSuccess) { g_grid = -1; return; }
        int per_cu = 0; (void)hipOccupancyMaxActiveBlocksPerMultiprocessor(&per_cu, (const void*)mk_fwd, NWAVES * 64, LDS_BYTES); (void)hipGetLastError();
        g_grid = (per_cu >= 1) ? cus : -1;
    }
    if (g_grid < 0) return;
    const float* x = (const float*)d_in[0]; const float* rel_bias = (const float*)d_in[6]; const float* conv_w = (const float*)d_in[7];
    const float* out_norm_a_g = (const float*)d_in[8]; const float* out_norm_b_g = (const float*)d_in[9]; const float* w_out = (const float*)d_in[10]; const float* norm_xattn_g = (const float*)d_in[11];
    const float* w_xq = (const float*)d_in[13]; const float* xq_norm_g = (const float*)d_in[15];
    const float* xk_norm_g = (const float*)d_in[16]; const float* w_xo = (const float*)d_in[17]; const float* norm_ffn_g = (const float*)d_in[18]; const float* w_router = (const float*)d_in[19];
    const float* b_router = (const float*)d_in[20]; const float* w_gate_up = (const float*)d_in[21]; const float* b_gate_up = (const float*)d_in[22]; const float* w_down = (const float*)d_in[23];
    const float* b_down = (const float*)d_in[24];
    unsigned char* ws = (unsigned char*)d_ws; float* out = (float*)d_out;
    unsigned* ctl = (unsigned*)(ws + WS_CTL);
    bf16_t *Wout = (bf16_t*)(ws + WS_WOUT), *Wxq = (bf16_t*)(ws + WS_WXQ), *Wxo = (bf16_t*)(ws + WS_WXO), *Wgu = (bf16_t*)(ws + WS_WGU), *Wdn = (bf16_t*)(ws + WS_WDN);
    bf16_t *hb = (bf16_t*)(ws + WS_HB), *proj = (bf16_t*)(ws + WS_PROJ), *kvmem = (bf16_t*)(ws + WS_KVMEM), *yb = (bf16_t*)(ws + WS_YB), *qx = (bf16_t*)(ws + WS_QX), *ox = (bf16_t*)(ws + WS_OX);
    bf16_t *act = (bf16_t*)(ws + WS_ACT), *ybuf = (bf16_t*)(ws + WS_YBUF);
    float *ya = (float*)(ws + WS_YA), *x1 = (float*)(ws + WS_X1), *gate = (float*)(ws + WS_GATE);
    int *list = (int*)(ws + WS_LIST), *slot_tk = (int*)(ws + WS_SLOTTK), *slot_src = (int*)(ws + WS_SLOTSRC), *blk_e = (int*)(ws + WS_BLKE);

    (void)hipMemsetAsync(ctl, 0, CTL_ZERO_BYTES, stream);
    Args a{}; for (int i = 0; i < 25; ++i) a.in[i] = (const float*)d_in[i]; a.out = out; a.ws = ws;
    launch_mk(a, 0, 11, 0, stream);
}
```

```cpp
#include <hip/hip_runtime.h>
#include <stdint.h>
#include <stdio.h>

#define LAS __attribute__((address_space(3)))
#define GAS __attribute__((address_space(1)))
typedef unsigned short bf16_t;
typedef short bf16x8 __attribute__((ext_vector_type(8)));
typedef float f32x4 __attribute__((ext_vector_type(4)));
typedef float f32x16 __attribute__((ext_vector_type(16)));
typedef float f32x8 __attribute__((ext_vector_type(8)));
typedef unsigned u32x4 __attribute__((ext_vector_type(4)));
typedef unsigned u32x2 __attribute__((ext_vector_type(2)));
typedef int v8i32 __attribute__((ext_vector_type(8)));
typedef int v4i32 __attribute__((ext_vector_type(4)));

constexpr int DM = 1024, BATCH = 16, SEQ = 2048, MTOK = BATCH * SEQ;
constexpr int CHUNK = 64, LEFT = 8, NMEM = 256, MMEM = BATCH * NMEM;
constexpr int DATT = 512, DCONV = 512, NPROJ = 3072;
constexpr int XH = 4, XHD = 128, DX = 512;
constexpr int NE = 32, TOPK = 4, DFF = 1024;
constexpr int NREL = 513, MAXREL = 256;
constexpr int NASSIGN = MTOK * TOPK;
constexpr int MAXSLOT = NASSIGN + NE * 256;
constexpr float EPS = 1e-6f;
constexpr float LOG2E = 1.4426950408889634f;

constexpr size_t MiB = 1u << 20;
constexpr size_t WS_CTL = 0, CTL_ZERO_BYTES = 256 * 1024;
constexpr size_t WS_WIN = 1 * MiB, WS_WOUT = 7 * MiB, WS_WXQ = 9 * MiB, WS_WXKV = 10 * MiB, WS_WXO = 12 * MiB, WS_WGU = 13 * MiB, WS_WDN = 141 * MiB;
constexpr size_t WS_HB = 205 * MiB, WS_HMB = 269 * MiB;
constexpr size_t WS_LIST = 277 * MiB, WS_GATE = 281 * MiB, WS_SLOTTK = 282 * MiB, WS_SLOTSRC = 283 * MiB, WS_BLKE = 284 * MiB;
constexpr size_t WS_PROJ = 285 * MiB, WS_KVMEM = 477 * MiB, WS_YA = 485 * MiB, WS_YB = 549 * MiB, WS_X1 = 613 * MiB, WS_QX = 741 * MiB, WS_OX = 773 * MiB;
constexpr size_t WS_ACT = 285 * MiB, WS_YBUF = 557 * MiB;
constexpr size_t WS_SQ1 = 813 * MiB, WS_SQ2 = 815 * MiB, WS_RSTD2 = 817 * MiB, WS_WRT = 818 * MiB, WS_END = 819 * MiB;
constexpr int CW_CNT = 0, CW_NBLK = 64, CW_PSTART = 128;
constexpr int CW_BAR = 4096;

__device__ __forceinline__ unsigned f2bf(float f) { unsigned u = __builtin_bit_cast(unsigned, f); return (u + 0x7fffu + ((u >> 16) & 1u)) >> 16; }
__device__ __forceinline__ float bf2f(bf16_t b) { return __builtin_bit_cast(float, ((unsigned)b) << 16); }
__device__ __forceinline__ unsigned pk2(float lo, float hi) { return f2bf(lo) | (f2bf(hi) << 16); }
__device__ __forceinline__ float bflo(unsigned w) { return __builtin_bit_cast(float, w << 16); }
__device__ __forceinline__ float bfhi(unsigned w) { return __builtin_bit_cast(float, w & 0xffff0000u); }
__device__ __forceinline__ float wave_sum(float v) {
#pragma unroll
    for (int o = 1; o < 64; o <<= 1) v += __shfl_xor(v, o);
    return v;
}
__device__ __forceinline__ unsigned cvt_pk_bf16(float lo, float hi) { unsigned r; asm volatile("v_cvt_pk_bf16_f32 %0, %1, %2" : "=v"(r) : "v"(lo), "v"(hi)); return r; }

namespace pg8 {
constexpr int BM = 256, BK = 64, HALF = 128, HTB = HALF * BK * 2  , STAGE_BYTES = 8 * HTB, NXCD = 8, WGM = 8;
__host__ __device__ __forceinline__ int lds_byte(int r, int c) { const int st = (r >> 4) * 2 + (c >> 5), rr = r & 15, cc = c & 31, ob = rr * 64 + cc * 2; return st * 1024 + (ob ^ (((ob >> 9) & 1) << 5)); }
__host__ __device__ __forceinline__ void stage_rc(int b, int& R, int& C) { const int st = b / 1024, sb = b % 1024, swz = sb ^ (((sb >> 9) & 1) << 5); R = (st >> 1) * 16 + swz / 64; C = (st & 1) * 32 + (swz % 64) / 2; }
__host__ __device__ __forceinline__ int perm32(int rho) { const int n = rho >> 4, i = rho & 15; return 8 * (i >> 2) + 4 * n + (i & 3); }

struct Unit { int pm, pn, e, rbl; };

__device__ __forceinline__ bool static_order(int nM, int nN, int G, int c, int i, int& pm, int& pn) {
    const int nwg = nM * nN; const long L = (long)i * G + c; if (L >= nwg) return false;
    int wgid = (int)L; { const int q = nwg / NXCD, r = nwg % NXCD, xcd = wgid % NXCD, off = wgid / NXCD; wgid = (xcd < r ? xcd * (q + 1) : r * (q + 1) + (xcd - r) * q) + off; }
    const int nig = WGM * nN, gid = wgid / nig, fm = gid * WGM, gsz = (nM - fm) < WGM ? (nM - fm) : WGM;
    pm = fm + ((wgid % nig) % gsz); pn = (wgid % nig) / gsz; return true;
}
struct DenseSched {
    const char* A; const char* Bt; int K, nM, nN, G, c;
    __device__ __forceinline__ void init(const void* A_, const void* Bt_, int M, int N, int K_, int G_, int c_) { A = (const char*)A_; Bt = (const char*)Bt_; K = K_; nM = M / BM; nN = N / BM; G = G_; c = c_; }
    __device__ __forceinline__ bool next(int i, Unit& u) const { u.e = 0; u.rbl = 0; return static_order(nM, nN, G, c, i, u.pm, u.pn); }
    __device__ __forceinline__ const char* a_base(const Unit& u) const { return A + (size_t)u.pm * BM * K * 2; }
    __device__ __forceinline__ const char* b_base(const Unit& u) const { return Bt + (size_t)u.pn * BM * K * 2; }
    __device__ __forceinline__ unsigned a_off(const Unit& u) const { return (unsigned)u.pm * BM * K; }
    __device__ __forceinline__ unsigned b_off(const Unit& u) const { return (unsigned)u.pn * BM * K; }
    __device__ __forceinline__ void issue_rows(const Unit&, LAS unsigned char*, int, int) const {}
    __device__ __forceinline__ void read_rows(const Unit&, const LAS unsigned char*, int, unsigned (&)[4]) const {}
};

template <class Epi, class Sched, int MODE>
__device__ __forceinline__ void gemm_phase(LAS unsigned char* lds, LAS unsigned char* ldsidx, const Sched& S, const Epi& E) {
    const int tid = threadIdx.x, wid = __builtin_amdgcn_readfirstlane(tid >> 6), lane = tid & 63, wr = wid >> 2, wc = wid & 3, fr = lane & 15, fq = lane >> 4;
    const int K = S.K, nt = K / BK;
    int R0, C0; stage_rc(tid * 16, R0, C0);
    const int Rb = (R0 & ~31) + perm32(R0 & 31);
    const unsigned voffB0 = (unsigned)(Rb * K + C0) * 2u, voffB1 = voffB0 + (unsigned)(64 * K) * 2u;
    const size_t kstep = (size_t)(BK * 2);
    const size_t hstep = (size_t)HALF * K * 2;
    const unsigned ldsw = (unsigned)wid * 1024u;
    const int aoff = lds_byte(wr * 64 + fr, fq * 8), boff = lds_byte(wc * 32 + fr, fq * 8);
#define PG8_SA(b, h) (((b) * 2 + (h)) * HTB)
#define PG8_SB(b, h) ((4 + (b) * 2 + (h)) * HTB)
#define PG8_STAGE(bufoff, gbase, o0, o1) do { \
        __builtin_amdgcn_global_load_lds((const unsigned*)((const char*)(gbase) + (o0)), (LAS unsigned*)(lds + (bufoff) + ldsw), 16, 0, 0); \
        __builtin_amdgcn_global_load_lds((const unsigned*)((const char*)(gbase) + (o1)), (LAS unsigned*)(lds + (bufoff) + ldsw + 8192), 16, 0, 0); } while (0)
#define PG8_LDA(dst, b, h) do { _Pragma("unroll") for (int m = 0; m < 4; ++m) _Pragma("unroll") for (int k = 0; k < 2; ++k) dst[m][k] = *(const LAS bf16x8*)(lds + PG8_SA(b, h) + aoff + m * 2048 + k * 1024); } while (0)
#define PG8_LDB(dst, b, h) do { _Pragma("unroll") for (int n = 0; n < 2; ++n) _Pragma("unroll") for (int k = 0; k < 2; ++k) dst[n][k] = *(const LAS bf16x8*)(lds + PG8_SB(b, h) + boff + n * 2048 + k * 1024); } while (0)
#define PG8_MMA(ai, bj, At, Bt) do { __builtin_amdgcn_s_setprio(1); _Pragma("unroll") for (int m = 0; m < 4; ++m) _Pragma("unroll") for (int n = 0; n < 2; ++n) _Pragma("unroll") for (int k = 0; k < 2; ++k) \
        acc[ai][bj][m][n] = __builtin_amdgcn_mfma_f32_16x16x32_bf16(Bt[n][k], At[m][k], acc[ai][bj][m][n], 0, 0, 0); __builtin_amdgcn_s_setprio(0); } while (0)
#define PG8_WAIT_V(n) asm volatile("s_waitcnt vmcnt(" #n ")" ::: "memory")
#define PG8_WAIT_L(n) asm volatile("s_waitcnt lgkmcnt(" #n ")" ::: "memory")
#define PG8_BAR __builtin_amdgcn_s_barrier()
#define PG8_SCHED __builtin_amdgcn_sched_barrier(0)
    Unit cur, nxt; int ui = 0, ib = 0;
    if (!S.next(0, cur)) return;
    unsigned vc[4], vn[4];
    constexpr bool GATHER = (MODE == 2);
    if constexpr (MODE >= 1) { S.issue_rows(cur, ldsidx, wid, lane); asm volatile("s_waitcnt vmcnt(0)" ::: "memory"); __builtin_amdgcn_s_barrier(); asm volatile("" ::: "memory"); }
    if constexpr (GATHER) { S.read_rows(cur, ldsidx, R0, vc); _Pragma("unroll") for (int q = 0; q < 4; ++q) vc[q] += (unsigned)C0 * 2u; }
    else { _Pragma("unroll") for (int q = 0; q < 4; ++q) vc[q] = (unsigned)((R0 + 64 * q) * K + C0) * 2u; }
#pragma unroll
    for (int q = 0; q < 4; ++q) vn[q] = vc[q];
    f32x4 acc[2][2][4][2];
#pragma unroll
    for (int a = 0; a < 2; ++a)
#pragma unroll
        for (int b = 0; b < 2; ++b)
#pragma unroll
            for (int m = 0; m < 4; ++m)
#pragma unroll
                for (int n = 0; n < 2; ++n) acc[a][b][m][n] = (f32x4){0.f, 0.f, 0.f, 0.f};
    bf16x8 At[4][2], B0[2][2], B1[2][2];
    const char* cA = S.a_base(cur); const char* cB = S.b_base(cur);
    PG8_STAGE(PG8_SB(0, 0), cB, voffB0, voffB1); PG8_STAGE(PG8_SB(0, 1), cB + hstep, voffB0, voffB1); PG8_STAGE(PG8_SA(0, 0), cA, vc[0], vc[1]); PG8_STAGE(PG8_SA(0, 1), cA, vc[2], vc[3]);
    if (wr == 1) PG8_BAR;
    PG8_WAIT_V(2); PG8_BAR;
    PG8_STAGE(PG8_SB(1, 0), cB + kstep, voffB0, voffB1); PG8_STAGE(PG8_SA(1, 0), cA + kstep, vc[0], vc[1]); PG8_STAGE(PG8_SB(1, 1), cB + hstep + kstep, voffB0, voffB1);
    PG8_WAIT_V(6); PG8_BAR;
    for (;;) {
        const bool has_next = S.next(ui + 1, nxt);
        if constexpr (MODE >= 1) { if (has_next) S.issue_rows(nxt, ldsidx + (ib == 2 ? 0 : ib + 1) * 1024, wid, lane); }
        const char* nA = has_next ? S.a_base(nxt) : cA; const char* nB = has_next ? S.b_base(nxt) : cB;
        for (int t = 0; t < nt; t += 2) {
            const bool last = (t == nt - 2);
            const char* a1 = cA + (size_t)(t + 1) * kstep;
            const char* a2 = last ? nA : cA + (size_t)(t + 2) * kstep; const char* b2 = last ? nB : cB + (size_t)(t + 2) * kstep;
            const char* a3 = a2 + kstep; const char* b3 = b2 + kstep;
            unsigned w0 = vc[0], w1 = vc[1], w2 = vc[2], w3 = vc[3];
            if constexpr (GATHER) { if (last && has_next) { S.read_rows(nxt, ldsidx + (ib == 2 ? 0 : ib + 1) * 1024, R0, vn); _Pragma("unroll") for (int q = 0; q < 4; ++q) vn[q] += (unsigned)C0 * 2u;
                w0 = vn[0]; w1 = vn[1]; w2 = vn[2]; w3 = vn[3]; } }
            PG8_LDB(B0, 0, 0); PG8_LDB(B1, 0, 1); PG8_SCHED; PG8_LDA(At, 0, 0); PG8_STAGE(PG8_SA(1, 1), a1, vc[2], vc[3]);
            PG8_WAIT_V(8); PG8_WAIT_L(0); PG8_BAR; PG8_MMA(0, 0, At, B0); PG8_MMA(0, 1, At, B1); PG8_BAR; PG8_SCHED;
            PG8_LDA(At, 0, 1); PG8_STAGE(PG8_SB(0, 0), b2, voffB0, voffB1); PG8_STAGE(PG8_SB(0, 1), b2 + hstep, voffB0, voffB1); PG8_STAGE(PG8_SA(0, 0), a2, w0, w1);
            PG8_WAIT_V(8); PG8_WAIT_L(0); PG8_BAR; PG8_MMA(1, 0, At, B0); PG8_MMA(1, 1, At, B1); PG8_BAR; PG8_SCHED;
            PG8_LDB(B0, 1, 0); PG8_LDB(B1, 1, 1); PG8_SCHED; PG8_LDA(At, 1, 0); PG8_STAGE(PG8_SA(0, 1), a2, w2, w3);
            PG8_WAIT_V(8); PG8_WAIT_L(0); PG8_BAR; PG8_MMA(0, 0, At, B0); PG8_MMA(0, 1, At, B1); PG8_BAR; PG8_SCHED;
            PG8_LDA(At, 1, 1); PG8_STAGE(PG8_SB(1, 0), b3, voffB0, voffB1); PG8_STAGE(PG8_SB(1, 1), b3 + hstep, voffB0, voffB1); PG8_STAGE(PG8_SA(1, 0), a3, w0, w1);
            PG8_WAIT_V(8); PG8_WAIT_L(0); PG8_BAR; PG8_MMA(1, 0, At, B0); PG8_MMA(1, 1, At, B1); PG8_BAR; PG8_SCHED;
        }
        if (wr == 0) PG8_BAR;
        E(acc, cur, wr, wc, fr, fq, (const LAS unsigned char*)(ldsidx + ib * 1024));
        if (!has_next) break;
#pragma unroll
        for (int a = 0; a < 2; ++a)
#pragma unroll
            for (int b = 0; b < 2; ++b)
#pragma unroll
                for (int m = 0; m < 4; ++m)
#pragma unroll
                    for (int n = 0; n < 2; ++n) acc[a][b][m][n] = (f32x4){0.f, 0.f, 0.f, 0.f};
        cur = nxt; cA = nA; cB = nB; ++ui; ib = (ib == 2 ? 0 : ib + 1);
#pragma unroll
        for (int q = 0; q < 4; ++q) vc[q] = vn[q];
        if (wr == 1) PG8_BAR;
    }
    PG8_WAIT_V(0);
    PG8_BAR;
#undef PG8_SA
#undef PG8_SB
#undef PG8_STAGE
#undef PG8_LDA
#undef PG8_LDB
#undef PG8_MMA
#undef PG8_WAIT_V
#undef PG8_WAIT_L
#undef PG8_BAR
#undef PG8_SCHED
}
template <class Epi, class Sched, int MODE>
__device__ __forceinline__ void gemm_phase_f8(LAS unsigned char* lds, LAS unsigned char* ldsidx, const Sched& S, const Epi& E) {
    const int tid = threadIdx.x, wid = __builtin_amdgcn_readfirstlane(tid >> 6), lane = tid & 63, wr = wid >> 2, wc = wid & 3, fr = lane & 15, fq = lane >> 4;
    constexpr bool GATHER = (MODE == 2);
    const int K = S.K, nt = K / 128;
    const int R0 = tid >> 3, C0 = ((tid & 7) ^ ((R0 >> 1) & 1)) * 16;
    const int Rb = (R0 & ~31) + perm32(R0 & 31);
    const unsigned voffB0 = (unsigned)(Rb * K + C0), r64 = 64u * (unsigned)K;
    const unsigned kstep = 128u;
    const unsigned hstep = (unsigned)(HALF * K);
    const char* const Abase = S.A; const char* const Bbase = S.Bt;
    const unsigned ldsw = (unsigned)wid * 1024u;
    const int sw16 = ((fr >> 1) & 1) * 16;
    const LAS unsigned char* a0p = lds + (wr * 64 + fr) * 128 + fq * 32 + sw16; const LAS unsigned char* a1p = lds + (wr * 64 + fr) * 128 + fq * 32 + 16 - sw16;
    const LAS unsigned char* b0p = lds + 4 * HTB + (wc * 32 + fr) * 128 + fq * 32 + sw16; const LAS unsigned char* b1p = lds + 4 * HTB + (wc * 32 + fr) * 128 + fq * 32 + 16 - sw16;
#define PG8_SA(b, h) (((b) * 2 + (h)) * HTB)
#define PG8_SB(b, h) ((4 + (b) * 2 + (h)) * HTB)
#define PG8_STAGE(bufoff, gbase, o0, o1) do { \
        __builtin_amdgcn_global_load_lds((const unsigned*)((const char*)(gbase) + (o0)), (LAS unsigned*)(lds + (bufoff) + ldsw), 16, 0, 0); \
        __builtin_amdgcn_global_load_lds((const unsigned*)((const char*)(gbase) + (o1)), (LAS unsigned*)(lds + (bufoff) + ldsw + 8192), 16, 0, 0); } while (0)
#define PG8_STAGEA(bufoff, uo, hh) do { \
        __builtin_amdgcn_global_load_lds((const unsigned*)(Abase + (unsigned)((uo) + vc[2 * (hh)])), (LAS unsigned*)(lds + (bufoff) + ldsw), 16, 0, 0); \
        __builtin_amdgcn_global_load_lds((const unsigned*)(Abase + (unsigned)((uo) + vc[2 * (hh) + 1])), (LAS unsigned*)(lds + (bufoff) + ldsw + 8192), 16, 0, 0); } while (0)
#define PG8_STAGEB(bufoff, uo) do { \
        __builtin_amdgcn_global_load_lds((const unsigned*)(Bbase + (unsigned)((uo) + voffB0)), (LAS unsigned*)(lds + (bufoff) + ldsw), 16, 0, 0); \
        __builtin_amdgcn_global_load_lds((const unsigned*)(Bbase + (unsigned)((uo) + r64 + voffB0)), (LAS unsigned*)(lds + (bufoff) + ldsw + 8192), 16, 0, 0); } while (0)
#define PG8_LD32(p0, p1, off) __builtin_shufflevector(*(const LAS v4i32*)((p0) + (off)), *(const LAS v4i32*)((p1) + (off)), 0, 1, 2, 3, 4, 5, 6, 7)
#define PG8_LDA(dst, b, h) do { _Pragma("unroll") for (int m = 0; m < 4; ++m) dst[m] = PG8_LD32(a0p, a1p, PG8_SA(b, h) + m * 2048); } while (0)
#define PG8_LDB(dst, b, h) do { _Pragma("unroll") for (int n = 0; n < 2; ++n) dst[n] = PG8_LD32(b0p, b1p, PG8_SB(b, h) - 4 * HTB + n * 2048); } while (0)
#define PG8_MMA(ai, bj, At, Bt) do { __builtin_amdgcn_s_setprio(1); _Pragma("unroll") for (int m = 0; m < 4; ++m) _Pragma("unroll") for (int n = 0; n < 2; ++n) \
        acc[ai][bj][m][n] = __builtin_amdgcn_mfma_scale_f32_16x16x128_f8f6f4(Bt[n], At[m], acc[ai][bj][m][n], 0, 0, 0, 0, 0, 0); __builtin_amdgcn_s_setprio(0); } while (0)
#define PG8_WAIT_V(n) asm volatile("s_waitcnt vmcnt(" #n ")" ::: "memory")
#define PG8_WAIT_L(n) asm volatile("s_waitcnt lgkmcnt(" #n ")" ::: "memory")
#define PG8_BAR __builtin_amdgcn_s_barrier()
#define PG8_SCHED __builtin_amdgcn_sched_barrier(0)
    Unit cur, nxt; int ui = 0, ib = 0;
    if (!S.next(0, cur)) return;
    unsigned vc[4];
    if constexpr (MODE >= 1) { S.issue_rows(cur, ldsidx, wid, lane); asm volatile("s_waitcnt vmcnt(0)" ::: "memory"); __builtin_amdgcn_s_barrier(); asm volatile("" ::: "memory"); }
    if constexpr (GATHER) { S.read_rows(cur, ldsidx, R0, vc); _Pragma("unroll") for (int q = 0; q < 4; ++q) vc[q] += (unsigned)C0; }
    else { const unsigned ua = S.a_off(cur); _Pragma("unroll") for (int q = 0; q < 4; ++q) vc[q] = ua + (unsigned)((R0 + 64 * q) * K + C0); }
    f32x4 acc[2][2][4][2];
#pragma unroll
    for (int a = 0; a < 2; ++a)
#pragma unroll
        for (int b = 0; b < 2; ++b)
#pragma unroll
            for (int m = 0; m < 4; ++m)
#pragma unroll
                for (int n = 0; n < 2; ++n) acc[a][b][m][n] = (f32x4){0.f, 0.f, 0.f, 0.f};
    v8i32 At[4], B0[2], B1[2];
    unsigned cB = S.b_off(cur);
    PG8_STAGEB(PG8_SB(0, 0), cB); PG8_STAGEB(PG8_SB(0, 1), cB + hstep); PG8_STAGEA(PG8_SA(0, 0), 0u, 0); PG8_STAGEA(PG8_SA(0, 1), 0u, 1);
    if (wr == 1) PG8_BAR;
    PG8_WAIT_V(2); PG8_BAR;
    PG8_STAGEB(PG8_SB(1, 0), cB + kstep); PG8_STAGEA(PG8_SA(1, 0), kstep, 0); PG8_STAGEB(PG8_SB(1, 1), cB + hstep + kstep);
    PG8_WAIT_V(6); PG8_BAR;
    for (;;) {
        const bool has_next = S.next(ui + 1, nxt);
        if constexpr (MODE >= 1) { if (has_next) S.issue_rows(nxt, ldsidx + (ib == 2 ? 0 : ib + 1) * 1024, wid, lane); }
        const unsigned nB = has_next ? S.b_off(nxt) : cB;
        for (int t = 0; t < nt; t += 2) {
            const bool last = (t == nt - 2);
            const unsigned a1 = (unsigned)(t + 1) * kstep;
            const unsigned a2 = last ? 0u : (unsigned)(t + 2) * kstep, b2 = last ? nB : cB + (unsigned)(t + 2) * kstep;
            const unsigned a3 = a2 + kstep, b3 = b2 + kstep;
            PG8_LDB(B0, 0, 0); PG8_LDB(B1, 0, 1); PG8_SCHED; PG8_LDA(At, 0, 0); PG8_STAGEA(PG8_SA(1, 1), a1, 1);
            if (last && has_next) {
                if constexpr (GATHER) { S.read_rows(nxt, ldsidx + (ib == 2 ? 0 : ib + 1) * 1024, R0, vc); _Pragma("unroll") for (int q = 0; q < 4; ++q) vc[q] += (unsigned)C0; }
                else { const unsigned ua = S.a_off(nxt); _Pragma("unroll") for (int q = 0; q < 4; ++q) vc[q] = ua + (unsigned)((R0 + 64 * q) * K + C0); } }
            PG8_WAIT_V(8); PG8_WAIT_L(0); PG8_BAR; PG8_MMA(0, 0, At, B0); PG8_MMA(0, 1, At, B1); PG8_BAR; PG8_SCHED;
            PG8_LDA(At, 0, 1); PG8_STAGEB(PG8_SB(0, 0), b2); PG8_STAGEB(PG8_SB(0, 1), b2 + hstep); PG8_STAGEA(PG8_SA(0, 0), a2, 0);
            PG8_WAIT_V(8); PG8_WAIT_L(0); PG8_BAR; PG8_MMA(1, 0, At, B0); PG8_MMA(1, 1, At, B1); PG8_BAR; PG8_SCHED;
            PG8_LDB(B0, 1, 0); PG8_LDB(B1, 1, 1); PG8_SCHED; PG8_LDA(At, 1, 0); PG8_STAGEA(PG8_SA(0, 1), a2, 1);
            PG8_WAIT_V(8); PG8_WAIT_L(0); PG8_BAR; PG8_MMA(0, 0, At, B0); PG8_MMA(0, 1, At, B1); PG8_BAR; PG8_SCHED;
            PG8_LDA(At, 1, 1); PG8_STAGEB(PG8_SB(1, 0), b3); PG8_STAGEB(PG8_SB(1, 1), b3 + hstep); PG8_STAGEA(PG8_SA(1, 0), a3, 0);
            PG8_WAIT_V(8); PG8_WAIT_L(0); PG8_BAR; PG8_MMA(1, 0, At, B0); PG8_MMA(1, 1, At, B1); PG8_BAR; PG8_SCHED;
        }
        if (wr == 0) PG8_BAR;
        E(acc, cur, wr, wc, fr, fq, (const LAS unsigned char*)(ldsidx + ib * 1024));
        if (!has_next) break;
#pragma unroll
        for (int a = 0; a < 2; ++a)
#pragma unroll
            for (int b = 0; b < 2; ++b)
#pragma unroll
                for (int m = 0; m < 4; ++m) { acc[a][b][m][0] = (f32x4){0.f, 0.f, 0.f, 0.f}; acc[a][b][m][1] = (f32x4){0.f, 0.f, 0.f, 0.f}; }
        cur = nxt; cB = nB; ++ui; ib = (ib == 2 ? 0 : ib + 1);
        if (wr == 1) PG8_BAR;
    }
    PG8_WAIT_V(0);
    PG8_BAR;
#undef PG8_SA
#undef PG8_SB
#undef PG8_STAGE
#undef PG8_STAGEB
#undef PG8_STAGEA
#undef PG8_LDA
#undef PG8_LDB
#undef PG8_MMA
#undef PG8_LD32
#undef PG8_WAIT_V
#undef PG8_WAIT_L
#undef PG8_BAR
#undef PG8_SCHED
}
}

#define XB_TMO      128
#define XB_XCNT(j)  (256  + 64 * (j))
#define XB_XSUB(j)  (1280 + 64 * (j))
#define XB_XGEN(j)  (2304 + 64 * (j))
#define XB_TOP      3328
#define XB_TOPGEN   3392
#define XCD_BAR_WORDS 3456
#define XB_SPIN_CAP (1u << 18)

__device__ __forceinline__ unsigned xb_ld(unsigned* p)              { return __hip_atomic_load(p, __ATOMIC_RELAXED, __HIP_MEMORY_SCOPE_AGENT); }
__device__ __forceinline__ unsigned xb_add(unsigned* p, unsigned v) { return __hip_atomic_fetch_add(p, v, __ATOMIC_RELAXED, __HIP_MEMORY_SCOPE_AGENT); }
__device__ __forceinline__ unsigned xb_xcc_id() { return (unsigned)__builtin_amdgcn_s_getreg((3 << 11) | 20) & 0xFu; }
#define XB_SPIN(cond, bar) do { unsigned _sp = 0; while (cond) { __builtin_amdgcn_s_sleep(1); \
    if ((++_sp & 255u) == 0u) { if (xb_ld(&(bar)[XB_TMO])) break; if (_sp > XB_SPIN_CAP) { atomicAdd(&(bar)[XB_TMO], 1u); break; } } } } while (0)

struct XcdBarrier {
    unsigned* bar; unsigned x;
    volatile LAS unsigned* st;
};
__device__ __forceinline__ XcdBarrier xcd_barrier_post(unsigned* bar, volatile LAS unsigned* st) {
    XcdBarrier b; b.bar = bar; b.x = xb_xcc_id(); b.st = st;
    if (threadIdx.x == 0) (void)xb_add(&bar[XB_XCNT(b.x)], 1u);
    return b;
}
__device__ __forceinline__ void xcd_barrier_complete(unsigned* bar, unsigned x, unsigned& nloc, unsigned& nx) {
    const unsigned G = gridDim.x * gridDim.y * gridDim.z;
    unsigned sum, cnt, mine, sp = 0u;
    for (;;) {
        sum = 0u; cnt = 0u; mine = 0u;
#pragma unroll
        for (unsigned j = 0; j < 16; ++j) { const unsigned c = xb_ld(&bar[XB_XCNT(j)]); sum += c; cnt += (c > 0u) ? 1u : 0u; mine = (j == x) ? c : mine; }
        if (sum == G) break;
        __builtin_amdgcn_s_sleep(1);
        if ((++sp & 255u) == 0u) { if (xb_ld(&bar[XB_TMO])) break; if (sp > XB_SPIN_CAP) { atomicAdd(&bar[XB_TMO], 1u); break; } }
    }
    nloc = mine > 0u ? mine : 1u; nx = cnt > 0u ? cnt : 1u;
}
__device__ __forceinline__ void xcd_barrier(const XcdBarrier& b) {
    asm volatile("s_waitcnt vmcnt(0)" ::: "memory");
    __syncthreads();
    if (threadIdx.x == 0) {
        unsigned* bar = b.bar;
        __builtin_amdgcn_s_waitcnt(0);
        unsigned nloc = b.st[0], nx = b.st[1];
        if (nloc == 0u) { xcd_barrier_complete(bar, b.x, nloc, nx); b.st[0] = nloc; b.st[1] = nx; }
        const unsigned old = xb_add(&bar[XB_XSUB(b.x)], 1u);
        const unsigned gen = old / nloc;
        if (old + 1u == (gen + 1u) * nloc) {
            __builtin_amdgcn_fence(__ATOMIC_RELEASE, "agent");
            asm volatile("s_waitcnt vmcnt(0)" ::: "memory");
            const unsigned og = xb_add(&bar[XB_TOP], 1u);
            const unsigned tg = og / nx;
            if (og + 1u == (tg + 1u) * nx) xb_add(&bar[XB_TOPGEN], 1u);
            else XB_SPIN(xb_ld(&bar[XB_TOPGEN]) == tg, bar);
            __builtin_amdgcn_fence(__ATOMIC_ACQUIRE, "agent");
            xb_add(&bar[XB_XGEN(b.x)], 1u);
            asm volatile("s_waitcnt vmcnt(0)" ::: "memory");
        } else {
            XB_SPIN(xb_ld(&bar[XB_XGEN(b.x)]) == gen, bar);
            __builtin_amdgcn_fence(__ATOMIC_ACQUIRE, "agent");
            asm volatile("s_waitcnt vmcnt(0)" ::: "memory");
        }
    }
    __syncthreads();
}

constexpr int NWAVES = 8;
constexpr int RING_OFF = 0, RING_BYTES = 139264;
constexpr int LDSCTL_OFF = RING_BYTES, MISC_OFF = LDSCTL_OFF + 320;
constexpr int MOE_OFF = LDSCTL_OFF + 512;
constexpr int IDX_OFF = LDSCTL_OFF + 1024;
constexpr int TBL_OFF = LDSCTL_OFF + 4096;
constexpr int SSQ_OFF = LDSCTL_OFF + 16384;
constexpr int LDS_BYTES = RING_BYTES + 20480;
static_assert(TBL_OFF + 8 * 384 * 4 <= SSQ_OFF && SSQ_OFF + 4096 <= LDS_BYTES && LDS_BYTES <= 160 * 1024, "LDS map");

struct Args { const float* in[25]; float* out; unsigned char* ws; int ph_lo, ph_hi, li, pad; };
enum { I_X = 0, I_MEM, I_NORM_MIX_G, I_W_IN, I_Q_G, I_K_G, I_REL_BIAS, I_CONV_W, I_ONA_G, I_ONB_G, I_W_OUT, I_NORM_X_G, I_NORM_MEM_G, I_W_XQ, I_W_XKV, I_XQ_G, I_XK_G, I_W_XO,
       I_NORM_FFN_G, I_W_ROUTER, I_B_ROUTER, I_W_GU, I_B_GU, I_W_DN, I_B_DN };

constexpr float X8SCALE = 4.0f, W8SCALE = 64.0f, A8SCALE = 8.0f;
struct Frame {
    LAS unsigned char* lds; int tid, lane, wave, vcu, G;
};

__device__ __forceinline__ void p0_transpose_item(const float* __restrict__ W, int ldw, int K, bf16_t* __restrict__ WT, int k0, int scol0, int cstride, int drow0, const float* __restrict__ g, LAS float* scr, int lane) {
#pragma unroll 8
    for (int i = 0; i < 32; ++i) { const int kk = 2 * i + (lane >> 5); float v = W[(size_t)(k0 + kk) * ldw + scol0 + (lane & 31) * cstride]; if (g) v *= g[k0 + kk]; scr[kk * 33 + (lane & 31)] = v; }
    asm volatile("s_waitcnt lgkmcnt(0)" ::: "memory");
    const int c = lane & 7;
#pragma unroll
    for (int j = 0; j < 4; ++j) { const int n = (lane >> 3) + 8 * j; const LAS float* s = scr + (8 * c) * 33 + n;
        u32x4 o; o.x = pk2(s[0 * 33], s[1 * 33]); o.y = pk2(s[2 * 33], s[3 * 33]); o.z = pk2(s[4 * 33], s[5 * 33]); o.w = pk2(s[6 * 33], s[7 * 33]);
        *(u32x4*)(WT + (size_t)(drow0 + n) * K + k0 + 8 * c) = o; }
    asm volatile("s_waitcnt lgkmcnt(0)" ::: "memory");
}
template <int MODE>
__device__ __forceinline__ void p0_transpose64(const float* __restrict__ W, int ldw, int K, bf16_t* __restrict__ WT, int k0, int n0, int drow0, const float* __restrict__ g, LAS float* scr, int lane) {
    const int krow = lane >> 4, c4 = lane & 15;
    f32x4 v[16];
#pragma unroll
    for (int i = 0; i < 16; ++i) v[i] = *(const f32x4*)(W + (size_t)(k0 + 4 * i + krow) * ldw + n0 + 4 * c4);
    if (g) {
#pragma unroll
        for (int i = 0; i < 16; ++i) v[i] = v[i] * g[k0 + 4 * i + krow]; }
#pragma unroll
    for (int i = 0; i < 16; ++i) { LAS float* d = scr + (4 * i + krow) * 65 + 4 * c4; d[0] = v[i].x; d[1] = v[i].y; d[2] = v[i].z; d[3] = v[i].w; }
    asm volatile("s_waitcnt lgkmcnt(0)" ::: "memory");
    const int kc = lane & 7;
#pragma unroll
    for (int j = 0; j < 8; ++j) { const int n = (lane >> 3) + 8 * j; const LAS float* s = scr + (8 * kc) * 65 + n;
        u32x4 o; o.x = pk2(s[0 * 65], s[1 * 65]); o.y = pk2(s[2 * 65], s[3 * 65]); o.z = pk2(s[4 * 65], s[5 * 65]); o.w = pk2(s[6 * 65], s[7 * 65]);
        const int dr = MODE == 0 ? n : (MODE == 1 ? 128 * (n >> 5) + (n & 31) : 128 * (n & 1) + (n >> 1));
        *(u32x4*)(WT + (size_t)(drow0 + dr) * K + k0 + 8 * kc) = o; }
    asm volatile("s_waitcnt lgkmcnt(0)" ::: "memory");
}
__device__ __forceinline__ unsigned pk4_fp8(float a, float b, float c, float d) { int w = 0; w = __builtin_amdgcn_cvt_pk_fp8_f32(a, b, w, false); w = __builtin_amdgcn_cvt_pk_fp8_f32(c, d, w, true); return (unsigned)w; }
template <int MODE>
__device__ __forceinline__ void p0_transpose64_f8(const float* __restrict__ W, int ldw, int K, unsigned char* __restrict__ WT, int k0, int n0, int drow0, const float* __restrict__ g, float sc, LAS float* scr, int lane) {
    const int krow = lane >> 4, c4 = lane & 15;
    f32x4 v[16];
#pragma unroll
    for (int i = 0; i < 16; ++i) v[i] = *(const f32x4*)(W + (size_t)(k0 + 4 * i + krow) * ldw + n0 + 4 * c4);
#pragma unroll
    for (int i = 0; i < 16; ++i) v[i] = v[i] * (g ? g[k0 + 4 * i + krow] * sc : sc);
#pragma unroll
    for (int i = 0; i < 16; ++i) { LAS float* d = scr + (4 * i + krow) * 65 + 4 * c4; d[0] = v[i].x; d[1] = v[i].y; d[2] = v[i].z; d[3] = v[i].w; }
    asm volatile("s_waitcnt lgkmcnt(0)" ::: "memory");
    const int kc = lane & 3;
#pragma unroll
    for (int j = 0; j < 4; ++j) { const int n = (lane >> 2) + 16 * j; const LAS float* s = scr + (16 * kc) * 65 + n;
        u32x4 o; o.x = pk4_fp8(s[0 * 65], s[1 * 65], s[2 * 65], s[3 * 65]); o.y = pk4_fp8(s[4 * 65], s[5 * 65], s[6 * 65], s[7 * 65]);
        o.z = pk4_fp8(s[8 * 65], s[9 * 65], s[10 * 65], s[11 * 65]); o.w = pk4_fp8(s[12 * 65], s[13 * 65], s[14 * 65], s[15 * 65]);
        const int dr = MODE == 0 ? n : (MODE == 1 ? 128 * (n >> 5) + (n & 31) : 128 * (n & 1) + (n >> 1));
        *(u32x4*)(WT + (size_t)(drow0 + dr) * K + k0 + 16 * kc) = o; }
    asm volatile("s_waitcnt lgkmcnt(0)" ::: "memory");
}
__device__ __forceinline__ void rms_row_to_bf16(const float* __restrict__ xrow, const float* __restrict__ g, bf16_t* __restrict__ orow, int lane) {
    const f32x4* xr = (const f32x4*)xrow + lane; const f32x4* gr = (const f32x4*)g + lane;
    f32x4 v[4]; float s = 0.f;
#pragma unroll
    for (int j = 0; j < 4; ++j) { v[j] = xr[64 * j]; s += (v[j].x * v[j].x + v[j].y * v[j].y) + (v[j].z * v[j].z + v[j].w * v[j].w); }
    const float rstd = 1.0f / sqrtf(wave_sum(s) * (1.0f / DM) + EPS);
    u32x2* o8 = (u32x2*)orow + lane;
#pragma unroll
    for (int j = 0; j < 4; ++j) { const f32x4 gg = gr[64 * j]; u32x2 o; o.x = pk2(v[j].x * rstd * gg.x, v[j].y * rstd * gg.y); o.y = pk2(v[j].z * rstd * gg.z, v[j].w * rstd * gg.w); o8[64 * j] = o; }
}

using pg8::Unit;
struct EpiProj { bf16_t* O; const float* qg; const float* kg; float qscale; int pad;
    __device__ __forceinline__ void operator()(const f32x4 (&acc)[2][2][4][2], const Unit& u, int wr, int wc, int fr, int fq, const LAS unsigned char*) const {
        const int row0 = u.pm * 256 + wr * 64 + fr, colb = u.pn * 256 + wc * 64 + 8 * fq;
        const int mode = u.pn < 2 ? 1 : (u.pn < 4 ? 2 : 0);
        f32x4 gv[2][2];
        if (mode) { const float* gp = (mode == 1 ? qg : kg) + 8 * fq; const float sc = mode == 1 ? qscale : 1.0f;
#pragma unroll
            for (int bj = 0; bj < 2; ++bj)
#pragma unroll
                for (int n = 0; n < 2; ++n) gv[bj][n] = *(const f32x4*)(gp + 32 * bj + 4 * n) * sc; }
#pragma unroll
        for (int ai = 0; ai < 2; ++ai)
#pragma unroll
            for (int m = 0; m < 4; ++m) {
                f32x4 v[2][2];
#pragma unroll
                for (int bj = 0; bj < 2; ++bj)
#pragma unroll
                    for (int n = 0; n < 2; ++n) v[bj][n] = acc[ai][bj][m][n];
                if (mode) { float ss = 0.f;
#pragma unroll
                    for (int bj = 0; bj < 2; ++bj)
#pragma unroll
                        for (int n = 0; n < 2; ++n) ss += (v[bj][n].x * v[bj][n].x + v[bj][n].y * v[bj][n].y) + (v[bj][n].z * v[bj][n].z + v[bj][n].w * v[bj][n].w);
                    ss += __shfl_xor(ss, 16); ss += __shfl_xor(ss, 32);
                    const float rstd = 1.0f / sqrtf(ss * (1.0f / 64.0f) + EPS);
#pragma unroll
                    for (int bj = 0; bj < 2; ++bj)
#pragma unroll
                        for (int n = 0; n < 2; ++n) v[bj][n] = v[bj][n] * rstd * gv[bj][n]; }
                bf16_t* rowp = O + (size_t)(row0 + ai * 128 + m * 16) * NPROJ + colb;
#pragma unroll
                for (int bj = 0; bj < 2; ++bj) { u32x4 w; w.x = cvt_pk_bf16(v[bj][0].x, v[bj][0].y); w.y = cvt_pk_bf16(v[bj][0].z, v[bj][0].w); w.z = cvt_pk_bf16(v[bj][1].x, v[bj][1].y); w.w = cvt_pk_bf16(v[bj][1].z, v[bj][1].w);
                    *(u32x4*)(rowp + 32 * bj) = w; }
            }
    }
};
struct EpiBf16 { bf16_t* O; int ldo; int pad;
    __device__ __forceinline__ void operator()(const f32x4 (&acc)[2][2][4][2], const Unit& u, int wr, int wc, int fr, int fq, const LAS unsigned char*) const {
        const int row0 = u.pm * 256 + wr * 64 + fr, col0 = u.pn * 256 + wc * 32 + 8 * fq;
#pragma unroll
        for (int ai = 0; ai < 2; ++ai)
#pragma unroll
            for (int m = 0; m < 4; ++m) { bf16_t* rowp = O + (size_t)(row0 + ai * 128 + m * 16) * ldo + col0;
#pragma unroll
                for (int bj = 0; bj < 2; ++bj) { const f32x4 v0 = acc[ai][bj][m][0], v1 = acc[ai][bj][m][1];
                    u32x4 w; w.x = cvt_pk_bf16(v0.x, v0.y); w.y = cvt_pk_bf16(v0.z, v0.w); w.z = cvt_pk_bf16(v1.x, v1.y); w.w = cvt_pk_bf16(v1.z, v1.w);
                    *(u32x4*)(rowp + bj * 128) = w; } }
    }
};
template <bool BASE_BF16, bool F8COPY = false> struct EpiRes { const void* base; bf16_t* outb; float* sq; unsigned char* out8;
    __device__ __forceinline__ void operator()(const f32x4 (&acc)[2][2][4][2], const Unit& u, int wr, int wc, int fr, int fq, const LAS unsigned char*) const {
        const int row0 = u.pm * 256 + wr * 64 + fr, col0 = u.pn * 256 + wc * 32 + 8 * fq;
#pragma unroll
        for (int ai = 0; ai < 2; ++ai)
#pragma unroll
            for (int m = 0; m < 4; ++m) { const int row = row0 + ai * 128 + m * 16; const size_t off = (size_t)row * DM + col0; float ss = 0.f;
#pragma unroll
                for (int bj = 0; bj < 2; ++bj) { f32x4 b0, b1;
                    if constexpr (BASE_BF16) { const u32x4 bb = *(const u32x4*)((const bf16_t*)base + off + bj * 128); b0 = (f32x4){bflo(bb.x), bfhi(bb.x), bflo(bb.y), bfhi(bb.y)}; b1 = (f32x4){bflo(bb.z), bfhi(bb.z), bflo(bb.w), bfhi(bb.w)}; }
                    else { b0 = *(const f32x4*)((const float*)base + off + bj * 128); b1 = *(const f32x4*)((const float*)base + off + bj * 128 + 4); }
                    const f32x4 v0 = acc[ai][bj][m][0] + b0, v1 = acc[ai][bj][m][1] + b1;
                    u32x4 w; w.x = cvt_pk_bf16(v0.x, v0.y); w.y = cvt_pk_bf16(v0.z, v0.w); w.z = cvt_pk_bf16(v1.x, v1.y); w.w = cvt_pk_bf16(v1.z, v1.w);
                    *(u32x4*)(outb + off + bj * 128) = w;
                    if constexpr (F8COPY) { u32x2 w8; w8.x = pk4_fp8(v0.x * X8SCALE, v0.y * X8SCALE, v0.z * X8SCALE, v0.w * X8SCALE); w8.y = pk4_fp8(v1.x * X8SCALE, v1.y * X8SCALE, v1.z * X8SCALE, v1.w * X8SCALE); *(u32x2*)(out8 + off + bj * 128) = w8; }
                    ss += (v0.x * v0.x + v0.y * v0.y) + (v0.z * v0.z + v0.w * v0.w) + (v1.x * v1.x + v1.y * v1.y) + (v1.z * v1.z + v1.w * v1.w); }
                ss += __shfl_xor(ss, 16); ss += __shfl_xor(ss, 32);
                if (fq == 0) sq[((size_t)u.pn * MTOK + row) * 4 + wc] = ss; }
    }
};
struct EpiRstdBf16 { bf16_t* O; const float* sq; int ldo; int pad;
    __device__ __forceinline__ void operator()(const f32x4 (&acc)[2][2][4][2], const Unit& u, int wr, int wc, int fr, int fq, const LAS unsigned char*) const {
        const int row0 = u.pm * 256 + wr * 64 + fr, col0 = u.pn * 256 + wc * 32 + 8 * fq;
#pragma unroll
        for (int ai = 0; ai < 2; ++ai)
#pragma unroll
            for (int m = 0; m < 4; ++m) { const int row = row0 + ai * 128 + m * 16; float s = 0.f;
#pragma unroll
                for (int t = 0; t < 4; ++t) { const f32x4 p = *(const f32x4*)(sq + ((size_t)t * MTOK + row) * 4); s += (p.x + p.y) + (p.z + p.w); }
                const float rstd = 1.0f / sqrtf(s * (1.0f / DM) + EPS);
                bf16_t* rowp = O + (size_t)row * ldo + col0;
#pragma unroll
                for (int bj = 0; bj < 2; ++bj) { const f32x4 v0 = acc[ai][bj][m][0] * rstd, v1 = acc[ai][bj][m][1] * rstd;
                    u32x4 w; w.x = cvt_pk_bf16(v0.x, v0.y); w.y = cvt_pk_bf16(v0.z, v0.w); w.z = cvt_pk_bf16(v1.x, v1.y); w.w = cvt_pk_bf16(v1.z, v1.w);
                    *(u32x4*)(rowp + bj * 128) = w; } }
    }
};
constexpr int LSTRIDE = MTOK;
struct MoeSched {
    const char* A; const char* Bt; size_t estride; const int* list; const LAS unsigned* tab; int K, nN, nblk, G, c, gather, esz;
    __device__ __forceinline__ bool next(int i, Unit& u) const {
        if (!pg8::static_order(nblk, nN, G, c, i, u.pm, u.pn)) return false;
        int e = 0; while (e < NE - 1 && (int)tab[32 + e + 1] <= u.pm) ++e;
        e = __builtin_amdgcn_readfirstlane(e); u.e = e; u.rbl = u.pm - (int)__builtin_amdgcn_readfirstlane(tab[32 + e]); return true;
    }
    __device__ __forceinline__ const char* a_base(const Unit& u) const { return gather ? A : A + (size_t)u.pm * 256 * K * esz; }
    __device__ __forceinline__ const char* b_base(const Unit& u) const { return Bt + (size_t)u.e * estride + (size_t)u.pn * 256 * K * esz; }
    __device__ __forceinline__ unsigned a_off(const Unit& u) const { return gather ? 0u : (unsigned)u.pm * 256u * (unsigned)(K * esz); }
    __device__ __forceinline__ unsigned b_off(const Unit& u) const { return (unsigned)u.e * (unsigned)estride + (unsigned)u.pn * 256u * (unsigned)(K * esz); }
    __device__ __forceinline__ void issue_rows(const Unit& u, LAS unsigned char* buf, int wid, int lane) const {
        if (wid < 4) __builtin_amdgcn_global_load_lds((const unsigned*)(list + (size_t)u.e * LSTRIDE + u.rbl * 256 + wid * 64 + lane), (LAS unsigned*)(buf + wid * 256), 4, 0, 0);
    }
    __device__ __forceinline__ void read_rows(const Unit& u, const LAS unsigned char* buf, int R0, unsigned (&off)[4]) const {
        const int cnt = (int)tab[u.e] - u.rbl * 256;
#pragma unroll
        for (int q = 0; q < 4; ++q) { const int j = R0 + 64 * q; const int v = ((const LAS int*)buf)[j]; const int tok = (j < cnt) ? (v >> 2) : 0; off[q] = (unsigned)tok * (unsigned)(K * esz); }
    }
};
struct EpiSwiglu2 { bf16_t* act; const float* bias; const float* rstd2; const LAS unsigned* tab;
    __device__ __forceinline__ void operator()(const f32x4 (&acc)[2][2][4][2], const Unit& u, int wr, int wc, int fr, int fq, const LAS unsigned char* idx) const {
        const int cnt = (int)tab[u.e] - u.rbl * 256, c0 = u.pn * 128 + wc * 32 + 8 * fq;
        const float* bp = bias + (size_t)u.e * 2 * DFF + 2 * c0; f32x4 bb[4];
#pragma unroll
        for (int i = 0; i < 4; ++i) bb[i] = *(const f32x4*)(bp + 4 * i);
#pragma unroll
        for (int ai = 0; ai < 2; ++ai)
#pragma unroll
            for (int m = 0; m < 4; ++m) { const int j = ai * 128 + wr * 64 + m * 16 + fr; const int v = ((const LAS int*)idx)[j]; const int tok = (j < cnt) ? (v >> 2) : 0; const float rs = rstd2[tok];
                float o[8];
#pragma unroll
                for (int n = 0; n < 2; ++n)
#pragma unroll
                    for (int k = 0; k < 4; ++k) { const int cc = 4 * n + k; const float bg = bb[cc >> 1][(cc & 1) * 2], bl = bb[cc >> 1][(cc & 1) * 2 + 1];
                        const float g = fminf(acc[ai][0][m][n][k] * rs + bg, 7.0f), l = fminf(fmaxf(acc[ai][1][m][n][k] * rs + bl, -7.0f), 7.0f);
                        o[cc] = g * __builtin_amdgcn_rcpf(1.0f + __builtin_amdgcn_exp2f(-1.702f * LOG2E * g)) * (l + 1.0f); }
                u32x4 w; w.x = cvt_pk_bf16(o[0], o[1]); w.y = cvt_pk_bf16(o[2], o[3]); w.z = cvt_pk_bf16(o[4], o[5]); w.w = cvt_pk_bf16(o[6], o[7]);
                *(u32x4*)(act + (size_t)(u.pm * 256 + j) * DFF + c0) = w; }
    }
};
struct EpiDown2 { bf16_t* ybuf; const float* bias; const float* gate; const LAS unsigned* tab;
    __device__ __forceinline__ void operator()(const f32x4 (&acc)[2][2][4][2], const Unit& u, int wr, int wc, int fr, int fq, const LAS unsigned char* idx) const {
        const int cnt = (int)tab[u.e] - u.rbl * 256, col0 = u.pn * 256 + wc * 32 + 8 * fq;
        const float* bp = bias + (size_t)u.e * DM + col0; f32x4 bb[2][2];
#pragma unroll
        for (int bj = 0; bj < 2; ++bj)
#pragma unroll
            for (int n = 0; n < 2; ++n) bb[bj][n] = *(const f32x4*)(bp + bj * 128 + 4 * n);
#pragma unroll
        for (int ai = 0; ai < 2; ++ai)
#pragma unroll
            for (int m = 0; m < 4; ++m) { const int j = ai * 128 + wr * 64 + m * 16 + fr;
                if (j < cnt) { const int tk = ((const LAS int*)idx)[j]; const float g = gate[tk]; bf16_t* rowp = ybuf + (size_t)tk * DM + col0;
#pragma unroll
                    for (int bj = 0; bj < 2; ++bj) { const f32x4 v0 = (acc[ai][bj][m][0] + bb[bj][0]) * g, v1 = (acc[ai][bj][m][1] + bb[bj][1]) * g;
                        u32x4 w; w.x = cvt_pk_bf16(v0.x, v0.y); w.y = cvt_pk_bf16(v0.z, v0.w); w.z = cvt_pk_bf16(v1.x, v1.y); w.w = cvt_pk_bf16(v1.z, v1.w);
                        *(u32x4*)(rowp + bj * 128) = w; } } }
    }
};
struct EpiSwiglu8 { unsigned char* act; const float* bias; const float* rstd2; const LAS unsigned* tab;
    __device__ __forceinline__ void operator()(const f32x4 (&acc)[2][2][4][2], const Unit& u, int wr, int wc, int fr, int fq, const LAS unsigned char* idx) const {
        const int cnt = (int)tab[u.e] - u.rbl * 256, c0 = u.pn * 128 + wc * 32 + 8 * fq;
        const float* bp = bias + (size_t)u.e * 2 * DFF + 2 * c0; f32x4 bb[4];
#pragma unroll
        for (int i = 0; i < 4; ++i) bb[i] = *(const f32x4*)(bp + 4 * i);
#pragma unroll
        for (int ai = 0; ai < 2; ++ai)
#pragma unroll
            for (int m = 0; m < 4; ++m) { const int j = ai * 128 + wr * 64 + m * 16 + fr; const int v = ((const LAS int*)idx)[j]; const int tok = (j < cnt) ? (v >> 2) : 0; const float rs = rstd2[tok] * (1.0f / (X8SCALE * W8SCALE));
                float o[8];
#pragma unroll
                for (int n = 0; n < 2; ++n)
#pragma unroll
                    for (int k = 0; k < 4; ++k) { const int cc = 4 * n + k; const float bg = bb[cc >> 1][(cc & 1) * 2], bl = bb[cc >> 1][(cc & 1) * 2 + 1];
                        const float g = fminf(acc[ai][0][m][n][k] * rs + bg, 7.0f), l = fminf(fmaxf(acc[ai][1][m][n][k] * rs + bl, -7.0f), 7.0f);
                        o[cc] = fminf(fmaxf(g * __builtin_amdgcn_rcpf(1.0f + __builtin_amdgcn_exp2f(-1.702f * LOG2E * g)) * (l + 1.0f) * A8SCALE, -448.0f), 448.0f); }
                u32x2 w; w.x = pk4_fp8(o[0], o[1], o[2], o[3]); w.y = pk4_fp8(o[4], o[5], o[6], o[7]);
                *(u32x2*)(act + (size_t)(u.pm * 256 + j) * DFF + c0) = w; }
    }
};
struct EpiDown8 { bf16_t* ybuf; const float* bias; const float* gate; const LAS unsigned* tab;
    __device__ __forceinline__ void operator()(const f32x4 (&acc)[2][2][4][2], const Unit& u, int wr, int wc, int fr, int fq, const LAS unsigned char* idx) const {
        const int cnt = (int)tab[u.e] - u.rbl * 256, col0 = u.pn * 256 + wc * 32 + 8 * fq; const float isc = 1.0f / (A8SCALE * W8SCALE);
        const float* bp = bias + (size_t)u.e * DM + col0;
#pragma unroll
        for (int ai = 0; ai < 2; ++ai)
#pragma unroll
            for (int m = 0; m < 4; ++m) { const int j = ai * 128 + wr * 64 + m * 16 + fr;
                if (j < cnt) { const int tk = ((const LAS int*)idx)[j]; const float g = gate[tk]; bf16_t* rowp = ybuf + (size_t)tk * DM + col0;
#pragma unroll
                    for (int bj = 0; bj < 2; ++bj) { const f32x4 b0 = *(const f32x4*)(bp + bj * 128), b1 = *(const f32x4*)(bp + bj * 128 + 4);
                        const f32x4 v0 = (acc[ai][bj][m][0] * isc + b0) * g, v1 = (acc[ai][bj][m][1] * isc + b1) * g;
                        u32x4 w; w.x = cvt_pk_bf16(v0.x, v0.y); w.y = cvt_pk_bf16(v0.z, v0.w); w.z = cvt_pk_bf16(v1.x, v1.y); w.w = cvt_pk_bf16(v1.z, v1.w);
                        *(u32x4*)(rowp + bj * 128) = w; } } }
    }
};
__device__ __forceinline__ void moe_tables(const unsigned* gcnt, LAS unsigned* tab, int tid) {
    if (tid < 64) { const unsigned c = tid < NE ? gcnt[tid] : 0u; const unsigned nb = (c + 255u) >> 8; unsigned inc = nb;
#pragma unroll
        for (int o = 1; o < 64; o <<= 1) { const unsigned t = __shfl_up(inc, o); if (tid >= o) inc += t; }
        if (tid < NE) { tab[tid] = c; tab[32 + tid] = inc - nb; } if (tid == NE) tab[32 + NE] = inc - nb; }
    __syncthreads();
}
__device__ __forceinline__ void p7_route(const Frame& F, const bf16_t* __restrict__ hb, const bf16_t* __restrict__ Wrt, const float* __restrict__ sq2, const float* __restrict__ br,
                                         unsigned* gcnt, int* __restrict__ list, float* __restrict__ gate, float* __restrict__ rstd2) {
    LAS unsigned* lcnt = (LAS unsigned*)(F.lds + RING_OFF); LAS unsigned* lbase = lcnt + 32;
    const int lane = F.lane, tcol = lane & 15, kq = lane >> 4;
    for (int round = blockIdx.x; round < MTOK / 128; round += F.G) {
        if (F.tid < 32) lcnt[F.tid] = 0u;
        __syncthreads();
        const int tok = round * 128 + F.wave * 16 + tcol;
        const bf16_t* xp = hb + (size_t)tok * DM + 8 * kq; const bf16_t* w0p = Wrt + (size_t)tcol * DM + 8 * kq; const bf16_t* w1p = w0p + 16 * DM;
        f32x4 a0 = {0.f, 0.f, 0.f, 0.f}, a1 = {0.f, 0.f, 0.f, 0.f};
#pragma unroll 8
        for (int ks = 0; ks < 32; ++ks) { const bf16x8 b = *(const bf16x8*)(xp + 32 * ks), w0 = *(const bf16x8*)(w0p + 32 * ks), w1 = *(const bf16x8*)(w1p + 32 * ks);
            a0 = __builtin_amdgcn_mfma_f32_16x16x32_bf16(w0, b, a0, 0, 0, 0); a1 = __builtin_amdgcn_mfma_f32_16x16x32_bf16(w1, b, a1, 0, 0, 0); }
        float s = 0.f;
#pragma unroll
        for (int t = 0; t < 4; ++t) { const f32x4 p = *(const f32x4*)(sq2 + ((size_t)t * MTOK + tok) * 4); s += (p.x + p.y) + (p.z + p.w); }
        const float rstd = 1.0f / sqrtf(s * (1.0f / DM) + EPS);
        float v[8]; int id[8];
#pragma unroll
        for (int r = 0; r < 4; ++r) { id[r] = 4 * kq + r; id[4 + r] = 16 + 4 * kq + r; v[r] = a0[r] * rstd + br[4 * kq + r]; v[4 + r] = a1[r] * rstd + br[16 + 4 * kq + r]; }
        float tv[4]; int ti[4];
#pragma unroll
        for (int r = 0; r < 4; ++r) { float bv = v[0]; int bi = id[0];
#pragma unroll
            for (int j = 1; j < 8; ++j) if (v[j] > bv) { bv = v[j]; bi = id[j]; }
#pragma unroll
            for (int o = 16; o < 64; o <<= 1) { const float ov = __shfl_xor(bv, o); const int oi = __shfl_xor(bi, o); if (ov > bv || (ov == bv && oi < bi)) { bv = ov; bi = oi; } }
            tv[r] = bv; ti[r] = bi;
#pragma unroll
            for (int j = 0; j < 8; ++j) if (id[j] == bi) v[j] = -3.0e38f; }
        const float e1 = __expf(tv[1] - tv[0]), e2 = __expf(tv[2] - tv[0]), e3 = __expf(tv[3] - tv[0]); const float inv = 1.0f / (1.0f + e1 + e2 + e3);
        unsigned lp[4];
        if (kq == 0) {
#pragma unroll
            for (int k = 0; k < 4; ++k) lp[k] = __hip_atomic_fetch_add(lcnt + ti[k], 1u, __ATOMIC_RELAXED, __HIP_MEMORY_SCOPE_WORKGROUP); }
        __syncthreads();
        if (F.tid < 32) { const unsigned c = lcnt[F.tid]; lbase[F.tid] = c ? __hip_atomic_fetch_add(gcnt + F.tid, c, __ATOMIC_RELAXED, __HIP_MEMORY_SCOPE_AGENT) : 0u; }
        __syncthreads();
        if (kq == 0) { const float gk[4] = {inv, e1 * inv, e2 * inv, e3 * inv};
#pragma unroll
            for (int k = 0; k < 4; ++k) { const unsigned pos = lbase[ti[k]] + lp[k]; list[(size_t)ti[k] * LSTRIDE + pos] = tok * 4 + k; gate[tok * 4 + k] = gk[k]; }
            rstd2[tok] = rstd; }
        __syncthreads();
    }
}
__device__ __forceinline__ void p10_combine(const Frame& F, float* __restrict__ out, const bf16_t* __restrict__ x2b, const bf16_t* __restrict__ ybuf) {
    const size_t n8 = (size_t)MTOK * DM / 8;
    for (size_t i = (size_t)blockIdx.x * (NWAVES * 64) + F.tid; i < n8; i += (size_t)F.G * (NWAVES * 64)) {
        const size_t tok = i / (DM / 8), c8 = i % (DM / 8);
        const u32x4 xb = *(const u32x4*)(x2b + i * 8);
        f32x4 v0 = {bflo(xb.x), bfhi(xb.x), bflo(xb.y), bfhi(xb.y)}, v1 = {bflo(xb.z), bfhi(xb.z), bflo(xb.w), bfhi(xb.w)};
#pragma unroll
        for (int k = 0; k < 4; ++k) { const u32x4 y = *(const u32x4*)(ybuf + (tok * 4 + k) * DM + c8 * 8);
            v0.x += bflo(y.x); v0.y += bfhi(y.x); v0.z += bflo(y.y); v0.w += bfhi(y.y); v1.x += bflo(y.z); v1.y += bfhi(y.z); v1.z += bflo(y.w); v1.w += bfhi(y.w); }
        *(f32x4*)(out + i * 8) = v0; *(f32x4*)(out + i * 8 + 4) = v1;
    }
}
typedef short v4i16_t __attribute__((ext_vector_type(4)));
__device__ __forceinline__ v4i16_t lds_tr16(const LAS unsigned char* p) { return __builtin_amdgcn_ds_read_tr16_b64_v4i16((LAS v4i16_t*)p); }
__device__ __forceinline__ bf16x8 cat8(v4i16_t a, v4i16_t b) { return (bf16x8){a[0], a[1], a[2], a[3], b[0], b[1], b[2], b[3]}; }
__device__ __forceinline__ int koff16(int rho) { return (rho & 3) + 8 * (rho >> 2); }

__device__ __forceinline__ void p2_attn(const Frame& F, const bf16_t* __restrict__ proj, const float* __restrict__ rel_bias, const float* __restrict__ conv_w,
                                        const float* __restrict__ ga, const float* __restrict__ gb, bf16_t* __restrict__ yb, bf16_t* __restrict__ kvmem, const float* __restrict__ xk_g, bool do_kv) {
    LAS float* tbl = (LAS float*)(F.lds + TBL_OFF);
    for (int i = F.tid; i < 8 * 384; i += NWAVES * 64) { const int h = i / 384, j = i % 384; int rel = 319 - j; rel = rel < -MAXREL ? -MAXREL : (rel > MAXREL ? MAXREL : rel); tbl[i] = rel_bias[h * NREL + rel + MAXREL] * LOG2E; }
    __syncthreads();
    const int lane = F.lane, h = F.wave, r = lane & 31, hi = lane >> 5;
    LAS unsigned char* wbuf = F.lds + RING_OFF + h * 16384;
    LAS float* ssq = (LAS float*)(F.lds + SSQ_OFF);
    const LAS float* tblh = tbl + h * 384;
    const float far_bias = rel_bias[h * NREL + 2 * MAXREL] * LOG2E;
    unsigned kso[4], vso[4];
#pragma unroll
    for (int i = 0; i < 4; ++i) { const int key = 8 * i + (lane >> 3), cp = lane & 7;
        kso[i] = (unsigned)(key * NPROJ + (cp ^ ((key >> 1) & 7)) * 8) * 2u; vso[i] = (unsigned)(key * NPROJ + DATT + (cp ^ (((key >> 1) & 1) << 2)) * 8) * 2u; }
    int kaddr[4];
#pragma unroll
    for (int s = 0; s < 4; ++s) kaddr[s] = r * 128 + (((2 * s + hi) ^ ((r >> 1) & 7)) * 16);
    const int G1 = (lane >> 4) & 1, tq = (lane & 15) >> 2, tp = lane & 3;
    int vaddr[2];
#pragma unroll
    for (int db = 0; db < 2; ++db) vaddr[db] = 4096 + (4 * hi + tq) * 128 + (((4 * db + 2 * G1 + (tp >> 1)) ^ (((tq >> 1) & 1) << 2)) * 16) + (tp & 1) * 8;
#define P2_DMA(T_, buf_) do { const char* kp_ = (const char*)(proj + ((size_t)b * SEQ + 32 * (T_)) * NPROJ + DATT + h * 64); \
        _Pragma("unroll") for (int i_ = 0; i_ < 4; ++i_) __builtin_amdgcn_global_load_lds((const unsigned*)(kp_ + kso[i_]), (LAS unsigned*)(wbuf + (buf_) * 8192 + i_ * 1024), 16, 0, 0); \
        _Pragma("unroll") for (int i_ = 0; i_ < 4; ++i_) __builtin_amdgcn_global_load_lds((const unsigned*)(kp_ + vso[i_]), (LAS unsigned*)(wbuf + (buf_) * 8192 + 4096 + i_ * 1024), 16, 0, 0); } while (0)
    const int upw = (512 + F.G - 1) / F.G;
    for (int ui = 0; ui < upw; ++ui) {
        const int unit = F.vcu * upw + ui; if (unit >= BATCH * (SEQ / CHUNK)) break;
        const int b = unit / (SEQ / CHUNK), c = unit % (SEQ / CHUNK); const size_t row0 = (size_t)b * SEQ + c * CHUNK;
        const int T0 = 2 * (c - LEFT < 0 ? 0 : c - LEFT), T1 = 2 * c + 1;
        P2_DMA(T0, 0);
        bf16x8 qf[2][4];
#pragma unroll
        for (int qb = 0; qb < 2; ++qb)
#pragma unroll
            for (int s = 0; s < 4; ++s) qf[qb][s] = *(const bf16x8*)(proj + (row0 + 32 * qb + r) * NPROJ + h * 64 + 16 * s + 8 * hi);
        f32x16 o[2][2];
#pragma unroll
        for (int db = 0; db < 2; ++db)
#pragma unroll
            for (int qb = 0; qb < 2; ++qb)
#pragma unroll
                for (int i = 0; i < 16; ++i) o[db][qb][i] = 0.f;
        float mrun[2] = {-1e30f, -1e30f}, lrun[2] = {0.f, 0.f};
        for (int T = T0; T <= T1; ++T) {
            const int pb = (T - T0) & 1; const LAS unsigned char* Ks = wbuf + pb * 8192;
            if (T < T1) { P2_DMA(T + 1, pb ^ 1); asm volatile("s_waitcnt vmcnt(8)" ::: "memory"); }
            else asm volatile("s_waitcnt vmcnt(0)" ::: "memory");
            f32x16 sacc[2];
#pragma unroll
            for (int qb = 0; qb < 2; ++qb)
#pragma unroll
                for (int i = 0; i < 16; ++i) sacc[qb][i] = 0.f;
#pragma unroll
            for (int s = 0; s < 4; ++s) { const bf16x8 kf = *(const LAS bf16x8*)(Ks + kaddr[s]);
                sacc[0] = __builtin_amdgcn_mfma_f32_32x32x16_bf16(kf, qf[0][s], sacc[0], 0, 0, 0); sacc[1] = __builtin_amdgcn_mfma_f32_32x32x16_bf16(kf, qf[1][s], sacc[1], 0, 0, 0); }
            if ((T >> 1) >= c - 4) {
#pragma unroll
                for (int qb = 0; qb < 2; ++qb) { const LAS float* tp0 = tblh + (319 - 64 * c - 32 * qb - r + 32 * T + 4 * hi);
#pragma unroll
                    for (int i = 0; i < 16; ++i) sacc[qb][i] += tp0[koff16(i)]; }
            } else {
#pragma unroll
                for (int qb = 0; qb < 2; ++qb)
#pragma unroll
                    for (int i = 0; i < 16; ++i) sacc[qb][i] += far_bias;
            }
            bf16x8 pf[2][2];
#pragma unroll
            for (int qb = 0; qb < 2; ++qb) {
                float mx = sacc[qb][0];
#pragma unroll
                for (int i = 1; i < 16; ++i) mx = fmaxf(mx, sacc[qb][i]);
                mx = fmaxf(mx, __shfl_xor(mx, 32));
                const float mn = fmaxf(mrun[qb], mx), f = __builtin_amdgcn_exp2f(mrun[qb] - mn); mrun[qb] = mn;
                float ls = 0.f; float p[16];
#pragma unroll
                for (int i = 0; i < 16; ++i) { p[i] = __builtin_amdgcn_exp2f(sacc[qb][i] - mn); ls += p[i]; }
                lrun[qb] = lrun[qb] * f + ls;
#pragma unroll
                for (int i = 0; i < 16; ++i) { o[0][qb][i] *= f; o[1][qb][i] *= f; }
#pragma unroll
                for (int ks = 0; ks < 2; ++ks) { u32x4 w; w.x = cvt_pk_bf16(p[8 * ks + 0], p[8 * ks + 1]); w.y = cvt_pk_bf16(p[8 * ks + 2], p[8 * ks + 3]); w.z = cvt_pk_bf16(p[8 * ks + 4], p[8 * ks + 5]); w.w = cvt_pk_bf16(p[8 * ks + 6], p[8 * ks + 7]);
                    pf[qb][ks] = __builtin_bit_cast(bf16x8, w); }
            }
#pragma unroll
            for (int db = 0; db < 2; ++db)
#pragma unroll
                for (int ks = 0; ks < 2; ++ks) {
                    const v4i16_t t0 = lds_tr16(Ks + vaddr[db] + (16 * ks) * 128), t1 = lds_tr16(Ks + vaddr[db] + (16 * ks + 8) * 128);
                    const bf16x8 vf = cat8(t0, t1);
                    o[db][0] = __builtin_amdgcn_mfma_f32_32x32x16_bf16(vf, pf[0][ks], o[db][0], 0, 0, 0); o[db][1] = __builtin_amdgcn_mfma_f32_32x32x16_bf16(vf, pf[1][ks], o[db][1], 0, 0, 0);
                }
        }

        LAS float* sq = ssq + (ui & 1) * 512;
#pragma unroll
        for (int qb = 0; qb < 2; ++qb) { const float lt = lrun[qb] + __shfl_xor(lrun[qb], 32); const float inv = 1.0f / lt; float ss = 0.f;
#pragma unroll
            for (int db = 0; db < 2; ++db)
#pragma unroll
                for (int i = 0; i < 16; ++i) { o[db][qb][i] *= inv; ss += o[db][qb][i] * o[db][qb][i]; }
            ss += __shfl_xor(ss, 32);
            if (hi == 0) sq[h * 64 + 32 * qb + r] = ss; }
        __syncthreads();
#pragma unroll
        for (int qb = 0; qb < 2; ++qb) { float tot = 0.f;
#pragma unroll
            for (int hh = 0; hh < 8; ++hh) tot += sq[hh * 64 + 32 * qb + r];
            const float rstd = 1.0f / sqrtf(tot * (1.0f / DATT) + EPS);
            bf16_t* orow = yb + (row0 + 32 * qb + r) * DM + h * 64;
#pragma unroll
            for (int db = 0; db < 2; ++db)
#pragma unroll
                for (int g4 = 0; g4 < 4; ++g4) { const int d0 = 32 * db + 8 * g4 + 4 * hi; const f32x4 gg = *(const f32x4*)(ga + h * 64 + d0);
                    u32x2 w; w.x = cvt_pk_bf16(o[db][qb][4 * g4 + 0] * rstd * gg.x, o[db][qb][4 * g4 + 1] * rstd * gg.y); w.y = cvt_pk_bf16(o[db][qb][4 * g4 + 2] * rstd * gg.z, o[db][qb][4 * g4 + 3] * rstd * gg.w);
                    *(u32x2*)(orow + d0) = w; } }
        { const int ch0 = 8 * lane; float cw[3][8], gbv[8];
#pragma unroll
          for (int t = 0; t < 3; ++t) { const f32x4 a = *(const f32x4*)(conv_w + t * DCONV + ch0), bq = *(const f32x4*)(conv_w + t * DCONV + ch0 + 4);
              cw[t][0] = a.x; cw[t][1] = a.y; cw[t][2] = a.z; cw[t][3] = a.w; cw[t][4] = bq.x; cw[t][5] = bq.y; cw[t][6] = bq.z; cw[t][7] = bq.w; }
          { const f32x4 a = *(const f32x4*)(gb + ch0), bq = *(const f32x4*)(gb + ch0 + 4); gbv[0] = a.x; gbv[1] = a.y; gbv[2] = a.z; gbv[3] = a.w; gbv[4] = bq.x; gbv[5] = bq.y; gbv[6] = bq.z; gbv[7] = bq.w; }
          const size_t tfirst = row0 + 8 * h; const int sfirst = c * CHUNK + 8 * h;
          float u1[8], u2[8];
#pragma unroll
          for (int j = 0; j < 8; ++j) { u1[j] = 0.f; u2[j] = 0.f; }
          if (sfirst >= 1) { const u32x4 cg = *(const u32x4*)(proj + (tfirst - 1) * NPROJ + 3 * DATT + DCONV + ch0), xv = *(const u32x4*)(proj + (tfirst - 1) * NPROJ + 3 * DATT + 2 * DCONV + ch0);
              u1[0] = bflo(cg.x) * bflo(xv.x); u1[1] = bfhi(cg.x) * bfhi(xv.x); u1[2] = bflo(cg.y) * bflo(xv.y); u1[3] = bfhi(cg.y) * bfhi(xv.y); u1[4] = bflo(cg.z) * bflo(xv.z); u1[5] = bfhi(cg.z) * bfhi(xv.z); u1[6] = bflo(cg.w) * bflo(xv.w); u1[7] = bfhi(cg.w) * bfhi(xv.w); }
          if (sfirst >= 2) { const u32x4 cg = *(const u32x4*)(proj + (tfirst - 2) * NPROJ + 3 * DATT + DCONV + ch0), xv = *(const u32x4*)(proj + (tfirst - 2) * NPROJ + 3 * DATT + 2 * DCONV + ch0);
              u2[0] = bflo(cg.x) * bflo(xv.x); u2[1] = bfhi(cg.x) * bfhi(xv.x); u2[2] = bflo(cg.y) * bflo(xv.y); u2[3] = bfhi(cg.y) * bfhi(xv.y); u2[4] = bflo(cg.z) * bflo(xv.z); u2[5] = bfhi(cg.z) * bfhi(xv.z); u2[6] = bflo(cg.w) * bflo(xv.w); u2[7] = bfhi(cg.w) * bfhi(xv.w); }
#pragma unroll
          for (int i = 0; i < 8; ++i) { const bf16_t* pr = proj + (tfirst + i) * NPROJ + 3 * DATT + ch0;
              const u32x4 bg = *(const u32x4*)pr, cg = *(const u32x4*)(pr + DCONV), xv = *(const u32x4*)(pr + 2 * DCONV);
              float u0[8], bgf[8], y[8];
              u0[0] = bflo(cg.x) * bflo(xv.x); u0[1] = bfhi(cg.x) * bfhi(xv.x); u0[2] = bflo(cg.y) * bflo(xv.y); u0[3] = bfhi(cg.y) * bfhi(xv.y); u0[4] = bflo(cg.z) * bflo(xv.z); u0[5] = bfhi(cg.z) * bfhi(xv.z); u0[6] = bflo(cg.w) * bflo(xv.w); u0[7] = bfhi(cg.w) * bfhi(xv.w);
              bgf[0] = bflo(bg.x); bgf[1] = bfhi(bg.x); bgf[2] = bflo(bg.y); bgf[3] = bfhi(bg.y); bgf[4] = bflo(bg.z); bgf[5] = bfhi(bg.z); bgf[6] = bflo(bg.w); bgf[7] = bfhi(bg.w);
              float ss = 0.f;
#pragma unroll
              for (int j = 0; j < 8; ++j) { y[j] = bgf[j] * (cw[0][j] * u2[j] + cw[1][j] * u1[j] + cw[2][j] * u0[j]); ss += y[j] * y[j]; u2[j] = u1[j]; u1[j] = u0[j]; }
              const float rstd = 1.0f / sqrtf(wave_sum(ss) * (1.0f / DCONV) + EPS);
              u32x4 w; w.x = cvt_pk_bf16(y[0] * rstd * gbv[0], y[1] * rstd * gbv[1]); w.y = cvt_pk_bf16(y[2] * rstd * gbv[2], y[3] * rstd * gbv[3]); w.z = cvt_pk_bf16(y[4] * rstd * gbv[4], y[5] * rstd * gbv[5]); w.w = cvt_pk_bf16(y[6] * rstd * gbv[6], y[7] * rstd * gbv[7]);
              *(u32x4*)(yb + (tfirst + i) * DM + DATT + ch0) = w; } }
        if (do_kv) { bf16_t* kp = kvmem + (size_t)(8 * unit + h) * (2 * DX) + 8 * lane; const u32x4 kv = *(const u32x4*)kp;
          float v[8] = {bflo(kv.x), bfhi(kv.x), bflo(kv.y), bfhi(kv.y), bflo(kv.z), bfhi(kv.z), bflo(kv.w), bfhi(kv.w)}; float ss = 0.f;
#pragma unroll
          for (int j = 0; j < 8; ++j) ss += v[j] * v[j];
          ss += __shfl_xor(ss, 1); ss += __shfl_xor(ss, 2); ss += __shfl_xor(ss, 4); ss += __shfl_xor(ss, 8);
          const float rstd = 1.0f / sqrtf(ss * (1.0f / XHD) + EPS); const float* gp = xk_g + ((8 * lane) & (XHD - 1)); const f32x4 g0 = *(const f32x4*)gp, g1 = *(const f32x4*)(gp + 4);
          u32x4 w; w.x = cvt_pk_bf16(v[0] * rstd * g0.x, v[1] * rstd * g0.y); w.y = cvt_pk_bf16(v[2] * rstd * g0.z, v[3] * rstd * g0.w); w.z = cvt_pk_bf16(v[4] * rstd * g1.x, v[5] * rstd * g1.y); w.w = cvt_pk_bf16(v[6] * rstd * g1.z, v[7] * rstd * g1.w);
          *(u32x4*)kp = w; }
    }
    __syncthreads();
}
__device__ __forceinline__ void p5_xattn(const Frame& F, const bf16_t* __restrict__ qx, const bf16_t* __restrict__ kvmem, const float* __restrict__ xq_g, bf16_t* __restrict__ ox) {
    const int lane = F.lane, r = lane & 31, hi = lane >> 5;
    LAS unsigned char* Kl = F.lds + RING_OFF; LAS unsigned char* Vl = Kl + 256 * 272;
    const int G1 = (lane >> 4) & 1, tq = (lane & 15) >> 2, tp = lane & 3;
    const float XS = 0.08838834764831845f * LOG2E;
    const int upw = (512 + F.G - 1) / F.G; int cur_bh = -1;
    for (int ui = 0; ui < upw; ++ui) {
        const int unit = F.vcu * upw + ui; if (unit >= BATCH * XH * 8) break;
        const int bh = unit >> 3, qt = unit & 7, b = bh >> 2, h = bh & 3;
        if (bh != cur_bh) {
            __syncthreads();
            const bf16_t* src = kvmem + (size_t)b * NMEM * (2 * DX) + h * XHD;
#pragma unroll
            for (int i = 0; i < 8; ++i) { const int ci = F.tid + 512 * i, key = ci >> 4, ch = ci & 15;
                const u32x4 kv = *(const u32x4*)(src + (size_t)key * (2 * DX) + ch * 8), vv = *(const u32x4*)(src + (size_t)key * (2 * DX) + DX + ch * 8);
                *(LAS u32x4*)(Kl + key * 272 + ch * 16) = kv; *(LAS u32x4*)(Vl + key * 256 + ((ch ^ ((key & 3) << 2)) * 16)) = vv; }
            __syncthreads();
            cur_bh = bh;
        }
        const size_t qrow = (size_t)b * SEQ + qt * 256 + F.wave * 32 + r;
        bf16x8 qf[8];
        { u32x4 raw[8]; float ss = 0.f;
#pragma unroll
          for (int s = 0; s < 8; ++s) { raw[s] = *(const u32x4*)(qx + qrow * DX + h * XHD + 16 * s + 8 * hi);
              const float a0 = bflo(raw[s].x), a1 = bfhi(raw[s].x), a2 = bflo(raw[s].y), a3 = bfhi(raw[s].y), a4 = bflo(raw[s].z), a5 = bfhi(raw[s].z), a6 = bflo(raw[s].w), a7 = bfhi(raw[s].w);
              ss += (a0 * a0 + a1 * a1) + (a2 * a2 + a3 * a3) + (a4 * a4 + a5 * a5) + (a6 * a6 + a7 * a7); }
          ss += __shfl_xor(ss, 32);
          const float rs = XS / sqrtf(ss * (1.0f / XHD) + EPS);
#pragma unroll
          for (int s = 0; s < 8; ++s) { const f32x4 g0 = *(const f32x4*)(xq_g + 16 * s + 8 * hi), g1 = *(const f32x4*)(xq_g + 16 * s + 8 * hi + 4);
              u32x4 w; w.x = cvt_pk_bf16(bflo(raw[s].x) * rs * g0.x, bfhi(raw[s].x) * rs * g0.y); w.y = cvt_pk_bf16(bflo(raw[s].y) * rs * g0.z, bfhi(raw[s].y) * rs * g0.w);
              w.z = cvt_pk_bf16(bflo(raw[s].z) * rs * g1.x, bfhi(raw[s].z) * rs * g1.y); w.w = cvt_pk_bf16(bflo(raw[s].w) * rs * g1.z, bfhi(raw[s].w) * rs * g1.w);
              qf[s] = __builtin_bit_cast(bf16x8, w); } }
        f32x16 o[4];
#pragma unroll
        for (int db = 0; db < 4; ++db)
#pragma unroll
            for (int i = 0; i < 16; ++i) o[db][i] = 0.f;
        float mrun = -1e30f, lrun = 0.f;
        const LAS unsigned char* kbase = Kl + r * 272 + hi * 16;
        const LAS unsigned char* vbase[4];
#pragma unroll
        for (int db = 0; db < 4; ++db) vbase[db] = Vl + (4 * hi + tq) * 256 + ((4 * (db ^ tq) + 2 * G1 + (tp >> 1)) * 16) + (tp & 1) * 8;
#pragma unroll 1
        for (int t = 0; t < 4; ++t) {
            f32x16 sacc[2];
#pragma unroll
            for (int kb = 0; kb < 2; ++kb) {
#pragma unroll
                for (int i = 0; i < 16; ++i) sacc[kb][i] = 0.f;
#pragma unroll
                for (int s = 0; s < 8; ++s) { const bf16x8 kf = *(const LAS bf16x8*)(kbase + (64 * t + 32 * kb) * 272 + 32 * s);
                    sacc[kb] = __builtin_amdgcn_mfma_f32_32x32x16_bf16(kf, qf[s], sacc[kb], 0, 0, 0); } }
            float mx = sacc[0][0];
#pragma unroll
            for (int i = 1; i < 16; ++i) mx = fmaxf(mx, sacc[0][i]);
#pragma unroll
            for (int i = 0; i < 16; ++i) mx = fmaxf(mx, sacc[1][i]);
            mx = fmaxf(mx, __shfl_xor(mx, 32));
            const float mn = fmaxf(mrun, mx), f = __builtin_amdgcn_exp2f(mrun - mn); mrun = mn;
            float ls = 0.f; bf16x8 pf[2][2];
#pragma unroll
            for (int kb = 0; kb < 2; ++kb) { float p[16];
#pragma unroll
                for (int i = 0; i < 16; ++i) { p[i] = __builtin_amdgcn_exp2f(sacc[kb][i] - mn); ls += p[i]; }
#pragma unroll
                for (int ks = 0; ks < 2; ++ks) { u32x4 w; w.x = cvt_pk_bf16(p[8 * ks + 0], p[8 * ks + 1]); w.y = cvt_pk_bf16(p[8 * ks + 2], p[8 * ks + 3]); w.z = cvt_pk_bf16(p[8 * ks + 4], p[8 * ks + 5]); w.w = cvt_pk_bf16(p[8 * ks + 6], p[8 * ks + 7]);
                    pf[kb][ks] = __builtin_bit_cast(bf16x8, w); } }
            lrun = lrun * f + ls;
#pragma unroll
            for (int db = 0; db < 4; ++db)
#pragma unroll
                for (int i = 0; i < 16; ++i) o[db][i] *= f;
#pragma unroll
            for (int db = 0; db < 4; ++db)
#pragma unroll
                for (int kb = 0; kb < 2; ++kb)
#pragma unroll
                    for (int ks = 0; ks < 2; ++ks) { const int ko = (64 * t + 32 * kb + 16 * ks) * 256;
                        const v4i16_t t0 = lds_tr16(vbase[db] + ko), t1 = lds_tr16(vbase[db] + ko + 8 * 256);
                        o[db] = __builtin_amdgcn_mfma_f32_32x32x16_bf16(cat8(t0, t1), pf[kb][ks], o[db], 0, 0, 0); }
        }
        const float lt = lrun + __shfl_xor(lrun, 32); const float inv = 1.0f / lt;
        bf16_t* orow = ox + qrow * DX + h * XHD;
#pragma unroll
        for (int db = 0; db < 4; ++db)
#pragma unroll
            for (int g4 = 0; g4 < 4; ++g4) { const int d0 = 32 * db + 8 * g4 + 4 * hi;
                u32x2 w; w.x = cvt_pk_bf16(o[db][4 * g4 + 0] * inv, o[db][4 * g4 + 1] * inv); w.y = cvt_pk_bf16(o[db][4 * g4 + 2] * inv, o[db][4 * g4 + 3] * inv);
                *(u32x2*)(orow + d0) = w; }
    }
    __syncthreads();
}

#ifndef QSCALE_V
#define QSCALE_V (0.125f * LOG2E)
#endif
__global__ void __launch_bounds__(NWAVES * 64, 2) mk_fwd(Args args) {
    extern __shared__ __attribute__((aligned(16))) unsigned char lds_raw[];
    Frame F; F.lds = (LAS unsigned char*)lds_raw; F.tid = threadIdx.x; F.lane = F.tid & 63; F.wave = __builtin_amdgcn_readfirstlane(F.tid >> 6); F.G = gridDim.x;
    { const int bx = blockIdx.x; F.vcu = (F.G % 8 == 0) ? (bx % 8) * (F.G / 8) + bx / 8 : bx; }
    unsigned char* ws = args.ws; unsigned* ctl = (unsigned*)(ws + WS_CTL);
    for (int u = F.tid; u < (LDS_BYTES - LDSCTL_OFF) / 4; u += NWAVES * 64) ((LAS unsigned*)(F.lds + LDSCTL_OFF))[u] = 0u;
    __syncthreads();
    volatile LAS unsigned* MISC = (volatile LAS unsigned*)(F.lds + MISC_OFF);
    XcdBarrier bar = xcd_barrier_post(ctl + CW_BAR + args.li * XCD_BAR_WORDS, MISC + 8);
    const int lo = args.ph_lo, hi = args.ph_hi;
#define IN(k) (lo <= (k) && (k) < hi)
#define BOTH(k) (IN(k) && IN((k) + 1))
    bf16_t *Win = (bf16_t*)(ws + WS_WIN), *Wxkv = (bf16_t*)(ws + WS_WXKV), *Wout = (bf16_t*)(ws + WS_WOUT), *Wxq = (bf16_t*)(ws + WS_WXQ), *Wxo = (bf16_t*)(ws + WS_WXO);
    bf16_t *yb = (bf16_t*)(ws + WS_YB), *qx = (bf16_t*)(ws + WS_QX), *ox = (bf16_t*)(ws + WS_OX);
    float *sq1 = (float*)(ws + WS_SQ1), *sq2 = (float*)(ws + WS_SQ2), *rstd2 = (float*)(ws + WS_RSTD2), *gate = (float*)(ws + WS_GATE);
    bf16_t *Wrt = (bf16_t*)(ws + WS_WRT), *Wgu = (bf16_t*)(ws + WS_WGU), *Wdn = (bf16_t*)(ws + WS_WDN), *act = (bf16_t*)(ws + WS_ACT), *ybuf = (bf16_t*)(ws + WS_YBUF);
    unsigned char *Wgu8 = (unsigned char*)(ws + WS_WGU), *Wdn8 = (unsigned char*)(ws + WS_WDN), *x2f8 = (unsigned char*)(ws + WS_QX), *act8 = (unsigned char*)(ws + WS_ACT);
    int* list = (int*)(ws + WS_LIST); LAS unsigned* mtab = (LAS unsigned*)(F.lds + MOE_OFF);
    bf16_t *hb = (bf16_t*)(ws + WS_HB), *hmb = (bf16_t*)(ws + WS_HMB), *proj = (bf16_t*)(ws + WS_PROJ), *kvmem = (bf16_t*)(ws + WS_KVMEM);
    const int gw = F.vcu * NWAVES + F.wave, NGW = F.G * NWAVES;

    if (IN(0)) {
        LAS float* scr = (LAS float*)(F.lds + RING_OFF + F.wave * 17408);
        constexpr int IT_IN = (DM / 64) * (NPROJ / 64), IT_XKV = (DM / 64) * (2 * DX / 64), IT_OUT = (DM / 64) * (DM / 64), IT_XQ = (DM / 64) * (DX / 64), IT_XO = (DX / 64) * (DM / 64), IT_RT = DM / 64,
                      GU_PER_E = (DM / 64) * (2 * DFF / 64), DN_PER_E = (DFF / 64) * (DM / 64), IT_GU = NE * GU_PER_E, IT_DN = NE * DN_PER_E;
        for (int it = gw; it < IT_GU + IT_DN + IT_IN + IT_XKV + IT_OUT + IT_XQ + IT_XO + IT_RT; it += NGW) {
            int r = it;
            if (r < IT_GU) { const int e = r / GU_PER_E, rr = r % GU_PER_E, kb = rr / (2 * DFF / 64), nb = rr % (2 * DFF / 64);
                const int c0 = 32 * nb, pn = c0 >> 7;
                p0_transpose64_f8<2>(args.in[I_W_GU] + (size_t)e * DM * 2 * DFF, 2 * DFF, DM, Wgu8 + (size_t)e * 2 * DFF * DM, 64 * kb, 64 * nb, 256 * pn + (c0 & 127), args.in[I_NORM_FFN_G], W8SCALE, scr, F.lane); continue; }
            r -= IT_GU;
            if (r < IT_DN) { const int e = r / DN_PER_E, rr = r % DN_PER_E, kb = rr / (DM / 64), nb = rr % (DM / 64);
                p0_transpose64_f8<0>(args.in[I_W_DN] + (size_t)e * DFF * DM, DM, DFF, Wdn8 + (size_t)e * DM * DFF, 64 * kb, 64 * nb, 64 * nb, nullptr, W8SCALE, scr, F.lane); continue; }
            r -= IT_DN;
            if (r < IT_IN) { const int kb = r / (NPROJ / 64), nb = r % (NPROJ / 64); const int pn = nb >> 2, wc = nb & 3;
                p0_transpose64<1>(args.in[I_W_IN], NPROJ, DM, Win, 64 * kb, 64 * nb, 256 * pn + 32 * wc, nullptr, scr, F.lane); continue; }
            r -= IT_IN;
            if (r < IT_XKV) { const int kb = r / (2 * DX / 64), nb = r % (2 * DX / 64);
                p0_transpose64<0>(args.in[I_W_XKV], 2 * DX, DM, Wxkv, 64 * kb, 64 * nb, 64 * nb, nullptr, scr, F.lane); continue; }
            r -= IT_XKV;
            if (r < IT_OUT) { const int kb = r / (DM / 64), nb = r % (DM / 64);
                p0_transpose64<0>(args.in[I_W_OUT], DM, DM, Wout, 64 * kb, 64 * nb, 64 * nb, nullptr, scr, F.lane); continue; }
            r -= IT_OUT;
            if (r < IT_XQ) { const int kb = r / (DX / 64), nb = r % (DX / 64);
                p0_transpose64<0>(args.in[I_W_XQ], DX, DM, Wxq, 64 * kb, 64 * nb, 64 * nb, args.in[I_NORM_X_G], scr, F.lane); continue; }
            r -= IT_XQ;
            if (r < IT_XO) { const int kb = r / (DM / 64), nb = r % (DM / 64);
                p0_transpose64<0>(args.in[I_W_XO], DM, DX, Wxo, 64 * kb, 64 * nb, 64 * nb, nullptr, scr, F.lane); continue; }
            r -= IT_XO;
            p0_transpose_item(args.in[I_W_ROUTER], NE, DM, Wrt, 64 * r, 0, 1, 0, args.in[I_NORM_FFN_G], scr, F.lane);
        }
        for (int m = gw; m < MTOK; m += NGW) rms_row_to_bf16(args.in[I_X] + (size_t)m * DM, args.in[I_NORM_MIX_G], hb + (size_t)m * DM, F.lane);
        for (int m = gw; m < MMEM; m += NGW) rms_row_to_bf16(args.in[I_MEM] + (size_t)m * DM, args.in[I_NORM_MEM_G], hmb + (size_t)m * DM, F.lane);
        if (BOTH(0)) xcd_barrier(bar);
    }
    if (IN(1)) {
        { pg8::DenseSched S; S.init(hb, Win, MTOK, NPROJ, DM, F.G, (int)blockIdx.x); EpiProj E{proj, args.in[I_Q_G], args.in[I_K_G], QSCALE_V, 0};
          pg8::gemm_phase<EpiProj, pg8::DenseSched, 0>(F.lds + RING_OFF, F.lds + IDX_OFF, S, E); }
        { pg8::DenseSched S; S.init(hmb, Wxkv, MMEM, 2 * DX, DM, F.G, (int)blockIdx.x); EpiBf16 E{kvmem, 2 * DX, 0};
          pg8::gemm_phase<EpiBf16, pg8::DenseSched, 0>(F.lds + RING_OFF, F.lds + IDX_OFF, S, E); }
        if (BOTH(1)) xcd_barrier(bar);
    }
    if (IN(2)) {
        p2_attn(F, proj, args.in[I_REL_BIAS], args.in[I_CONV_W], args.in[I_ONA_G], args.in[I_ONB_G], yb, kvmem, args.in[I_XK_G], true);
        if (BOTH(2)) xcd_barrier(bar);
    }
    if (IN(3)) {
        pg8::DenseSched S; S.init(yb, Wout, MTOK, DM, DM, F.G, (int)blockIdx.x); EpiRes<false> E{args.in[I_X], hb, sq1, nullptr};
        pg8::gemm_phase<EpiRes<false>, pg8::DenseSched, 0>(F.lds + RING_OFF, F.lds + IDX_OFF, S, E);
        if (BOTH(3)) xcd_barrier(bar);
    }
    if (IN(4)) {
        pg8::DenseSched S; S.init(hb, Wxq, MTOK, DX, DM, F.G, (int)blockIdx.x); EpiRstdBf16 E{qx, sq1, DX, 0};
        pg8::gemm_phase<EpiRstdBf16, pg8::DenseSched, 0>(F.lds + RING_OFF, F.lds + IDX_OFF, S, E);
        if (BOTH(4)) xcd_barrier(bar);
    }
    if (IN(5)) {
        p5_xattn(F, qx, kvmem, args.in[I_XQ_G], ox);
        if (BOTH(5)) xcd_barrier(bar);
    }
    if (IN(6)) {
        pg8::DenseSched S; S.init(ox, Wxo, MTOK, DM, DX, F.G, (int)blockIdx.x); EpiRes<true, true> E{hb, hb, sq2, x2f8};
        pg8::gemm_phase<EpiRes<true, true>, pg8::DenseSched, 0>(F.lds + RING_OFF, F.lds + IDX_OFF, S, E);
        if (BOTH(6)) xcd_barrier(bar);
    }
    if (IN(7)) {
        p7_route(F, hb, Wrt, sq2, args.in[I_B_ROUTER], ctl + CW_CNT, list, gate, rstd2);
        if (BOTH(7)) xcd_barrier(bar);
    }
    if (IN(8)) {
        moe_tables(ctl + CW_CNT, mtab, F.tid);
        MoeSched S{(const char*)x2f8, (const char*)Wgu8, (size_t)2 * DFF * DM, list, mtab, DM, 2 * DFF / 256, (int)mtab[32 + NE], F.G, (int)blockIdx.x, 1, 1};
        EpiSwiglu8 E{act8, args.in[I_B_GU], rstd2, mtab};
        pg8::gemm_phase_f8<EpiSwiglu8, MoeSched, 2>(F.lds + RING_OFF, F.lds + IDX_OFF, S, E);
        if (BOTH(8)) xcd_barrier(bar);
    }
    if (IN(9)) {
        moe_tables(ctl + CW_CNT, mtab, F.tid);
        MoeSched S{(const char*)act8, (const char*)Wdn8, (size_t)DM * DFF, list, mtab, DFF, DM / 256, (int)mtab[32 + NE], F.G, (int)blockIdx.x, 0, 1};
        EpiDown8 E{ybuf, args.in[I_B_DN], gate, mtab};
        pg8::gemm_phase_f8<EpiDown8, MoeSched, 1>(F.lds + RING_OFF, F.lds + IDX_OFF, S, E);
        if (BOTH(9)) xcd_barrier(bar);
    }
    if (IN(10)) p10_combine(F, args.out, hb, ybuf);
#undef IN
#undef BOTH
}

static int g_grid = 0;
static void launch_mk(Args& a, int lo, int hi, int li, hipStream_t stream) {
    a.ph_lo = lo; a.ph_hi = hi; a.li = li; a.pad = 0;
    hipLaunchKernelGGL(mk_fwd, dim3(g_grid), dim3(NWAVES * 64), LDS_BYTES, stream, a);
}
extern "C" void kernel_launch(void* const* d_in, const int* in_sizes, int n_in, void* d_out, int out_size, void* d_ws, size_t ws_size, hipStream_t stream) {
    if (n_in != 25 || ws_size < WS_END || out_size != MTOK * DM) { fprintf(stderr, "kernel_launch: unexpected problem (n_in %d ws %zu out %d)\n", n_in, ws_size, out_size); return; }
    if (g_grid == 0) {
        int dev = 0, cus = 0;
        if (hipGetDevice(&dev) != hipSuccess || hipDeviceGetAttribute(&cus, hipDeviceAttributeMultiprocessorCount, dev) != hipSuccess) { g_grid = -1; return; }
        if (hipFuncSetAttribute((const void*)mk_fwd, hipFuncAttributeMaxDynamicSharedMemorySize, LDS_BYTES) != hipSuccess) { g_grid = -1; return; }
        int per_cu = 0; (void)hipOccupancyMaxActiveBlocksPerMultiprocessor(&per_cu, (const void*)mk_fwd, NWAVES * 64, LDS_BYTES); (void)hipGetLastError();
        g_grid = (per_cu >= 1) ? cus : -1;
    }
    if (g_grid < 0) return;
    const float* x = (const float*)d_in[0]; const float* rel_bias = (const float*)d_in[6]; const float* conv_w = (const float*)d_in[7];
    const float* out_norm_a_g = (const float*)d_in[8]; const float* out_norm_b_g = (const float*)d_in[9]; const float* w_out = (const float*)d_in[10]; const float* norm_xattn_g = (const float*)d_in[11];
    const float* w_xq = (const float*)d_in[13]; const float* xq_norm_g = (const float*)d_in[15];
    const float* xk_norm_g = (const float*)d_in[16]; const float* w_xo = (const float*)d_in[17]; const float* norm_ffn_g = (const float*)d_in[18]; const float* w_router = (const float*)d_in[19];
    const float* b_router = (const float*)d_in[20]; const float* w_gate_up = (const float*)d_in[21]; const float* b_gate_up = (const float*)d_in[22]; const float* w_down = (const float*)d_in[23];
    const float* b_down = (const float*)d_in[24];
    unsigned char* ws = (unsigned char*)d_ws; float* out = (float*)d_out;
    unsigned* ctl = (unsigned*)(ws + WS_CTL);
    bf16_t *Wout = (bf16_t*)(ws + WS_WOUT), *Wxq = (bf16_t*)(ws + WS_WXQ), *Wxo = (bf16_t*)(ws + WS_WXO), *Wgu = (bf16_t*)(ws + WS_WGU), *Wdn = (bf16_t*)(ws + WS_WDN);
    bf16_t *hb = (bf16_t*)(ws + WS_HB), *proj = (bf16_t*)(ws + WS_PROJ), *kvmem = (bf16_t*)(ws + WS_KVMEM), *yb = (bf16_t*)(ws + WS_YB), *qx = (bf16_t*)(ws + WS_QX), *ox = (bf16_t*)(ws + WS_OX);
    bf16_t *act = (bf16_t*)(ws + WS_ACT), *ybuf = (bf16_t*)(ws + WS_YBUF);
    float *ya = (float*)(ws + WS_YA), *x1 = (float*)(ws + WS_X1), *gate = (float*)(ws + WS_GATE);
    int *list = (int*)(ws + WS_LIST), *slot_tk = (int*)(ws + WS_SLOTTK), *slot_src = (int*)(ws + WS_SLOTSRC), *blk_e = (int*)(ws + WS_BLKE);

    (void)hipMemsetAsync(ctl, 0, CTL_ZERO_BYTES, stream);
    Args a{}; for (int i = 0; i < 25; ++i) a.in[i] = (const float*)d_in[i]; a.out = out; a.ws = ws;
    launch_mk(a, 0, 11, 0, stream);
}
```

```cpp
#include <hip/hip_runtime.h>
#include <stdint.h>
#include <stdio.h>

#define LAS __attribute__((address_space(3)))
#define GAS __attribute__((address_space(1)))
typedef unsigned short bf16_t;
typedef short bf16x8 __attribute__((ext_vector_type(8)));
typedef float f32x4 __attribute__((ext_vector_type(4)));
typedef float f32x2 __attribute__((ext_vector_type(2)));
typedef float f32x16 __attribute__((ext_vector_type(16)));
typedef float f32x8 __attribute__((ext_vector_type(8)));
typedef unsigned u32x4 __attribute__((ext_vector_type(4)));
typedef unsigned u32x2 __attribute__((ext_vector_type(2)));
typedef int v8i32 __attribute__((ext_vector_type(8)));
typedef int v4i32 __attribute__((ext_vector_type(4)));

constexpr int DM = 1024, BATCH = 16, SEQ = 2048, MTOK = BATCH * SEQ;
constexpr int CHUNK = 64, LEFT = 8, NMEM = 256, MMEM = BATCH * NMEM;
constexpr int DATT = 512, DCONV = 512, NPROJ = 3072;
constexpr int XH = 4, XHD = 128, DX = 512;
constexpr int NE = 32, TOPK = 4, DFF = 1024;
constexpr int NREL = 513, MAXREL = 256;
constexpr int NASSIGN = MTOK * TOPK;
constexpr int MAXSLOT = NASSIGN + NE * 256;
constexpr float EPS = 1e-6f;
constexpr float LOG2E = 1.4426950408889634f;

constexpr size_t MiB = 1u << 20;
constexpr size_t WS_CTL = 0, CTL_ZERO_BYTES = 256 * 1024;
constexpr size_t WS_WIN = 1 * MiB, WS_WOUT = 7 * MiB, WS_WXQ = 9 * MiB, WS_WXKV = 10 * MiB, WS_WXO = 12 * MiB, WS_WGU = 13 * MiB, WS_WDN = 141 * MiB;
constexpr size_t WS_HB = 205 * MiB, WS_HMB = 269 * MiB;
constexpr size_t WS_LIST = 277 * MiB, WS_GATE = 281 * MiB, WS_SLOTTK = 282 * MiB, WS_SLOTSRC = 283 * MiB, WS_BLKE = 284 * MiB;
constexpr size_t WS_PROJ = 285 * MiB, WS_KVMEM = 477 * MiB, WS_YA = 485 * MiB, WS_YB = 549 * MiB, WS_X1 = 613 * MiB, WS_QX = 741 * MiB, WS_OX = 773 * MiB;
constexpr size_t WS_ACT = 285 * MiB, WS_YBUF = 557 * MiB;
constexpr size_t WS_SQ1 = 813 * MiB, WS_SQ2 = 815 * MiB, WS_RSTD2 = 817 * MiB, WS_WRT = 818 * MiB, WS_LISTR = 819 * MiB, WS_LISTG = 824 * MiB, WS_END = 829 * MiB;
constexpr int CW_CNT = 0, CW_NBLK = 64, CW_PSTART = 128;
constexpr int CW_BAR = 4096;

__device__ __forceinline__ unsigned f2bf(float f) { unsigned u = __builtin_bit_cast(unsigned, f); return (u + 0x7fffu + ((u >> 16) & 1u)) >> 16; }
__device__ __forceinline__ float bf2f(bf16_t b) { return __builtin_bit_cast(float, ((unsigned)b) << 16); }
__device__ __forceinline__ unsigned pk2(float lo, float hi) { return f2bf(lo) | (f2bf(hi) << 16); }
__device__ __forceinline__ float bflo(unsigned w) { return __builtin_bit_cast(float, w << 16); }
__device__ __forceinline__ float bfhi(unsigned w) { return __builtin_bit_cast(float, w & 0xffff0000u); }
__device__ __forceinline__ float wave_sum(float v) {
#pragma unroll
    for (int o = 1; o < 64; o <<= 1) v += __shfl_xor(v, o);
    return v;
}
__device__ __forceinline__ unsigned cvt_pk_bf16(float lo, float hi) { unsigned r; asm volatile("v_cvt_pk_bf16_f32 %0, %1, %2" : "=v"(r) : "v"(lo), "v"(hi)); return r; }

namespace pg8 {
constexpr int BM = 256, BK = 64, HALF = 128, HTB = HALF * BK * 2  , STAGE_BYTES = 8 * HTB, NXCD = 8, WGM = 8;
__host__ __device__ __forceinline__ int lds_byte(int r, int c) { const int st = (r >> 4) * 2 + (c >> 5), rr = r & 15, cc = c & 31, ob = rr * 64 + cc * 2; return st * 1024 + (ob ^ (((ob >> 9) & 1) << 5)); }
__host__ __device__ __forceinline__ void stage_rc(int b, int& R, int& C) { const int st = b / 1024, sb = b % 1024, swz = sb ^ (((sb >> 9) & 1) << 5); R = (st >> 1) * 16 + swz / 64; C = (st & 1) * 32 + (swz % 64) / 2; }
__host__ __device__ __forceinline__ int perm32(int rho) { const int n = rho >> 4, i = rho & 15; return 8 * (i >> 2) + 4 * n + (i & 3); }

struct Unit { int pm, pn, e, rbl; };

__device__ __forceinline__ bool static_order(int nM, int nN, int G, int c, int i, int& pm, int& pn) {
    const int nwg = nM * nN; const long L = (long)i * G + c; if (L >= nwg) return false;
    int wgid = (int)L; { const int q = nwg / NXCD, r = nwg % NXCD, xcd = wgid % NXCD, off = wgid / NXCD; wgid = (xcd < r ? xcd * (q + 1) : r * (q + 1) + (xcd - r) * q) + off; }
    const int nig = WGM * nN, gid = wgid / nig, fm = gid * WGM, gsz = (nM - fm) < WGM ? (nM - fm) : WGM;
    pm = fm + ((wgid % nig) % gsz); pn = (wgid % nig) / gsz; return true;
}
struct DenseSched {
    const char* A; const char* Bt; int K, nM, nN, G, c;
    __device__ __forceinline__ void init(const void* A_, const void* Bt_, int M, int N, int K_, int G_, int c_) { A = (const char*)A_; Bt = (const char*)Bt_; K = K_; nM = M / BM; nN = N / BM; G = G_; c = c_; }
    __device__ __forceinline__ bool next(int i, Unit& u) const { u.e = 0; u.rbl = 0; return static_order(nM, nN, G, c, i, u.pm, u.pn); }
    __device__ __forceinline__ const char* a_base(const Unit& u) const { return A + (size_t)u.pm * BM * K * 2; }
    __device__ __forceinline__ const char* b_base(const Unit& u) const { return Bt + (size_t)u.pn * BM * K * 2; }
    __device__ __forceinline__ unsigned a_off(const Unit& u) const { return (unsigned)u.pm * BM * K; }
    __device__ __forceinline__ unsigned b_off(const Unit& u) const { return (unsigned)u.pn * BM * K; }
    __device__ __forceinline__ void issue_rows(const Unit&, LAS unsigned char*, int, int) const {}
    __device__ __forceinline__ void read_rows(const Unit&, const LAS unsigned char*, int, unsigned (&)[4]) const {}
};

struct ListSched {
    const char* A; const char* Bt; int K, nN, id0, cnt;
    __device__ __forceinline__ bool next(int i, Unit& u) const { if (i >= cnt) return false; const int id = id0 + i; u.pm = id / nN; u.pn = id % nN; u.e = 0; u.rbl = 0; return true; }
    __device__ __forceinline__ const char* a_base(const Unit& u) const { return A + (size_t)u.pm * BM * K * 2; }
    __device__ __forceinline__ const char* b_base(const Unit& u) const { return Bt + (size_t)u.pn * BM * K * 2; }
    __device__ __forceinline__ void issue_rows(const Unit&, LAS unsigned char*, int, int) const {}
    __device__ __forceinline__ void read_rows(const Unit&, const LAS unsigned char*, int, unsigned (&)[4]) const {}
};

template <class Epi, class Sched, int MODE>
__device__ __forceinline__ void gemm_phase(LAS unsigned char* lds, LAS unsigned char* ldsidx, const Sched& S, const Epi& E) {
    int tid_ = threadIdx.x; asm volatile("" : "+v"(tid_));
    const int tid = tid_, wid = __builtin_amdgcn_readfirstlane(tid >> 6), lane = tid & 63, wr = wid >> 2, wc = wid & 3, fr = lane & 15, fq = lane >> 4;
    const int K = S.K, nt = K / BK;
    int R0, C0; stage_rc(tid * 16, R0, C0);
    const int Rb = (R0 & ~31) + perm32(R0 & 31);
    const unsigned voffB0 = (unsigned)(Rb * K + C0) * 2u, voffB1 = voffB0 + (unsigned)(64 * K) * 2u;
    const size_t kstep = (size_t)(BK * 2);
    const size_t hstep = (size_t)HALF * K * 2;
    const unsigned ldsw = (unsigned)wid * 1024u;
    const int aoff = lds_byte(wr * 64 + fr, fq * 8), boff = lds_byte(wc * 32 + fr, fq * 8);
#define PG8_SA(b, h) (((b) * 2 + (h)) * HTB)
#define PG8_SB(b, h) ((4 + (b) * 2 + (h)) * HTB)
#define PG8_STAGE(bufoff, gbase, o0, o1) do { \
        __builtin_amdgcn_global_load_lds((const unsigned*)((const char*)(gbase) + (o0)), (LAS unsigned*)(lds + (bufoff) + ldsw), 16, 0, 0); \
        __builtin_amdgcn_global_load_lds((const unsigned*)((const char*)(gbase) + (o1)), (LAS unsigned*)(lds + (bufoff) + ldsw + 8192), 16, 0, 0); } while (0)
#define PG8_LDA(dst, b, h) do { _Pragma("unroll") for (int m = 0; m < 4; ++m) _Pragma("unroll") for (int k = 0; k < 2; ++k) dst[m][k] = *(const LAS bf16x8*)(lds + PG8_SA(b, h) + aoff + m * 2048 + k * 1024); } while (0)
#define PG8_LDB(dst, b, h) do { _Pragma("unroll") for (int n = 0; n < 2; ++n) _Pragma("unroll") for (int k = 0; k < 2; ++k) dst[n][k] = *(const LAS bf16x8*)(lds + PG8_SB(b, h) + boff + n * 2048 + k * 1024); } while (0)
#define PG8_MMA(ai, bj, At, Bt) do { __builtin_amdgcn_s_setprio(1); _Pragma("unroll") for (int m = 0; m < 4; ++m) _Pragma("unroll") for (int n = 0; n < 2; ++n) _Pragma("unroll") for (int k = 0; k < 2; ++k) \
        acc[ai][bj][m][n] = __builtin_amdgcn_mfma_f32_16x16x32_bf16(Bt[n][k], At[m][k], acc[ai][bj][m][n], 0, 0, 0); __builtin_amdgcn_s_setprio(0); } while (0)
#define PG8_WAIT_V(n) asm volatile("s_waitcnt vmcnt(" #n ")" ::: "memory")
#define PG8_WAIT_L(n) asm volatile("s_waitcnt lgkmcnt(" #n ")" ::: "memory")
#define PG8_BAR __builtin_amdgcn_s_barrier()
#define PG8_SCHED __builtin_amdgcn_sched_barrier(0)
    Unit cur, nxt; int ui = 0, ib = 0;
    if (!S.next(0, cur)) return;
    unsigned vc[4], vn[4];
    constexpr bool GATHER = (MODE == 2);
    if constexpr (MODE >= 1) { S.issue_rows(cur, ldsidx, wid, lane); asm volatile("s_waitcnt vmcnt(0)" ::: "memory"); __builtin_amdgcn_s_barrier(); asm volatile("" ::: "memory"); }
    if constexpr (GATHER) { S.read_rows(cur, ldsidx, R0, vc); _Pragma("unroll") for (int q = 0; q < 4; ++q) vc[q] += (unsigned)C0 * 2u; }
    else { _Pragma("unroll") for (int q = 0; q < 4; ++q) vc[q] = (unsigned)((R0 + 64 * q) * K + C0) * 2u; }
#pragma unroll
    for (int q = 0; q < 4; ++q) vn[q] = vc[q];
    f32x4 acc[2][2][4][2];
#pragma unroll
    for (int a = 0; a < 2; ++a)
#pragma unroll
        for (int b = 0; b < 2; ++b)
#pragma unroll
            for (int m = 0; m < 4; ++m)
#pragma unroll
                for (int n = 0; n < 2; ++n) acc[a][b][m][n] = (f32x4){0.f, 0.f, 0.f, 0.f};
    bf16x8 At[4][2], B0[2][2], B1[2][2];
    const char* cA = S.a_base(cur); const char* cB = S.b_base(cur);
    PG8_STAGE(PG8_SB(0, 0), cB, voffB0, voffB1); PG8_STAGE(PG8_SB(0, 1), cB + hstep, voffB0, voffB1); PG8_STAGE(PG8_SA(0, 0), cA, vc[0], vc[1]); PG8_STAGE(PG8_SA(0, 1), cA, vc[2], vc[3]);
    if (wr == 1) PG8_BAR;
    PG8_WAIT_V(2); PG8_BAR;
    PG8_STAGE(PG8_SB(1, 0), cB + kstep, voffB0, voffB1); PG8_STAGE(PG8_SA(1, 0), cA + kstep, vc[0], vc[1]); PG8_STAGE(PG8_SB(1, 1), cB + hstep + kstep, voffB0, voffB1);
    PG8_WAIT_V(6); PG8_BAR;
    for (;;) {
        const bool has_next = S.next(ui + 1, nxt);
        if constexpr (MODE >= 1) { if (has_next) S.issue_rows(nxt, ldsidx + (ib == 2 ? 0 : ib + 1) * 3072, wid, lane); }
        const char* nA = has_next ? S.a_base(nxt) : cA; const char* nB = has_next ? S.b_base(nxt) : cB;
        for (int t = 0; t < nt; t += 2) {
            const bool last = (t == nt - 2);
            const char* a1 = cA + (size_t)(t + 1) * kstep;
            const char* a2 = last ? nA : cA + (size_t)(t + 2) * kstep; const char* b2 = last ? nB : cB + (size_t)(t + 2) * kstep;
            const char* a3 = a2 + kstep; const char* b3 = b2 + kstep;
            unsigned w0 = vc[0], w1 = vc[1], w2 = vc[2], w3 = vc[3];
            if constexpr (GATHER) { if (last && has_next) { S.read_rows(nxt, ldsidx + (ib == 2 ? 0 : ib + 1) * 3072, R0, vn); _Pragma("unroll") for (int q = 0; q < 4; ++q) vn[q] += (unsigned)C0 * 2u;
                w0 = vn[0]; w1 = vn[1]; w2 = vn[2]; w3 = vn[3]; } }
            PG8_LDB(B0, 0, 0); PG8_LDB(B1, 0, 1); PG8_SCHED; PG8_LDA(At, 0, 0); PG8_STAGE(PG8_SA(1, 1), a1, vc[2], vc[3]);
            PG8_WAIT_V(8); PG8_WAIT_L(0); PG8_BAR; PG8_MMA(0, 0, At, B0); PG8_MMA(0, 1, At, B1); PG8_BAR; PG8_SCHED;
            PG8_LDA(At, 0, 1); PG8_STAGE(PG8_SB(0, 0), b2, voffB0, voffB1); PG8_STAGE(PG8_SB(0, 1), b2 + hstep, voffB0, voffB1); PG8_STAGE(PG8_SA(0, 0), a2, w0, w1);
            PG8_WAIT_V(8); PG8_WAIT_L(0); PG8_BAR; PG8_MMA(1, 0, At, B0); PG8_MMA(1, 1, At, B1); PG8_BAR; PG8_SCHED;
            PG8_LDB(B0, 1, 0); PG8_LDB(B1, 1, 1); PG8_SCHED; PG8_LDA(At, 1, 0); PG8_STAGE(PG8_SA(0, 1), a2, w2, w3);
            PG8_WAIT_V(8); PG8_WAIT_L(0); PG8_BAR; PG8_MMA(0, 0, At, B0); PG8_MMA(0, 1, At, B1); PG8_BAR; PG8_SCHED;
            PG8_LDA(At, 1, 1); PG8_STAGE(PG8_SB(1, 0), b3, voffB0, voffB1); PG8_STAGE(PG8_SB(1, 1), b3 + hstep, voffB0, voffB1); PG8_STAGE(PG8_SA(1, 0), a3, w0, w1);
            PG8_WAIT_V(8); PG8_WAIT_L(0); PG8_BAR; PG8_MMA(1, 0, At, B0); PG8_MMA(1, 1, At, B1); PG8_BAR; PG8_SCHED;
        }
        if (wr == 0) PG8_BAR;
        E(acc, cur, wr, wc, fr, fq, (const LAS unsigned char*)(ldsidx + ib * 3072));
        if (!has_next) break;
#pragma unroll
        for (int a = 0; a < 2; ++a)
#pragma unroll
            for (int b = 0; b < 2; ++b)
#pragma unroll
                for (int m = 0; m < 4; ++m)
#pragma unroll
                    for (int n = 0; n < 2; ++n) acc[a][b][m][n] = (f32x4){0.f, 0.f, 0.f, 0.f};
        cur = nxt; cA = nA; cB = nB; ++ui; ib = (ib == 2 ? 0 : ib + 1);
#pragma unroll
        for (int q = 0; q < 4; ++q) vc[q] = vn[q];
        if (wr == 1) PG8_BAR;
    }
    PG8_WAIT_V(0);
    PG8_BAR;
#undef PG8_SA
#undef PG8_SB
#undef PG8_STAGE
#undef PG8_LDA
#undef PG8_LDB
#undef PG8_MMA
#undef PG8_WAIT_V
#undef PG8_WAIT_L
#undef PG8_BAR
#undef PG8_SCHED
}
template <class Epi, class Sched, int MODE>
__device__ __forceinline__ void gemm_phase_f8(LAS unsigned char* lds, LAS unsigned char* ldsidx, const Sched& S, const Epi& E) {
    int tid_ = threadIdx.x; asm volatile("" : "+v"(tid_));
    const int tid = tid_, wid = __builtin_amdgcn_readfirstlane(tid >> 6), lane = tid & 63, wr = wid >> 2, wc = wid & 3, fr = lane & 15, fq = lane >> 4;
    constexpr bool GATHER = (MODE == 2);
    const int K = S.K, nt = K / 128;
    const int R0 = tid >> 3, C0 = ((tid & 7) ^ ((R0 >> 1) & 1)) * 16;
    const int Rb = (R0 & ~31) + perm32(R0 & 31);
    const unsigned voffB0 = (unsigned)(Rb * K + C0), r64 = 64u * (unsigned)K;
    const unsigned kstep = 128u;
    const unsigned hstep = (unsigned)(HALF * K);
    const char* const Abase = S.A; const char* const Bbase = S.Bt;
    const unsigned ldsw = (unsigned)wid * 1024u;
    const int sw16 = ((fr >> 1) & 1) * 16;
    const LAS unsigned char* a0p = lds + (wr * 64 + fr) * 128 + fq * 32 + sw16; const LAS unsigned char* a1p = lds + (wr * 64 + fr) * 128 + fq * 32 + 16 - sw16;
    const LAS unsigned char* b0p = lds + 4 * HTB + (wc * 32 + fr) * 128 + fq * 32 + sw16; const LAS unsigned char* b1p = lds + 4 * HTB + (wc * 32 + fr) * 128 + fq * 32 + 16 - sw16;
#define PG8_SA(b, h) (((b) * 2 + (h)) * HTB)
#define PG8_SB(b, h) ((4 + (b) * 2 + (h)) * HTB)
#define PG8_STAGE(bufoff, gbase, o0, o1) do { \
        __builtin_amdgcn_global_load_lds((const unsigned*)((const char*)(gbase) + (o0)), (LAS unsigned*)(lds + (bufoff) + ldsw), 16, 0, 0); \
        __builtin_amdgcn_global_load_lds((const unsigned*)((const char*)(gbase) + (o1)), (LAS unsigned*)(lds + (bufoff) + ldsw + 8192), 16, 0, 0); } while (0)
#define PG8_STAGEA(bufoff, uo, hh) do { \
        __builtin_amdgcn_global_load_lds((const unsigned*)(Abase + (unsigned)((uo) + vc[2 * (hh)])), (LAS unsigned*)(lds + (bufoff) + ldsw), 16, 0, 0); \
        __builtin_amdgcn_global_load_lds((const unsigned*)(Abase + (unsigned)((uo) + vc[2 * (hh) + 1])), (LAS unsigned*)(lds + (bufoff) + ldsw + 8192), 16, 0, 0); } while (0)
#define PG8_STAGEB(bufoff, uo) do { \
        __builtin_amdgcn_global_load_lds((const unsigned*)(Bbase + (unsigned)((uo) + voffB0)), (LAS unsigned*)(lds + (bufoff) + ldsw), 16, 0, 0); \
        __builtin_amdgcn_global_load_lds((const unsigned*)(Bbase + (unsigned)((uo) + r64 + voffB0)), (LAS unsigned*)(lds + (bufoff) + ldsw + 8192), 16, 0, 0); } while (0)
#define PG8_LD32(p0, p1, off) __builtin_shufflevector(*(const LAS v4i32*)((p0) + (off)), *(const LAS v4i32*)((p1) + (off)), 0, 1, 2, 3, 4, 5, 6, 7)
#define PG8_LDA(dst, b, h) do { _Pragma("unroll") for (int m = 0; m < 4; ++m) dst[m] = PG8_LD32(a0p, a1p, PG8_SA(b, h) + m * 2048); } while (0)
#define PG8_LDB(dst, b, h) do { _Pragma("unroll") for (int n = 0; n < 2; ++n) dst[n] = PG8_LD32(b0p, b1p, PG8_SB(b, h) - 4 * HTB + n * 2048); } while (0)
#define PG8_MMA(ai, bj, At, Bt) do { __builtin_amdgcn_s_setprio(1); _Pragma("unroll") for (int m = 0; m < 4; ++m) _Pragma("unroll") for (int n = 0; n < 2; ++n) \
        acc[ai][bj][m][n] = __builtin_amdgcn_mfma_scale_f32_16x16x128_f8f6f4(Bt[n], At[m], acc[ai][bj][m][n], 0, 0, 0, 0, 0, 0); __builtin_amdgcn_s_setprio(0); } while (0)
#define PG8_WAIT_V(n) asm volatile("s_waitcnt vmcnt(" #n ")" ::: "memory")
#define PG8_WAIT_L(n) asm volatile("s_waitcnt lgkmcnt(" #n ")" ::: "memory")
#define PG8_BAR __builtin_amdgcn_s_barrier()
#define PG8_SCHED __builtin_amdgcn_sched_barrier(0)
    Unit cur, nxt; int ui = 0, ib = 0;
    if (!S.next(0, cur)) return;
    unsigned vc[4];
    if constexpr (MODE >= 1) { S.issue_rows(cur, ldsidx, wid, lane); asm volatile("s_waitcnt vmcnt(0)" ::: "memory"); __builtin_amdgcn_s_barrier(); asm volatile("" ::: "memory"); }
    if constexpr (GATHER) { S.read_rows(cur, ldsidx, R0, vc); _Pragma("unroll") for (int q = 0; q < 4; ++q) vc[q] += (unsigned)C0; }
    else { const unsigned ua = S.a_off(cur); _Pragma("unroll") for (int q = 0; q < 4; ++q) vc[q] = ua + (unsigned)((R0 + 64 * q) * K + C0); }
    f32x4 acc[2][2][4][2];
#pragma unroll
    for (int a = 0; a < 2; ++a)
#pragma unroll
        for (int b = 0; b < 2; ++b)
#pragma unroll
            for (int m = 0; m < 4; ++m)
#pragma unroll
                for (int n = 0; n < 2; ++n) acc[a][b][m][n] = (f32x4){0.f, 0.f, 0.f, 0.f};
    v8i32 At[4], B0[2], B1[2];
    unsigned cB = S.b_off(cur);
    PG8_STAGEB(PG8_SB(0, 0), cB); PG8_STAGEB(PG8_SB(0, 1), cB + hstep); PG8_STAGEA(PG8_SA(0, 0), 0u, 0); PG8_STAGEA(PG8_SA(0, 1), 0u, 1);
    if (wr == 1) PG8_BAR;
    PG8_WAIT_V(2); PG8_BAR;
    PG8_STAGEB(PG8_SB(1, 0), cB + kstep); PG8_STAGEA(PG8_SA(1, 0), kstep, 0); PG8_STAGEB(PG8_SB(1, 1), cB + hstep + kstep);
    PG8_WAIT_V(6); PG8_BAR;
    for (;;) {
        const bool has_next = S.next(ui + 1, nxt);
        if constexpr (MODE >= 1) { if (has_next) S.issue_rows(nxt, ldsidx + (ib == 2 ? 0 : ib + 1) * 3072, wid, lane); }
        const unsigned nB = has_next ? S.b_off(nxt) : cB;
        for (int t = 0; t < nt; t += 2) {
            const bool last = (t == nt - 2);
            const unsigned a1 = (unsigned)(t + 1) * kstep;
            const unsigned a2 = last ? 0u : (unsigned)(t + 2) * kstep, b2 = last ? nB : cB + (unsigned)(t + 2) * kstep;
            const unsigned a3 = a2 + kstep, b3 = b2 + kstep;
            PG8_LDB(B0, 0, 0); PG8_LDB(B1, 0, 1); PG8_SCHED; PG8_LDA(At, 0, 0); PG8_STAGEA(PG8_SA(1, 1), a1, 1);
            if (last && has_next) {
                if constexpr (GATHER) { S.read_rows(nxt, ldsidx + (ib == 2 ? 0 : ib + 1) * 3072, R0, vc); _Pragma("unroll") for (int q = 0; q < 4; ++q) vc[q] += (unsigned)C0; }
                else { const unsigned ua = S.a_off(nxt); _Pragma("unroll") for (int q = 0; q < 4; ++q) vc[q] = ua + (unsigned)((R0 + 64 * q) * K + C0); } }
            PG8_WAIT_V(8); PG8_WAIT_L(0); PG8_BAR; PG8_MMA(0, 0, At, B0); PG8_MMA(0, 1, At, B1); PG8_BAR; PG8_SCHED;
            PG8_LDA(At, 0, 1); PG8_STAGEB(PG8_SB(0, 0), b2); PG8_STAGEB(PG8_SB(0, 1), b2 + hstep); PG8_STAGEA(PG8_SA(0, 0), a2, 0);
            PG8_WAIT_V(8); PG8_WAIT_L(0); PG8_BAR; PG8_MMA(1, 0, At, B0); PG8_MMA(1, 1, At, B1); PG8_BAR; PG8_SCHED;
            PG8_LDB(B0, 1, 0); PG8_LDB(B1, 1, 1); PG8_SCHED; PG8_LDA(At, 1, 0); PG8_STAGEA(PG8_SA(0, 1), a2, 1);
            PG8_WAIT_V(8); PG8_WAIT_L(0); PG8_BAR; PG8_MMA(0, 0, At, B0); PG8_MMA(0, 1, At, B1); PG8_BAR; PG8_SCHED;
            PG8_LDA(At, 1, 1); PG8_STAGEB(PG8_SB(1, 0), b3); PG8_STAGEB(PG8_SB(1, 1), b3 + hstep); PG8_STAGEA(PG8_SA(1, 0), a3, 0);
            PG8_WAIT_V(8); PG8_WAIT_L(0); PG8_BAR; PG8_MMA(1, 0, At, B0); PG8_MMA(1, 1, At, B1); PG8_BAR; PG8_SCHED;
        }
        if (wr == 0) PG8_BAR;
        E(acc, cur, wr, wc, fr, fq, (const LAS unsigned char*)(ldsidx + ib * 3072));
        if (!has_next) break;
#pragma unroll
        for (int a = 0; a < 2; ++a)
#pragma unroll
            for (int b = 0; b < 2; ++b)
#pragma unroll
                for (int m = 0; m < 4; ++m) { acc[a][b][m][0] = (f32x4){0.f, 0.f, 0.f, 0.f}; acc[a][b][m][1] = (f32x4){0.f, 0.f, 0.f, 0.f}; }
        cur = nxt; cB = nB; ++ui; ib = (ib == 2 ? 0 : ib + 1);
        if (wr == 1) PG8_BAR;
    }
    PG8_WAIT_V(0);
    PG8_BAR;
#undef PG8_SA
#undef PG8_SB
#undef PG8_STAGE
#undef PG8_STAGEB
#undef PG8_STAGEA
#undef PG8_LDA
#undef PG8_LDB
#undef PG8_MMA
#undef PG8_LD32
#undef PG8_WAIT_V
#undef PG8_WAIT_L
#undef PG8_BAR
#undef PG8_SCHED
}
}

#define XB_TMO      128
#define XB_XCNT(j)  (256  + 64 * (j))
#define XB_XSUB(j)  (1280 + 64 * (j))
#define XB_XGEN(j)  (2304 + 64 * (j))
#define XB_TOP      3328
#define XB_TOPGEN   3392
#define XCD_BAR_WORDS 3456
#define XB_SPIN_CAP (1u << 18)

__device__ __forceinline__ unsigned xb_ld(unsigned* p)              { return __hip_atomic_load(p, __ATOMIC_RELAXED, __HIP_MEMORY_SCOPE_AGENT); }
__device__ __forceinline__ unsigned xb_add(unsigned* p, unsigned v) { return __hip_atomic_fetch_add(p, v, __ATOMIC_RELAXED, __HIP_MEMORY_SCOPE_AGENT); }
__device__ __forceinline__ unsigned xb_xcc_id() { return (unsigned)__builtin_amdgcn_s_getreg((3 << 11) | 20) & 0xFu; }
#define XB_SPIN(cond, bar) do { unsigned _sp = 0; while (cond) { __builtin_amdgcn_s_sleep(1); \
    if ((++_sp & 255u) == 0u) { if (xb_ld(&(bar)[XB_TMO])) break; if (_sp > XB_SPIN_CAP) { atomicAdd(&(bar)[XB_TMO], 1u); break; } } } } while (0)

struct XcdBarrier {
    unsigned* bar; unsigned x;
    volatile LAS unsigned* st;
};
__device__ __forceinline__ XcdBarrier xcd_barrier_post(unsigned* bar, volatile LAS unsigned* st) {
    XcdBarrier b; b.bar = bar; b.x = xb_xcc_id(); b.st = st;
    if (threadIdx.x == 0) (void)xb_add(&bar[XB_XCNT(b.x)], 1u);
    return b;
}
__device__ __forceinline__ void xcd_barrier_complete(unsigned* bar, unsigned x, unsigned& nloc, unsigned& nx) {
    const unsigned G = gridDim.x * gridDim.y * gridDim.z;
    unsigned sum, cnt, mine, sp = 0u;
    for (;;) {
        sum = 0u; cnt = 0u; mine = 0u;
#pragma unroll
        for (unsigned j = 0; j < 16; ++j) { const unsigned c = xb_ld(&bar[XB_XCNT(j)]); sum += c; cnt += (c > 0u) ? 1u : 0u; mine = (j == x) ? c : mine; }
        if (sum == G) break;
        __builtin_amdgcn_s_sleep(1);
        if ((++sp & 255u) == 0u) { if (xb_ld(&bar[XB_TMO])) break; if (sp > XB_SPIN_CAP) { atomicAdd(&bar[XB_TMO], 1u); break; } }
    }
    nloc = mine > 0u ? mine : 1u; nx = cnt > 0u ? cnt : 1u;
}
__device__ __forceinline__ void xcd_barrier(const XcdBarrier& b) {
    asm volatile("s_waitcnt vmcnt(0)" ::: "memory");
    __syncthreads();
    if (threadIdx.x == 0) {
        unsigned* bar = b.bar;
        __builtin_amdgcn_s_waitcnt(0);
        unsigned nloc = b.st[0], nx = b.st[1];
        if (nloc == 0u) { xcd_barrier_complete(bar, b.x, nloc, nx); b.st[0] = nloc; b.st[1] = nx; }
        const unsigned old = xb_add(&bar[XB_XSUB(b.x)], 1u);
        const unsigned gen = old / nloc;
        if (old + 1u == (gen + 1u) * nloc) {
            __builtin_amdgcn_fence(__ATOMIC_RELEASE, "agent");
            asm volatile("s_waitcnt vmcnt(0)" ::: "memory");
            const unsigned og = xb_add(&bar[XB_TOP], 1u);
            const unsigned tg = og / nx;
            if (og + 1u == (tg + 1u) * nx) xb_add(&bar[XB_TOPGEN], 1u);
            else XB_SPIN(xb_ld(&bar[XB_TOPGEN]) == tg, bar);
            __builtin_amdgcn_fence(__ATOMIC_ACQUIRE, "agent");
            xb_add(&bar[XB_XGEN(b.x)], 1u);
            asm volatile("s_waitcnt vmcnt(0)" ::: "memory");
        } else {
            XB_SPIN(xb_ld(&bar[XB_XGEN(b.x)]) == gen, bar);
            __builtin_amdgcn_fence(__ATOMIC_ACQUIRE, "agent");
            asm volatile("s_waitcnt vmcnt(0)" ::: "memory");
        }
    }
    __syncthreads();
}

constexpr int NWAVES = 8;
constexpr int RING_OFF = 0, RING_BYTES = 139264;
constexpr int LDSCTL_OFF = RING_BYTES, MISC_OFF = LDSCTL_OFF + 320;
constexpr int MOE_OFF = LDSCTL_OFF + 512;
constexpr int IDX_OFF = LDSCTL_OFF + 4096;
constexpr int TBL_OFF = LDSCTL_OFF + 4096;
constexpr int SSQ_OFF = LDSCTL_OFF + 16384;
constexpr int LDS_BYTES = RING_BYTES + 20480;
static_assert(TBL_OFF + 8 * 384 * 4 <= SSQ_OFF && SSQ_OFF + 4096 <= LDS_BYTES && LDS_BYTES <= 160 * 1024, "LDS map");

struct Args { const float* in[25]; float* out; unsigned char* ws; int ph_lo, ph_hi, li, pad; };
enum { I_X = 0, I_MEM, I_NORM_MIX_G, I_W_IN, I_Q_G, I_K_G, I_REL_BIAS, I_CONV_W, I_ONA_G, I_ONB_G, I_W_OUT, I_NORM_X_G, I_NORM_MEM_G, I_W_XQ, I_W_XKV, I_XQ_G, I_XK_G, I_W_XO,
       I_NORM_FFN_G, I_W_ROUTER, I_B_ROUTER, I_W_GU, I_B_GU, I_W_DN, I_B_DN };

constexpr float X8SCALE = 4.0f, W8SCALE = 64.0f, A8SCALE = 8.0f, Y8SCALE = 32.0f;
struct Frame {
    LAS unsigned char* lds; int tid, lane, wave, vcu, G;
};

__device__ __forceinline__ void p0_transpose_item(const float* __restrict__ W, int ldw, int K, bf16_t* __restrict__ WT, int k0, int scol0, int cstride, int drow0, const float* __restrict__ g, LAS float* scr, int lane) {
#pragma unroll 8
    for (int i = 0; i < 32; ++i) { const int kk = 2 * i + (lane >> 5); float v = W[(size_t)(k0 + kk) * ldw + scol0 + (lane & 31) * cstride]; if (g) v *= g[k0 + kk]; scr[kk * 33 + (lane & 31)] = v; }
    asm volatile("s_waitcnt lgkmcnt(0)" ::: "memory");
    const int c = lane & 7;
#pragma unroll
    for (int j = 0; j < 4; ++j) { const int n = (lane >> 3) + 8 * j; const LAS float* s = scr + (8 * c) * 33 + n;
        u32x4 o; o.x = pk2(s[0 * 33], s[1 * 33]); o.y = pk2(s[2 * 33], s[3 * 33]); o.z = pk2(s[4 * 33], s[5 * 33]); o.w = pk2(s[6 * 33], s[7 * 33]);
        *(u32x4*)(WT + (size_t)(drow0 + n) * K + k0 + 8 * c) = o; }
    asm volatile("s_waitcnt lgkmcnt(0)" ::: "memory");
}
template <int MODE>
__device__ __forceinline__ void p0_transpose64(const float* __restrict__ W, int ldw, int K, bf16_t* __restrict__ WT, int k0, int n0, int drow0, const float* __restrict__ g, LAS float* scr, int lane) {
    const int krow = lane >> 4, c4 = lane & 15;
    f32x4 v[16];
#pragma unroll
    for (int i = 0; i < 16; ++i) v[i] = *(const f32x4*)(W + (size_t)(k0 + 4 * i + krow) * ldw + n0 + 4 * c4);
    if (g) {
#pragma unroll
        for (int i = 0; i < 16; ++i) v[i] = v[i] * g[k0 + 4 * i + krow]; }
#pragma unroll
    for (int i = 0; i < 16; ++i) { LAS float* d = scr + (4 * i + krow) * 65 + 4 * c4; d[0] = v[i].x; d[1] = v[i].y; d[2] = v[i].z; d[3] = v[i].w; }
    asm volatile("s_waitcnt lgkmcnt(0)" ::: "memory");
    const int kc = lane & 7;
#pragma unroll
    for (int j = 0; j < 8; ++j) { const int n = (lane >> 3) + 8 * j; const LAS float* s = scr + (8 * kc) * 65 + n;
        u32x4 o; o.x = pk2(s[0 * 65], s[1 * 65]); o.y = pk2(s[2 * 65], s[3 * 65]); o.z = pk2(s[4 * 65], s[5 * 65]); o.w = pk2(s[6 * 65], s[7 * 65]);
        const int dr = MODE == 0 ? n : (MODE == 1 ? 128 * (n >> 5) + (n & 31) : 128 * (n & 1) + (n >> 1));
        *(u32x4*)(WT + (size_t)(drow0 + dr) * K + k0 + 8 * kc) = o; }
    asm volatile("s_waitcnt lgkmcnt(0)" ::: "memory");
}
__device__ __forceinline__ float clamp8(float v) { return fminf(fmaxf(v, -448.0f), 448.0f); }
__device__ __forceinline__ unsigned pk4_fp8(float a, float b, float c, float d) { int w = 0; w = __builtin_amdgcn_cvt_pk_fp8_f32(a, b, w, false); w = __builtin_amdgcn_cvt_pk_fp8_f32(c, d, w, true); return (unsigned)w; }
template <int MODE>
__device__ __forceinline__ void p0_transpose64_f8(const float* __restrict__ W, int ldw, int K, unsigned char* __restrict__ WT, int k0, int n0, int drow0, const float* __restrict__ g, float sc, LAS float* scr, int lane) {
    const int krow = lane >> 4, c4 = lane & 15;
    f32x4 v[16];
#pragma unroll
    for (int i = 0; i < 16; ++i) v[i] = *(const f32x4*)(W + (size_t)(k0 + 4 * i + krow) * ldw + n0 + 4 * c4);
#pragma unroll
    for (int i = 0; i < 16; ++i) v[i] = v[i] * (g ? g[k0 + 4 * i + krow] * sc : sc);
#pragma unroll
    for (int i = 0; i < 16; ++i) { LAS float* d = scr + (4 * i + krow) * 65 + 4 * c4; d[0] = v[i].x; d[1] = v[i].y; d[2] = v[i].z; d[3] = v[i].w; }
    asm volatile("s_waitcnt lgkmcnt(0)" ::: "memory");
    const int kc = lane & 3;
#pragma unroll
    for (int j = 0; j < 4; ++j) { const int n = (lane >> 2) + 16 * j; const LAS float* s = scr + (16 * kc) * 65 + n;
        u32x4 o; o.x = pk4_fp8(s[0 * 65], s[1 * 65], s[2 * 65], s[3 * 65]); o.y = pk4_fp8(s[4 * 65], s[5 * 65], s[6 * 65], s[7 * 65]);
        o.z = pk4_fp8(s[8 * 65], s[9 * 65], s[10 * 65], s[11 * 65]); o.w = pk4_fp8(s[12 * 65], s[13 * 65], s[14 * 65], s[15 * 65]);
        const int dr = MODE == 0 ? n : (MODE == 1 ? 128 * (n >> 5) + (n & 31) : 128 * (n & 1) + (n >> 1));
        *(u32x4*)(WT + (size_t)(drow0 + dr) * K + k0 + 16 * kc) = o; }
    asm volatile("s_waitcnt lgkmcnt(0)" ::: "memory");
}
struct F8Item { const float* W; unsigned char* WT; const float* g; int ldw, k0, n0, drow0, mode; };
__device__ __forceinline__ void p0_f8_load(const F8Item& I, f32x4 (&v)[16], int lane) {
    const int krow = lane >> 4, c4 = lane & 15;
#pragma unroll
    for (int i = 0; i < 16; ++i) v[i] = *(const f32x4*)(I.W + (size_t)(I.k0 + 4 * i + krow) * I.ldw + I.n0 + 4 * c4);
}
__device__ __forceinline__ void p0_f8_store(const F8Item& I, const f32x4 (&v)[16], int K, float sc, LAS float* scr, int lane) {
    const int krow = lane >> 4, c4 = lane & 15;
#pragma unroll
    for (int i = 0; i < 16; ++i) { const float s = I.g ? I.g[I.k0 + 4 * i + krow] * sc : sc; LAS float* d = scr + (4 * i + krow) * 65 + 4 * c4; d[0] = v[i].x * s; d[1] = v[i].y * s; d[2] = v[i].z * s; d[3] = v[i].w * s; }
    asm volatile("s_waitcnt lgkmcnt(0)" ::: "memory");
    const int kc = lane & 3;
#pragma unroll
    for (int j = 0; j < 4; ++j) { const int n = (lane >> 2) + 16 * j; const LAS float* s = scr + (16 * kc) * 65 + n;
        u32x4 o; o.x = pk4_fp8(s[0 * 65], s[1 * 65], s[2 * 65], s[3 * 65]); o.y = pk4_fp8(s[4 * 65], s[5 * 65], s[6 * 65], s[7 * 65]);
        o.z = pk4_fp8(s[8 * 65], s[9 * 65], s[10 * 65], s[11 * 65]); o.w = pk4_fp8(s[12 * 65], s[13 * 65], s[14 * 65], s[15 * 65]);
        const int dr = I.mode == 0 ? n : 128 * (n & 1) + (n >> 1);
        *(u32x4*)(I.WT + (size_t)(I.drow0 + dr) * K + I.k0 + 16 * kc) = o; }
    asm volatile("s_waitcnt lgkmcnt(0)" ::: "memory");
}
__device__ __forceinline__ void rms_row_to_bf16(const float* __restrict__ xrow, const float* __restrict__ g, bf16_t* __restrict__ orow, int lane) {
    const f32x4* xr = (const f32x4*)xrow + lane; const f32x4* gr = (const f32x4*)g + lane;
    f32x4 v[4]; float s = 0.f;
#pragma unroll
    for (int j = 0; j < 4; ++j) { v[j] = xr[64 * j]; s += (v[j].x * v[j].x + v[j].y * v[j].y) + (v[j].z * v[j].z + v[j].w * v[j].w); }
    const float rstd = 1.0f / sqrtf(wave_sum(s) * (1.0f / DM) + EPS);
    u32x2* o8 = (u32x2*)orow + lane;
#pragma unroll
    for (int j = 0; j < 4; ++j) { const f32x4 gg = gr[64 * j]; u32x2 o; o.x = pk2(v[j].x * rstd * gg.x, v[j].y * rstd * gg.y); o.y = pk2(v[j].z * rstd * gg.z, v[j].w * rstd * gg.w); o8[64 * j] = o; }
}

using pg8::Unit;
struct EpiProj { bf16_t* O; const float* qg; const float* kg; float qscale; int pad;
    __device__ __forceinline__ void operator()(const f32x4 (&acc)[2][2][4][2], const Unit& u, int wr, int wc, int fr, int fq, const LAS unsigned char*) const {
        const int row0 = u.pm * 256 + wr * 64 + fr, colb = u.pn * 256 + wc * 64 + 8 * fq;
        const int mode = u.pn < 2 ? 1 : (u.pn < 4 ? 2 : 0);
        f32x4 gv[2][2];
        if (mode) { const float* gp = (mode == 1 ? qg : kg) + 8 * fq; const float sc = mode == 1 ? qscale : 1.0f;
#pragma unroll
            for (int bj = 0; bj < 2; ++bj)
#pragma unroll
                for (int n = 0; n < 2; ++n) gv[bj][n] = *(const f32x4*)(gp + 32 * bj + 4 * n) * sc; }
#pragma unroll
        for (int ai = 0; ai < 2; ++ai)
#pragma unroll
            for (int m = 0; m < 4; ++m) {
                f32x4 v[2][2];
#pragma unroll
                for (int bj = 0; bj < 2; ++bj)
#pragma unroll
                    for (int n = 0; n < 2; ++n) v[bj][n] = acc[ai][bj][m][n];
                if (mode) { float ss = 0.f;
#pragma unroll
                    for (int bj = 0; bj < 2; ++bj)
#pragma unroll
                        for (int n = 0; n < 2; ++n) ss += (v[bj][n].x * v[bj][n].x + v[bj][n].y * v[bj][n].y) + (v[bj][n].z * v[bj][n].z + v[bj][n].w * v[bj][n].w);
                    ss += __shfl_xor(ss, 16); ss += __shfl_xor(ss, 32);
                    const float rstd = 1.0f / sqrtf(ss * (1.0f / 64.0f) + EPS);
#pragma unroll
                    for (int bj = 0; bj < 2; ++bj)
#pragma unroll
                        for (int n = 0; n < 2; ++n) v[bj][n] = v[bj][n] * rstd * gv[bj][n]; }
                bf16_t* rowp = O + (size_t)(row0 + ai * 128 + m * 16) * NPROJ + colb;
#pragma unroll
                for (int bj = 0; bj < 2; ++bj) { u32x4 w; w.x = cvt_pk_bf16(v[bj][0].x, v[bj][0].y); w.y = cvt_pk_bf16(v[bj][0].z, v[bj][0].w); w.z = cvt_pk_bf16(v[bj][1].x, v[bj][1].y); w.w = cvt_pk_bf16(v[bj][1].z, v[bj][1].w);
                    *(u32x4*)(rowp + 32 * bj) = w; }
            }
    }
};
struct EpiBf16 { bf16_t* O; int ldo; int pad;
    __device__ __forceinline__ void operator()(const f32x4 (&acc)[2][2][4][2], const Unit& u, int wr, int wc, int fr, int fq, const LAS unsigned char*) const {
        const int row0 = u.pm * 256 + wr * 64 + fr, col0 = u.pn * 256 + wc * 32 + 8 * fq;
#pragma unroll
        for (int ai = 0; ai < 2; ++ai)
#pragma unroll
            for (int m = 0; m < 4; ++m) { bf16_t* rowp = O + (size_t)(row0 + ai * 128 + m * 16) * ldo + col0;
#pragma unroll
                for (int bj = 0; bj < 2; ++bj) { const f32x4 v0 = acc[ai][bj][m][0], v1 = acc[ai][bj][m][1];
                    u32x4 w; w.x = cvt_pk_bf16(v0.x, v0.y); w.y = cvt_pk_bf16(v0.z, v0.w); w.z = cvt_pk_bf16(v1.x, v1.y); w.w = cvt_pk_bf16(v1.z, v1.w);
                    *(u32x4*)(rowp + bj * 128) = w; } }
    }
};
template <bool BASE_BF16, bool F8COPY = false> struct EpiRes { const void* base; bf16_t* outb; float* sq; unsigned char* out8;
    __device__ __forceinline__ void operator()(const f32x4 (&acc)[2][2][4][2], const Unit& u, int wr, int wc, int fr, int fq, const LAS unsigned char*) const {
        const int row0 = u.pm * 256 + wr * 64 + fr, col0 = u.pn * 256 + wc * 32 + 8 * fq;
#pragma unroll
        for (int ai = 0; ai < 2; ++ai)
#pragma unroll
            for (int m = 0; m < 4; ++m) { const int row = row0 + ai * 128 + m * 16; const size_t off = (size_t)row * DM + col0; float ss = 0.f;
#pragma unroll
                for (int bj = 0; bj < 2; ++bj) { f32x4 b0, b1;
                    if constexpr (BASE_BF16) { const u32x4 bb = *(const u32x4*)((const bf16_t*)base + off + bj * 128); b0 = (f32x4){bflo(bb.x), bfhi(bb.x), bflo(bb.y), bfhi(bb.y)}; b1 = (f32x4){bflo(bb.z), bfhi(bb.z), bflo(bb.w), bfhi(bb.w)}; }
                    else { b0 = *(const f32x4*)((const float*)base + off + bj * 128); b1 = *(const f32x4*)((const float*)base + off + bj * 128 + 4); }
                    const f32x4 v0 = acc[ai][bj][m][0] + b0, v1 = acc[ai][bj][m][1] + b1;
                    u32x4 w; w.x = cvt_pk_bf16(v0.x, v0.y); w.y = cvt_pk_bf16(v0.z, v0.w); w.z = cvt_pk_bf16(v1.x, v1.y); w.w = cvt_pk_bf16(v1.z, v1.w);
                    *(u32x4*)(outb + off + bj * 128) = w;
                    if constexpr (F8COPY) { u32x2 w8; w8.x = pk4_fp8(clamp8(v0.x * X8SCALE), clamp8(v0.y * X8SCALE), clamp8(v0.z * X8SCALE), clamp8(v0.w * X8SCALE)); w8.y = pk4_fp8(clamp8(v1.x * X8SCALE), clamp8(v1.y * X8SCALE), clamp8(v1.z * X8SCALE), clamp8(v1.w * X8SCALE)); *(u32x2*)(out8 + off + bj * 128) = w8; }
                    ss += (v0.x * v0.x + v0.y * v0.y) + (v0.z * v0.z + v0.w * v0.w) + (v1.x * v1.x + v1.y * v1.y) + (v1.z * v1.z + v1.w * v1.w); }
                ss += __shfl_xor(ss, 16); ss += __shfl_xor(ss, 32);
                if (fq == 0) sq[((size_t)u.pn * MTOK + row) * 4 + wc] = ss; }
    }
};
struct EpiRstdBf16 { bf16_t* O; const float* sq; int ldo; int pad;
    __device__ __forceinline__ void operator()(const f32x4 (&acc)[2][2][4][2], const Unit& u, int wr, int wc, int fr, int fq, const LAS unsigned char*) const {
        const int row0 = u.pm * 256 + wr * 64 + fr, col0 = u.pn * 256 + wc * 32 + 8 * fq;
#pragma unroll
        for (int ai = 0; ai < 2; ++ai)
#pragma unroll
            for (int m = 0; m < 4; ++m) { const int row = row0 + ai * 128 + m * 16; float s = 0.f;
#pragma unroll
                for (int t = 0; t < 4; ++t) { const f32x4 p = *(const f32x4*)(sq + ((size_t)t * MTOK + row) * 4); s += (p.x + p.y) + (p.z + p.w); }
                const float rstd = 1.0f / sqrtf(s * (1.0f / DM) + EPS);
                bf16_t* rowp = O + (size_t)row * ldo + col0;
#pragma unroll
                for (int bj = 0; bj < 2; ++bj) { const f32x4 v0 = acc[ai][bj][m][0] * rstd, v1 = acc[ai][bj][m][1] * rstd;
                    u32x4 w; w.x = cvt_pk_bf16(v0.x, v0.y); w.y = cvt_pk_bf16(v0.z, v0.w); w.z = cvt_pk_bf16(v1.x, v1.y); w.w = cvt_pk_bf16(v1.z, v1.w);
                    *(u32x4*)(rowp + bj * 128) = w; } }
    }
};
constexpr int LSTRIDE = MTOK;
struct MoeSched {
    const char* A; const char* Bt; size_t estride; const int* list; const float* listv; const float* bias; const LAS unsigned* tab; int K, nN, nblk, G, c, gather, esz, bstride;
    __device__ __forceinline__ bool next(int i, Unit& u) const {
        if (!pg8::static_order(nblk, nN, G, c, i, u.pm, u.pn)) return false;
        int e = 0; while (e < NE - 1 && (int)tab[32 + e + 1] <= u.pm) ++e;
        e = __builtin_amdgcn_readfirstlane(e); u.e = e; u.rbl = u.pm - (int)__builtin_amdgcn_readfirstlane(tab[32 + e]); return true;
    }
    __device__ __forceinline__ const char* a_base(const Unit& u) const { return gather ? A : A + (size_t)u.pm * 256 * K * esz; }
    __device__ __forceinline__ const char* b_base(const Unit& u) const { return Bt + (size_t)u.e * estride + (size_t)u.pn * 256 * K * esz; }
    __device__ __forceinline__ unsigned a_off(const Unit& u) const { return gather ? 0u : (unsigned)u.pm * 256u * (unsigned)(K * esz); }
    __device__ __forceinline__ unsigned b_off(const Unit& u) const { return (unsigned)u.e * (unsigned)estride + (unsigned)u.pn * 256u * (unsigned)(K * esz); }
    __device__ __forceinline__ void issue_rows(const Unit& u, LAS unsigned char* buf, int wid, int lane) const {
        const size_t li = (size_t)u.e * LSTRIDE + u.rbl * 256 + (wid & 3) * 64 + lane;
        if (wid < 4) __builtin_amdgcn_global_load_lds((const unsigned*)(list + li), (LAS unsigned*)(buf + wid * 256), 4, 0, 0);
        else __builtin_amdgcn_global_load_lds((const unsigned*)(listv + li), (LAS unsigned*)(buf + 1024 + (wid - 4) * 256), 4, 0, 0);
        if (wid == 0) __builtin_amdgcn_global_load_lds((const unsigned*)(bias + (size_t)u.e * bstride + u.pn * 256 + lane * 4), (LAS unsigned*)(buf + 2048), 16, 0, 0);
    }
    __device__ __forceinline__ void read_rows(const Unit& u, const LAS unsigned char* buf, int R0, unsigned (&off)[4]) const {
        const int cnt = (int)tab[u.e] - u.rbl * 256;
#pragma unroll
        for (int q = 0; q < 4; ++q) { const int j = R0 + 64 * q; const int v = ((const LAS int*)buf)[j]; const int tok = (j < cnt) ? (v >> 2) : 0; off[q] = (unsigned)tok * (unsigned)(K * esz); }
    }
};
struct EpiSwiglu2 { bf16_t* act; const float* bias; const float* rstd2; const LAS unsigned* tab;
    __device__ __forceinline__ void operator()(const f32x4 (&acc)[2][2][4][2], const Unit& u, int wr, int wc, int fr, int fq, const LAS unsigned char* idx) const {
        const int cnt = (int)tab[u.e] - u.rbl * 256, c0 = u.pn * 128 + wc * 32 + 8 * fq;
        const float* bp = bias + (size_t)u.e * 2 * DFF + 2 * c0; f32x4 bb[4];
#pragma unroll
        for (int i = 0; i < 4; ++i) bb[i] = *(const f32x4*)(bp + 4 * i);
#pragma unroll
        for (int ai = 0; ai < 2; ++ai)
#pragma unroll
            for (int m = 0; m < 4; ++m) { const int j = ai * 128 + wr * 64 + m * 16 + fr; const int v = ((const LAS int*)idx)[j]; const int tok = (j < cnt) ? (v >> 2) : 0; const float rs = rstd2[tok];
                float o[8];
#pragma unroll
                for (int n = 0; n < 2; ++n)
#pragma unroll
                    for (int k = 0; k < 4; ++k) { const int cc = 4 * n + k; const float bg = bb[cc >> 1][(cc & 1) * 2], bl = bb[cc >> 1][(cc & 1) * 2 + 1];
                        const float g = fminf(acc[ai][0][m][n][k] * rs + bg, 7.0f), l = fminf(fmaxf(acc[ai][1][m][n][k] * rs + bl, -7.0f), 7.0f);
                        o[cc] = g * __builtin_amdgcn_rcpf(1.0f + __builtin_amdgcn_exp2f(-1.702f * LOG2E * g)) * (l + 1.0f); }
                u32x4 w; w.x = cvt_pk_bf16(o[0], o[1]); w.y = cvt_pk_bf16(o[2], o[3]); w.z = cvt_pk_bf16(o[4], o[5]); w.w = cvt_pk_bf16(o[6], o[7]);
                *(u32x4*)(act + (size_t)(u.pm * 256 + j) * DFF + c0) = w; }
    }
};
struct EpiDown2 { bf16_t* ybuf; const float* bias; const float* gate; const LAS unsigned* tab;
    __device__ __forceinline__ void operator()(const f32x4 (&acc)[2][2][4][2], const Unit& u, int wr, int wc, int fr, int fq, const LAS unsigned char* idx) const {
        const int cnt = (int)tab[u.e] - u.rbl * 256, col0 = u.pn * 256 + wc * 32 + 8 * fq;
        const float* bp = bias + (size_t)u.e * DM + col0; f32x4 bb[2][2];
#pragma unroll
        for (int bj = 0; bj < 2; ++bj)
#pragma unroll
            for (int n = 0; n < 2; ++n) bb[bj][n] = *(const f32x4*)(bp + bj * 128 + 4 * n);
#pragma unroll
        for (int ai = 0; ai < 2; ++ai)
#pragma unroll
            for (int m = 0; m < 4; ++m) { const int j = ai * 128 + wr * 64 + m * 16 + fr;
                if (j < cnt) { const int tk = ((const LAS int*)idx)[j]; const float g = gate[tk]; bf16_t* rowp = ybuf + (size_t)tk * DM + col0;
#pragma unroll
                    for (int bj = 0; bj < 2; ++bj) { const f32x4 v0 = (acc[ai][bj][m][0] + bb[bj][0]) * g, v1 = (acc[ai][bj][m][1] + bb[bj][1]) * g;
                        u32x4 w; w.x = cvt_pk_bf16(v0.x, v0.y); w.y = cvt_pk_bf16(v0.z, v0.w); w.z = cvt_pk_bf16(v1.x, v1.y); w.w = cvt_pk_bf16(v1.z, v1.w);
                        *(u32x4*)(rowp + bj * 128) = w; } } }
    }
};
struct EpiSwiglu8 { unsigned char* act; const LAS unsigned* tab;
    __device__ __forceinline__ void operator()(const f32x4 (&acc)[2][2][4][2], const Unit& u, int wr, int wc, int fr, int fq, const LAS unsigned char* meta) const {
        const int cnt = (int)tab[u.e] - u.rbl * 256, c0 = u.pn * 128 + wc * 32 + 8 * fq;
        const LAS f32x4* bp = (const LAS f32x4*)(meta + 2048 + (64 * wc + 16 * fq) * 4); f32x4 bb[4];
#pragma unroll
        for (int i = 0; i < 4; ++i) bb[i] = bp[i];
#pragma unroll
        for (int ai = 0; ai < 2; ++ai)
#pragma unroll
            for (int m = 0; m < 4; ++m) { const int j = ai * 128 + wr * 64 + m * 16 + fr; const float rs = (j < cnt) ? ((const LAS float*)(meta + 1024))[j] * (1.0f / (X8SCALE * W8SCALE)) : 0.f;
                float o[8];
#pragma unroll
                for (int n = 0; n < 2; ++n)
#pragma unroll
                    for (int k = 0; k < 4; ++k) { const int cc = 4 * n + k; const float bg = bb[cc >> 1][(cc & 1) * 2], bl = bb[cc >> 1][(cc & 1) * 2 + 1];
                        const float g = fminf(acc[ai][0][m][n][k] * rs + bg, 7.0f), l = fminf(fmaxf(acc[ai][1][m][n][k] * rs + bl, -7.0f), 7.0f);
                        o[cc] = fminf(fmaxf(g * __builtin_amdgcn_rcpf(1.0f + __builtin_amdgcn_exp2f(-1.702f * LOG2E * g)) * (l + 1.0f) * A8SCALE, -448.0f), 448.0f); }
                u32x2 w; w.x = pk4_fp8(o[0], o[1], o[2], o[3]); w.y = pk4_fp8(o[4], o[5], o[6], o[7]);
                *(u32x2*)(act + (size_t)(u.pm * 256 + j) * DFF + c0) = w; }
    }
};
struct EpiDown8 { unsigned char* ybuf; const LAS unsigned* tab;
    __device__ __forceinline__ void operator()(const f32x4 (&acc)[2][2][4][2], const Unit& u, int wr, int wc, int fr, int fq, const LAS unsigned char* meta) const {
        const int cnt = (int)tab[u.e] - u.rbl * 256, col0 = u.pn * 256 + wc * 32 + 8 * fq; const float isc = Y8SCALE / (A8SCALE * W8SCALE);
        const LAS f32x4* bp = (const LAS f32x4*)(meta + 2048 + (32 * wc + 8 * fq) * 4);
        f32x4 bb[2][2];
#pragma unroll
        for (int bj = 0; bj < 2; ++bj) { bb[bj][0] = bp[bj * 32] * Y8SCALE; bb[bj][1] = bp[bj * 32 + 1] * Y8SCALE; }
#pragma unroll
        for (int ai = 0; ai < 2; ++ai)
#pragma unroll
            for (int m = 0; m < 4; ++m) { const int j = ai * 128 + wr * 64 + m * 16 + fr;
                if (j < cnt) { const int tk = ((const LAS int*)meta)[j]; const float g = ((const LAS float*)(meta + 1024))[j]; unsigned char* rowp = ybuf + (size_t)tk * DM + col0;
#pragma unroll
                    for (int bj = 0; bj < 2; ++bj) { const f32x4 v0 = (acc[ai][bj][m][0] * isc + bb[bj][0]) * g, v1 = (acc[ai][bj][m][1] * isc + bb[bj][1]) * g;
                        u32x2 w; w.x = pk4_fp8(clamp8(v0.x), clamp8(v0.y), clamp8(v0.z), clamp8(v0.w)); w.y = pk4_fp8(clamp8(v1.x), clamp8(v1.y), clamp8(v1.z), clamp8(v1.w));
                        *(u32x2*)(rowp + bj * 128) = w; } } }
    }
};
__device__ __forceinline__ void moe_tables(const unsigned* gcnt, LAS unsigned* tab, int tid) {
    if (tid < 64) { const unsigned c = tid < NE ? gcnt[tid] : 0u; const unsigned nb = (c + 255u) >> 8; unsigned inc = nb;
#pragma unroll
        for (int o = 1; o < 64; o <<= 1) { const unsigned t = __shfl_up(inc, o); if (tid >= o) inc += t; }
        if (tid < NE) { tab[tid] = c; tab[32 + tid] = inc - nb; } if (tid == NE) tab[32 + NE] = inc - nb; }
    __syncthreads();
}
__device__ __forceinline__ void p7_route(const Frame& F, const bf16_t* __restrict__ hb, const bf16_t* __restrict__ Wrt, const float* __restrict__ sq2, const float* __restrict__ br,
                                         unsigned* gcnt, int* __restrict__ list, float* __restrict__ listg, float* __restrict__ listr) {
    LAS unsigned* lcnt = (LAS unsigned*)(F.lds + RING_OFF); LAS unsigned* lbase = lcnt + 32;
    const int lane = F.lane, tcol = lane & 15, kq = lane >> 4;
    for (int round = blockIdx.x; round < MTOK / 128; round += F.G) {
        if (F.tid < 32) lcnt[F.tid] = 0u;
        __syncthreads();
        const int tok = round * 128 + F.wave * 16 + tcol;
        const bf16_t* xp = hb + (size_t)tok * DM + 8 * kq; const bf16_t* w0p = Wrt + (size_t)tcol * DM + 8 * kq; const bf16_t* w1p = w0p + 16 * DM;
        f32x4 a0 = {0.f, 0.f, 0.f, 0.f}, a1 = {0.f, 0.f, 0.f, 0.f};
#pragma unroll 8
        for (int ks = 0; ks < 32; ++ks) { const bf16x8 b = *(const bf16x8*)(xp + 32 * ks), w0 = *(const bf16x8*)(w0p + 32 * ks), w1 = *(const bf16x8*)(w1p + 32 * ks);
            a0 = __builtin_amdgcn_mfma_f32_16x16x32_bf16(w0, b, a0, 0, 0, 0); a1 = __builtin_amdgcn_mfma_f32_16x16x32_bf16(w1, b, a1, 0, 0, 0); }
        float s = 0.f;
#pragma unroll
        for (int t = 0; t < 4; ++t) { const f32x4 p = *(const f32x4*)(sq2 + ((size_t)t * MTOK + tok) * 4); s += (p.x + p.y) + (p.z + p.w); }
        const float rstd = 1.0f / sqrtf(s * (1.0f / DM) + EPS);
        float v[8]; int id[8];
#pragma unroll
        for (int r = 0; r < 4; ++r) { id[r] = 4 * kq + r; id[4 + r] = 16 + 4 * kq + r; v[r] = a0[r] * rstd + br[4 * kq + r]; v[4 + r] = a1[r] * rstd + br[16 + 4 * kq + r]; }
        float tv[4]; int ti[4];
#pragma unroll
        for (int r = 0; r < 4; ++r) { float bv = v[0]; int bi = id[0];
#pragma unroll
            for (int j = 1; j < 8; ++j) if (v[j] > bv) { bv = v[j]; bi = id[j]; }
#pragma unroll
            for (int o = 16; o < 64; o <<= 1) { const float ov = __shfl_xor(bv, o); const int oi = __shfl_xor(bi, o); if (ov > bv || (ov == bv && oi < bi)) { bv = ov; bi = oi; } }
            tv[r] = bv; ti[r] = bi;
#pragma unroll
            for (int j = 0; j < 8; ++j) if (id[j] == bi) v[j] = -3.0e38f; }
        const float e1 = __expf(tv[1] - tv[0]), e2 = __expf(tv[2] - tv[0]), e3 = __expf(tv[3] - tv[0]); const float inv = 1.0f / (1.0f + e1 + e2 + e3);
        unsigned lp[4];
        if (kq == 0) {
#pragma unroll
            for (int k = 0; k < 4; ++k) lp[k] = __hip_atomic_fetch_add(lcnt + ti[k], 1u, __ATOMIC_RELAXED, __HIP_MEMORY_SCOPE_WORKGROUP); }
        __syncthreads();
        if (F.tid < 32) { const unsigned c = lcnt[F.tid]; lbase[F.tid] = c ? __hip_atomic_fetch_add(gcnt + F.tid, c, __ATOMIC_RELAXED, __HIP_MEMORY_SCOPE_AGENT) : 0u; }
        __syncthreads();
        if (kq == 0) { const float gk[4] = {inv, e1 * inv, e2 * inv, e3 * inv};
#pragma unroll
            for (int k = 0; k < 4; ++k) { const size_t pos = (size_t)ti[k] * LSTRIDE + lbase[ti[k]] + lp[k]; list[pos] = tok * 4 + k; listg[pos] = gk[k]; listr[pos] = rstd; } }
        __syncthreads();
    }
}
__device__ __forceinline__ void p10_combine(const Frame& F, float* __restrict__ out, const bf16_t* __restrict__ x2b, const unsigned char* __restrict__ ybuf) {
    const size_t n8 = (size_t)MTOK * DM / 8;
    for (size_t i = (size_t)blockIdx.x * (NWAVES * 64) + F.tid; i < n8; i += (size_t)F.G * (NWAVES * 64)) {
        const size_t tok = i / (DM / 8), c8 = i % (DM / 8);
        const u32x4 xb = *(const u32x4*)(x2b + i * 8);
        f32x4 s0 = {0.f, 0.f, 0.f, 0.f}, s1 = {0.f, 0.f, 0.f, 0.f};
#pragma unroll
        for (int k = 0; k < 4; ++k) { const u32x2 y = *(const u32x2*)(ybuf + (tok * 4 + k) * DM + c8 * 8);
            const f32x2 a = __builtin_amdgcn_cvt_pk_f32_fp8((int)y.x, false), b = __builtin_amdgcn_cvt_pk_f32_fp8((int)y.x, true), c = __builtin_amdgcn_cvt_pk_f32_fp8((int)y.y, false), d = __builtin_amdgcn_cvt_pk_f32_fp8((int)y.y, true);
            s0.x += a.x; s0.y += a.y; s0.z += b.x; s0.w += b.y; s1.x += c.x; s1.y += c.y; s1.z += d.x; s1.w += d.y; }
        const f32x4 v0 = (f32x4){bflo(xb.x), bfhi(xb.x), bflo(xb.y), bfhi(xb.y)} + s0 * (1.0f / Y8SCALE), v1 = (f32x4){bflo(xb.z), bfhi(xb.z), bflo(xb.w), bfhi(xb.w)} + s1 * (1.0f / Y8SCALE);
        *(f32x4*)(out + i * 8) = v0; *(f32x4*)(out + i * 8 + 4) = v1;
    }
}
typedef short v4i16_t __attribute__((ext_vector_type(4)));
__device__ __forceinline__ v4i16_t lds_tr16(const LAS unsigned char* p) { return __builtin_amdgcn_ds_read_tr16_b64_v4i16((LAS v4i16_t*)p); }
__device__ __forceinline__ bf16x8 cat8(v4i16_t a, v4i16_t b) { return (bf16x8){a[0], a[1], a[2], a[3], b[0], b[1], b[2], b[3]}; }
__device__ __forceinline__ int koff16(int rho) { return (rho & 3) + 8 * (rho >> 2); }

__device__ __forceinline__ void kv_knorm_row(bf16_t* __restrict__ kvmem, const float* __restrict__ xk_g, int row, int lane) {
    bf16_t* kp = kvmem + (size_t)row * (2 * DX) + 8 * lane; const u32x4 kv = *(const u32x4*)kp;
    float v[8] = {bflo(kv.x), bfhi(kv.x), bflo(kv.y), bfhi(kv.y), bflo(kv.z), bfhi(kv.z), bflo(kv.w), bfhi(kv.w)}; float ss = 0.f;
#pragma unroll
    for (int j = 0; j < 8; ++j) ss += v[j] * v[j];
    ss += __shfl_xor(ss, 1); ss += __shfl_xor(ss, 2); ss += __shfl_xor(ss, 4); ss += __shfl_xor(ss, 8);
    const float rstd = 1.0f / sqrtf(ss * (1.0f / XHD) + EPS); const float* gp = xk_g + ((8 * lane) & (XHD - 1)); const f32x4 g0 = *(const f32x4*)gp, g1 = *(const f32x4*)(gp + 4);
    u32x4 w; w.x = cvt_pk_bf16(v[0] * rstd * g0.x, v[1] * rstd * g0.y); w.y = cvt_pk_bf16(v[2] * rstd * g0.z, v[3] * rstd * g0.w); w.z = cvt_pk_bf16(v[4] * rstd * g1.x, v[5] * rstd * g1.y); w.w = cvt_pk_bf16(v[6] * rstd * g1.z, v[7] * rstd * g1.w);
    *(u32x4*)kp = w;
}
__device__ __forceinline__ void p2_attn(const Frame& F, const bf16_t* __restrict__ proj, const float* __restrict__ rel_bias, const float* __restrict__ conv_w,
                                        const float* __restrict__ ga, const float* __restrict__ gb, bf16_t* __restrict__ yb) {
    LAS float* tbl = (LAS float*)(F.lds + TBL_OFF);
    for (int i = F.tid; i < 8 * 384; i += NWAVES * 64) { const int h = i / 384, j = i % 384; int rel = 319 - j; rel = rel < -MAXREL ? -MAXREL : (rel > MAXREL ? MAXREL : rel); tbl[i] = rel_bias[h * NREL + rel + MAXREL] * LOG2E; }
    __syncthreads();
    int lane_ = F.lane; asm volatile("" : "+v"(lane_));
    const int lane = lane_, h = F.wave, r = lane & 31, hi = lane >> 5;
    LAS unsigned char* wbuf = F.lds + RING_OFF + h * 16384;
    LAS float* ssq = (LAS float*)(F.lds + SSQ_OFF);
    const LAS float* tblh = tbl + h * 384;
    const float far_bias = rel_bias[h * NREL + 2 * MAXREL] * LOG2E;
    unsigned kso[2], vso0;
#pragma unroll
    for (int i = 0; i < 2; ++i) { const int key = 8 * i + (lane >> 3), cp = lane & 7; kso[i] = (unsigned)(key * NPROJ + (cp ^ ((key >> 1) & 7)) * 8) * 2u; }
    { const int key = lane >> 3, cp = lane & 7; vso0 = (unsigned)(key * NPROJ + DATT + (cp ^ (((key >> 1) & 1) << 2)) * 8) * 2u; }
    int kaddr[4];
#pragma unroll
    for (int s = 0; s < 4; ++s) kaddr[s] = r * 128 + (((2 * s + hi) ^ ((r >> 1) & 7)) * 16);
    const int G1 = (lane >> 4) & 1, tq = (lane & 15) >> 2, tp = lane & 3;
    int vaddr[2];
#pragma unroll
    for (int db = 0; db < 2; ++db) vaddr[db] = (4 * hi + tq) * 128 + (((4 * db + 2 * G1 + (tp >> 1)) ^ (((tq >> 1) & 1) << 2)) * 16) + (tp & 1) * 8;
#define P2_DMA_K(T_, slot_) do { const char* kp_ = (const char*)(proj + ((size_t)b * SEQ + 32 * (T_)) * NPROJ + DATT + h * 64); \
        _Pragma("unroll") for (int i_ = 0; i_ < 4; ++i_) __builtin_amdgcn_global_load_lds((const unsigned*)(kp_ + (size_t)(i_ >> 1) * (16 * NPROJ * 2) + kso[i_ & 1]), (LAS unsigned*)(wbuf + (slot_) * 4096 + i_ * 1024), 16, 0, 0); } while (0)
#define P2_DMA_V(T_, slot_) do { const char* kp_ = (const char*)(proj + ((size_t)b * SEQ + 32 * (T_)) * NPROJ + DATT + h * 64); \
        _Pragma("unroll") for (int i_ = 0; i_ < 4; ++i_) __builtin_amdgcn_global_load_lds((const unsigned*)(kp_ + (size_t)i_ * (8 * NPROJ * 2) + vso0), (LAS unsigned*)(wbuf + 8192 + (slot_) * 4096 + i_ * 1024), 16, 0, 0); } while (0)
#define P2_QK(dst, ks_) do { const LAS unsigned char* Kp_ = wbuf + (ks_) * 4096; \
        _Pragma("unroll") for (int qb_ = 0; qb_ < 2; ++qb_) _Pragma("unroll") for (int i_ = 0; i_ < 16; ++i_) dst[qb_][i_] = 0.f; \
        _Pragma("unroll") for (int s_ = 0; s_ < 4; ++s_) { const bf16x8 kf_ = *(const LAS bf16x8*)(Kp_ + kaddr[s_]); \
            dst[0] = __builtin_amdgcn_mfma_f32_32x32x16_bf16(kf_, qf[0][s_], dst[0], 0, 0, 0); dst[1] = __builtin_amdgcn_mfma_f32_32x32x16_bf16(kf_, qf[1][s_], dst[1], 0, 0, 0); } } while (0)
    const int upw = (512 + F.G - 1) / F.G;
    for (int ui = 0; ui < upw; ++ui) {
        const int unit = F.vcu * upw + ui; if (unit >= BATCH * (SEQ / CHUNK)) break;
        const int b = unit / (SEQ / CHUNK), c = unit % (SEQ / CHUNK); const size_t row0 = (size_t)b * SEQ + c * CHUNK;
        const int T0 = 2 * (c - LEFT < 0 ? 0 : c - LEFT), nT = 2 * c + 2 - T0;
        int oz = 0; asm volatile("" : "+s"(oz));
        P2_DMA_K(T0, 0); P2_DMA_V(T0, 0); P2_DMA_K(T0 + 1, 1);
        bf16x8 qf[2][4];
#pragma unroll
        for (int qb = 0; qb < 2; ++qb)
#pragma unroll
            for (int s = 0; s < 4; ++s) qf[qb][s] = *(const bf16x8*)(proj + (row0 + 32 * qb + r) * NPROJ + h * 64 + 16 * s + 8 * hi);
        f32x16 o[2][2];
#pragma unroll
        for (int db = 0; db < 2; ++db)
#pragma unroll
            for (int qb = 0; qb < 2; ++qb)
#pragma unroll
                for (int i = 0; i < 16; ++i) o[db][qb][i] = 0.f;
        float mrun[2] = {-1e30f, -1e30f}, lrun[2] = {0.f, 0.f};
        f32x16 scur[2];
        asm volatile("s_waitcnt vmcnt(0)" ::: "memory");
        P2_QK(scur, 0);
        for (int t = 0; t < nT; ++t) {
            const int T = T0 + t;
            if (t + 2 < nT) { P2_DMA_K(T + 2, t & 1); P2_DMA_V(T + 1, (t + 1) & 1); }
            else if (t + 1 < nT) { P2_DMA_V(T + 1, (t + 1) & 1); }
            if ((T >> 1) >= c - 4) {
#pragma unroll
                for (int qb = 0; qb < 2; ++qb) { const LAS float* tp0 = tblh + (319 - 64 * c - 32 * qb - r + 32 * T + 4 * hi);
#pragma unroll
                    for (int i = 0; i < 16; ++i) scur[qb][i] += tp0[koff16(i)];
                    __builtin_amdgcn_sched_barrier(0); }
            } else {
#pragma unroll
                for (int qb = 0; qb < 2; ++qb)
#pragma unroll
                    for (int i = 0; i < 16; ++i) scur[qb][i] += far_bias;
            }
            float mx[2];
#pragma unroll
            for (int qb = 0; qb < 2; ++qb) { float m_ = scur[qb][0];
#pragma unroll
                for (int i = 1; i < 16; ++i) m_ = fmaxf(m_, scur[qb][i]);
                mx[qb] = fmaxf(m_, __shfl_xor(m_, 32)); }
            if (__any((mx[0] - mrun[0] > 8.0f) || (mx[1] - mrun[1] > 8.0f))) {
#pragma unroll
                for (int qb = 0; qb < 2; ++qb) { const float mn = fmaxf(mrun[qb], mx[qb]), f = __builtin_amdgcn_exp2f(mrun[qb] - mn); mrun[qb] = mn; lrun[qb] *= f;
#pragma unroll
                    for (int i = 0; i < 16; ++i) { o[0][qb][i] *= f; o[1][qb][i] *= f; } }
            }
            bf16x8 pf[2][2];
#pragma unroll
            for (int qb = 0; qb < 2; ++qb) { float ls = 0.f; float p[16];
#pragma unroll
                for (int i = 0; i < 16; ++i) { p[i] = __builtin_amdgcn_exp2f(scur[qb][i] - mrun[qb]); ls += p[i]; }
                lrun[qb] += ls;
#pragma unroll
                for (int ks = 0; ks < 2; ++ks) { u32x4 w; w.x = cvt_pk_bf16(p[8 * ks + 0], p[8 * ks + 1]); w.y = cvt_pk_bf16(p[8 * ks + 2], p[8 * ks + 3]); w.z = cvt_pk_bf16(p[8 * ks + 4], p[8 * ks + 5]); w.w = cvt_pk_bf16(p[8 * ks + 6], p[8 * ks + 7]);
                    pf[qb][ks] = __builtin_bit_cast(bf16x8, w); } }
            __builtin_amdgcn_sched_barrier(0);
            if (t + 2 < nT) asm volatile("s_waitcnt vmcnt(8)" ::: "memory"); else if (t + 1 < nT) asm volatile("s_waitcnt vmcnt(4)" ::: "memory"); else asm volatile("s_waitcnt vmcnt(0)" ::: "memory");
            if (t + 1 < nT) P2_QK(scur, (t + 1) & 1);
            { const LAS unsigned char* Vp = wbuf + 8192 + (t & 1) * 4096;
#pragma unroll
              for (int db = 0; db < 2; ++db)
#pragma unroll
                  for (int ks = 0; ks < 2; ++ks) {
                      const v4i16_t t0 = lds_tr16(Vp + vaddr[db] + (16 * ks) * 128), t1 = lds_tr16(Vp + vaddr[db] + (16 * ks + 8) * 128);
                      const bf16x8 vf = cat8(t0, t1);
                      o[db][0] = __builtin_amdgcn_mfma_f32_32x32x16_bf16(vf, pf[0][ks], o[db][0], 0, 0, 0); o[db][1] = __builtin_amdgcn_mfma_f32_32x32x16_bf16(vf, pf[1][ks], o[db][1], 0, 0, 0);
                  } }
        }
        int oz2 = 0; asm volatile("" : "+v"(oz2));
        const int r2 = r + oz2, lane2 = lane + oz2;

        LAS float* sq = ssq + (ui & 1) * 512;
#pragma unroll
        for (int qb = 0; qb < 2; ++qb) { const float lt = lrun[qb] + __shfl_xor(lrun[qb], 32); const float inv = 1.0f / lt; float ss = 0.f;
#pragma unroll
            for (int db = 0; db < 2; ++db)
#pragma unroll
                for (int i = 0; i < 16; ++i) { o[db][qb][i] *= inv; ss += o[db][qb][i] * o[db][qb][i]; }
            ss += __shfl_xor(ss, 32);
            if (hi == 0) sq[h * 64 + 32 * qb + r] = ss; }
        __syncthreads();
#pragma unroll
        for (int qb = 0; qb < 2; ++qb) { float tot = 0.f;
#pragma unroll
            for (int hh = 0; hh < 8; ++hh) tot += sq[hh * 64 + 32 * qb + r];
            const float rstd = 1.0f / sqrtf(tot * (1.0f / DATT) + EPS);
            bf16_t* orow = yb + (row0 + 32 * qb + r2) * DM + h * 64;
#pragma unroll
            for (int db = 0; db < 2; ++db)
#pragma unroll
                for (int g4 = 0; g4 < 4; ++g4) { const int d0 = 32 * db + 8 * g4 + 4 * hi; const f32x4 gg = *(const f32x4*)(ga + oz + h * 64 + d0);
                    u32x2 w; w.x = cvt_pk_bf16(o[db][qb][4 * g4 + 0] * rstd * gg.x, o[db][qb][4 * g4 + 1] * rstd * gg.y); w.y = cvt_pk_bf16(o[db][qb][4 * g4 + 2] * rstd * gg.z, o[db][qb][4 * g4 + 3] * rstd * gg.w);
                    *(u32x2*)(orow + d0) = w; } }
        { const int ch0 = 8 * lane2; float cw[3][8], gbv[8];
#pragma unroll
          for (int t = 0; t < 3; ++t) { const f32x4 a = *(const f32x4*)(conv_w + oz + t * DCONV + ch0), bq = *(const f32x4*)(conv_w + oz + t * DCONV + ch0 + 4);
              cw[t][0] = a.x; cw[t][1] = a.y; cw[t][2] = a.z; cw[t][3] = a.w; cw[t][4] = bq.x; cw[t][5] = bq.y; cw[t][6] = bq.z; cw[t][7] = bq.w; }
          { const f32x4 a = *(const f32x4*)(gb + oz + ch0), bq = *(const f32x4*)(gb + oz + ch0 + 4); gbv[0] = a.x; gbv[1] = a.y; gbv[2] = a.z; gbv[3] = a.w; gbv[4] = bq.x; gbv[5] = bq.y; gbv[6] = bq.z; gbv[7] = bq.w; }
          const size_t tfirst = row0 + 8 * h; const int sfirst = c * CHUNK + 8 * h;
          float u1[8], u2[8];
#pragma unroll
          for (int j = 0; j < 8; ++j) { u1[j] = 0.f; u2[j] = 0.f; }
          if (sfirst >= 1) { const u32x4 cg = *(const u32x4*)(proj + (tfirst - 1) * NPROJ + 3 * DATT + DCONV + ch0), xv = *(const u32x4*)(proj + (tfirst - 1) * NPROJ + 3 * DATT + 2 * DCONV + ch0);
              u1[0] = bflo(cg.x) * bflo(xv.x); u1[1] = bfhi(cg.x) * bfhi(xv.x); u1[2] = bflo(cg.y) * bflo(xv.y); u1[3] = bfhi(cg.y) * bfhi(xv.y); u1[4] = bflo(cg.z) * bflo(xv.z); u1[5] = bfhi(cg.z) * bfhi(xv.z); u1[6] = bflo(cg.w) * bflo(xv.w); u1[7] = bfhi(cg.w) * bfhi(xv.w); }
          if (sfirst >= 2) { const u32x4 cg = *(const u32x4*)(proj + (tfirst - 2) * NPROJ + 3 * DATT + DCONV + ch0), xv = *(const u32x4*)(proj + (tfirst - 2) * NPROJ + 3 * DATT + 2 * DCONV + ch0);
              u2[0] = bflo(cg.x) * bflo(xv.x); u2[1] = bfhi(cg.x) * bfhi(xv.x); u2[2] = bflo(cg.y) * bflo(xv.y); u2[3] = bfhi(cg.y) * bfhi(xv.y); u2[4] = bflo(cg.z) * bflo(xv.z); u2[5] = bfhi(cg.z) * bfhi(xv.z); u2[6] = bflo(cg.w) * bflo(xv.w); u2[7] = bfhi(cg.w) * bfhi(xv.w); }
#pragma unroll
          for (int i = 0; i < 8; ++i) { const bf16_t* pr = proj + (tfirst + i) * NPROJ + 3 * DATT + ch0;
              const u32x4 bg = *(const u32x4*)pr, cg = *(const u32x4*)(pr + DCONV), xv = *(const u32x4*)(pr + 2 * DCONV);
              float u0[8], bgf[8], y[8];
              u0[0] = bflo(cg.x) * bflo(xv.x); u0[1] = bfhi(cg.x) * bfhi(xv.x); u0[2] = bflo(cg.y) * bflo(xv.y); u0[3] = bfhi(cg.y) * bfhi(xv.y); u0[4] = bflo(cg.z) * bflo(xv.z); u0[5] = bfhi(cg.z) * bfhi(xv.z); u0[6] = bflo(cg.w) * bflo(xv.w); u0[7] = bfhi(cg.w) * bfhi(xv.w);
              bgf[0] = bflo(bg.x); bgf[1] = bfhi(bg.x); bgf[2] = bflo(bg.y); bgf[3] = bfhi(bg.y); bgf[4] = bflo(bg.z); bgf[5] = bfhi(bg.z); bgf[6] = bflo(bg.w); bgf[7] = bfhi(bg.w);
              float ss = 0.f;
#pragma unroll
              for (int j = 0; j < 8; ++j) { y[j] = bgf[j] * (cw[0][j] * u2[j] + cw[1][j] * u1[j] + cw[2][j] * u0[j]); ss += y[j] * y[j]; u2[j] = u1[j]; u1[j] = u0[j]; }
              const float rstd = 1.0f / sqrtf(wave_sum(ss) * (1.0f / DCONV) + EPS);
              u32x4 w; w.x = cvt_pk_bf16(y[0] * rstd * gbv[0], y[1] * rstd * gbv[1]); w.y = cvt_pk_bf16(y[2] * rstd * gbv[2], y[3] * rstd * gbv[3]); w.z = cvt_pk_bf16(y[4] * rstd * gbv[4], y[5] * rstd * gbv[5]); w.w = cvt_pk_bf16(y[6] * rstd * gbv[6], y[7] * rstd * gbv[7]);
              *(u32x4*)(yb + (tfirst + i) * DM + DATT + ch0) = w; } }
    }
#undef P2_DMA_K
#undef P2_DMA_V
#undef P2_QK
    __syncthreads();
}
__device__ __forceinline__ void p5_xattn(const Frame& F, const bf16_t* __restrict__ qx, const bf16_t* __restrict__ kvmem, const float* __restrict__ xq_g, bf16_t* __restrict__ ox) {
    int lane_ = F.lane; asm volatile("" : "+v"(lane_));
    const int lane = lane_, r = lane & 31, hi = lane >> 5;
    LAS unsigned char* Kl = F.lds + RING_OFF; LAS unsigned char* Vl = Kl + 256 * 272;
    const int G1 = (lane >> 4) & 1, tq = (lane & 15) >> 2, tp = lane & 3;
    const float XS = 0.08838834764831845f * LOG2E;
    const int upw = (512 + F.G - 1) / F.G; int cur_bh = -1;
    for (int ui = 0; ui < upw; ++ui) {
        const int unit = F.vcu * upw + ui; if (unit >= BATCH * XH * 8) break;
        const int bh = unit >> 3, qt = unit & 7, b = bh >> 2, h = bh & 3;
        if (bh != cur_bh) {
            __syncthreads();
            const bf16_t* src = kvmem + (size_t)b * NMEM * (2 * DX) + h * XHD;
#pragma unroll
            for (int i = 0; i < 8; ++i) { const int ci = F.tid + 512 * i, key = ci >> 4, ch = ci & 15;
                const u32x4 kv = *(const u32x4*)(src + (size_t)key * (2 * DX) + ch * 8), vv = *(const u32x4*)(src + (size_t)key * (2 * DX) + DX + ch * 8);
                *(LAS u32x4*)(Kl + key * 272 + ch * 16) = kv; *(LAS u32x4*)(Vl + key * 256 + ((ch ^ ((key & 3) << 2)) * 16)) = vv; }
            __syncthreads();
            cur_bh = bh;
        }
        const size_t qrow = (size_t)b * SEQ + qt * 256 + F.wave * 32 + r;
        bf16x8 qf[8];
        { u32x4 raw[8]; float ss = 0.f;
#pragma unroll
          for (int s = 0; s < 8; ++s) { raw[s] = *(const u32x4*)(qx + qrow * DX + h * XHD + 16 * s + 8 * hi);
              const float a0 = bflo(raw[s].x), a1 = bfhi(raw[s].x), a2 = bflo(raw[s].y), a3 = bfhi(raw[s].y), a4 = bflo(raw[s].z), a5 = bfhi(raw[s].z), a6 = bflo(raw[s].w), a7 = bfhi(raw[s].w);
              ss += (a0 * a0 + a1 * a1) + (a2 * a2 + a3 * a3) + (a4 * a4 + a5 * a5) + (a6 * a6 + a7 * a7); }
          ss += __shfl_xor(ss, 32);
          const float rs = XS / sqrtf(ss * (1.0f / XHD) + EPS);
#pragma unroll
          for (int s = 0; s < 8; ++s) { const f32x4 g0 = *(const f32x4*)(xq_g + 16 * s + 8 * hi), g1 = *(const f32x4*)(xq_g + 16 * s + 8 * hi + 4);
              u32x4 w; w.x = cvt_pk_bf16(bflo(raw[s].x) * rs * g0.x, bfhi(raw[s].x) * rs * g0.y); w.y = cvt_pk_bf16(bflo(raw[s].y) * rs * g0.z, bfhi(raw[s].y) * rs * g0.w);
              w.z = cvt_pk_bf16(bflo(raw[s].z) * rs * g1.x, bfhi(raw[s].z) * rs * g1.y); w.w = cvt_pk_bf16(bflo(raw[s].w) * rs * g1.z, bfhi(raw[s].w) * rs * g1.w);
              qf[s] = __builtin_bit_cast(bf16x8, w); } }
        f32x16 o[4];
#pragma unroll
        for (int db = 0; db < 4; ++db)
#pragma unroll
            for (int i = 0; i < 16; ++i) o[db][i] = 0.f;
        float mrun = -1e30f, lrun = 0.f;
        const LAS unsigned char* kbase = Kl + r * 272 + hi * 16;
        const LAS unsigned char* vbase[4];
#pragma unroll
        for (int db = 0; db < 4; ++db) vbase[db] = Vl + (4 * hi + tq) * 256 + ((4 * (db ^ tq) + 2 * G1 + (tp >> 1)) * 16) + (tp & 1) * 8;
#pragma unroll 1
        for (int t = 0; t < 4; ++t) {
            f32x16 sacc[2];
#pragma unroll
            for (int kb = 0; kb < 2; ++kb) {
#pragma unroll
                for (int i = 0; i < 16; ++i) sacc[kb][i] = 0.f;
#pragma unroll
                for (int s = 0; s < 8; ++s) { const bf16x8 kf = *(const LAS bf16x8*)(kbase + (64 * t + 32 * kb) * 272 + 32 * s);
                    sacc[kb] = __builtin_amdgcn_mfma_f32_32x32x16_bf16(kf, qf[s], sacc[kb], 0, 0, 0); } }
            float mx = sacc[0][0];
#pragma unroll
            for (int i = 1; i < 16; ++i) mx = fmaxf(mx, sacc[0][i]);
#pragma unroll
            for (int i = 0; i < 16; ++i) mx = fmaxf(mx, sacc[1][i]);
            mx = fmaxf(mx, __shfl_xor(mx, 32));
            const float mn = fmaxf(mrun, mx), f = __builtin_amdgcn_exp2f(mrun - mn); mrun = mn;
            float ls = 0.f; bf16x8 pf[2][2];
#pragma unroll
            for (int kb = 0; kb < 2; ++kb) { float p[16];
#pragma unroll
                for (int i = 0; i < 16; ++i) { p[i] = __builtin_amdgcn_exp2f(sacc[kb][i] - mn); ls += p[i]; }
#pragma unroll
                for (int ks = 0; ks < 2; ++ks) { u32x4 w; w.x = cvt_pk_bf16(p[8 * ks + 0], p[8 * ks + 1]); w.y = cvt_pk_bf16(p[8 * ks + 2], p[8 * ks + 3]); w.z = cvt_pk_bf16(p[8 * ks + 4], p[8 * ks + 5]); w.w = cvt_pk_bf16(p[8 * ks + 6], p[8 * ks + 7]);
                    pf[kb][ks] = __builtin_bit_cast(bf16x8, w); } }
            lrun = lrun * f + ls;
#pragma unroll
            for (int db = 0; db < 4; ++db)
#pragma unroll
                for (int i = 0; i < 16; ++i) o[db][i] *= f;
#pragma unroll
            for (int db = 0; db < 4; ++db)
#pragma unroll
                for (int kb = 0; kb < 2; ++kb)
#pragma unroll
                    for (int ks = 0; ks < 2; ++ks) { const int ko = (64 * t + 32 * kb + 16 * ks) * 256;
                        const v4i16_t t0 = lds_tr16(vbase[db] + ko), t1 = lds_tr16(vbase[db] + ko + 8 * 256);
                        o[db] = __builtin_amdgcn_mfma_f32_32x32x16_bf16(cat8(t0, t1), pf[kb][ks], o[db], 0, 0, 0); }
        }
        const float lt = lrun + __shfl_xor(lrun, 32); const float inv = 1.0f / lt;
        bf16_t* orow = ox + qrow * DX + h * XHD;
#pragma unroll
        for (int db = 0; db < 4; ++db)
#pragma unroll
            for (int g4 = 0; g4 < 4; ++g4) { const int d0 = 32 * db + 8 * g4 + 4 * hi;
                u32x2 w; w.x = cvt_pk_bf16(o[db][4 * g4 + 0] * inv, o[db][4 * g4 + 1] * inv); w.y = cvt_pk_bf16(o[db][4 * g4 + 2] * inv, o[db][4 * g4 + 3] * inv);
                *(u32x2*)(orow + d0) = w; }
    }
    __syncthreads();
}

#ifndef QSCALE_V
#define QSCALE_V (0.125f * LOG2E)
#endif
__global__ void __launch_bounds__(NWAVES * 64, 2) mk_fwd(Args args) {
    extern __shared__ __attribute__((aligned(16))) unsigned char lds_raw[];
    Frame F; F.lds = (LAS unsigned char*)lds_raw; F.tid = threadIdx.x; F.lane = F.tid & 63; F.wave = __builtin_amdgcn_readfirstlane(F.tid >> 6); F.G = gridDim.x;
    { const int bx = blockIdx.x; F.vcu = (F.G % 8 == 0) ? (bx % 8) * (F.G / 8) + bx / 8 : bx; }
    unsigned char* ws = args.ws; unsigned* ctl = (unsigned*)(ws + WS_CTL);
    for (int u = F.tid; u < (LDS_BYTES - LDSCTL_OFF) / 4; u += NWAVES * 64) ((LAS unsigned*)(F.lds + LDSCTL_OFF))[u] = 0u;
    __syncthreads();
    volatile LAS unsigned* MISC = (volatile LAS unsigned*)(F.lds + MISC_OFF);
    XcdBarrier bar = xcd_barrier_post(ctl + CW_BAR + args.li * XCD_BAR_WORDS, MISC + 8);
    const int lo = args.ph_lo, hi = args.ph_hi;
#define IN(k) (lo <= (k) && (k) < hi)
#define BOTH(k) (IN(k) && IN((k) + 1))
    bf16_t *Win = (bf16_t*)(ws + WS_WIN), *Wxkv = (bf16_t*)(ws + WS_WXKV), *Wout = (bf16_t*)(ws + WS_WOUT), *Wxq = (bf16_t*)(ws + WS_WXQ), *Wxo = (bf16_t*)(ws + WS_WXO);
    bf16_t *yb = (bf16_t*)(ws + WS_YB), *qx = (bf16_t*)(ws + WS_QX), *ox = (bf16_t*)(ws + WS_OX);
    float *sq1 = (float*)(ws + WS_SQ1), *sq2 = (float*)(ws + WS_SQ2), *listr = (float*)(ws + WS_LISTR), *listg = (float*)(ws + WS_LISTG);
    bf16_t *Wrt = (bf16_t*)(ws + WS_WRT), *Wgu = (bf16_t*)(ws + WS_WGU), *Wdn = (bf16_t*)(ws + WS_WDN), *act = (bf16_t*)(ws + WS_ACT), *ybuf = (bf16_t*)(ws + WS_YBUF);
    unsigned char *Wgu8 = (unsigned char*)(ws + WS_WGU), *Wdn8 = (unsigned char*)(ws + WS_WDN), *x2f8 = (unsigned char*)(ws + WS_QX), *act8 = (unsigned char*)(ws + WS_ACT);
    int* list = (int*)(ws + WS_LIST); LAS unsigned* mtab = (LAS unsigned*)(F.lds + MOE_OFF);
    bf16_t *hb = (bf16_t*)(ws + WS_HB), *hmb = (bf16_t*)(ws + WS_HMB), *proj = (bf16_t*)(ws + WS_PROJ), *kvmem = (bf16_t*)(ws + WS_KVMEM);
    const int gw = F.vcu * NWAVES + F.wave, NGW = F.G * NWAVES;

    if (IN(0)) {
        LAS float* scr = (LAS float*)(F.lds + RING_OFF + F.wave * 17408);
        constexpr int IT_IN = (DM / 64) * (NPROJ / 64), IT_XKV = (DM / 64) * (2 * DX / 64), IT_OUT = (DM / 64) * (DM / 64), IT_XQ = (DM / 64) * (DX / 64), IT_XO = (DX / 64) * (DM / 64), IT_RT = DM / 64,
                      GU_PER_E = (DM / 64) * (2 * DFF / 64), DN_PER_E = (DFF / 64) * (DM / 64), IT_GU = NE * GU_PER_E, IT_DN = NE * DN_PER_E;
        {
            auto decode = [&](int r) -> F8Item { F8Item I;
                if (r < IT_GU) { const int e = r / GU_PER_E, rr = r % GU_PER_E, kb = rr / (2 * DFF / 64), nb = rr % (2 * DFF / 64), c0 = 32 * nb, pn = c0 >> 7;
                    I.W = args.in[I_W_GU] + (size_t)e * DM * 2 * DFF; I.WT = Wgu8 + (size_t)e * 2 * DFF * DM; I.g = args.in[I_NORM_FFN_G]; I.ldw = 2 * DFF; I.k0 = 64 * kb; I.n0 = 64 * nb; I.drow0 = 256 * pn + (c0 & 127); I.mode = 2; }
                else { r -= IT_GU; const int e = r / DN_PER_E, rr = r % DN_PER_E, kb = rr / (DM / 64), nb = rr % (DM / 64);
                    I.W = args.in[I_W_DN] + (size_t)e * DFF * DM; I.WT = Wdn8 + (size_t)e * DM * DFF; I.g = nullptr; I.ldw = DM; I.k0 = 64 * kb; I.n0 = 64 * nb; I.drow0 = 64 * nb; I.mode = 0; }
                return I; };
            int it = gw; F8Item A{}, B{}; f32x4 va[16], vb[16];
            if (it < IT_GU + IT_DN) { A = decode(it); p0_f8_load(A, va, F.lane); }
            while (it < IT_GU + IT_DN) { const int nit = it + NGW;
                if (nit < IT_GU + IT_DN) { B = decode(nit); p0_f8_load(B, vb, F.lane); }
                p0_f8_store(A, va, DM, W8SCALE, scr, F.lane);
                A = B; it = nit;
#pragma unroll
                for (int i = 0; i < 16; ++i) va[i] = vb[i]; }
        }
        for (int it = gw; it < IT_IN + IT_XKV + IT_OUT + IT_XQ + IT_XO + IT_RT; it += NGW) {
            int r = it;
            if (r < IT_IN) { const int kb = r / (NPROJ / 64), nb = r % (NPROJ / 64); const int pn = nb >> 2, wc = nb & 3;
                p0_transpose64<1>(args.in[I_W_IN], NPROJ, DM, Win, 64 * kb, 64 * nb, 256 * pn + 32 * wc, nullptr, scr, F.lane); continue; }
            r -= IT_IN;
            if (r < IT_XKV) { const int kb = r / (2 * DX / 64), nb = r % (2 * DX / 64);
                p0_transpose64<0>(args.in[I_W_XKV], 2 * DX, DM, Wxkv, 64 * kb, 64 * nb, 64 * nb, nullptr, scr, F.lane); continue; }
            r -= IT_XKV;
            if (r < IT_OUT) { const int kb = r / (DM / 64), nb = r % (DM / 64);
                p0_transpose64<0>(args.in[I_W_OUT], DM, DM, Wout, 64 * kb, 64 * nb, 64 * nb, nullptr, scr, F.lane); continue; }
            r -= IT_OUT;
            if (r < IT_XQ) { const int kb = r / (DX / 64), nb = r % (DX / 64);
                p0_transpose64<0>(args.in[I_W_XQ], DX, DM, Wxq, 64 * kb, 64 * nb, 64 * nb, args.in[I_NORM_X_G], scr, F.lane); continue; }
            r -= IT_XQ;
            if (r < IT_XO) { const int kb = r / (DM / 64), nb = r % (DM / 64);
                p0_transpose64<0>(args.in[I_W_XO], DM, DX, Wxo, 64 * kb, 64 * nb, 64 * nb, nullptr, scr, F.lane); continue; }
            r -= IT_XO;
            p0_transpose_item(args.in[I_W_ROUTER], NE, DM, Wrt, 64 * r, 0, 1, 0, args.in[I_NORM_FFN_G], scr, F.lane);
        }
        for (int m = gw; m < MTOK; m += NGW) rms_row_to_bf16(args.in[I_X] + (size_t)m * DM, args.in[I_NORM_MIX_G], hb + (size_t)m * DM, F.lane);
        for (int m = gw; m < MMEM; m += NGW) rms_row_to_bf16(args.in[I_MEM] + (size_t)m * DM, args.in[I_NORM_MEM_G], hmb + (size_t)m * DM, F.lane);
        if (BOTH(0)) xcd_barrier(bar);
    }
    if (IN(1)) {
        { pg8::DenseSched S; S.init(hb, Win, MTOK, NPROJ, DM, F.G, (int)blockIdx.x); EpiProj E{proj, args.in[I_Q_G], args.in[I_K_G], QSCALE_V, 0};
          pg8::gemm_phase<EpiProj, pg8::DenseSched, 0>(F.lds + RING_OFF, F.lds + IDX_OFF, S, E); }
        if (F.G != 256) { pg8::DenseSched S; S.init(hmb, Wxkv, MMEM, 2 * DX, DM, F.G, (int)blockIdx.x); EpiBf16 E{kvmem, 2 * DX, 0};
          pg8::gemm_phase<EpiBf16, pg8::DenseSched, 0>(F.lds + RING_OFF, F.lds + IDX_OFF, S, E); }
        if (BOTH(1)) xcd_barrier(bar);
    }
    if (IN(2)) {
        if (F.G == 256) {
            const int bq = F.vcu >> 4, cls = F.vcu & 15;
            if (cls < 3) { pg8::ListSched S{(const char*)hmb, (const char*)Wxkv, DM, 2 * DX / 256, cls == 0 ? 2 * bq : 16 + 16 * cls + bq, cls == 0 ? 2 : 1}; EpiBf16 E{kvmem, 2 * DX, 0};
                pg8::gemm_phase<EpiBf16, pg8::ListSched, 0>(F.lds + RING_OFF, F.lds + IDX_OFF, S, E); }
        }
        p2_attn(F, proj, args.in[I_REL_BIAS], args.in[I_CONV_W], args.in[I_ONA_G], args.in[I_ONB_G], yb);
        if (BOTH(2)) xcd_barrier(bar);
    }
    if (IN(3)) {
        for (int m = gw; m < MMEM; m += NGW) kv_knorm_row(kvmem, args.in[I_XK_G], m, F.lane);
        pg8::DenseSched S; S.init(yb, Wout, MTOK, DM, DM, F.G, (int)blockIdx.x); EpiRes<false> E{args.in[I_X], hb, sq1, nullptr};
        pg8::gemm_phase<EpiRes<false>, pg8::DenseSched, 0>(F.lds + RING_OFF, F.lds + IDX_OFF, S, E);
        if (BOTH(3)) xcd_barrier(bar);
    }
    if (IN(4)) {
        pg8::DenseSched S; S.init(hb, Wxq, MTOK, DX, DM, F.G, (int)blockIdx.x); EpiRstdBf16 E{qx, sq1, DX, 0};
        pg8::gemm_phase<EpiRstdBf16, pg8::DenseSched, 0>(F.lds + RING_OFF, F.lds + IDX_OFF, S, E);
        if (BOTH(4)) xcd_barrier(bar);
    }
    if (IN(5)) {
        p5_xattn(F, qx, kvmem, args.in[I_XQ_G], ox);
        if (BOTH(5)) xcd_barrier(bar);
    }
    if (IN(6)) {
        pg8::DenseSched S; S.init(ox, Wxo, MTOK, DM, DX, F.G, (int)blockIdx.x); EpiRes<true, true> E{hb, hb, sq2, x2f8};
        pg8::gemm_phase<EpiRes<true, true>, pg8::DenseSched, 0>(F.lds + RING_OFF, F.lds + IDX_OFF, S, E);
        if (BOTH(6)) xcd_barrier(bar);
    }
    if (IN(7)) {
        p7_route(F, hb, Wrt, sq2, args.in[I_B_ROUTER], ctl + CW_CNT, list, listg, listr);
        if (BOTH(7)) xcd_barrier(bar);
    }
    if (IN(8)) {
        moe_tables(ctl + CW_CNT, mtab, F.tid);
        MoeSched S{(const char*)x2f8, (const char*)Wgu8, (size_t)2 * DFF * DM, list, listr, args.in[I_B_GU], mtab, DM, 2 * DFF / 256, (int)mtab[32 + NE], F.G, (int)blockIdx.x, 1, 1, 2 * DFF};
        EpiSwiglu8 E{act8, mtab};
        pg8::gemm_phase_f8<EpiSwiglu8, MoeSched, 2>(F.lds + RING_OFF, F.lds + IDX_OFF, S, E);
        if (BOTH(8)) xcd_barrier(bar);
    }
    if (IN(9)) {
        moe_tables(ctl + CW_CNT, mtab, F.tid);
        MoeSched S{(const char*)act8, (const char*)Wdn8, (size_t)DM * DFF, list, listg, args.in[I_B_DN], mtab, DFF, DM / 256, (int)mtab[32 + NE], F.G, (int)blockIdx.x, 0, 1, DM};
        EpiDown8 E{(unsigned char*)ybuf, mtab};
        pg8::gemm_phase_f8<EpiDown8, MoeSched, 1>(F.lds + RING_OFF, F.lds + IDX_OFF, S, E);
        if (BOTH(9)) xcd_barrier(bar);
    }
    if (IN(10)) p10_combine(F, args.out, hb, (const unsigned char*)ybuf);
#undef IN
#undef BOTH
}

static int g_grid = 0;
static void launch_mk(Args& a, int lo, int hi, int li, hipStream_t stream) {
    a.ph_lo = lo; a.ph_hi = hi; a.li = li; a.pad = 0;
    hipLaunchKernelGGL(mk_fwd, dim3(g_grid), dim3(NWAVES * 64), LDS_BYTES, stream, a);
}
extern "C" void kernel_launch(void* const* d_in, const int* in_sizes, int n_in, void* d_out, int out_size, void* d_ws, size_t ws_size, hipStream_t stream) {
    if (n_in != 25 || ws_size < WS_END || out_size != MTOK * DM) { fprintf(stderr, "kernel_launch: unexpected problem (n_in %d ws %zu out %d)\n", n_in, ws_size, out_size); return; }
    if (g_grid == 0) {
        int dev = 0, cus = 0;
        if (hipGetDevice(&dev) != hipSuccess || hipDeviceGetAttribute(&cus, hipDeviceAttributeMultiprocessorCount, dev) != hipSuccess) { g_grid = -1; return; }
        if (hipFuncSetAttribute((const void*)mk_fwd, hipFuncAttributeMaxDynamicSharedMemorySize, LDS_BYTES) != hipSuccess) { g_grid = -1; return; }
        int per_cu = 0; (void)hipOccupancyMaxActiveBlocksPerMultiprocessor(&per_cu, (const void*)mk_fwd, NWAVES * 64, LDS_BYTES); (void)hipGetLastError();
        g_grid = (per_cu >= 1) ? cus : -1;
    }
    if (g_grid < 0) return;
    const float* x = (const float*)d_in[0]; const float* rel_bias = (const float*)d_in[6]; const float* conv_w = (const float*)d_in[7];
    const float* out_norm_a_g = (const float*)d_in[8]; const float* out_norm_b_g = (const float*)d_in[9]; const float* w_out = (const float*)d_in[10]; const float* norm_xattn_g = (const float*)d_in[11];
    const float* w_xq = (const float*)d_in[13]; const float* xq_norm_g = (const float*)d_in[15];
    const float* xk_norm_g = (const float*)d_in[16]; const float* w_xo = (const float*)d_in[17]; const float* norm_ffn_g = (const float*)d_in[18]; const float* w_router = (const float*)d_in[19];
    const float* b_router = (const float*)d_in[20]; const float* w_gate_up = (const float*)d_in[21]; const float* b_gate_up = (const float*)d_in[22]; const float* w_down = (const float*)d_in[23];
    const float* b_down = (const float*)d_in[24];
    unsigned char* ws = (unsigned char*)d_ws; float* out = (float*)d_out;
    unsigned* ctl = (unsigned*)(ws + WS_CTL);
    bf16_t *Wout = (bf16_t*)(ws + WS_WOUT), *Wxq = (bf16_t*)(ws + WS_WXQ), *Wxo = (bf16_t*)(ws + WS_WXO), *Wgu = (bf16_t*)(ws + WS_WGU), *Wdn = (bf16_t*)(ws + WS_WDN);
    bf16_t *hb = (bf16_t*)(ws + WS_HB), *proj = (bf16_t*)(ws + WS_PROJ), *kvmem = (bf16_t*)(ws + WS_KVMEM), *yb = (bf16_t*)(ws + WS_YB), *qx = (bf16_t*)(ws + WS_QX), *ox = (bf16_t*)(ws + WS_OX);
    bf16_t *act = (bf16_t*)(ws + WS_ACT), *ybuf = (bf16_t*)(ws + WS_YBUF);
    float *ya = (float*)(ws + WS_YA), *x1 = (float*)(ws + WS_X1), *gate = (float*)(ws + WS_GATE);
    int *list = (int*)(ws + WS_LIST), *slot_tk = (int*)(ws + WS_SLOTTK), *slot_src = (int*)(ws + WS_SLOTSRC), *blk_e = (int*)(ws + WS_BLKE);

    (void)hipMemsetAsync(ctl, 0, CTL_ZERO_BYTES, stream);
    Args a{}; for (int i = 0; i < 25; ++i) a.in[i] = (const float*)d_in[i]; a.out = out; a.ws = ws;
    launch_mk(a, 0, 11, 0, stream);
}
```

```cpp
#include <hip/hip_runtime.h>
#include <stdint.h>
#include <stdio.h>

#define LAS __attribute__((address_space(3)))
#define GAS __attribute__((address_space(1)))
typedef unsigned short bf16_t;
typedef short bf16x8 __attribute__((ext_vector_type(8)));
typedef float f32x4 __attribute__((ext_vector_type(4)));
typedef float f32x2 __attribute__((ext_vector_type(2)));
typedef float f32x16 __attribute__((ext_vector_type(16)));
typedef float f32x8 __attribute__((ext_vector_type(8)));
typedef unsigned u32x4 __attribute__((ext_vector_type(4)));
typedef unsigned u32x2 __attribute__((ext_vector_type(2)));
typedef int v8i32 __attribute__((ext_vector_type(8)));
typedef int v4i32 __attribute__((ext_vector_type(4)));

constexpr int DM = 1024, BATCH = 16, SEQ = 2048, MTOK = BATCH * SEQ;
constexpr int CHUNK = 64, LEFT = 8, NMEM = 256, MMEM = BATCH * NMEM;
constexpr int DATT = 512, DCONV = 512, NPROJ = 3072;
constexpr int XH = 4, XHD = 128, DX = 512;
constexpr int NE = 32, TOPK = 4, DFF = 1024;
constexpr int NREL = 513, MAXREL = 256;
constexpr int NASSIGN = MTOK * TOPK;
constexpr int MAXSLOT = NASSIGN + NE * 256;
constexpr float EPS = 1e-6f;
constexpr float LOG2E = 1.4426950408889634f;

constexpr size_t MiB = 1u << 20;
constexpr size_t WS_CTL = 0, CTL_ZERO_BYTES = 256 * 1024;
constexpr size_t WS_WIN = 1 * MiB, WS_WOUT = 7 * MiB, WS_WXQ = 9 * MiB, WS_WXKV = 10 * MiB, WS_WXO = 12 * MiB, WS_WGU = 13 * MiB, WS_WDN = 141 * MiB;
constexpr size_t WS_HB = 205 * MiB, WS_HMB = 269 * MiB;
constexpr size_t WS_LIST = 277 * MiB, WS_GATE = 281 * MiB, WS_SLOTTK = 282 * MiB, WS_SLOTSRC = 283 * MiB, WS_BLKE = 284 * MiB;
constexpr size_t WS_PROJ = 285 * MiB, WS_KVMEM = 477 * MiB, WS_YA = 485 * MiB, WS_YB = 549 * MiB, WS_X1 = 613 * MiB, WS_QX = 741 * MiB, WS_OX = 773 * MiB;
constexpr size_t WS_ACT = 285 * MiB, WS_YBUF = 557 * MiB;
constexpr size_t WS_SQ1 = 813 * MiB, WS_SQ2 = 815 * MiB, WS_RSTD2 = 817 * MiB, WS_WRT = 818 * MiB, WS_LISTR = 819 * MiB, WS_LISTG = 824 * MiB, WS_END = 829 * MiB;
constexpr int CW_CNT = 0, CW_NBLK = 64, CW_PSTART = 128;
constexpr int CW_BAR = 4096;

__device__ __forceinline__ unsigned f2bf(float f) { unsigned u = __builtin_bit_cast(unsigned, f); return (u + 0x7fffu + ((u >> 16) & 1u)) >> 16; }
__device__ __forceinline__ float bf2f(bf16_t b) { return __builtin_bit_cast(float, ((unsigned)b) << 16); }
__device__ __forceinline__ unsigned pk2(float lo, float hi) { return f2bf(lo) | (f2bf(hi) << 16); }
__device__ __forceinline__ float bflo(unsigned w) { return __builtin_bit_cast(float, w << 16); }
__device__ __forceinline__ float bfhi(unsigned w) { return __builtin_bit_cast(float, w & 0xffff0000u); }
__device__ __forceinline__ float wave_sum(float v) {
#pragma unroll
    for (int o = 1; o < 64; o <<= 1) v += __shfl_xor(v, o);
    return v;
}
__device__ __forceinline__ unsigned cvt_pk_bf16(float lo, float hi) { unsigned r; asm volatile("v_cvt_pk_bf16_f32 %0, %1, %2" : "=v"(r) : "v"(lo), "v"(hi)); return r; }

namespace pg8 {
constexpr int BM = 256, BK = 64, HALF = 128, HTB = HALF * BK * 2  , STAGE_BYTES = 8 * HTB, NXCD = 8, WGM = 8;
__host__ __device__ __forceinline__ int lds_byte(int r, int c) { const int st = (r >> 4) * 2 + (c >> 5), rr = r & 15, cc = c & 31, ob = rr * 64 + cc * 2; return st * 1024 + (ob ^ (((ob >> 9) & 1) << 5)); }
__host__ __device__ __forceinline__ void stage_rc(int b, int& R, int& C) { const int st = b / 1024, sb = b % 1024, swz = sb ^ (((sb >> 9) & 1) << 5); R = (st >> 1) * 16 + swz / 64; C = (st & 1) * 32 + (swz % 64) / 2; }
__host__ __device__ __forceinline__ int perm32(int rho) { const int n = rho >> 4, i = rho & 15; return 8 * (i >> 2) + 4 * n + (i & 3); }

struct Unit { int pm, pn, e, rbl; };

__device__ __forceinline__ bool static_order(int nM, int nN, int G, int c, int i, int& pm, int& pn) {
    const int nwg = nM * nN; const long L = (long)i * G + c; if (L >= nwg) return false;
    int wgid = (int)L; { const int q = nwg / NXCD, r = nwg % NXCD, xcd = wgid % NXCD, off = wgid / NXCD; wgid = (xcd < r ? xcd * (q + 1) : r * (q + 1) + (xcd - r) * q) + off; }
    const int nig = WGM * nN, gid = wgid / nig, fm = gid * WGM, gsz = (nM - fm) < WGM ? (nM - fm) : WGM;
    pm = fm + ((wgid % nig) % gsz); pn = (wgid % nig) / gsz; return true;
}
struct DenseSched {
    const char* A; const char* Bt; int K, nM, nN, G, c;
    __device__ __forceinline__ void init(const void* A_, const void* Bt_, int M, int N, int K_, int G_, int c_) { A = (const char*)A_; Bt = (const char*)Bt_; K = K_; nM = M / BM; nN = N / BM; G = G_; c = c_; }
    __device__ __forceinline__ bool next(int i, Unit& u) const { u.e = 0; u.rbl = 0; return static_order(nM, nN, G, c, i, u.pm, u.pn); }
    __device__ __forceinline__ const char* a_base(const Unit& u) const { return A + (size_t)u.pm * BM * K * 2; }
    __device__ __forceinline__ const char* b_base(const Unit& u) const { return Bt + (size_t)u.pn * BM * K * 2; }
    __device__ __forceinline__ unsigned a_off(const Unit& u) const { return (unsigned)u.pm * BM * K; }
    __device__ __forceinline__ unsigned b_off(const Unit& u) const { return (unsigned)u.pn * BM * K; }
    __device__ __forceinline__ void issue_rows(const Unit&, LAS unsigned char*, int, int) const {}
    __device__ __forceinline__ void read_rows(const Unit&, const LAS unsigned char*, int, unsigned (&)[4]) const {}
};

struct ListSched {
    const char* A; const char* Bt; int K, nN, id0, cnt;
    __device__ __forceinline__ bool next(int i, Unit& u) const { if (i >= cnt) return false; const int id = id0 + i; u.pm = id / nN; u.pn = id % nN; u.e = 0; u.rbl = 0; return true; }
    __device__ __forceinline__ const char* a_base(const Unit& u) const { return A + (size_t)u.pm * BM * K * 2; }
    __device__ __forceinline__ const char* b_base(const Unit& u) const { return Bt + (size_t)u.pn * BM * K * 2; }
    __device__ __forceinline__ void issue_rows(const Unit&, LAS unsigned char*, int, int) const {}
    __device__ __forceinline__ void read_rows(const Unit&, const LAS unsigned char*, int, unsigned (&)[4]) const {}
};

template <class Epi, class Sched, int MODE>
__device__ __forceinline__ void gemm_phase(LAS unsigned char* lds, LAS unsigned char* ldsidx, const Sched& S, const Epi& E) {
    int tid_ = threadIdx.x; asm volatile("" : "+v"(tid_));
    const int tid = tid_, wid = __builtin_amdgcn_readfirstlane(tid >> 6), lane = tid & 63, wr = wid >> 2, wc = wid & 3, fr = lane & 15, fq = lane >> 4;
    const int K = S.K, nt = K / BK;
    int R0, C0; stage_rc(tid * 16, R0, C0);
    const int Rb = (R0 & ~31) + perm32(R0 & 31);
    const unsigned voffB0 = (unsigned)(Rb * K + C0) * 2u, voffB1 = voffB0 + (unsigned)(64 * K) * 2u;
    const size_t kstep = (size_t)(BK * 2);
    const size_t hstep = (size_t)HALF * K * 2;
    const unsigned ldsw = (unsigned)wid * 1024u;
    const int aoff = lds_byte(wr * 64 + fr, fq * 8), boff = lds_byte(wc * 32 + fr, fq * 8);
#define PG8_SA(b, h) (((b) * 2 + (h)) * HTB)
#define PG8_SB(b, h) ((4 + (b) * 2 + (h)) * HTB)
#define PG8_STAGE(bufoff, gbase, o0, o1) do { \
        __builtin_amdgcn_global_load_lds((const unsigned*)((const char*)(gbase) + (o0)), (LAS unsigned*)(lds + (bufoff) + ldsw), 16, 0, 0); \
        __builtin_amdgcn_global_load_lds((const unsigned*)((const char*)(gbase) + (o1)), (LAS unsigned*)(lds + (bufoff) + ldsw + 8192), 16, 0, 0); } while (0)
#define PG8_LDA(dst, b, h) do { _Pragma("unroll") for (int m = 0; m < 4; ++m) _Pragma("unroll") for (int k = 0; k < 2; ++k) dst[m][k] = *(const LAS bf16x8*)(lds + PG8_SA(b, h) + aoff + m * 2048 + k * 1024); } while (0)
#define PG8_LDB(dst, b, h) do { _Pragma("unroll") for (int n = 0; n < 2; ++n) _Pragma("unroll") for (int k = 0; k < 2; ++k) dst[n][k] = *(const LAS bf16x8*)(lds + PG8_SB(b, h) + boff + n * 2048 + k * 1024); } while (0)
#define PG8_MMA(ai, bj, At, Bt) do { __builtin_amdgcn_s_setprio(1); _Pragma("unroll") for (int m = 0; m < 4; ++m) _Pragma("unroll") for (int n = 0; n < 2; ++n) _Pragma("unroll") for (int k = 0; k < 2; ++k) \
        acc[ai][bj][m][n] = __builtin_amdgcn_mfma_f32_16x16x32_bf16(Bt[n][k], At[m][k], acc[ai][bj][m][n], 0, 0, 0); __builtin_amdgcn_s_setprio(0); } while (0)
#define PG8_WAIT_V(n) asm volatile("s_waitcnt vmcnt(" #n ")" ::: "memory")
#define PG8_WAIT_L(n) asm volatile("s_waitcnt lgkmcnt(" #n ")" ::: "memory")
#define PG8_BAR __builtin_amdgcn_s_barrier()
#define PG8_SCHED __builtin_amdgcn_sched_barrier(0)
    Unit cur, nxt; int ui = 0, ib = 0;
    if (!S.next(0, cur)) return;
    unsigned vc[4], vn[4];
    constexpr bool GATHER = (MODE == 2);
    if constexpr (MODE >= 1) { S.issue_rows(cur, ldsidx, wid, lane); asm volatile("s_waitcnt vmcnt(0)" ::: "memory"); __builtin_amdgcn_s_barrier(); asm volatile("" ::: "memory"); }
    if constexpr (GATHER) { S.read_rows(cur, ldsidx, R0, vc); _Pragma("unroll") for (int q = 0; q < 4; ++q) vc[q] += (unsigned)C0 * 2u; }
    else { _Pragma("unroll") for (int q = 0; q < 4; ++q) vc[q] = (unsigned)((R0 + 64 * q) * K + C0) * 2u; }
#pragma unroll
    for (int q = 0; q < 4; ++q) vn[q] = vc[q];
    f32x4 acc[2][2][4][2];
#pragma unroll
    for (int a = 0; a < 2; ++a)
#pragma unroll
        for (int b = 0; b < 2; ++b)
#pragma unroll
            for (int m = 0; m < 4; ++m)
#pragma unroll
                for (int n = 0; n < 2; ++n) acc[a][b][m][n] = (f32x4){0.f, 0.f, 0.f, 0.f};
    bf16x8 At[4][2], B0[2][2], B1[2][2];
    const char* cA = S.a_base(cur); const char* cB = S.b_base(cur);
    PG8_STAGE(PG8_SB(0, 0), cB, voffB0, voffB1); PG8_STAGE(PG8_SB(0, 1), cB + hstep, voffB0, voffB1); PG8_STAGE(PG8_SA(0, 0), cA, vc[0], vc[1]); PG8_STAGE(PG8_SA(0, 1), cA, vc[2], vc[3]);
    if (wr == 1) PG8_BAR;
    PG8_WAIT_V(2); PG8_BAR;
    PG8_STAGE(PG8_SB(1, 0), cB + kstep, voffB0, voffB1); PG8_STAGE(PG8_SA(1, 0), cA + kstep, vc[0], vc[1]); PG8_STAGE(PG8_SB(1, 1), cB + hstep + kstep, voffB0, voffB1);
    PG8_WAIT_V(6); PG8_BAR;
    for (;;) {
        const bool has_next = S.next(ui + 1, nxt);
        if constexpr (MODE >= 1) { if (has_next) S.issue_rows(nxt, ldsidx + (ib == 2 ? 0 : ib + 1) * 3072, wid, lane); }
        const char* nA = has_next ? S.a_base(nxt) : cA; const char* nB = has_next ? S.b_base(nxt) : cB;
        for (int t = 0; t < nt; t += 2) {
            const bool last = (t == nt - 2);
            const char* a1 = cA + (size_t)(t + 1) * kstep;
            const char* a2 = last ? nA : cA + (size_t)(t + 2) * kstep; const char* b2 = last ? nB : cB + (size_t)(t + 2) * kstep;
            const char* a3 = a2 + kstep; const char* b3 = b2 + kstep;
            unsigned w0 = vc[0], w1 = vc[1], w2 = vc[2], w3 = vc[3];
            if constexpr (GATHER) { if (last && has_next) { S.read_rows(nxt, ldsidx + (ib == 2 ? 0 : ib + 1) * 3072, R0, vn); _Pragma("unroll") for (int q = 0; q < 4; ++q) vn[q] += (unsigned)C0 * 2u;
                w0 = vn[0]; w1 = vn[1]; w2 = vn[2]; w3 = vn[3]; } }
            PG8_LDB(B0, 0, 0); PG8_LDB(B1, 0, 1); PG8_SCHED; PG8_LDA(At, 0, 0); PG8_STAGE(PG8_SA(1, 1), a1, vc[2], vc[3]);
            PG8_WAIT_V(8); PG8_WAIT_L(0); PG8_BAR; PG8_MMA(0, 0, At, B0); PG8_MMA(0, 1, At, B1); PG8_BAR; PG8_SCHED;
            PG8_LDA(At, 0, 1); PG8_STAGE(PG8_SB(0, 0), b2, voffB0, voffB1); PG8_STAGE(PG8_SB(0, 1), b2 + hstep, voffB0, voffB1); PG8_STAGE(PG8_SA(0, 0), a2, w0, w1);
            PG8_WAIT_V(8); PG8_WAIT_L(0); PG8_BAR; PG8_MMA(1, 0, At, B0); PG8_MMA(1, 1, At, B1); PG8_BAR; PG8_SCHED;
            PG8_LDB(B0, 1, 0); PG8_LDB(B1, 1, 1); PG8_SCHED; PG8_LDA(At, 1, 0); PG8_STAGE(PG8_SA(0, 1), a2, w2, w3);
            PG8_WAIT_V(8); PG8_WAIT_L(0); PG8_BAR; PG8_MMA(0, 0, At, B0); PG8_MMA(0, 1, At, B1); PG8_BAR; PG8_SCHED;
            PG8_LDA(At, 1, 1); PG8_STAGE(PG8_SB(1, 0), b3, voffB0, voffB1); PG8_STAGE(PG8_SB(1, 1), b3 + hstep, voffB0, voffB1); PG8_STAGE(PG8_SA(1, 0), a3, w0, w1);
            PG8_WAIT_V(8); PG8_WAIT_L(0); PG8_BAR; PG8_MMA(1, 0, At, B0); PG8_MMA(1, 1, At, B1); PG8_BAR; PG8_SCHED;
        }
        if (wr == 0) PG8_BAR;
        E(acc, cur, wr, wc, fr, fq, (const LAS unsigned char*)(ldsidx + ib * 3072));
        if (!has_next) break;
#pragma unroll
        for (int a = 0; a < 2; ++a)
#pragma unroll
            for (int b = 0; b < 2; ++b)
#pragma unroll
                for (int m = 0; m < 4; ++m)
#pragma unroll
                    for (int n = 0; n < 2; ++n) acc[a][b][m][n] = (f32x4){0.f, 0.f, 0.f, 0.f};
        cur = nxt; cA = nA; cB = nB; ++ui; ib = (ib == 2 ? 0 : ib + 1);
#pragma unroll
        for (int q = 0; q < 4; ++q) vc[q] = vn[q];
        if (wr == 1) PG8_BAR;
    }
    PG8_WAIT_V(0);
    PG8_BAR;
#undef PG8_SA
#undef PG8_SB
#undef PG8_STAGE
#undef PG8_LDA
#undef PG8_LDB
#undef PG8_MMA
#undef PG8_WAIT_V
#undef PG8_WAIT_L
#undef PG8_BAR
#undef PG8_SCHED
}
template <class Epi, class Sched, int MODE>
__device__ __forceinline__ void gemm_phase_f8(LAS unsigned char* lds, LAS unsigned char* ldsidx, const Sched& S, const Epi& E) {
    int tid_ = threadIdx.x; asm volatile("" : "+v"(tid_));
    const int tid = tid_, wid = __builtin_amdgcn_readfirstlane(tid >> 6), lane = tid & 63, wr = wid >> 2, wc = wid & 3, fr = lane & 15, fq = lane >> 4;
    constexpr bool GATHER = (MODE == 2);
    const int K = S.K, nt = K / 128;
    const int R0 = tid >> 3, C0 = ((tid & 7) ^ (((R0 >> 1) & 1) | (((R0 >> 3) & 1) << 2))) * 16;
    const int Rb = (R0 & ~31) + perm32(R0 & 31);
    const unsigned voffB0 = (unsigned)(Rb * K + C0), r64 = 64u * (unsigned)K;
    const unsigned kstep = 128u;
    const unsigned hstep = (unsigned)(HALF * K);
    const char* const Abase = S.A; const char* const Bbase = S.Bt;
    const unsigned ldsw = (unsigned)wid * 1024u;
    const int sg = ((fr >> 1) & 1) | (((fr >> 3) & 1) << 2);
    const LAS unsigned char* a0p = lds + (wr * 64 + fr) * 128 + (((2 * fq) ^ sg) * 16); const LAS unsigned char* a1p = lds + (wr * 64 + fr) * 128 + (((2 * fq + 1) ^ sg) * 16);
    const LAS unsigned char* b0p = lds + 4 * HTB + (wc * 32 + fr) * 128 + (((2 * fq) ^ sg) * 16); const LAS unsigned char* b1p = lds + 4 * HTB + (wc * 32 + fr) * 128 + (((2 * fq + 1) ^ sg) * 16);
#define PG8_SA(b, h) (((b) * 2 + (h)) * HTB)
#define PG8_SB(b, h) ((4 + (b) * 2 + (h)) * HTB)
#define PG8_STAGE(bufoff, gbase, o0, o1) do { \
        __builtin_amdgcn_global_load_lds((const unsigned*)((const char*)(gbase) + (o0)), (LAS unsigned*)(lds + (bufoff) + ldsw), 16, 0, 0); \
        __builtin_amdgcn_global_load_lds((const unsigned*)((const char*)(gbase) + (o1)), (LAS unsigned*)(lds + (bufoff) + ldsw + 8192), 16, 0, 0); } while (0)
#define PG8_STAGEA(bufoff, uo, hh) do { \
        __builtin_amdgcn_global_load_lds((const unsigned*)(Abase + (unsigned)((uo) + vc[2 * (hh)])), (LAS unsigned*)(lds + (bufoff) + ldsw), 16, 0, 0); \
        __builtin_amdgcn_global_load_lds((const unsigned*)(Abase + (unsigned)((uo) + vc[2 * (hh) + 1])), (LAS unsigned*)(lds + (bufoff) + ldsw + 8192), 16, 0, 0); } while (0)
#define PG8_STAGEB(bufoff, uo) do { \
        __builtin_amdgcn_global_load_lds((const unsigned*)(Bbase + (unsigned)((uo) + voffB0)), (LAS unsigned*)(lds + (bufoff) + ldsw), 16, 0, 0); \
        __builtin_amdgcn_global_load_lds((const unsigned*)(Bbase + (unsigned)((uo) + r64 + voffB0)), (LAS unsigned*)(lds + (bufoff) + ldsw + 8192), 16, 0, 0); } while (0)
#define PG8_LD32(p0, p1, off) __builtin_shufflevector(*(const LAS v4i32*)((p0) + (off)), *(const LAS v4i32*)((p1) + (off)), 0, 1, 2, 3, 4, 5, 6, 7)
#define PG8_LDA(dst, b, h) do { _Pragma("unroll") for (int m = 0; m < 4; ++m) dst[m] = PG8_LD32(a0p, a1p, PG8_SA(b, h) + m * 2048); } while (0)
#define PG8_LDB(dst, b, h) do { _Pragma("unroll") for (int n = 0; n < 2; ++n) dst[n] = PG8_LD32(b0p, b1p, PG8_SB(b, h) - 4 * HTB + n * 2048); } while (0)
#define PG8_MMA(ai, bj, At, Bt) do { __builtin_amdgcn_s_setprio(1); _Pragma("unroll") for (int m = 0; m < 4; ++m) _Pragma("unroll") for (int n = 0; n < 2; ++n) \
        acc[ai][bj][m][n] = __builtin_amdgcn_mfma_scale_f32_16x16x128_f8f6f4(Bt[n], At[m], acc[ai][bj][m][n], 0, 0, 0, 0, 0, 0); __builtin_amdgcn_s_setprio(0); } while (0)
#define PG8_WAIT_V(n) asm volatile("s_waitcnt vmcnt(" #n ")" ::: "memory")
#define PG8_WAIT_L(n) asm volatile("s_waitcnt lgkmcnt(" #n ")" ::: "memory")
#define PG8_BAR __builtin_amdgcn_s_barrier()
#define PG8_SCHED __builtin_amdgcn_sched_barrier(0)
    Unit cur, nxt; int ui = 0, ib = 0;
    if (!S.next(0, cur)) return;
    unsigned vc[4];
    if constexpr (MODE >= 1) { S.issue_rows(cur, ldsidx, wid, lane); asm volatile("s_waitcnt vmcnt(0)" ::: "memory"); __builtin_amdgcn_s_barrier(); asm volatile("" ::: "memory"); }
    if constexpr (GATHER) { S.read_rows(cur, ldsidx, R0, vc); _Pragma("unroll") for (int q = 0; q < 4; ++q) vc[q] += (unsigned)C0; }
    else { const unsigned ua = S.a_off(cur); _Pragma("unroll") for (int q = 0; q < 4; ++q) vc[q] = ua + (unsigned)((R0 + 64 * q) * K + C0); }
    f32x4 acc[2][2][4][2];
#pragma unroll
    for (int a = 0; a < 2; ++a)
#pragma unroll
        for (int b = 0; b < 2; ++b)
#pragma unroll
            for (int m = 0; m < 4; ++m)
#pragma unroll
                for (int n = 0; n < 2; ++n) acc[a][b][m][n] = (f32x4){0.f, 0.f, 0.f, 0.f};
    v8i32 At[4], B0[2], B1[2];
    unsigned cB = S.b_off(cur);
    PG8_STAGEB(PG8_SB(0, 0), cB); PG8_STAGEB(PG8_SB(0, 1), cB + hstep); PG8_STAGEA(PG8_SA(0, 0), 0u, 0); PG8_STAGEA(PG8_SA(0, 1), 0u, 1);
    if (wr == 1) PG8_BAR;
    PG8_WAIT_V(2); PG8_BAR;
    PG8_STAGEB(PG8_SB(1, 0), cB + kstep); PG8_STAGEA(PG8_SA(1, 0), kstep, 0); PG8_STAGEB(PG8_SB(1, 1), cB + hstep + kstep);
    PG8_WAIT_V(6); PG8_BAR;
    for (;;) {
        const bool has_next = S.next(ui + 1, nxt);
        if constexpr (MODE >= 1) { if (has_next) S.issue_rows(nxt, ldsidx + (ib == 2 ? 0 : ib + 1) * 3072, wid, lane); }
        const unsigned nB = has_next ? S.b_off(nxt) : cB;
        for (int t = 0; t < nt; t += 2) {
            const bool last = (t == nt - 2);
            const unsigned a1 = (unsigned)(t + 1) * kstep;
            const unsigned a2 = last ? 0u : (unsigned)(t + 2) * kstep, b2 = last ? nB : cB + (unsigned)(t + 2) * kstep;
            const unsigned a3 = a2 + kstep, b3 = b2 + kstep;
            PG8_LDB(B0, 0, 0); PG8_LDB(B1, 0, 1); PG8_SCHED; PG8_LDA(At, 0, 0); PG8_STAGEA(PG8_SA(1, 1), a1, 1);
            if (last && has_next) {
                if constexpr (GATHER) { S.read_rows(nxt, ldsidx + (ib == 2 ? 0 : ib + 1) * 3072, R0, vc); _Pragma("unroll") for (int q = 0; q < 4; ++q) vc[q] += (unsigned)C0; }
                else { const unsigned ua = S.a_off(nxt); _Pragma("unroll") for (int q = 0; q < 4; ++q) vc[q] = ua + (unsigned)((R0 + 64 * q) * K + C0); } }
            PG8_WAIT_V(8); PG8_WAIT_L(0); PG8_BAR; PG8_MMA(0, 0, At, B0); PG8_MMA(0, 1, At, B1); PG8_BAR; PG8_SCHED;
            PG8_LDA(At, 0, 1); PG8_STAGEB(PG8_SB(0, 0), b2); PG8_STAGEB(PG8_SB(0, 1), b2 + hstep); PG8_STAGEA(PG8_SA(0, 0), a2, 0);
            PG8_WAIT_V(8); PG8_WAIT_L(0); PG8_BAR; PG8_MMA(1, 0, At, B0); PG8_MMA(1, 1, At, B1); PG8_BAR; PG8_SCHED;
            PG8_LDB(B0, 1, 0); PG8_LDB(B1, 1, 1); PG8_SCHED; PG8_LDA(At, 1, 0); PG8_STAGEA(PG8_SA(0, 1), a2, 1);
            PG8_WAIT_V(8); PG8_WAIT_L(0); PG8_BAR; PG8_MMA(0, 0, At, B0); PG8_MMA(0, 1, At, B1); PG8_BAR; PG8_SCHED;
            PG8_LDA(At, 1, 1); PG8_STAGEB(PG8_SB(1, 0), b3); PG8_STAGEB(PG8_SB(1, 1), b3 + hstep); PG8_STAGEA(PG8_SA(1, 0), a3, 0);
            PG8_WAIT_V(8); PG8_WAIT_L(0); PG8_BAR; PG8_MMA(1, 0, At, B0); PG8_MMA(1, 1, At, B1); PG8_BAR; PG8_SCHED;
        }
        if (wr == 0) PG8_BAR;
        E(acc, cur, wr, wc, fr, fq, (const LAS unsigned char*)(ldsidx + ib * 3072));
        if (!has_next) break;
#pragma unroll
        for (int a = 0; a < 2; ++a)
#pragma unroll
            for (int b = 0; b < 2; ++b)
#pragma unroll
                for (int m = 0; m < 4; ++m) { acc[a][b][m][0] = (f32x4){0.f, 0.f, 0.f, 0.f}; acc[a][b][m][1] = (f32x4){0.f, 0.f, 0.f, 0.f}; }
        cur = nxt; cB = nB; ++ui; ib = (ib == 2 ? 0 : ib + 1);
        if (wr == 1) PG8_BAR;
    }
    PG8_WAIT_V(0);
    PG8_BAR;
#undef PG8_SA
#undef PG8_SB
#undef PG8_STAGE
#undef PG8_STAGEB
#undef PG8_STAGEA
#undef PG8_LDA
#undef PG8_LDB
#undef PG8_MMA
#undef PG8_LD32
#undef PG8_WAIT_V
#undef PG8_WAIT_L
#undef PG8_BAR
#undef PG8_SCHED
}
}

#define XB_TMO      128
#define XB_XCNT(j)  (256  + 64 * (j))
#define XB_XSUB(j)  (1280 + 64 * (j))
#define XB_XGEN(j)  (2304 + 64 * (j))
#define XB_TOP      3328
#define XB_TOPGEN   3392
#define XCD_BAR_WORDS 3456
#define XB_SPIN_CAP (1u << 18)

__device__ __forceinline__ unsigned xb_ld(unsigned* p)              { return __hip_atomic_load(p, __ATOMIC_RELAXED, __HIP_MEMORY_SCOPE_AGENT); }
__device__ __forceinline__ unsigned xb_add(unsigned* p, unsigned v) { return __hip_atomic_fetch_add(p, v, __ATOMIC_RELAXED, __HIP_MEMORY_SCOPE_AGENT); }
__device__ __forceinline__ unsigned xb_xcc_id() { return (unsigned)__builtin_amdgcn_s_getreg((3 << 11) | 20) & 0xFu; }
#define XB_SPIN(cond, bar) do { unsigned _sp = 0; while (cond) { __builtin_amdgcn_s_sleep(1); \
    if ((++_sp & 255u) == 0u) { if (xb_ld(&(bar)[XB_TMO])) break; if (_sp > XB_SPIN_CAP) { atomicAdd(&(bar)[XB_TMO], 1u); break; } } } } while (0)

struct XcdBarrier {
    unsigned* bar; unsigned x;
    volatile LAS unsigned* st;
};
__device__ __forceinline__ XcdBarrier xcd_barrier_post(unsigned* bar, volatile LAS unsigned* st) {
    XcdBarrier b; b.bar = bar; b.x = xb_xcc_id(); b.st = st;
    if (threadIdx.x == 0) (void)xb_add(&bar[XB_XCNT(b.x)], 1u);
    return b;
}
__device__ __forceinline__ void xcd_barrier_complete(unsigned* bar, unsigned x, unsigned& nloc, unsigned& nx) {
    const unsigned G = gridDim.x * gridDim.y * gridDim.z;
    unsigned sum, cnt, mine, sp = 0u;
    for (;;) {
        sum = 0u; cnt = 0u; mine = 0u;
#pragma unroll
        for (unsigned j = 0; j < 16; ++j) { const unsigned c = xb_ld(&bar[XB_XCNT(j)]); sum += c; cnt += (c > 0u) ? 1u : 0u; mine = (j == x) ? c : mine; }
        if (sum == G) break;
        __builtin_amdgcn_s_sleep(1);
        if ((++sp & 255u) == 0u) { if (xb_ld(&bar[XB_TMO])) break; if (sp > XB_SPIN_CAP) { atomicAdd(&bar[XB_TMO], 1u); break; } }
    }
    nloc = mine > 0u ? mine : 1u; nx = cnt > 0u ? cnt : 1u;
}
__device__ __forceinline__ void xcd_barrier(const XcdBarrier& b) {
    asm volatile("s_waitcnt vmcnt(0)" ::: "memory");
    __syncthreads();
    if (threadIdx.x == 0) {
        unsigned* bar = b.bar;
        __builtin_amdgcn_s_waitcnt(0);
        unsigned nloc = b.st[0], nx = b.st[1];
        if (nloc == 0u) { xcd_barrier_complete(bar, b.x, nloc, nx); b.st[0] = nloc; b.st[1] = nx; }
        const unsigned old = xb_add(&bar[XB_XSUB(b.x)], 1u);
        const unsigned gen = old / nloc;
        if (old + 1u == (gen + 1u) * nloc) {
            __builtin_amdgcn_fence(__ATOMIC_RELEASE, "agent");
            asm volatile("s_waitcnt vmcnt(0)" ::: "memory");
            const unsigned og = xb_add(&bar[XB_TOP], 1u);
            const unsigned tg = og / nx;
            if (og + 1u == (tg + 1u) * nx) xb_add(&bar[XB_TOPGEN], 1u);
            else XB_SPIN(xb_ld(&bar[XB_TOPGEN]) == tg, bar);
            __builtin_amdgcn_fence(__ATOMIC_ACQUIRE, "agent");
            xb_add(&bar[XB_XGEN(b.x)], 1u);
            asm volatile("s_waitcnt vmcnt(0)" ::: "memory");
        } else {
            XB_SPIN(xb_ld(&bar[XB_XGEN(b.x)]) == gen, bar);
            __builtin_amdgcn_fence(__ATOMIC_ACQUIRE, "agent");
            asm volatile("s_waitcnt vmcnt(0)" ::: "memory");
        }
    }
    __syncthreads();
}

constexpr int NWAVES = 8;
constexpr int RING_OFF = 0, RING_BYTES = 139264;
constexpr int LDSCTL_OFF = RING_BYTES, MISC_OFF = LDSCTL_OFF + 320;
constexpr int MOE_OFF = LDSCTL_OFF + 512;
constexpr int IDX_OFF = LDSCTL_OFF + 4096;
constexpr int TBL_OFF = LDSCTL_OFF + 4096;
constexpr int SSQ_OFF = LDSCTL_OFF + 16384;
constexpr int LDS_BYTES = RING_BYTES + 20480;
static_assert(TBL_OFF + 8 * 384 * 4 <= SSQ_OFF && SSQ_OFF + 4096 <= LDS_BYTES && LDS_BYTES <= 160 * 1024, "LDS map");

struct Args { const float* in[25]; float* out; unsigned char* ws; int ph_lo, ph_hi, li, pad; };
enum { I_X = 0, I_MEM, I_NORM_MIX_G, I_W_IN, I_Q_G, I_K_G, I_REL_BIAS, I_CONV_W, I_ONA_G, I_ONB_G, I_W_OUT, I_NORM_X_G, I_NORM_MEM_G, I_W_XQ, I_W_XKV, I_XQ_G, I_XK_G, I_W_XO,
       I_NORM_FFN_G, I_W_ROUTER, I_B_ROUTER, I_W_GU, I_B_GU, I_W_DN, I_B_DN };

constexpr float X8SCALE = 4.0f, W8SCALE = 64.0f, A8SCALE = 8.0f, Y8SCALE = 32.0f;
__device__ __forceinline__ int fresh_tid() { int t = threadIdx.x; asm volatile("" : "+v"(t)); return t; }
struct Frame {
    LAS unsigned char* lds; int tid, lane, wave, vcu, G;
};

__device__ __forceinline__ void p0_transpose_item(const float* __restrict__ W, int ldw, int K, bf16_t* __restrict__ WT, int k0, int scol0, int cstride, int drow0, const float* __restrict__ g, LAS float* scr, int lane) {
#pragma unroll 8
    for (int i = 0; i < 32; ++i) { const int kk = 2 * i + (lane >> 5); float v = W[(size_t)(k0 + kk) * ldw + scol0 + (lane & 31) * cstride]; if (g) v *= g[k0 + kk]; scr[kk * 33 + (lane & 31)] = v; }
    asm volatile("s_waitcnt lgkmcnt(0)" ::: "memory");
    const int c = lane & 7;
#pragma unroll
    for (int j = 0; j < 4; ++j) { const int n = (lane >> 3) + 8 * j; const LAS float* s = scr + (8 * c) * 33 + n;
        u32x4 o; o.x = pk2(s[0 * 33], s[1 * 33]); o.y = pk2(s[2 * 33], s[3 * 33]); o.z = pk2(s[4 * 33], s[5 * 33]); o.w = pk2(s[6 * 33], s[7 * 33]);
        *(u32x4*)(WT + (size_t)(drow0 + n) * K + k0 + 8 * c) = o; }
    asm volatile("s_waitcnt lgkmcnt(0)" ::: "memory");
}
template <int MODE>
__device__ __forceinline__ void p0_transpose64(const float* __restrict__ W, int ldw, int K, bf16_t* __restrict__ WT, int k0, int n0, int drow0, const float* __restrict__ g, LAS float* scr, int lane) {
    const int krow = lane >> 4, c4 = lane & 15;
    f32x4 v[16];
#pragma unroll
    for (int i = 0; i < 16; ++i) v[i] = *(const f32x4*)(W + (size_t)(k0 + 4 * i + krow) * ldw + n0 + 4 * c4);
    if (g) {
#pragma unroll
        for (int i = 0; i < 16; ++i) v[i] = v[i] * g[k0 + 4 * i + krow]; }
#pragma unroll
    for (int i = 0; i < 16; ++i) { LAS float* d = scr + (4 * i + krow) * 65 + 4 * c4; d[0] = v[i].x; d[1] = v[i].y; d[2] = v[i].z; d[3] = v[i].w; }
    asm volatile("s_waitcnt lgkmcnt(0)" ::: "memory");
    const int kc = lane & 7;
#pragma unroll
    for (int j = 0; j < 8; ++j) { const int n = (lane >> 3) + 8 * j; const LAS float* s = scr + (8 * kc) * 65 + n;
        u32x4 o; o.x = pk2(s[0 * 65], s[1 * 65]); o.y = pk2(s[2 * 65], s[3 * 65]); o.z = pk2(s[4 * 65], s[5 * 65]); o.w = pk2(s[6 * 65], s[7 * 65]);
        const int dr = MODE == 0 ? n : (MODE == 1 ? 128 * (n >> 5) + (n & 31) : 128 * (n & 1) + (n >> 1));
        *(u32x4*)(WT + (size_t)(drow0 + dr) * K + k0 + 8 * kc) = o; }
    asm volatile("s_waitcnt lgkmcnt(0)" ::: "memory");
}
__device__ __forceinline__ float clamp8(float v) { return fminf(fmaxf(v, -448.0f), 448.0f); }
__device__ __forceinline__ unsigned pk4_fp8(float a, float b, float c, float d) { int w = 0; w = __builtin_amdgcn_cvt_pk_fp8_f32(a, b, w, false); w = __builtin_amdgcn_cvt_pk_fp8_f32(c, d, w, true); return (unsigned)w; }
template <int MODE>
__device__ __forceinline__ void p0_transpose64_f8(const float* __restrict__ W, int ldw, int K, unsigned char* __restrict__ WT, int k0, int n0, int drow0, const float* __restrict__ g, float sc, LAS float* scr, int lane) {
    const int krow = lane >> 4, c4 = lane & 15;
    f32x4 v[16];
#pragma unroll
    for (int i = 0; i < 16; ++i) v[i] = *(const f32x4*)(W + (size_t)(k0 + 4 * i + krow) * ldw + n0 + 4 * c4);
#pragma unroll
    for (int i = 0; i < 16; ++i) v[i] = v[i] * (g ? g[k0 + 4 * i + krow] * sc : sc);
#pragma unroll
    for (int i = 0; i < 16; ++i) { LAS float* d = scr + (4 * i + krow) * 65 + 4 * c4; d[0] = v[i].x; d[1] = v[i].y; d[2] = v[i].z; d[3] = v[i].w; }
    asm volatile("s_waitcnt lgkmcnt(0)" ::: "memory");
    const int kc = lane & 3;
#pragma unroll
    for (int j = 0; j < 4; ++j) { const int n = (lane >> 2) + 16 * j; const LAS float* s = scr + (16 * kc) * 65 + n;
        u32x4 o; o.x = pk4_fp8(s[0 * 65], s[1 * 65], s[2 * 65], s[3 * 65]); o.y = pk4_fp8(s[4 * 65], s[5 * 65], s[6 * 65], s[7 * 65]);
        o.z = pk4_fp8(s[8 * 65], s[9 * 65], s[10 * 65], s[11 * 65]); o.w = pk4_fp8(s[12 * 65], s[13 * 65], s[14 * 65], s[15 * 65]);
        const int dr = MODE == 0 ? n : (MODE == 1 ? 128 * (n >> 5) + (n & 31) : 128 * (n & 1) + (n >> 1));
        *(u32x4*)(WT + (size_t)(drow0 + dr) * K + k0 + 16 * kc) = o; }
    asm volatile("s_waitcnt lgkmcnt(0)" ::: "memory");
}
struct F8Item { const float* W; unsigned char* WT; const float* g; int ldw, k0, n0, drow0, mode; };
__device__ __forceinline__ void p0_f8_load(const F8Item& I, f32x4 (&v)[16], int lane) {
    const int krow = lane >> 4, c4 = lane & 15;
#pragma unroll
    for (int i = 0; i < 16; ++i) v[i] = *(const f32x4*)(I.W + (size_t)(I.k0 + 4 * i + krow) * I.ldw + I.n0 + 4 * c4);
}
__device__ __forceinline__ void p0_f8_store(const F8Item& I, const f32x4 (&v)[16], int K, float sc, LAS float* scr, int lane) {
    const int krow = lane >> 4, c4 = lane & 15;
#pragma unroll
    for (int i = 0; i < 16; ++i) { const float s = I.g ? I.g[I.k0 + 4 * i + krow] * sc : sc; LAS float* d = scr + (4 * i + krow) * 65 + 4 * c4; d[0] = v[i].x * s; d[1] = v[i].y * s; d[2] = v[i].z * s; d[3] = v[i].w * s; }
    asm volatile("s_waitcnt lgkmcnt(0)" ::: "memory");
    const int kc = lane & 3;
#pragma unroll
    for (int j = 0; j < 4; ++j) { const int n = (lane >> 2) + 16 * j; const LAS float* s = scr + (16 * kc) * 65 + n;
        u32x4 o; o.x = pk4_fp8(s[0 * 65], s[1 * 65], s[2 * 65], s[3 * 65]); o.y = pk4_fp8(s[4 * 65], s[5 * 65], s[6 * 65], s[7 * 65]);
        o.z = pk4_fp8(s[8 * 65], s[9 * 65], s[10 * 65], s[11 * 65]); o.w = pk4_fp8(s[12 * 65], s[13 * 65], s[14 * 65], s[15 * 65]);
        const int dr = I.mode == 0 ? n : 128 * (n & 1) + (n >> 1);
        *(u32x4*)(I.WT + (size_t)(I.drow0 + dr) * K + I.k0 + 16 * kc) = o; }
    asm volatile("s_waitcnt lgkmcnt(0)" ::: "memory");
}
__device__ __forceinline__ void rms_row_to_bf16(const float* __restrict__ xrow, const float* __restrict__ g, bf16_t* __restrict__ orow, int lane) {
    const f32x4* xr = (const f32x4*)xrow + lane; const f32x4* gr = (const f32x4*)g + lane;
    f32x4 v[4]; float s = 0.f;
#pragma unroll
    for (int j = 0; j < 4; ++j) { v[j] = xr[64 * j]; s += (v[j].x * v[j].x + v[j].y * v[j].y) + (v[j].z * v[j].z + v[j].w * v[j].w); }
    const float rstd = 1.0f / sqrtf(wave_sum(s) * (1.0f / DM) + EPS);
    u32x2* o8 = (u32x2*)orow + lane;
#pragma unroll
    for (int j = 0; j < 4; ++j) { const f32x4 gg = gr[64 * j]; u32x2 o; o.x = pk2(v[j].x * rstd * gg.x, v[j].y * rstd * gg.y); o.y = pk2(v[j].z * rstd * gg.z, v[j].w * rstd * gg.w); o8[64 * j] = o; }
}

using pg8::Unit;
struct EpiProj { bf16_t* O; const float* qg; const float* kg; float qscale; int pad;
    __device__ __forceinline__ void operator()(const f32x4 (&acc)[2][2][4][2], const Unit& u, int wr, int wc, int fr, int fq, const LAS unsigned char*) const {
        const int row0 = u.pm * 256 + wr * 64 + fr, colb = u.pn * 256 + wc * 64 + 8 * fq;
        const int mode = u.pn < 2 ? 1 : (u.pn < 4 ? 2 : 0);
        f32x4 gv[2][2];
        if (mode) { const float* gp = (mode == 1 ? qg : kg) + 8 * fq; const float sc = mode == 1 ? qscale : 1.0f;
#pragma unroll
            for (int bj = 0; bj < 2; ++bj)
#pragma unroll
                for (int n = 0; n < 2; ++n) gv[bj][n] = *(const f32x4*)(gp + 32 * bj + 4 * n) * sc; }
#pragma unroll
        for (int ai = 0; ai < 2; ++ai)
#pragma unroll
            for (int m = 0; m < 4; ++m) {
                f32x4 v[2][2];
#pragma unroll
                for (int bj = 0; bj < 2; ++bj)
#pragma unroll
                    for (int n = 0; n < 2; ++n) v[bj][n] = acc[ai][bj][m][n];
                if (mode) { float ss = 0.f;
#pragma unroll
                    for (int bj = 0; bj < 2; ++bj)
#pragma unroll
                        for (int n = 0; n < 2; ++n) ss += (v[bj][n].x * v[bj][n].x + v[bj][n].y * v[bj][n].y) + (v[bj][n].z * v[bj][n].z + v[bj][n].w * v[bj][n].w);
                    ss += __shfl_xor(ss, 16); ss += __shfl_xor(ss, 32);
                    const float rstd = 1.0f / sqrtf(ss * (1.0f / 64.0f) + EPS);
#pragma unroll
                    for (int bj = 0; bj < 2; ++bj)
#pragma unroll
                        for (int n = 0; n < 2; ++n) v[bj][n] = v[bj][n] * rstd * gv[bj][n]; }
                bf16_t* rowp = O + (size_t)(row0 + ai * 128 + m * 16) * NPROJ + colb;
#pragma unroll
                for (int bj = 0; bj < 2; ++bj) { u32x4 w; w.x = cvt_pk_bf16(v[bj][0].x, v[bj][0].y); w.y = cvt_pk_bf16(v[bj][0].z, v[bj][0].w); w.z = cvt_pk_bf16(v[bj][1].x, v[bj][1].y); w.w = cvt_pk_bf16(v[bj][1].z, v[bj][1].w);
                    *(u32x4*)(rowp + 32 * bj) = w; }
            }
    }
};
struct EpiBf16 { bf16_t* O; int ldo; int pad;
    __device__ __forceinline__ void operator()(const f32x4 (&acc)[2][2][4][2], const Unit& u, int wr, int wc, int fr, int fq, const LAS unsigned char*) const {
        const int row0 = u.pm * 256 + wr * 64 + fr, col0 = u.pn * 256 + wc * 32 + 8 * fq;
#pragma unroll
        for (int ai = 0; ai < 2; ++ai)
#pragma unroll
            for (int m = 0; m < 4; ++m) { bf16_t* rowp = O + (size_t)(row0 + ai * 128 + m * 16) * ldo + col0;
#pragma unroll
                for (int bj = 0; bj < 2; ++bj) { const f32x4 v0 = acc[ai][bj][m][0], v1 = acc[ai][bj][m][1];
                    u32x4 w; w.x = cvt_pk_bf16(v0.x, v0.y); w.y = cvt_pk_bf16(v0.z, v0.w); w.z = cvt_pk_bf16(v1.x, v1.y); w.w = cvt_pk_bf16(v1.z, v1.w);
                    *(u32x4*)(rowp + bj * 128) = w; } }
    }
};
template <bool BASE_BF16, bool F8COPY = false> struct EpiRes { const void* base; bf16_t* outb; float* sq; unsigned char* out8;
    __device__ __forceinline__ void operator()(const f32x4 (&acc)[2][2][4][2], const Unit& u, int wr, int wc, int fr, int fq, const LAS unsigned char*) const {
        const int row0 = u.pm * 256 + wr * 64 + fr, col0 = u.pn * 256 + wc * 32 + 8 * fq;
#pragma unroll
        for (int ai = 0; ai < 2; ++ai)
#pragma unroll
            for (int m = 0; m < 4; ++m) { const int row = row0 + ai * 128 + m * 16; const size_t off = (size_t)row * DM + col0; float ss = 0.f;
#pragma unroll
                for (int bj = 0; bj < 2; ++bj) { f32x4 b0, b1;
                    if constexpr (BASE_BF16) { const u32x4 bb = *(const u32x4*)((const bf16_t*)base + off + bj * 128); b0 = (f32x4){bflo(bb.x), bfhi(bb.x), bflo(bb.y), bfhi(bb.y)}; b1 = (f32x4){bflo(bb.z), bfhi(bb.z), bflo(bb.w), bfhi(bb.w)}; }
                    else { b0 = *(const f32x4*)((const float*)base + off + bj * 128); b1 = *(const f32x4*)((const float*)base + off + bj * 128 + 4); }
                    const f32x4 v0 = acc[ai][bj][m][0] + b0, v1 = acc[ai][bj][m][1] + b1;
                    u32x4 w; w.x = cvt_pk_bf16(v0.x, v0.y); w.y = cvt_pk_bf16(v0.z, v0.w); w.z = cvt_pk_bf16(v1.x, v1.y); w.w = cvt_pk_bf16(v1.z, v1.w);
                    *(u32x4*)(outb + off + bj * 128) = w;
                    if constexpr (F8COPY) { u32x2 w8; w8.x = pk4_fp8(clamp8(v0.x * X8SCALE), clamp8(v0.y * X8SCALE), clamp8(v0.z * X8SCALE), clamp8(v0.w * X8SCALE)); w8.y = pk4_fp8(clamp8(v1.x * X8SCALE), clamp8(v1.y * X8SCALE), clamp8(v1.z * X8SCALE), clamp8(v1.w * X8SCALE)); *(u32x2*)(out8 + off + bj * 128) = w8; }
                    ss += (v0.x * v0.x + v0.y * v0.y) + (v0.z * v0.z + v0.w * v0.w) + (v1.x * v1.x + v1.y * v1.y) + (v1.z * v1.z + v1.w * v1.w); }
                ss += __shfl_xor(ss, 16); ss += __shfl_xor(ss, 32);
                if (fq == 0) sq[((size_t)u.pn * MTOK + row) * 4 + wc] = ss; }
    }
};
struct EpiRstdBf16 { bf16_t* O; const float* sq; int ldo; int pad;
    __device__ __forceinline__ void operator()(const f32x4 (&acc)[2][2][4][2], const Unit& u, int wr, int wc, int fr, int fq, const LAS unsigned char*) const {
        const int row0 = u.pm * 256 + wr * 64 + fr, col0 = u.pn * 256 + wc * 32 + 8 * fq;
#pragma unroll
        for (int ai = 0; ai < 2; ++ai)
#pragma unroll
            for (int m = 0; m < 4; ++m) { const int row = row0 + ai * 128 + m * 16; float s = 0.f;
#pragma unroll
                for (int t = 0; t < 4; ++t) { const f32x4 p = *(const f32x4*)(sq + ((size_t)t * MTOK + row) * 4); s += (p.x + p.y) + (p.z + p.w); }
                const float rstd = 1.0f / sqrtf(s * (1.0f / DM) + EPS);
                bf16_t* rowp = O + (size_t)row * ldo + col0;
#pragma unroll
                for (int bj = 0; bj < 2; ++bj) { const f32x4 v0 = acc[ai][bj][m][0] * rstd, v1 = acc[ai][bj][m][1] * rstd;
                    u32x4 w; w.x = cvt_pk_bf16(v0.x, v0.y); w.y = cvt_pk_bf16(v0.z, v0.w); w.z = cvt_pk_bf16(v1.x, v1.y); w.w = cvt_pk_bf16(v1.z, v1.w);
                    *(u32x4*)(rowp + bj * 128) = w; } }
    }
};
constexpr int LSTRIDE = MTOK;
struct MoeSched {
    const char* A; const char* Bt; size_t estride; const int* list; const float* listv; const float* bias; const LAS unsigned* tab; int K, nN, nblk, G, c, gather, esz, bstride;
    __device__ __forceinline__ bool next(int i, Unit& u) const {
        if (!pg8::static_order(nblk, nN, G, c, i, u.pm, u.pn)) return false;
        int e = 0; while (e < NE - 1 && (int)tab[32 + e + 1] <= u.pm) ++e;
        e = __builtin_amdgcn_readfirstlane(e); u.e = e; u.rbl = u.pm - (int)__builtin_amdgcn_readfirstlane(tab[32 + e]); return true;
    }
    __device__ __forceinline__ const char* a_base(const Unit& u) const { return gather ? A : A + (size_t)u.pm * 256 * K * esz; }
    __device__ __forceinline__ const char* b_base(const Unit& u) const { return Bt + (size_t)u.e * estride + (size_t)u.pn * 256 * K * esz; }
    __device__ __forceinline__ unsigned a_off(const Unit& u) const { return gather ? 0u : (unsigned)u.pm * 256u * (unsigned)(K * esz); }
    __device__ __forceinline__ unsigned b_off(const Unit& u) const { return (unsigned)u.e * (unsigned)estride + (unsigned)u.pn * 256u * (unsigned)(K * esz); }
    __device__ __forceinline__ void issue_rows(const Unit& u, LAS unsigned char* buf, int wid, int lane) const {
        const size_t li = (size_t)u.e * LSTRIDE + u.rbl * 256 + (wid & 3) * 64 + lane;
        if (wid < 4) __builtin_amdgcn_global_load_lds((const unsigned*)(list + li), (LAS unsigned*)(buf + wid * 256), 4, 0, 0);
        else __builtin_amdgcn_global_load_lds((const unsigned*)(listv + li), (LAS unsigned*)(buf + 1024 + (wid - 4) * 256), 4, 0, 0);
        if (wid == 0) __builtin_amdgcn_global_load_lds((const unsigned*)(bias + (size_t)u.e * bstride + u.pn * 256 + lane * 4), (LAS unsigned*)(buf + 2048), 16, 0, 0);
    }
    __device__ __forceinline__ void read_rows(const Unit& u, const LAS unsigned char* buf, int R0, unsigned (&off)[4]) const {
        const int cnt = (int)tab[u.e] - u.rbl * 256;
#pragma unroll
        for (int q = 0; q < 4; ++q) { const int j = R0 + 64 * q; const int v = ((const LAS int*)buf)[j]; const int tok = (j < cnt) ? (v >> 2) : 0; off[q] = (unsigned)tok * (unsigned)(K * esz); }
    }
};
struct EpiSwiglu8 { unsigned char* act; const LAS unsigned* tab;
    __device__ __forceinline__ void operator()(const f32x4 (&acc)[2][2][4][2], const Unit& u, int wr, int wc, int fr, int fq, const LAS unsigned char* meta) const {
        const int cnt = (int)tab[u.e] - u.rbl * 256, c0 = u.pn * 128 + wc * 32 + 8 * fq;
        const LAS f32x4* bp = (const LAS f32x4*)(meta + 2048 + (64 * wc + 16 * fq) * 4); f32x4 bb[4];
#pragma unroll
        for (int i = 0; i < 4; ++i) bb[i] = bp[i];
#pragma unroll
        for (int ai = 0; ai < 2; ++ai)
#pragma unroll
            for (int m = 0; m < 4; ++m) { const int j = ai * 128 + wr * 64 + m * 16 + fr; const float rs = (j < cnt) ? ((const LAS float*)(meta + 1024))[j] * (1.0f / (X8SCALE * W8SCALE)) : 0.f;
                float o[8];
#pragma unroll
                for (int n = 0; n < 2; ++n)
#pragma unroll
                    for (int k = 0; k < 4; ++k) { const int cc = 4 * n + k; const float bg = bb[cc >> 1][(cc & 1) * 2], bl = bb[cc >> 1][(cc & 1) * 2 + 1];
                        const float g = fminf(acc[ai][0][m][n][k] * rs + bg, 7.0f), l = fminf(fmaxf(acc[ai][1][m][n][k] * rs + bl, -7.0f), 7.0f);
                        o[cc] = fminf(fmaxf(g * __builtin_amdgcn_rcpf(1.0f + __builtin_amdgcn_exp2f(-1.702f * LOG2E * g)) * (l + 1.0f) * A8SCALE, -448.0f), 448.0f); }
                u32x2 w; w.x = pk4_fp8(o[0], o[1], o[2], o[3]); w.y = pk4_fp8(o[4], o[5], o[6], o[7]);
                *(u32x2*)(act + (size_t)(u.pm * 256 + j) * DFF + c0) = w; }
    }
};
struct EpiDown8 { unsigned char* ybuf; const LAS unsigned* tab;
    __device__ __forceinline__ void operator()(const f32x4 (&acc)[2][2][4][2], const Unit& u, int wr, int wc, int fr, int fq, const LAS unsigned char* meta) const {
        const int cnt = (int)tab[u.e] - u.rbl * 256, col0 = u.pn * 256 + wc * 32 + 8 * fq; const float isc = Y8SCALE / (A8SCALE * W8SCALE);
        const LAS f32x4* bp = (const LAS f32x4*)(meta + 2048 + (32 * wc + 8 * fq) * 4);
        f32x4 bb[2][2];
#pragma unroll
        for (int bj = 0; bj < 2; ++bj) { bb[bj][0] = bp[bj * 32] * Y8SCALE; bb[bj][1] = bp[bj * 32 + 1] * Y8SCALE; }
#pragma unroll
        for (int ai = 0; ai < 2; ++ai)
#pragma unroll
            for (int m = 0; m < 4; ++m) { const int j = ai * 128 + wr * 64 + m * 16 + fr;
                if (j < cnt) { const int tk = ((const LAS int*)meta)[j]; const float g = ((const LAS float*)(meta + 1024))[j]; unsigned char* rowp = ybuf + (size_t)tk * DM + col0;
#pragma unroll
                    for (int bj = 0; bj < 2; ++bj) { const f32x4 v0 = (acc[ai][bj][m][0] * isc + bb[bj][0]) * g, v1 = (acc[ai][bj][m][1] * isc + bb[bj][1]) * g;
                        u32x2 w; w.x = pk4_fp8(clamp8(v0.x), clamp8(v0.y), clamp8(v0.z), clamp8(v0.w)); w.y = pk4_fp8(clamp8(v1.x), clamp8(v1.y), clamp8(v1.z), clamp8(v1.w));
                        *(u32x2*)(rowp + bj * 128) = w; } } }
    }
};
__device__ __forceinline__ void moe_tables(const unsigned* gcnt, LAS unsigned* tab) {
    const int tid = fresh_tid();
    if (tid < 64) { const unsigned c = tid < NE ? gcnt[tid] : 0u; const unsigned nb = (c + 255u) >> 8; unsigned inc = nb;
#pragma unroll
        for (int o = 1; o < 64; o <<= 1) { const unsigned t = __shfl_up(inc, o); if (tid >= o) inc += t; }
        if (tid < NE) { tab[tid] = c; tab[32 + tid] = inc - nb; } if (tid == NE) tab[32 + NE] = inc - nb; }
    __syncthreads();
}
__device__ __forceinline__ void p7_route(const Frame& F, const bf16_t* __restrict__ hb, const bf16_t* __restrict__ Wrt, const float* __restrict__ sq2, const float* __restrict__ br,
                                         unsigned* gcnt, int* __restrict__ list, float* __restrict__ listg, float* __restrict__ listr) {
    LAS unsigned* lcnt = (LAS unsigned*)(F.lds + RING_OFF); LAS unsigned* lbase = lcnt + 32;
    const int tid = fresh_tid(), lane = tid & 63, tcol = lane & 15, kq = lane >> 4;
    for (int round = blockIdx.x; round < MTOK / 128; round += F.G) {
        if (tid < 32) lcnt[tid] = 0u;
        __syncthreads();
        const int tok = round * 128 + F.wave * 16 + tcol;
        const bf16_t* xp = hb + (size_t)tok * DM + 8 * kq; const bf16_t* w0p = Wrt + (size_t)tcol * DM + 8 * kq; const bf16_t* w1p = w0p + 16 * DM;
        f32x4 a0 = {0.f, 0.f, 0.f, 0.f}, a1 = {0.f, 0.f, 0.f, 0.f};
#pragma unroll 8
        for (int ks = 0; ks < 32; ++ks) { const bf16x8 b = *(const bf16x8*)(xp + 32 * ks), w0 = *(const bf16x8*)(w0p + 32 * ks), w1 = *(const bf16x8*)(w1p + 32 * ks);
            a0 = __builtin_amdgcn_mfma_f32_16x16x32_bf16(w0, b, a0, 0, 0, 0); a1 = __builtin_amdgcn_mfma_f32_16x16x32_bf16(w1, b, a1, 0, 0, 0); }
        float s = 0.f;
#pragma unroll
        for (int t = 0; t < 4; ++t) { const f32x4 p = *(const f32x4*)(sq2 + ((size_t)t * MTOK + tok) * 4); s += (p.x + p.y) + (p.z + p.w); }
        const float rstd = 1.0f / sqrtf(s * (1.0f / DM) + EPS);
        float v[8]; int id[8];
#pragma unroll
        for (int r = 0; r < 4; ++r) { id[r] = 4 * kq + r; id[4 + r] = 16 + 4 * kq + r; v[r] = a0[r] * rstd + br[4 * kq + r]; v[4 + r] = a1[r] * rstd + br[16 + 4 * kq + r]; }
        float tv[4]; int ti[4];
#pragma unroll
        for (int r = 0; r < 4; ++r) { float bv = v[0]; int bi = id[0];
#pragma unroll
            for (int j = 1; j < 8; ++j) if (v[j] > bv) { bv = v[j]; bi = id[j]; }
#pragma unroll
            for (int o = 16; o < 64; o <<= 1) { const float ov = __shfl_xor(bv, o); const int oi = __shfl_xor(bi, o); if (ov > bv || (ov == bv && oi < bi)) { bv = ov; bi = oi; } }
            tv[r] = bv; ti[r] = bi;
#pragma unroll
            for (int j = 0; j < 8; ++j) if (id[j] == bi) v[j] = -3.0e38f; }
        const float e1 = __expf(tv[1] - tv[0]), e2 = __expf(tv[2] - tv[0]), e3 = __expf(tv[3] - tv[0]); const float inv = 1.0f / (1.0f + e1 + e2 + e3);
        unsigned lp[4];
        if (kq == 0) {
#pragma unroll
            for (int k = 0; k < 4; ++k) lp[k] = __hip_atomic_fetch_add(lcnt + ti[k], 1u, __ATOMIC_RELAXED, __HIP_MEMORY_SCOPE_WORKGROUP); }
        __syncthreads();
        if (tid < 32) { const unsigned c = lcnt[tid]; lbase[tid] = c ? __hip_atomic_fetch_add(gcnt + tid, c, __ATOMIC_RELAXED, __HIP_MEMORY_SCOPE_AGENT) : 0u; }
        __syncthreads();
        if (kq == 0) { const float gk[4] = {inv, e1 * inv, e2 * inv, e3 * inv};
#pragma unroll
            for (int k = 0; k < 4; ++k) { const size_t pos = (size_t)ti[k] * LSTRIDE + lbase[ti[k]] + lp[k]; list[pos] = tok * 4 + k; listg[pos] = gk[k]; listr[pos] = rstd; } }
        __syncthreads();
    }
}
__device__ __forceinline__ void p10_combine(const Frame& F, float* __restrict__ out, const bf16_t* __restrict__ x2b, const unsigned char* __restrict__ ybuf) {
    const size_t n8 = (size_t)MTOK * DM / 8;
    for (size_t i = (size_t)blockIdx.x * (NWAVES * 64) + fresh_tid(); i < n8; i += (size_t)F.G * (NWAVES * 64)) {
        const size_t tok = i / (DM / 8), c8 = i % (DM / 8);
        const u32x4 xb = *(const u32x4*)(x2b + i * 8);
        f32x4 s0 = {0.f, 0.f, 0.f, 0.f}, s1 = {0.f, 0.f, 0.f, 0.f};
#pragma unroll
        for (int k = 0; k < 4; ++k) { const u32x2 y = *(const u32x2*)(ybuf + (tok * 4 + k) * DM + c8 * 8);
            const f32x2 a = __builtin_amdgcn_cvt_pk_f32_fp8((int)y.x, false), b = __builtin_amdgcn_cvt_pk_f32_fp8((int)y.x, true), c = __builtin_amdgcn_cvt_pk_f32_fp8((int)y.y, false), d = __builtin_amdgcn_cvt_pk_f32_fp8((int)y.y, true);
            s0.x += a.x; s0.y += a.y; s0.z += b.x; s0.w += b.y; s1.x += c.x; s1.y += c.y; s1.z += d.x; s1.w += d.y; }
        const f32x4 v0 = (f32x4){bflo(xb.x), bfhi(xb.x), bflo(xb.y), bfhi(xb.y)} + s0 * (1.0f / Y8SCALE), v1 = (f32x4){bflo(xb.z), bfhi(xb.z), bflo(xb.w), bfhi(xb.w)} + s1 * (1.0f / Y8SCALE);
        *(f32x4*)(out + i * 8) = v0; *(f32x4*)(out + i * 8 + 4) = v1;
    }
}
typedef short v4i16_t __attribute__((ext_vector_type(4)));
__device__ __forceinline__ v4i16_t lds_tr16(const LAS unsigned char* p) { return __builtin_amdgcn_ds_read_tr16_b64_v4i16((LAS v4i16_t*)p); }
__device__ __forceinline__ bf16x8 cat8(v4i16_t a, v4i16_t b) { return (bf16x8){a[0], a[1], a[2], a[3], b[0], b[1], b[2], b[3]}; }
__device__ __forceinline__ int koff16(int rho) { return (rho & 3) + 8 * (rho >> 2); }

__device__ __forceinline__ void kv_knorm_row(bf16_t* __restrict__ kvmem, const float* __restrict__ xk_g, int row, int lane) {
    bf16_t* kp = kvmem + (size_t)row * (2 * DX) + 8 * lane; const u32x4 kv = *(const u32x4*)kp;
    float v[8] = {bflo(kv.x), bfhi(kv.x), bflo(kv.y), bfhi(kv.y), bflo(kv.z), bfhi(kv.z), bflo(kv.w), bfhi(kv.w)}; float ss = 0.f;
#pragma unroll
    for (int j = 0; j < 8; ++j) ss += v[j] * v[j];
    ss += __shfl_xor(ss, 1); ss += __shfl_xor(ss, 2); ss += __shfl_xor(ss, 4); ss += __shfl_xor(ss, 8);
    const float rstd = 1.0f / sqrtf(ss * (1.0f / XHD) + EPS); const float* gp = xk_g + ((8 * lane) & (XHD - 1)); const f32x4 g0 = *(const f32x4*)gp, g1 = *(const f32x4*)(gp + 4);
    u32x4 w; w.x = cvt_pk_bf16(v[0] * rstd * g0.x, v[1] * rstd * g0.y); w.y = cvt_pk_bf16(v[2] * rstd * g0.z, v[3] * rstd * g0.w); w.z = cvt_pk_bf16(v[4] * rstd * g1.x, v[5] * rstd * g1.y); w.w = cvt_pk_bf16(v[6] * rstd * g1.z, v[7] * rstd * g1.w);
    *(u32x4*)kp = w;
}
__device__ __forceinline__ void p2_attn(const Frame& F, const bf16_t* __restrict__ proj, const float* __restrict__ rel_bias, const float* __restrict__ conv_w,
                                        const float* __restrict__ ga, const float* __restrict__ gb, bf16_t* __restrict__ yb) {
    LAS float* tbl = (LAS float*)(F.lds + TBL_OFF);
    for (int i = fresh_tid(); i < 8 * 384; i += NWAVES * 64) { const int h = i / 384, j = i % 384; int rel = 319 - j; rel = rel < -MAXREL ? -MAXREL : (rel > MAXREL ? MAXREL : rel); tbl[i] = rel_bias[h * NREL + rel + MAXREL] * LOG2E; }
    __syncthreads();
    int lane_ = F.lane; asm volatile("" : "+v"(lane_));
    const int lane = lane_, h = F.wave, r = lane & 31, hi = lane >> 5;
    LAS unsigned char* wbuf = F.lds + RING_OFF + h * 16384;
    LAS float* ssq = (LAS float*)(F.lds + SSQ_OFF);
    const LAS float* tblh = tbl + h * 384;
    const float far_bias = rel_bias[h * NREL + 2 * MAXREL] * LOG2E;
    unsigned kso[2], vso0;
#pragma unroll
    for (int i = 0; i < 2; ++i) { const int key = 8 * i + (lane >> 3), cp = lane & 7; kso[i] = (unsigned)(key * NPROJ + (cp ^ ((key >> 1) & 7)) * 8) * 2u; }
    { const int key = lane >> 3, cp = lane & 7; vso0 = (unsigned)(key * NPROJ + DATT + (cp ^ (((key >> 1) & 1) << 2)) * 8) * 2u; }
    int kaddr[4];
#pragma unroll
    for (int s = 0; s < 4; ++s) kaddr[s] = r * 128 + (((2 * s + hi) ^ ((r >> 1) & 7)) * 16);
    const int G1 = (lane >> 4) & 1, tq = (lane & 15) >> 2, tp = lane & 3;
    int vaddr[2];
#pragma unroll
    for (int db = 0; db < 2; ++db) vaddr[db] = (4 * hi + tq) * 128 + (((4 * db + 2 * G1 + (tp >> 1)) ^ (((tq >> 1) & 1) << 2)) * 16) + (tp & 1) * 8;
#define P2_DMA_K(T_, slot_) do { const char* kp_ = (const char*)(proj + ((size_t)b * SEQ + 32 * (T_)) * NPROJ + DATT + h * 64); \
        _Pragma("unroll") for (int i_ = 0; i_ < 4; ++i_) __builtin_amdgcn_global_load_lds((const unsigned*)(kp_ + (size_t)(i_ >> 1) * (16 * NPROJ * 2) + kso[i_ & 1]), (LAS unsigned*)(wbuf + (slot_) * 4096 + i_ * 1024), 16, 0, 0); } while (0)
#define P2_DMA_V(T_, slot_) do { const char* kp_ = (const char*)(proj + ((size_t)b * SEQ + 32 * (T_)) * NPROJ + DATT + h * 64); \
        _Pragma("unroll") for (int i_ = 0; i_ < 4; ++i_) __builtin_amdgcn_global_load_lds((const unsigned*)(kp_ + (size_t)i_ * (8 * NPROJ * 2) + vso0), (LAS unsigned*)(wbuf + 8192 + (slot_) * 4096 + i_ * 1024), 16, 0, 0); } while (0)
#define P2_QK(dst, ks_) do { const LAS unsigned char* Kp_ = wbuf + (ks_) * 4096; \
        _Pragma("unroll") for (int qb_ = 0; qb_ < 2; ++qb_) _Pragma("unroll") for (int i_ = 0; i_ < 16; ++i_) dst[qb_][i_] = 0.f; \
        _Pragma("unroll") for (int s_ = 0; s_ < 4; ++s_) { const bf16x8 kf_ = *(const LAS bf16x8*)(Kp_ + kaddr[s_]); \
            dst[0] = __builtin_amdgcn_mfma_f32_32x32x16_bf16(kf_, qf[0][s_], dst[0], 0, 0, 0); dst[1] = __builtin_amdgcn_mfma_f32_32x32x16_bf16(kf_, qf[1][s_], dst[1], 0, 0, 0); } } while (0)
    const int upw = (512 + F.G - 1) / F.G;
    for (int ui = 0; ui < upw; ++ui) {
        const int unit = F.vcu * upw + ui; if (unit >= BATCH * (SEQ / CHUNK)) break;
        const int b = unit / (SEQ / CHUNK), c = unit % (SEQ / CHUNK); const size_t row0 = (size_t)b * SEQ + c * CHUNK;
        const int T0 = 2 * (c - LEFT < 0 ? 0 : c - LEFT), nT = 2 * c + 2 - T0;
        int oz = 0; asm volatile("" : "+s"(oz));
        P2_DMA_K(T0, 0); P2_DMA_V(T0, 0); P2_DMA_K(T0 + 1, 1);
        { int lane3 = lane; asm volatile("" : "+v"(lane3));
          const int ch0 = 8 * lane3; const size_t tfirst = row0 + 8 * h; const int sfirst = c * CHUNK + 8 * h;
          u32x4 bgv[8], cgv[8], xvv[8], hc[2], hx[2];
#pragma unroll
          for (int i = 0; i < 8; ++i) { const bf16_t* pr = proj + (tfirst + i) * NPROJ + 3 * DATT + ch0; bgv[i] = *(const u32x4*)pr; cgv[i] = *(const u32x4*)(pr + DCONV); xvv[i] = *(const u32x4*)(pr + 2 * DCONV); }
#pragma unroll
          for (int j = 0; j < 2; ++j) { if (sfirst >= j + 1) { const bf16_t* pr = proj + (tfirst - 1 - j) * NPROJ + 3 * DATT + ch0; hc[j] = *(const u32x4*)(pr + DCONV); hx[j] = *(const u32x4*)(pr + 2 * DCONV); }
              else { hc[j] = (u32x4){0u, 0u, 0u, 0u}; hx[j] = (u32x4){0u, 0u, 0u, 0u}; } }
          f32x4 cwv[3][2], gbq[2];
#pragma unroll
          for (int t = 0; t < 3; ++t) { cwv[t][0] = *(const f32x4*)(conv_w + t * DCONV + ch0); cwv[t][1] = *(const f32x4*)(conv_w + t * DCONV + ch0 + 4); }
          gbq[0] = *(const f32x4*)(gb + ch0); gbq[1] = *(const f32x4*)(gb + ch0 + 4);
#define P2_UNPK(dst, vv_) do { const u32x4 q_ = (vv_); dst[0] = bflo(q_.x); dst[1] = bfhi(q_.x); dst[2] = bflo(q_.y); dst[3] = bfhi(q_.y); dst[4] = bflo(q_.z); dst[5] = bfhi(q_.z); dst[6] = bflo(q_.w); dst[7] = bfhi(q_.w); } while (0)
          float u1[8], u2[8], ta[8], tb[8];
          P2_UNPK(ta, hc[0]); P2_UNPK(tb, hx[0]);
#pragma unroll
          for (int j = 0; j < 8; ++j) u1[j] = ta[j] * tb[j];
          P2_UNPK(ta, hc[1]); P2_UNPK(tb, hx[1]);
#pragma unroll
          for (int j = 0; j < 8; ++j) u2[j] = ta[j] * tb[j];
#pragma unroll
          for (int i = 0; i < 8; ++i) { float u0[8], bgf[8], y[8]; P2_UNPK(ta, cgv[i]); P2_UNPK(tb, xvv[i]); P2_UNPK(bgf, bgv[i]);
              float ss = 0.f;
#pragma unroll
              for (int j = 0; j < 8; ++j) { u0[j] = ta[j] * tb[j]; y[j] = bgf[j] * (cwv[0][j >> 2][j & 3] * u2[j] + cwv[1][j >> 2][j & 3] * u1[j] + cwv[2][j >> 2][j & 3] * u0[j]); ss += y[j] * y[j]; u2[j] = u1[j]; u1[j] = u0[j]; }
              const float rstd = 1.0f / sqrtf(wave_sum(ss) * (1.0f / DCONV) + EPS);
              u32x4 w; w.x = cvt_pk_bf16(y[0] * rstd * gbq[0].x, y[1] * rstd * gbq[0].y); w.y = cvt_pk_bf16(y[2] * rstd * gbq[0].z, y[3] * rstd * gbq[0].w); w.z = cvt_pk_bf16(y[4] * rstd * gbq[1].x, y[5] * rstd * gbq[1].y); w.w = cvt_pk_bf16(y[6] * rstd * gbq[1].z, y[7] * rstd * gbq[1].w);
              *(u32x4*)(yb + (tfirst + i) * DM + DATT + ch0) = w; }
#undef P2_UNPK
        }
        asm volatile("" ::: "memory");
        bf16x8 qf[2][4];
#pragma unroll
        for (int qb = 0; qb < 2; ++qb)
#pragma unroll
            for (int s = 0; s < 4; ++s) qf[qb][s] = *(const bf16x8*)(proj + (row0 + 32 * qb + r) * NPROJ + h * 64 + 16 * s + 8 * hi);
        f32x16 o[2][2];
#pragma unroll
        for (int db = 0; db < 2; ++db)
#pragma unroll
            for (int qb = 0; qb < 2; ++qb)
#pragma unroll
                for (int i = 0; i < 16; ++i) o[db][qb][i] = 0.f;
        float mrun[2] = {-1e30f, -1e30f}, lrun[2] = {0.f, 0.f};
        f32x16 scur[2];
        asm volatile("s_waitcnt vmcnt(0)" ::: "memory");
        P2_QK(scur, 0);
        for (int t = 0; t < nT; ++t) {
            const int T = T0 + t;
            if (t + 2 < nT) { P2_DMA_K(T + 2, t & 1); P2_DMA_V(T + 1, (t + 1) & 1); }
            else if (t + 1 < nT) { P2_DMA_V(T + 1, (t + 1) & 1); }
            if ((T >> 1) >= c - 4) {
#pragma unroll
                for (int qb = 0; qb < 2; ++qb) { const LAS float* tp0 = tblh + (319 - 64 * c - 32 * qb - r + 32 * T + 4 * hi);
#pragma unroll
                    for (int i = 0; i < 16; ++i) scur[qb][i] += tp0[koff16(i)];
                    __builtin_amdgcn_sched_barrier(0); }
            } else {
#pragma unroll
                for (int qb = 0; qb < 2; ++qb)
#pragma unroll
                    for (int i = 0; i < 16; ++i) scur[qb][i] += far_bias;
            }
            float mx[2];
#pragma unroll
            for (int qb = 0; qb < 2; ++qb) { float m_ = scur[qb][0];
#pragma unroll
                for (int i = 1; i < 16; ++i) m_ = fmaxf(m_, scur[qb][i]);
                mx[qb] = fmaxf(m_, __shfl_xor(m_, 32)); }
            if (__any((mx[0] - mrun[0] > 8.0f) || (mx[1] - mrun[1] > 8.0f))) {
#pragma unroll
                for (int qb = 0; qb < 2; ++qb) { const float mn = fmaxf(mrun[qb], mx[qb]), f = __builtin_amdgcn_exp2f(mrun[qb] - mn); mrun[qb] = mn; lrun[qb] *= f;
#pragma unroll
                    for (int i = 0; i < 16; ++i) { o[0][qb][i] *= f; o[1][qb][i] *= f; } }
            }
            bf16x8 pf[2][2];
#pragma unroll
            for (int qb = 0; qb < 2; ++qb) { float ls = 0.f; float p[16];
#pragma unroll
                for (int i = 0; i < 16; ++i) { p[i] = __builtin_amdgcn_exp2f(scur[qb][i] - mrun[qb]); ls += p[i]; }
                lrun[qb] += ls;
#pragma unroll
                for (int ks = 0; ks < 2; ++ks) { u32x4 w; w.x = cvt_pk_bf16(p[8 * ks + 0], p[8 * ks + 1]); w.y = cvt_pk_bf16(p[8 * ks + 2], p[8 * ks + 3]); w.z = cvt_pk_bf16(p[8 * ks + 4], p[8 * ks + 5]); w.w = cvt_pk_bf16(p[8 * ks + 6], p[8 * ks + 7]);
                    pf[qb][ks] = __builtin_bit_cast(bf16x8, w); } }
            __builtin_amdgcn_sched_barrier(0);
            if (t + 2 < nT) asm volatile("s_waitcnt vmcnt(8)" ::: "memory"); else if (t + 1 < nT) asm volatile("s_waitcnt vmcnt(4)" ::: "memory"); else asm volatile("s_waitcnt vmcnt(0)" ::: "memory");
            if (t + 1 < nT) P2_QK(scur, (t + 1) & 1);
            { const LAS unsigned char* Vp = wbuf + 8192 + (t & 1) * 4096;
#pragma unroll
              for (int db = 0; db < 2; ++db)
#pragma unroll
                  for (int ks = 0; ks < 2; ++ks) {
                      const v4i16_t t0 = lds_tr16(Vp + vaddr[db] + (16 * ks) * 128), t1 = lds_tr16(Vp + vaddr[db] + (16 * ks + 8) * 128);
                      const bf16x8 vf = cat8(t0, t1);
                      o[db][0] = __builtin_amdgcn_mfma_f32_32x32x16_bf16(vf, pf[0][ks], o[db][0], 0, 0, 0); o[db][1] = __builtin_amdgcn_mfma_f32_32x32x16_bf16(vf, pf[1][ks], o[db][1], 0, 0, 0);
                      if (ks == 1 && db == 0) __builtin_amdgcn_sched_barrier(0);
                  } }
        }
        int oz2 = 0; asm volatile("" : "+v"(oz2));
        const int r2 = r + oz2;

        LAS float* sq = ssq + (ui & 1) * 512;
#pragma unroll
        for (int qb = 0; qb < 2; ++qb) { const float lt = lrun[qb] + __shfl_xor(lrun[qb], 32); const float inv = 1.0f / lt; float ss = 0.f;
#pragma unroll
            for (int db = 0; db < 2; ++db)
#pragma unroll
                for (int i = 0; i < 16; ++i) { o[db][qb][i] *= inv; ss += o[db][qb][i] * o[db][qb][i]; }
            ss += __shfl_xor(ss, 32);
            if (hi == 0) sq[h * 64 + 32 * qb + r] = ss; }
        f32x4 gg[2][4];
#pragma unroll
        for (int db = 0; db < 2; ++db)
#pragma unroll
            for (int g4 = 0; g4 < 4; ++g4) gg[db][g4] = *(const f32x4*)(ga + oz2 + h * 64 + 32 * db + 8 * g4 + 4 * hi);
        __syncthreads();
#pragma unroll
        for (int qb = 0; qb < 2; ++qb) { float tot = 0.f;
#pragma unroll
            for (int hh = 0; hh < 8; ++hh) tot += sq[hh * 64 + 32 * qb + r];
            const float rstd = 1.0f / sqrtf(tot * (1.0f / DATT) + EPS);
            bf16_t* orow = yb + (row0 + 32 * qb + r2) * DM + h * 64;
#pragma unroll
            for (int db = 0; db < 2; ++db)
#pragma unroll
                for (int g4 = 0; g4 < 4; ++g4) { const int d0 = 32 * db + 8 * g4 + 4 * hi; const f32x4 g_ = gg[db][g4];
                    u32x2 w; w.x = cvt_pk_bf16(o[db][qb][4 * g4 + 0] * rstd * g_.x, o[db][qb][4 * g4 + 1] * rstd * g_.y); w.y = cvt_pk_bf16(o[db][qb][4 * g4 + 2] * rstd * g_.z, o[db][qb][4 * g4 + 3] * rstd * g_.w);
                    *(u32x2*)(orow + d0) = w; } }
    }
#undef P2_DMA_K
#undef P2_DMA_V
#undef P2_QK
    __syncthreads();
}
__device__ __forceinline__ void p5_xattn(const Frame& F, const bf16_t* __restrict__ qx, const bf16_t* __restrict__ kvmem, const float* __restrict__ xq_g, bf16_t* __restrict__ ox) {
    const int ptid = fresh_tid(), lane = ptid & 63, r = lane & 31, hi = lane >> 5;
    LAS unsigned char* Kl = F.lds + RING_OFF; LAS unsigned char* Vl = Kl + 256 * 272;
    const int G1 = (lane >> 4) & 1, tq = (lane & 15) >> 2, tp = lane & 3;
    const float XS = 0.08838834764831845f * LOG2E;
    const int upw = (512 + F.G - 1) / F.G; int cur_bh = -1;
    for (int ui = 0; ui < upw; ++ui) {
        const int unit = F.vcu * upw + ui; if (unit >= BATCH * XH * 8) break;
        const int bh = unit >> 3, qt = unit & 7, b = bh >> 2, h = bh & 3;
        if (bh != cur_bh) {
            __syncthreads();
            const bf16_t* src = kvmem + (size_t)b * NMEM * (2 * DX) + h * XHD;
#pragma unroll
            for (int i = 0; i < 8; ++i) { const int ci = ptid + 512 * i, key = ci >> 4, ch = ci & 15;
                const u32x4 kv = *(const u32x4*)(src + (size_t)key * (2 * DX) + ch * 8), vv = *(const u32x4*)(src + (size_t)key * (2 * DX) + DX + ch * 8);
                *(LAS u32x4*)(Kl + key * 272 + ch * 16) = kv; *(LAS u32x4*)(Vl + key * 256 + ((ch ^ ((key & 3) << 2)) * 16)) = vv; }
            __syncthreads();
            cur_bh = bh;
        }
        const size_t qrow = (size_t)b * SEQ + qt * 256 + F.wave * 32 + r;
        bf16x8 qf[8];
        { u32x4 raw[8]; float ss = 0.f;
#pragma unroll
          for (int s = 0; s < 8; ++s) { raw[s] = *(const u32x4*)(qx + qrow * DX + h * XHD + 16 * s + 8 * hi);
              const float a0 = bflo(raw[s].x), a1 = bfhi(raw[s].x), a2 = bflo(raw[s].y), a3 = bfhi(raw[s].y), a4 = bflo(raw[s].z), a5 = bfhi(raw[s].z), a6 = bflo(raw[s].w), a7 = bfhi(raw[s].w);
              ss += (a0 * a0 + a1 * a1) + (a2 * a2 + a3 * a3) + (a4 * a4 + a5 * a5) + (a6 * a6 + a7 * a7); }
          ss += __shfl_xor(ss, 32);
          const float rs = XS / sqrtf(ss * (1.0f / XHD) + EPS);
#pragma unroll
          for (int s = 0; s < 8; ++s) { const f32x4 g0 = *(const f32x4*)(xq_g + 16 * s + 8 * hi), g1 = *(const f32x4*)(xq_g + 16 * s + 8 * hi + 4);
              u32x4 w; w.x = cvt_pk_bf16(bflo(raw[s].x) * rs * g0.x, bfhi(raw[s].x) * rs * g0.y); w.y = cvt_pk_bf16(bflo(raw[s].y) * rs * g0.z, bfhi(raw[s].y) * rs * g0.w);
              w.z = cvt_pk_bf16(bflo(raw[s].z) * rs * g1.x, bfhi(raw[s].z) * rs * g1.y); w.w = cvt_pk_bf16(bflo(raw[s].w) * rs * g1.z, bfhi(raw[s].w) * rs * g1.w);
              qf[s] = __builtin_bit_cast(bf16x8, w); } }
        f32x16 o[4];
#pragma unroll
        for (int db = 0; db < 4; ++db)
#pragma unroll
            for (int i = 0; i < 16; ++i) o[db][i] = 0.f;
        float mrun = -1e30f, lrun = 0.f;
        const LAS unsigned char* kbase = Kl + r * 272 + hi * 16;
        const LAS unsigned char* vbase[4];
#pragma unroll
        for (int db = 0; db < 4; ++db) vbase[db] = Vl + (4 * hi + tq) * 256 + ((4 * (db ^ tq) + 2 * G1 + (tp >> 1)) * 16) + (tp & 1) * 8;
#pragma unroll 1
        for (int t = 0; t < 4; ++t) {
            f32x16 sacc[2];
#pragma unroll
            for (int kb = 0; kb < 2; ++kb) {
#pragma unroll
                for (int i = 0; i < 16; ++i) sacc[kb][i] = 0.f;
#pragma unroll
                for (int s = 0; s < 8; ++s) { const bf16x8 kf = *(const LAS bf16x8*)(kbase + (64 * t + 32 * kb) * 272 + 32 * s);
                    sacc[kb] = __builtin_amdgcn_mfma_f32_32x32x16_bf16(kf, qf[s], sacc[kb], 0, 0, 0); } }
            float mx = sacc[0][0];
#pragma unroll
            for (int i = 1; i < 16; ++i) mx = fmaxf(mx, sacc[0][i]);
#pragma unroll
            for (int i = 0; i < 16; ++i) mx = fmaxf(mx, sacc[1][i]);
            mx = fmaxf(mx, __shfl_xor(mx, 32));
            const float mn = fmaxf(mrun, mx), f = __builtin_amdgcn_exp2f(mrun - mn); mrun = mn;
            float ls = 0.f; bf16x8 pf[2][2];
#pragma unroll
            for (int kb = 0; kb < 2; ++kb) { float p[16];
#pragma unroll
                for (int i = 0; i < 16; ++i) { p[i] = __builtin_amdgcn_exp2f(sacc[kb][i] - mn); ls += p[i]; }
#pragma unroll
                for (int ks = 0; ks < 2; ++ks) { u32x4 w; w.x = cvt_pk_bf16(p[8 * ks + 0], p[8 * ks + 1]); w.y = cvt_pk_bf16(p[8 * ks + 2], p[8 * ks + 3]); w.z = cvt_pk_bf16(p[8 * ks + 4], p[8 * ks + 5]); w.w = cvt_pk_bf16(p[8 * ks + 6], p[8 * ks + 7]);
                    pf[kb][ks] = __builtin_bit_cast(bf16x8, w); } }
            lrun = lrun * f + ls;
#pragma unroll
            for (int db = 0; db < 4; ++db)
#pragma unroll
                for (int i = 0; i < 16; ++i) o[db][i] *= f;
#pragma unroll
            for (int db = 0; db < 4; ++db)
#pragma unroll
                for (int kb = 0; kb < 2; ++kb)
#pragma unroll
                    for (int ks = 0; ks < 2; ++ks) { const int ko = (64 * t + 32 * kb + 16 * ks) * 256;
                        const v4i16_t t0 = lds_tr16(vbase[db] + ko), t1 = lds_tr16(vbase[db] + ko + 8 * 256);
                        o[db] = __builtin_amdgcn_mfma_f32_32x32x16_bf16(cat8(t0, t1), pf[kb][ks], o[db], 0, 0, 0); }
        }
        const float lt = lrun + __shfl_xor(lrun, 32); const float inv = 1.0f / lt;
        bf16_t* orow = ox + qrow * DX + h * XHD;
#pragma unroll
        for (int db = 0; db < 4; ++db)
#pragma unroll
            for (int g4 = 0; g4 < 4; ++g4) { const int d0 = 32 * db + 8 * g4 + 4 * hi;
                u32x2 w; w.x = cvt_pk_bf16(o[db][4 * g4 + 0] * inv, o[db][4 * g4 + 1] * inv); w.y = cvt_pk_bf16(o[db][4 * g4 + 2] * inv, o[db][4 * g4 + 3] * inv);
                *(u32x2*)(orow + d0) = w; }
    }
    __syncthreads();
}

#ifndef QSCALE_V
#define QSCALE_V (0.125f * LOG2E)
#endif
typedef __attribute__((address_space(4))) const Args* KArgP;
__device__ __forceinline__ KArgP kargs() { KArgP p = (KArgP)__builtin_amdgcn_kernarg_segment_ptr(); asm volatile("" : "+s"(p)); return p; }
#define AIN(k) (kargs()->in[k])
__global__ void __launch_bounds__(NWAVES * 64, 2) mk_fwd(Args args) {
    extern __shared__ __attribute__((aligned(16))) unsigned char lds_raw[];
    Frame F; F.lds = (LAS unsigned char*)lds_raw; F.tid = threadIdx.x; F.lane = F.tid & 63; F.wave = __builtin_amdgcn_readfirstlane(F.tid >> 6); F.G = gridDim.x;
    { const int bx = blockIdx.x; F.vcu = (F.G % 8 == 0) ? (bx % 8) * (F.G / 8) + bx / 8 : bx; }

    for (int u = F.tid; u < (LDS_BYTES - LDSCTL_OFF) / 4; u += NWAVES * 64) ((LAS unsigned*)(F.lds + LDSCTL_OFF))[u] = 0u;
    __syncthreads();
    volatile LAS unsigned* MISC = (volatile LAS unsigned*)(F.lds + MISC_OFF);
    (void)xcd_barrier_post((unsigned*)(kargs()->ws + WS_CTL) + CW_BAR + kargs()->li * XCD_BAR_WORDS, MISC + 8);
#define GRID_BARRIER() do { XcdBarrier bar_; bar_.bar = (unsigned*)(kargs()->ws + WS_CTL) + CW_BAR + kargs()->li * XCD_BAR_WORDS; bar_.x = xb_xcc_id(); bar_.st = (volatile LAS unsigned*)(F.lds + MISC_OFF) + 8; xcd_barrier(bar_); } while (0)
    const int lo = kargs()->ph_lo, hi = kargs()->ph_hi;
#define IN(k) (lo <= (k) && (k) < hi)
#define BOTH(k) (IN(k) && IN((k) + 1))
#define WSP(T, off) ((T*)(kargs()->ws + (off)))
#define Win WSP(bf16_t, WS_WIN)
#define Wxkv WSP(bf16_t, WS_WXKV)
#define Wout WSP(bf16_t, WS_WOUT)
#define Wxq WSP(bf16_t, WS_WXQ)
#define Wxo WSP(bf16_t, WS_WXO)
#define yb WSP(bf16_t, WS_YB)
#define qx WSP(bf16_t, WS_QX)
#define ox WSP(bf16_t, WS_OX)
#define sq1 WSP(float, WS_SQ1)
#define sq2 WSP(float, WS_SQ2)
#define listr WSP(float, WS_LISTR)
#define listg WSP(float, WS_LISTG)
#define Wrt WSP(bf16_t, WS_WRT)
#define ybuf WSP(bf16_t, WS_YBUF)
#define Wgu8 WSP(unsigned char, WS_WGU)
#define Wdn8 WSP(unsigned char, WS_WDN)
#define x2f8 WSP(unsigned char, WS_QX)
#define act8 WSP(unsigned char, WS_ACT)
#define list WSP(int, WS_LIST)
#define hb WSP(bf16_t, WS_HB)
#define hmb WSP(bf16_t, WS_HMB)
#define proj WSP(bf16_t, WS_PROJ)
#define kvmem WSP(bf16_t, WS_KVMEM)
    LAS unsigned* mtab = (LAS unsigned*)(F.lds + MOE_OFF);
    const int gw = F.vcu * NWAVES + F.wave, NGW = F.G * NWAVES;

    if (IN(0)) {
        const int plane = fresh_tid() & 63;
        LAS float* scr = (LAS float*)(F.lds + RING_OFF + F.wave * 17408);
        constexpr int IT_IN = (DM / 64) * (NPROJ / 64), IT_XKV = (DM / 64) * (2 * DX / 64), IT_OUT = (DM / 64) * (DM / 64), IT_XQ = (DM / 64) * (DX / 64), IT_XO = (DX / 64) * (DM / 64), IT_RT = DM / 64,
                      GU_PER_E = (DM / 64) * (2 * DFF / 64), DN_PER_E = (DFF / 64) * (DM / 64), IT_GU = NE * GU_PER_E, IT_DN = NE * DN_PER_E;
        {
            auto decode = [&](int r) -> F8Item { F8Item I;
                if (r < IT_GU) { const int e = r / GU_PER_E, rr = r % GU_PER_E, kb = rr / (2 * DFF / 64), nb = rr % (2 * DFF / 64), c0 = 32 * nb, pn = c0 >> 7;
                    I.W = AIN(I_W_GU) + (size_t)e * DM * 2 * DFF; I.WT = Wgu8 + (size_t)e * 2 * DFF * DM; I.g = AIN(I_NORM_FFN_G); I.ldw = 2 * DFF; I.k0 = 64 * kb; I.n0 = 64 * nb; I.drow0 = 256 * pn + (c0 & 127); I.mode = 2; }
                else { r -= IT_GU; const int e = r / DN_PER_E, rr = r % DN_PER_E, kb = rr / (DM / 64), nb = rr % (DM / 64);
                    I.W = AIN(I_W_DN) + (size_t)e * DFF * DM; I.WT = Wdn8 + (size_t)e * DM * DFF; I.g = nullptr; I.ldw = DM; I.k0 = 64 * kb; I.n0 = 64 * nb; I.drow0 = 64 * nb; I.mode = 0; }
                return I; };
            int it = gw; F8Item A{}, B{}; f32x4 va[16], vb[16];
            if (it < IT_GU + IT_DN) { A = decode(it); p0_f8_load(A, va, plane); }
            while (it < IT_GU + IT_DN) { const int nit = it + NGW;
                if (nit < IT_GU + IT_DN) { B = decode(nit); p0_f8_load(B, vb, plane); }
                p0_f8_store(A, va, DM, W8SCALE, scr, plane);
                A = B; it = nit;
#pragma unroll
                for (int i = 0; i < 16; ++i) va[i] = vb[i]; }
        }
        for (int it = gw; it < IT_IN + IT_XKV + IT_OUT + IT_XQ + IT_XO + IT_RT; it += NGW) {
            int r = it;
            if (r < IT_IN) { const int kb = r / (NPROJ / 64), nb = r % (NPROJ / 64); const int pn = nb >> 2, wc = nb & 3;
                p0_transpose64<1>(AIN(I_W_IN), NPROJ, DM, Win, 64 * kb, 64 * nb, 256 * pn + 32 * wc, nullptr, scr, plane); continue; }
            r -= IT_IN;
            if (r < IT_XKV) { const int kb = r / (2 * DX / 64), nb = r % (2 * DX / 64);
                p0_transpose64<0>(AIN(I_W_XKV), 2 * DX, DM, Wxkv, 64 * kb, 64 * nb, 64 * nb, nullptr, scr, plane); continue; }
            r -= IT_XKV;
            if (r < IT_OUT) { const int kb = r / (DM / 64), nb = r % (DM / 64);
                p0_transpose64<0>(AIN(I_W_OUT), DM, DM, Wout, 64 * kb, 64 * nb, 64 * nb, nullptr, scr, plane); continue; }
            r -= IT_OUT;
            if (r < IT_XQ) { const int kb = r / (DX / 64), nb = r % (DX / 64);
                p0_transpose64<0>(AIN(I_W_XQ), DX, DM, Wxq, 64 * kb, 64 * nb, 64 * nb, AIN(I_NORM_X_G), scr, plane); continue; }
            r -= IT_XQ;
            if (r < IT_XO) { const int kb = r / (DM / 64), nb = r % (DM / 64);
                p0_transpose64<0>(AIN(I_W_XO), DM, DX, Wxo, 64 * kb, 64 * nb, 64 * nb, nullptr, scr, plane); continue; }
            r -= IT_XO;
            p0_transpose_item(AIN(I_W_ROUTER), NE, DM, Wrt, 64 * r, 0, 1, 0, AIN(I_NORM_FFN_G), scr, plane);
        }
        for (int m = gw; m < MTOK; m += NGW) rms_row_to_bf16(AIN(I_X) + (size_t)m * DM, AIN(I_NORM_MIX_G), hb + (size_t)m * DM, plane);
        for (int m = gw; m < MMEM; m += NGW) rms_row_to_bf16(AIN(I_MEM) + (size_t)m * DM, AIN(I_NORM_MEM_G), hmb + (size_t)m * DM, plane);
        if (BOTH(0)) GRID_BARRIER();
    }
    if (IN(1)) {
        { pg8::DenseSched S; S.init(hb, Win, MTOK, NPROJ, DM, F.G, (int)blockIdx.x); EpiProj E{proj, AIN(I_Q_G), AIN(I_K_G), QSCALE_V, 0};
          pg8::gemm_phase<EpiProj, pg8::DenseSched, 0>(F.lds + RING_OFF, F.lds + IDX_OFF, S, E); }
        if (F.G != 256) { pg8::DenseSched S; S.init(hmb, Wxkv, MMEM, 2 * DX, DM, F.G, (int)blockIdx.x); EpiBf16 E{kvmem, 2 * DX, 0};
          pg8::gemm_phase<EpiBf16, pg8::DenseSched, 0>(F.lds + RING_OFF, F.lds + IDX_OFF, S, E); }
        if (BOTH(1)) GRID_BARRIER();
    }
    if (IN(2)) {
        if (F.G == 256) {
            const int bq = F.vcu >> 4, cls = F.vcu & 15;
            if (cls < 3) { pg8::ListSched S{(const char*)hmb, (const char*)Wxkv, DM, 2 * DX / 256, cls == 0 ? 2 * bq : 16 + 16 * cls + bq, cls == 0 ? 2 : 1}; EpiBf16 E{kvmem, 2 * DX, 0};
                pg8::gemm_phase<EpiBf16, pg8::ListSched, 0>(F.lds + RING_OFF, F.lds + IDX_OFF, S, E); }
        }
        p2_attn(F, proj, AIN(I_REL_BIAS), AIN(I_CONV_W), AIN(I_ONA_G), AIN(I_ONB_G), yb);
        if (BOTH(2)) GRID_BARRIER();
    }
    if (IN(3)) {
        for (int m = gw; m < MMEM; m += NGW) kv_knorm_row(kvmem, AIN(I_XK_G), m, fresh_tid() & 63);
        pg8::DenseSched S; S.init(yb, Wout, MTOK, DM, DM, F.G, (int)blockIdx.x); EpiRes<false> E{AIN(I_X), hb, sq1, nullptr};
        pg8::gemm_phase<EpiRes<false>, pg8::DenseSched, 0>(F.lds + RING_OFF, F.lds + IDX_OFF, S, E);
        if (BOTH(3)) GRID_BARRIER();
    }
    if (IN(4)) {
        pg8::DenseSched S; S.init(hb, Wxq, MTOK, DX, DM, F.G, (int)blockIdx.x); EpiRstdBf16 E{qx, sq1, DX, 0};
        pg8::gemm_phase<EpiRstdBf16, pg8::DenseSched, 0>(F.lds + RING_OFF, F.lds + IDX_OFF, S, E);
        if (BOTH(4)) GRID_BARRIER();
    }
    if (IN(5)) {
        p5_xattn(F, qx, kvmem, AIN(I_XQ_G), ox);
        if (BOTH(5)) GRID_BARRIER();
    }
    if (IN(6)) {
        pg8::DenseSched S; S.init(ox, Wxo, MTOK, DM, DX, F.G, (int)blockIdx.x); EpiRes<true, true> E{hb, hb, sq2, x2f8};
        pg8::gemm_phase<EpiRes<true, true>, pg8::DenseSched, 0>(F.lds + RING_OFF, F.lds + IDX_OFF, S, E);
        if (BOTH(6)) GRID_BARRIER();
    }
    if (IN(7)) {
        p7_route(F, hb, Wrt, sq2, AIN(I_B_ROUTER), (unsigned*)(kargs()->ws + WS_CTL) + CW_CNT, list, listg, listr);
        if (BOTH(7)) GRID_BARRIER();
    }
    if (IN(8)) {
        moe_tables((unsigned*)(kargs()->ws + WS_CTL) + CW_CNT, mtab);
        MoeSched S{(const char*)x2f8, (const char*)Wgu8, (size_t)2 * DFF * DM, list, listr, AIN(I_B_GU), mtab, DM, 2 * DFF / 256, (int)mtab[32 + NE], F.G, (int)blockIdx.x, 1, 1, 2 * DFF};
        EpiSwiglu8 E{act8, mtab};
        pg8::gemm_phase_f8<EpiSwiglu8, MoeSched, 2>(F.lds + RING_OFF, F.lds + IDX_OFF, S, E);
        if (BOTH(8)) GRID_BARRIER();
    }
    if (IN(9)) {
        moe_tables((unsigned*)(kargs()->ws + WS_CTL) + CW_CNT, mtab);
        MoeSched S{(const char*)act8, (const char*)Wdn8, (size_t)DM * DFF, list, listg, AIN(I_B_DN), mtab, DFF, DM / 256, (int)mtab[32 + NE], F.G, (int)blockIdx.x, 0, 1, DM};
        EpiDown8 E{(unsigned char*)ybuf, mtab};
        pg8::gemm_phase_f8<EpiDown8, MoeSched, 1>(F.lds + RING_OFF, F.lds + IDX_OFF, S, E);
        if (BOTH(9)) GRID_BARRIER();
    }
    if (IN(10)) p10_combine(F, kargs()->out, hb, (const unsigned char*)ybuf);
#undef IN
#undef BOTH
#undef GRID_BARRIER
#undef WSP
#undef Win
#undef Wxkv
#undef Wout
#undef Wxq
#undef Wxo
#undef yb
#undef qx
#undef ox
#undef sq1
#undef sq2
#undef listr
#undef listg
#undef Wrt
#undef ybuf
#undef Wgu8
#undef Wdn8
#undef x2f8
#undef act8
#undef list
#undef hb
#undef hmb
#undef proj
#undef kvmem
}

static int g_grid = 0;
static void launch_mk(Args& a, int lo, int hi, int li, hipStream_t stream) {
    a.ph_lo = lo; a.ph_hi = hi; a.li = li; a.pad = 0;
    hipLaunchKernelGGL(mk_fwd, dim3(g_grid), dim3(NWAVES * 64), LDS_BYTES, stream, a);
}
extern "C" void kernel_launch(void* const* d_in, const int* in_sizes, int n_in, void* d_out, int out_size, void* d_ws, size_t ws_size, hipStream_t stream) {
    if (n_in != 25 || ws_size < WS_END || out_size != MTOK * DM) { fprintf(stderr, "kernel_launch: unexpected problem (n_in %d ws %zu out %d)\n", n_in, ws_size, out_size); return; }
    if (g_grid == 0) {
        int dev = 0, cus = 0;
        if (hipGetDevice(&dev) != hipSuccess || hipDeviceGetAttribute(&cus, hipDeviceAttributeMultiprocessorCount, dev) != hipSuccess) { g_grid = -1; return; }
        if (hipFuncSetAttribute((const void*)mk_fwd, hipFuncAttributeMaxDynamicSharedMemorySize, LDS_BYTES) != hipSuccess) { g_grid = -1; return; }
        int per_cu = 0; (void)hipOccupancyMaxActiveBlocksPerMultiprocessor(&per_cu, (const void*)mk_fwd, NWAVES * 64, LDS_BYTES); (void)hipGetLastError();
        g_grid = (per_cu >= 1) ? cus : -1;
    }
    if (g_grid < 0) return;
    unsigned char* ws = (unsigned char*)d_ws; float* out = (float*)d_out; unsigned* ctl = (unsigned*)(ws + WS_CTL);
    (void)hipMemsetAsync(ctl, 0, CTL_ZERO_BYTES, stream);
    Args a{}; for (int i = 0; i < 25; ++i) a.in[i] = (const float*)d_in[i]; a.out = out; a.ws = ws;
    launch_mk(a, 0, 11, 0, stream);
}
```

```cpp
#include <hip/hip_runtime.h>
#include <stdint.h>
#include <stdio.h>

#define LAS __attribute__((address_space(3)))
#define GAS __attribute__((address_space(1)))
typedef unsigned short bf16_t;
typedef short bf16x8 __attribute__((ext_vector_type(8)));
typedef float f32x4 __attribute__((ext_vector_type(4)));
typedef float f32x2 __attribute__((ext_vector_type(2)));
typedef float f32x16 __attribute__((ext_vector_type(16)));
typedef float f32x8 __attribute__((ext_vector_type(8)));
typedef unsigned u32x4 __attribute__((ext_vector_type(4)));
typedef unsigned u32x2 __attribute__((ext_vector_type(2)));
typedef int v8i32 __attribute__((ext_vector_type(8)));
typedef int v4i32 __attribute__((ext_vector_type(4)));
typedef int v2i32 __attribute__((ext_vector_type(2)));

constexpr int DM = 1024, BATCH = 16, SEQ = 2048, MTOK = BATCH * SEQ;
constexpr int CHUNK = 64, LEFT = 8, NMEM = 256, MMEM = BATCH * NMEM;
constexpr int DATT = 512, DCONV = 512, NPROJ = 3072;
constexpr int XH = 4, XHD = 128, DX = 512;
constexpr int NE = 32, TOPK = 4, DFF = 1024;
constexpr int NREL = 513, MAXREL = 256;
constexpr int NASSIGN = MTOK * TOPK;
constexpr int MAXSLOT = NASSIGN + NE * 256;
constexpr float EPS = 1e-6f;
constexpr float LOG2E = 1.4426950408889634f;

constexpr size_t MiB = 1u << 20;
constexpr size_t WS_CTL = 0, CTL_ZERO_BYTES = 256 * 1024;
constexpr size_t WS_WIN = 1 * MiB, WS_WOUT = 7 * MiB, WS_WXQ = 9 * MiB, WS_WXKV = 10 * MiB, WS_WXO = 12 * MiB, WS_WGU = 13 * MiB, WS_WDN = 141 * MiB;
constexpr size_t WS_HB = 205 * MiB, WS_HMB = 269 * MiB;
constexpr size_t WS_LIST = 277 * MiB, WS_GATE = 281 * MiB, WS_SLOTTK = 282 * MiB, WS_SLOTSRC = 283 * MiB, WS_BLKE = 284 * MiB;
constexpr size_t WS_PROJ = 285 * MiB, WS_KVMEM = 477 * MiB, WS_YA = 485 * MiB, WS_YB = 549 * MiB, WS_X1 = 613 * MiB, WS_QX = 741 * MiB, WS_OX = 773 * MiB;
constexpr size_t WS_ACT = 285 * MiB, WS_YBUF = 557 * MiB, WS_X2F6 = 700 * MiB;
constexpr size_t WS_SQ1 = 813 * MiB, WS_SQ2 = 815 * MiB, WS_RSTD2 = 817 * MiB, WS_WRT = 818 * MiB, WS_LISTR = 819 * MiB, WS_LISTG = 824 * MiB, WS_END = 829 * MiB;
constexpr int CW_CNT = 0, CW_NBLK = 64, CW_PSTART = 128;
constexpr int CW_GMASK = 512;
constexpr int CW_GBAR = 1024;
constexpr int CW_BAR = 4096;

__device__ __forceinline__ unsigned f2bf(float f) { unsigned u = __builtin_bit_cast(unsigned, f); return (u + 0x7fffu + ((u >> 16) & 1u)) >> 16; }
__device__ __forceinline__ float bf2f(bf16_t b) { return __builtin_bit_cast(float, ((unsigned)b) << 16); }
__device__ __forceinline__ unsigned pk2(float lo, float hi) { return f2bf(lo) | (f2bf(hi) << 16); }
__device__ __forceinline__ float bflo(unsigned w) { return __builtin_bit_cast(float, w << 16); }
__device__ __forceinline__ float bfhi(unsigned w) { return __builtin_bit_cast(float, w & 0xffff0000u); }
__device__ __forceinline__ float wave_sum(float v) {
#pragma unroll
    for (int o = 1; o < 64; o <<= 1) v += __shfl_xor(v, o);
    return v;
}
__device__ __forceinline__ unsigned cvt_pk_bf16(float lo, float hi) { unsigned r; asm volatile("v_cvt_pk_bf16_f32 %0, %1, %2" : "=v"(r) : "v"(lo), "v"(hi)); return r; }
__device__ __forceinline__ v8i32 cat6(v2i32 a, v2i32 b, v2i32 c) { return (v8i32){a.x, a.y, b.x, b.y, c.x, c.y, 0, 0}; }
__device__ __forceinline__ v8i32 cat6h(v4i32 h, v2i32 t) { return (v8i32){h.x, h.y, h.z, h.w, t.x, t.y, 0, 0}; }
typedef unsigned u32x6 __attribute__((ext_vector_type(6)));

namespace pg8 {
constexpr int BM = 256, BK = 64, HALF = 128, HTB = HALF * BK * 2  , STAGE_BYTES = 8 * HTB, NXCD = 8, WGM = 8;
__host__ __device__ __forceinline__ int lds_byte(int r, int c) { const int st = (r >> 4) * 2 + (c >> 5), rr = r & 15, cc = c & 31, ob = rr * 64 + cc * 2; return st * 1024 + (ob ^ (((ob >> 9) & 1) << 5)); }
__host__ __device__ __forceinline__ void stage_rc(int b, int& R, int& C) { const int st = b / 1024, sb = b % 1024, swz = sb ^ (((sb >> 9) & 1) << 5); R = (st >> 1) * 16 + swz / 64; C = (st & 1) * 32 + (swz % 64) / 2; }
__host__ __device__ __forceinline__ int perm32(int rho) { const int n = rho >> 4, i = rho & 15; return 8 * (i >> 2) + 4 * n + (i & 3); }

struct Unit { int pm, pn, e, rbl; };

__device__ __forceinline__ bool static_order(int nM, int nN, int G, int c, int i, int& pm, int& pn) {
    const int nwg = nM * nN; const long L = (long)i * G + c; if (L >= nwg) return false;
    int wgid = (int)L; { const int q = nwg / NXCD, r = nwg % NXCD, xcd = wgid % NXCD, off = wgid / NXCD; wgid = (xcd < r ? xcd * (q + 1) : r * (q + 1) + (xcd - r) * q) + off; }
    const int nig = WGM * nN, gid = wgid / nig, fm = gid * WGM, gsz = (nM - fm) < WGM ? (nM - fm) : WGM;
    pm = fm + ((wgid % nig) % gsz); pn = (wgid % nig) / gsz; return true;
}
struct DenseSched {
    const char* A; const char* Bt; int K, nM, nN, G, c, i0, cnt;
    __device__ __forceinline__ void init(const void* A_, const void* Bt_, int M, int N, int K_, int G_, int c_) { A = (const char*)A_; Bt = (const char*)Bt_; K = K_; nM = M / BM; nN = N / BM; G = G_; c = c_; i0 = 0; cnt = 1 << 30; }
    __device__ __forceinline__ bool next(int i, Unit& u) const { u.e = 0; u.rbl = 0; if (i >= cnt) return false; return static_order(nM, nN, G, c, i0 + i, u.pm, u.pn); }
    __device__ __forceinline__ const char* a_base(const Unit& u) const { return A + (size_t)u.pm * BM * K * 2; }
    __device__ __forceinline__ const char* b_base(const Unit& u) const { return Bt + (size_t)u.pn * BM * K * 2; }
    __device__ __forceinline__ unsigned a_off(const Unit& u) const { return (unsigned)u.pm * BM * K; }
    __device__ __forceinline__ unsigned b_off(const Unit& u) const { return (unsigned)u.pn * BM * K; }
    __device__ __forceinline__ void issue_rows(const Unit&, LAS unsigned char*, int, int) const {}
    __device__ __forceinline__ void read_rows(const Unit&, const LAS unsigned char*, int, unsigned (&)[4]) const {}
};

struct ListSched {
    const char* A; const char* Bt; int K, nN, id0, cnt;
    __device__ __forceinline__ bool next(int i, Unit& u) const { if (i >= cnt) return false; const int id = id0 + i; u.pm = id / nN; u.pn = id % nN; u.e = 0; u.rbl = 0; return true; }
    __device__ __forceinline__ const char* a_base(const Unit& u) const { return A + (size_t)u.pm * BM * K * 2; }
    __device__ __forceinline__ const char* b_base(const Unit& u) const { return Bt + (size_t)u.pn * BM * K * 2; }
    __device__ __forceinline__ void issue_rows(const Unit&, LAS unsigned char*, int, int) const {}
    __device__ __forceinline__ void read_rows(const Unit&, const LAS unsigned char*, int, unsigned (&)[4]) const {}
};

template <class Epi, class Sched, int MODE>
__device__ __forceinline__ void gemm_phase(LAS unsigned char* lds, LAS unsigned char* ldsidx, const Sched& S, const Epi& E) {
    int tid_ = threadIdx.x; asm volatile("" : "+v"(tid_));
    const int tid = tid_, wid = __builtin_amdgcn_readfirstlane(tid >> 6), lane = tid & 63, wr = wid >> 2, wc = wid & 3, fr = lane & 15, fq = lane >> 4;
    const int K = S.K, nt = K / BK;
    int R0, C0; stage_rc(tid * 16, R0, C0);
    const int Rb = (R0 & ~31) + perm32(R0 & 31);
    const unsigned voffB0 = (unsigned)tid * 16u, voffB1 = voffB0 + 8192u;
    const size_t kstep = (size_t)(BK * 2), kstepB = (size_t)(2 * HTB);
    const size_t hstep = (size_t)HTB;
    (void)Rb;
    const unsigned ldsw = (unsigned)wid * 1024u;
    const int aoff = lds_byte(wr * 64 + fr, fq * 8), boff = lds_byte(wc * 32 + fr, fq * 8);
#define PG8_SA(b, h) (((b) * 2 + (h)) * HTB)
#define PG8_SB(b, h) ((4 + (b) * 2 + (h)) * HTB)
#define PG8_STAGE(bufoff, gbase, o0, o1) do { \
        __builtin_amdgcn_global_load_lds((const unsigned*)((const char*)(gbase) + (o0)), (LAS unsigned*)(lds + (bufoff) + ldsw), 16, 0, 0); \
        __builtin_amdgcn_global_load_lds((const unsigned*)((const char*)(gbase) + (o1)), (LAS unsigned*)(lds + (bufoff) + ldsw + 8192), 16, 0, 0); } while (0)
#define PG8_LDA(dst, b, h) do { _Pragma("unroll") for (int m = 0; m < 4; ++m) _Pragma("unroll") for (int k = 0; k < 2; ++k) dst[m][k] = *(const LAS bf16x8*)(lds + PG8_SA(b, h) + aoff + m * 2048 + k * 1024); } while (0)
#define PG8_LDB(dst, b, h) do { _Pragma("unroll") for (int n = 0; n < 2; ++n) _Pragma("unroll") for (int k = 0; k < 2; ++k) dst[n][k] = *(const LAS bf16x8*)(lds + PG8_SB(b, h) + boff + n * 2048 + k * 1024); } while (0)
#define PG8_MMA(ai, bj, At, Bt) do { __builtin_amdgcn_s_setprio(1); _Pragma("unroll") for (int m = 0; m < 4; ++m) _Pragma("unroll") for (int n = 0; n < 2; ++n) _Pragma("unroll") for (int k = 0; k < 2; ++k) \
        acc[ai][bj][m][n] = __builtin_amdgcn_mfma_f32_16x16x32_bf16(Bt[n][k], At[m][k], acc[ai][bj][m][n], 0, 0, 0); __builtin_amdgcn_s_setprio(0); } while (0)
#define PG8_WAIT_V(n) asm volatile("s_waitcnt vmcnt(" #n ")" ::: "memory")
#define PG8_WAIT_L(n) asm volatile("s_waitcnt lgkmcnt(" #n ")" ::: "memory")
#define PG8_BAR __builtin_amdgcn_s_barrier()
#define PG8_SCHED __builtin_amdgcn_sched_barrier(0)
    Unit cur, nxt; int ui = 0, ib = 0;
    if (!S.next(0, cur)) return;
    unsigned vc[4], vn[4];
    constexpr bool GATHER = (MODE == 2);
    if constexpr (MODE >= 1) { S.issue_rows(cur, ldsidx, wid, lane); asm volatile("s_waitcnt vmcnt(0)" ::: "memory"); __builtin_amdgcn_s_barrier(); asm volatile("" ::: "memory"); }
    if constexpr (GATHER) { S.read_rows(cur, ldsidx, R0, vc); _Pragma("unroll") for (int q = 0; q < 4; ++q) vc[q] += (unsigned)C0 * 2u; }
    else { _Pragma("unroll") for (int q = 0; q < 4; ++q) vc[q] = (unsigned)((R0 + 64 * q) * K + C0) * 2u; }
#pragma unroll
    for (int q = 0; q < 4; ++q) vn[q] = vc[q];
    f32x4 acc[2][2][4][2];
#pragma unroll
    for (int a = 0; a < 2; ++a)
#pragma unroll
        for (int b = 0; b < 2; ++b)
#pragma unroll
            for (int m = 0; m < 4; ++m)
#pragma unroll
                for (int n = 0; n < 2; ++n) acc[a][b][m][n] = (f32x4){0.f, 0.f, 0.f, 0.f};
    bf16x8 At[4][2], B0[2][2], B1[2][2];
    const char* cA = S.a_base(cur); const char* cB = S.b_base(cur);
    PG8_STAGE(PG8_SB(0, 0), cB, voffB0, voffB1); PG8_STAGE(PG8_SB(0, 1), cB + hstep, voffB0, voffB1); PG8_STAGE(PG8_SA(0, 0), cA, vc[0], vc[1]); PG8_STAGE(PG8_SA(0, 1), cA, vc[2], vc[3]);
    if (wr == 1) PG8_BAR;
    PG8_WAIT_V(2); PG8_BAR;
    PG8_STAGE(PG8_SB(1, 0), cB + kstepB, voffB0, voffB1); PG8_STAGE(PG8_SA(1, 0), cA + kstep, vc[0], vc[1]); PG8_STAGE(PG8_SB(1, 1), cB + hstep + kstepB, voffB0, voffB1);
    PG8_WAIT_V(6); PG8_BAR;
    for (;;) {
        const bool has_next = S.next(ui + 1, nxt);
        if constexpr (MODE >= 1) { if (has_next) S.issue_rows(nxt, ldsidx + (ib == 2 ? 0 : ib + 1) * 3072, wid, lane); }
        const char* nA = has_next ? S.a_base(nxt) : cA; const char* nB = has_next ? S.b_base(nxt) : cB;
        for (int t = 0; t < nt; t += 2) {
            const bool last = (t == nt - 2);
            const char* a1 = cA + (size_t)(t + 1) * kstep;
            const char* a2 = last ? nA : cA + (size_t)(t + 2) * kstep; const char* b2 = last ? nB : cB + (size_t)(t + 2) * kstepB;
            const char* a3 = a2 + kstep; const char* b3 = b2 + kstepB;
            unsigned w0 = vc[0], w1 = vc[1], w2 = vc[2], w3 = vc[3];
            if constexpr (GATHER) { if (last && has_next) { S.read_rows(nxt, ldsidx + (ib == 2 ? 0 : ib + 1) * 3072, R0, vn); _Pragma("unroll") for (int q = 0; q < 4; ++q) vn[q] += (unsigned)C0 * 2u;
                w0 = vn[0]; w1 = vn[1]; w2 = vn[2]; w3 = vn[3]; } }
            PG8_LDB(B0, 0, 0); PG8_LDB(B1, 0, 1); PG8_SCHED; PG8_LDA(At, 0, 0); PG8_STAGE(PG8_SA(1, 1), a1, vc[2], vc[3]);
            PG8_WAIT_V(8); PG8_WAIT_L(0); PG8_BAR; PG8_MMA(0, 0, At, B0); PG8_MMA(0, 1, At, B1); PG8_BAR; PG8_SCHED;
            PG8_LDA(At, 0, 1); PG8_STAGE(PG8_SB(0, 0), b2, voffB0, voffB1); PG8_STAGE(PG8_SB(0, 1), b2 + hstep, voffB0, voffB1); PG8_STAGE(PG8_SA(0, 0), a2, w0, w1);
            PG8_WAIT_V(8); PG8_WAIT_L(0); PG8_BAR; PG8_MMA(1, 0, At, B0); PG8_MMA(1, 1, At, B1); PG8_BAR; PG8_SCHED;
            PG8_LDB(B0, 1, 0); PG8_LDB(B1, 1, 1); PG8_SCHED; PG8_LDA(At, 1, 0); PG8_STAGE(PG8_SA(0, 1), a2, w2, w3);
            PG8_WAIT_V(8); PG8_WAIT_L(0); PG8_BAR; PG8_MMA(0, 0, At, B0); PG8_MMA(0, 1, At, B1); PG8_BAR; PG8_SCHED;
            PG8_LDA(At, 1, 1); PG8_STAGE(PG8_SB(1, 0), b3, voffB0, voffB1); PG8_STAGE(PG8_SB(1, 1), b3 + hstep, voffB0, voffB1); PG8_STAGE(PG8_SA(1, 0), a3, w0, w1);
            PG8_WAIT_V(8); PG8_WAIT_L(0); PG8_BAR; PG8_MMA(1, 0, At, B0); PG8_MMA(1, 1, At, B1); PG8_BAR; PG8_SCHED;
        }
        if (wr == 0) PG8_BAR;
        E(acc, cur, wr, wc, fr, fq, (const LAS unsigned char*)(ldsidx + ib * 3072));
        if (!has_next) break;
#pragma unroll
        for (int a = 0; a < 2; ++a)
#pragma unroll
            for (int b = 0; b < 2; ++b)
#pragma unroll
                for (int m = 0; m < 4; ++m)
#pragma unroll
                    for (int n = 0; n < 2; ++n) acc[a][b][m][n] = (f32x4){0.f, 0.f, 0.f, 0.f};
        cur = nxt; cA = nA; cB = nB; ++ui; ib = (ib == 2 ? 0 : ib + 1);
#pragma unroll
        for (int q = 0; q < 4; ++q) vc[q] = vn[q];
        if (wr == 1) PG8_BAR;
    }
    PG8_WAIT_V(0);
    PG8_BAR;
#undef PG8_SA
#undef PG8_SB
#undef PG8_STAGE
#undef PG8_LDA
#undef PG8_LDB
#undef PG8_MMA
#undef PG8_WAIT_V
#undef PG8_WAIT_L
#undef PG8_BAR
#undef PG8_SCHED
}
template <class Epi, class Sched, int MODE>
__device__ __forceinline__ void gemm_phase_f8(LAS unsigned char* lds, LAS unsigned char* ldsidx, const Sched& S, const Epi& E) {
    int tid_ = threadIdx.x; asm volatile("" : "+v"(tid_));
    const int tid = tid_, wid = __builtin_amdgcn_readfirstlane(tid >> 6), lane = tid & 63, wr = wid >> 2, wc = wid & 3, fr = lane & 15, fq = lane >> 4;
    constexpr bool GATHER = (MODE == 2);
    const int K = S.K, nt = K / 128;
    const int R0 = tid >> 3, C0 = ((tid & 7) ^ (((R0 >> 1) & 1) | (((R0 >> 3) & 1) << 2))) * 16;
    const int Rb = (R0 & ~31) + perm32(R0 & 31);
    const unsigned voffB0 = (unsigned)(Rb * K + C0), r64 = 64u * (unsigned)K;
    const unsigned kstep = 128u;
    const unsigned hstep = (unsigned)(HALF * K);
    const char* const Abase = S.A; const char* const Bbase = S.Bt;
    const unsigned ldsw = (unsigned)wid * 1024u;
    const int sg = ((fr >> 1) & 1) | (((fr >> 3) & 1) << 2);
    const LAS unsigned char* a0p = lds + (wr * 64 + fr) * 128 + (((2 * fq) ^ sg) * 16); const LAS unsigned char* a1p = lds + (wr * 64 + fr) * 128 + (((2 * fq + 1) ^ sg) * 16);
    const LAS unsigned char* b0p = lds + 4 * HTB + (wc * 32 + fr) * 128 + (((2 * fq) ^ sg) * 16); const LAS unsigned char* b1p = lds + 4 * HTB + (wc * 32 + fr) * 128 + (((2 * fq + 1) ^ sg) * 16);
#define PG8_SA(b, h) (((b) * 2 + (h)) * HTB)
#define PG8_SB(b, h) ((4 + (b) * 2 + (h)) * HTB)
#define PG8_STAGE(bufoff, gbase, o0, o1) do { \
        __builtin_amdgcn_global_load_lds((const unsigned*)((const char*)(gbase) + (o0)), (LAS unsigned*)(lds + (bufoff) + ldsw), 16, 0, 0); \
        __builtin_amdgcn_global_load_lds((const unsigned*)((const char*)(gbase) + (o1)), (LAS unsigned*)(lds + (bufoff) + ldsw + 8192), 16, 0, 0); } while (0)
#define PG8_STAGEA(bufoff, uo, hh) do { \
        __builtin_amdgcn_global_load_lds((const unsigned*)(Abase + (unsigned)((uo) + vc[2 * (hh)])), (LAS unsigned*)(lds + (bufoff) + ldsw), 16, 0, 0); \
        __builtin_amdgcn_global_load_lds((const unsigned*)(Abase + (unsigned)((uo) + vc[2 * (hh) + 1])), (LAS unsigned*)(lds + (bufoff) + ldsw + 8192), 16, 0, 0); } while (0)
#define PG8_STAGEB(bufoff, uo) do { \
        __builtin_amdgcn_global_load_lds((const unsigned*)(Bbase + (unsigned)((uo) + voffB0)), (LAS unsigned*)(lds + (bufoff) + ldsw), 16, 0, 0); \
        __builtin_amdgcn_global_load_lds((const unsigned*)(Bbase + (unsigned)((uo) + r64 + voffB0)), (LAS unsigned*)(lds + (bufoff) + ldsw + 8192), 16, 0, 0); } while (0)
#define PG8_LD32(p0, p1, off) __builtin_shufflevector(*(const LAS v4i32*)((p0) + (off)), *(const LAS v4i32*)((p1) + (off)), 0, 1, 2, 3, 4, 5, 6, 7)
#define PG8_LDA(dst, b, h) do { _Pragma("unroll") for (int m = 0; m < 4; ++m) dst[m] = PG8_LD32(a0p, a1p, PG8_SA(b, h) + m * 2048); } while (0)
#define PG8_LDB(dst, b, h) do { _Pragma("unroll") for (int n = 0; n < 2; ++n) dst[n] = PG8_LD32(b0p, b1p, PG8_SB(b, h) - 4 * HTB + n * 2048); } while (0)
#define PG8_MMA(ai, bj, At, Bt) do { __builtin_amdgcn_s_setprio(1); _Pragma("unroll") for (int m = 0; m < 4; ++m) _Pragma("unroll") for (int n = 0; n < 2; ++n) \
        acc[ai][bj][m][n] = __builtin_amdgcn_mfma_scale_f32_16x16x128_f8f6f4(Bt[n], At[m], acc[ai][bj][m][n], 0, 0, 0, 0, 0, 0); __builtin_amdgcn_s_setprio(0); } while (0)
#define PG8_WAIT_V(n) asm volatile("s_waitcnt vmcnt(" #n ")" ::: "memory")
#define PG8_WAIT_L(n) asm volatile("s_waitcnt lgkmcnt(" #n ")" ::: "memory")
#define PG8_BAR __builtin_amdgcn_s_barrier()
#define PG8_SCHED __builtin_amdgcn_sched_barrier(0)
    Unit cur, nxt; int ui = 0, ib = 0;
    if (!S.next(0, cur)) return;
    unsigned vc[4];
    if constexpr (MODE >= 1) { S.issue_rows(cur, ldsidx, wid, lane); asm volatile("s_waitcnt vmcnt(0)" ::: "memory"); __builtin_amdgcn_s_barrier(); asm volatile("" ::: "memory"); }
    if constexpr (GATHER) { S.read_rows(cur, ldsidx, R0, vc); _Pragma("unroll") for (int q = 0; q < 4; ++q) vc[q] += (unsigned)C0; }
    else { const unsigned ua = S.a_off(cur); _Pragma("unroll") for (int q = 0; q < 4; ++q) vc[q] = ua + (unsigned)((R0 + 64 * q) * K + C0); }
    f32x4 acc[2][2][4][2];
#pragma unroll
    for (int a = 0; a < 2; ++a)
#pragma unroll
        for (int b = 0; b < 2; ++b)
#pragma unroll
            for (int m = 0; m < 4; ++m)
#pragma unroll
                for (int n = 0; n < 2; ++n) acc[a][b][m][n] = (f32x4){0.f, 0.f, 0.f, 0.f};
    v8i32 At[4], B0[2], B1[2];
    unsigned cB = S.b_off(cur);
    PG8_STAGEB(PG8_SB(0, 0), cB); PG8_STAGEB(PG8_SB(0, 1), cB + hstep); PG8_STAGEA(PG8_SA(0, 0), 0u, 0); PG8_STAGEA(PG8_SA(0, 1), 0u, 1);
    if (wr == 1) PG8_BAR;
    PG8_WAIT_V(2); PG8_BAR;
    PG8_STAGEB(PG8_SB(1, 0), cB + kstep); PG8_STAGEA(PG8_SA(1, 0), kstep, 0); PG8_STAGEB(PG8_SB(1, 1), cB + hstep + kstep);
    PG8_WAIT_V(6); PG8_BAR;
    for (;;) {
        const bool has_next = S.next(ui + 1, nxt);
        if constexpr (MODE >= 1) { if (has_next) S.issue_rows(nxt, ldsidx + (ib == 2 ? 0 : ib + 1) * 3072, wid, lane); }
        const unsigned nB = has_next ? S.b_off(nxt) : cB;
        for (int t = 0; t < nt; t += 2) {
            const bool last = (t == nt - 2);
            const unsigned a1 = (unsigned)(t + 1) * kstep;
            const unsigned a2 = last ? 0u : (unsigned)(t + 2) * kstep, b2 = last ? nB : cB + (unsigned)(t + 2) * kstep;
            const unsigned a3 = a2 + kstep, b3 = b2 + kstep;
            PG8_LDB(B0, 0, 0); PG8_LDB(B1, 0, 1); PG8_SCHED; PG8_LDA(At, 0, 0); PG8_STAGEA(PG8_SA(1, 1), a1, 1);
            if (last && has_next) {
                if constexpr (GATHER) { S.read_rows(nxt, ldsidx + (ib == 2 ? 0 : ib + 1) * 3072, R0, vc); _Pragma("unroll") for (int q = 0; q < 4; ++q) vc[q] += (unsigned)C0; }
                else { const unsigned ua = S.a_off(nxt); _Pragma("unroll") for (int q = 0; q < 4; ++q) vc[q] = ua + (unsigned)((R0 + 64 * q) * K + C0); } }
            PG8_WAIT_V(8); PG8_WAIT_L(0); PG8_BAR; PG8_MMA(0, 0, At, B0); PG8_MMA(0, 1, At, B1); PG8_BAR; PG8_SCHED;
            PG8_LDA(At, 0, 1); PG8_STAGEB(PG8_SB(0, 0), b2); PG8_STAGEB(PG8_SB(0, 1), b2 + hstep); PG8_STAGEA(PG8_SA(0, 0), a2, 0);
            PG8_WAIT_V(8); PG8_WAIT_L(0); PG8_BAR; PG8_MMA(1, 0, At, B0); PG8_MMA(1, 1, At, B1); PG8_BAR; PG8_SCHED;
            PG8_LDB(B0, 1, 0); PG8_LDB(B1, 1, 1); PG8_SCHED; PG8_LDA(At, 1, 0); PG8_STAGEA(PG8_SA(0, 1), a2, 1);
            PG8_WAIT_V(8); PG8_WAIT_L(0); PG8_BAR; PG8_MMA(0, 0, At, B0); PG8_MMA(0, 1, At, B1); PG8_BAR; PG8_SCHED;
            PG8_LDA(At, 1, 1); PG8_STAGEB(PG8_SB(1, 0), b3); PG8_STAGEB(PG8_SB(1, 1), b3 + hstep); PG8_STAGEA(PG8_SA(1, 0), a3, 0);
            PG8_WAIT_V(8); PG8_WAIT_L(0); PG8_BAR; PG8_MMA(1, 0, At, B0); PG8_MMA(1, 1, At, B1); PG8_BAR; PG8_SCHED;
        }
        if (wr == 0) PG8_BAR;
        E(acc, cur, wr, wc, fr, fq, (const LAS unsigned char*)(ldsidx + ib * 3072));
        if (!has_next) break;
#pragma unroll
        for (int a = 0; a < 2; ++a)
#pragma unroll
            for (int b = 0; b < 2; ++b)
#pragma unroll
                for (int m = 0; m < 4; ++m) { acc[a][b][m][0] = (f32x4){0.f, 0.f, 0.f, 0.f}; acc[a][b][m][1] = (f32x4){0.f, 0.f, 0.f, 0.f}; }
        cur = nxt; cB = nB; ++ui; ib = (ib == 2 ? 0 : ib + 1);
        if (wr == 1) PG8_BAR;
    }
    PG8_WAIT_V(0);
    PG8_BAR;
#undef PG8_SA
#undef PG8_SB
#undef PG8_STAGE
#undef PG8_STAGEB
#undef PG8_STAGEA
#undef PG8_LDA
#undef PG8_LDB
#undef PG8_MMA
#undef PG8_LD32
#undef PG8_WAIT_V
#undef PG8_WAIT_L
#undef PG8_BAR
#undef PG8_SCHED
}
template <class Epi, class Sched, int MODE, int AFMT, int PM = 0>
__device__ __forceinline__ void gemm_phase_f6(LAS unsigned char* lds, LAS unsigned char* ldsidx, const Sched& S, const Epi& E) {
    int tid_ = threadIdx.x; asm volatile("" : "+v"(tid_));
    const int tid = tid_, wid = __builtin_amdgcn_readfirstlane(tid >> 6), lane = tid & 63, wr = wid >> 2, wc = wid & 3, fr = lane & 15, fq = lane >> 4;
    constexpr bool GATHER = (MODE == 2);
    constexpr int HT6 = HALF * 96;
    const int K = S.K, nt = K / 128, KB = (K >> 2) * 3;
    const int s0 = tid, s1 = 512 + wid * 32 + (lane & 31);
    const int Ra = s0 / 6, Rc = s1 / 6;
    const int pa = s0 - Ra * 6, pc = s1 - Rc * 6;
    const int ca = (pa < 4 ? pa : 4 + ((pa - 4) ^ ((Ra >> 3) & 1))) * 16, cc = (pc < 4 ? pc : 4 + ((pc - 4) ^ ((Rc >> 3) & 1))) * 16;
    const bool lo32 = lane < 32;
    const unsigned voffBa = (unsigned)s0 * 16u, voffBc = (unsigned)s1 * 16u;
    const unsigned kstep = 2u * HT6, kstepA = (unsigned)S.akstep;
    const unsigned hstep = (unsigned)HT6;
    const char* const Abase = S.A; const char* const Bbase = S.Bt;
    const unsigned ldsw = (unsigned)wid * 1024u, ldsw2 = 8192u + (unsigned)wid * 512u;
    const int hd6 = 16 * fq, tl6 = 64 + ((8 * fq + 16 * ((fr >> 3) & 1)) & 31);
    const LAS unsigned char* aP = lds + (wr * 64 + fr) * 96 + hd6; const LAS unsigned char* aT = lds + (wr * 64 + fr) * 96 + tl6;
    const LAS unsigned char* bP = lds + 4 * HT6 + (wc * 32 + fr) * 96 + hd6; const LAS unsigned char* bT = lds + 4 * HT6 + (wc * 32 + fr) * 96 + tl6;
#define PG6_SA(b, h) (((b) * 2 + (h)) * HT6)
#define PG6_SB(b, h) ((4 + (b) * 2 + (h)) * HT6)
#define PG6_FA(bufoff, uo, hh) if constexpr (PM != 2) __builtin_amdgcn_global_load_lds((const unsigned*)(Abase + (unsigned)((uo) + vc[2 * (hh)])), (LAS unsigned*)(lds + (bufoff) + ldsw), 16, 0, 0)
#define PG6_HA(bufoff, uo, hh) if constexpr (PM != 2) __builtin_amdgcn_global_load_lds((const unsigned*)(Abase + (unsigned)((uo) + vc[2 * (hh) + 1])), (LAS unsigned*)(lds + (bufoff) + ldsw2), 16, 0, 0)
#define PG6_FB(bufoff, uo) __builtin_amdgcn_global_load_lds((const unsigned*)(Bbase + (unsigned)((uo) + voffBa)), (LAS unsigned*)(lds + (bufoff) + ldsw), 16, 0, 0)
#define PG6_HB(bufoff, uo) __builtin_amdgcn_global_load_lds((const unsigned*)(Bbase + (unsigned)((uo) + voffBc)), (LAS unsigned*)(lds + (bufoff) + ldsw2), 16, 0, 0)
#define PG6_B3(b, uo) do { if constexpr (PM != 2) _Pragma("unroll") for (int i3 = 0; i3 < 3; ++i3) __builtin_amdgcn_global_load_lds((const unsigned*)(Bbase + (unsigned)((uo) + i3 * 8192u + voffBa)), (LAS unsigned*)(lds + PG6_SB(b, 0) + i3 * 8192 + ldsw), 16, 0, 0); } while (0)
#define PG6_LD24(ph, pt, off) cat6h(*(const LAS v4i32*)((ph) + (off)), *(const volatile LAS v2i32*)((pt) + (off)))
#define PG6_LDA(dst, b, h) do { if constexpr (PM != 3) _Pragma("unroll") for (int m = 0; m < 4; ++m) dst[m] = PG6_LD24(aP, aT, PG6_SA(b, h) + m * 1536); } while (0)
#define PG6_LDB(dst, b, h) do { if constexpr (PM != 3) _Pragma("unroll") for (int n = 0; n < 2; ++n) dst[n] = PG6_LD24(bP, bT, PG6_SB(b, h) - 4 * HT6 + n * 1536); } while (0)
#define PG6_MMA(ai, bj, At, Bt) do { __builtin_amdgcn_s_setprio(1); if constexpr (PM < 3) { _Pragma("unroll") for (int m = 0; m < 4; ++m) _Pragma("unroll") for (int n = 0; n < 2; ++n) \
        acc[ai][bj][m][n] = __builtin_amdgcn_mfma_scale_f32_16x16x128_f8f6f4(Bt[n], At[m], acc[ai][bj][m][n], 2, AFMT, 0, 0, 0, 0); } \
        else if constexpr (PM == 4) { _Pragma("unroll") for (int m = 0; m < 4; ++m) _Pragma("unroll") for (int i6 = 0; i6 < 6; ++i6) sink ^= At[m][i6]; _Pragma("unroll") for (int n = 0; n < 2; ++n) _Pragma("unroll") for (int i6 = 0; i6 < 6; ++i6) sink ^= Bt[n][i6]; } \
        __builtin_amdgcn_s_setprio(0); } while (0)
#define PG6_WAIT_V(n) asm volatile("s_waitcnt vmcnt(" #n ")" ::: "memory")
#define PG6_WAIT_L(n) asm volatile("s_waitcnt lgkmcnt(" #n ")" ::: "memory")
#define PG6_BAR __builtin_amdgcn_s_barrier()
#define PG6_SCHED __builtin_amdgcn_sched_barrier(0)
#define PG6_ROWS(u) do { if constexpr (GATHER) { S.read_rows2(u, ldsidx + ibn * 3072, Ra, Rc, vc); vc[0] += (unsigned)ca; vc[2] += (unsigned)ca; vc[1] += (unsigned)cc; vc[3] += (unsigned)cc; } \
        else { const unsigned ua = S.a_off(u); vc[0] = ua + voffBa; vc[1] = ua + voffBc; vc[2] = vc[0] + hstep; vc[3] = vc[1] + hstep; } } while (0)
    Unit cur, nxt; int ui = 0, ib = 0;
    if (!S.next(0, cur)) return;
    unsigned vc[4];
    if constexpr (MODE >= 1) { S.issue_rows(cur, ldsidx, wid, lane); asm volatile("s_waitcnt vmcnt(0)" ::: "memory"); __builtin_amdgcn_s_barrier(); asm volatile("" ::: "memory"); }
    { const int ibn = 0; PG6_ROWS(cur); }
    f32x4 acc[2][2][4][2];
#pragma unroll
    for (int a = 0; a < 2; ++a)
#pragma unroll
        for (int b = 0; b < 2; ++b)
#pragma unroll
            for (int m = 0; m < 4; ++m)
#pragma unroll
                for (int n = 0; n < 2; ++n) acc[a][b][m][n] = (f32x4){0.f, 0.f, 0.f, 0.f};
    v8i32 At[4], B0[2], B1[2]; int sink = 0; (void)sink;
    unsigned cB = S.b_off(cur);
    PG6_B3(0, cB); PG6_FA(PG6_SA(0, 0), 0u, 0); if (lo32) { PG6_HA(PG6_SA(0, 0), 0u, 0); }
    PG6_SCHED; PG6_FA(PG6_SA(0, 1), 0u, 1); if (lo32) { PG6_HA(PG6_SA(0, 1), 0u, 1); }
    if (wr == 1) PG6_BAR;
    PG6_WAIT_V(2); PG6_BAR;
    PG6_B3(1, cB + kstep); PG6_FA(PG6_SA(1, 0), kstepA, 0); if (lo32) { PG6_HA(PG6_SA(1, 0), kstepA, 0); }
    PG6_WAIT_V(5); PG6_BAR;
    for (;;) {
        const bool has_next = S.next(ui + 1, nxt);
        const int ibn = (ib == 2 ? 0 : ib + 1);
        if constexpr (MODE >= 1) { if (has_next) S.issue_rows(nxt, ldsidx + ibn * 3072, wid, lane); }
        const unsigned nB = has_next ? S.b_off(nxt) : cB;
        for (int t = 0; t < nt; t += 2) {
            const bool last = (t == nt - 2);
            const unsigned a1 = (unsigned)(t + 1) * kstepA;
            const unsigned a2 = last ? 0u : (unsigned)(t + 2) * kstepA, b2 = last ? nB : cB + (unsigned)(t + 2) * kstep;
            const unsigned a3 = a2 + kstepA, b3 = b2 + kstep;
            PG6_LDB(B0, 0, 0); PG6_LDB(B1, 0, 1); PG6_SCHED; PG6_LDA(At, 0, 0); PG6_FA(PG6_SA(1, 1), a1, 1); if (lo32) { PG6_HA(PG6_SA(1, 1), a1, 1); }
            if (last && has_next) PG6_ROWS(nxt);
            PG6_WAIT_V(7); PG6_WAIT_L(0); PG6_BAR; PG6_MMA(0, 0, At, B0); PG6_MMA(0, 1, At, B1); PG6_BAR; PG6_SCHED;
            PG6_LDA(At, 0, 1); PG6_B3(0, b2); PG6_FA(PG6_SA(0, 0), a2, 0); if (lo32) { PG6_HA(PG6_SA(0, 0), a2, 0); }
            PG6_WAIT_V(7); PG6_WAIT_L(0); PG6_BAR; PG6_MMA(1, 0, At, B0); PG6_MMA(1, 1, At, B1); PG6_BAR; PG6_SCHED;
            PG6_LDB(B0, 1, 0); PG6_LDB(B1, 1, 1); PG6_SCHED; PG6_LDA(At, 1, 0); PG6_FA(PG6_SA(0, 1), a2, 1); if (lo32) { PG6_HA(PG6_SA(0, 1), a2, 1); }
            PG6_WAIT_V(7); PG6_WAIT_L(0); PG6_BAR; PG6_MMA(0, 0, At, B0); PG6_MMA(0, 1, At, B1); PG6_BAR; PG6_SCHED;
            PG6_LDA(At, 1, 1); PG6_B3(1, b3); PG6_FA(PG6_SA(1, 0), a3, 0); if (lo32) { PG6_HA(PG6_SA(1, 0), a3, 0); }
            PG6_WAIT_V(7); PG6_WAIT_L(0); PG6_BAR; PG6_MMA(1, 0, At, B0); PG6_MMA(1, 1, At, B1); PG6_BAR; PG6_SCHED;
        }
        if (wr == 0) PG6_BAR;
        if constexpr (PM == 0) E(acc, cur, wr, wc, fr, fq, (const LAS unsigned char*)(ldsidx + ib * 3072));
        else { float sm = 0.f;
#pragma unroll
            for (int a = 0; a < 2; ++a)
#pragma unroll
                for (int b2 = 0; b2 < 2; ++b2)
#pragma unroll
                    for (int m = 0; m < 4; ++m)
#pragma unroll
                        for (int n = 0; n < 2; ++n) sm += (acc[a][b2][m][n].x + acc[a][b2][m][n].y) + (acc[a][b2][m][n].z + acc[a][b2][m][n].w);
            if (sm == 1.2345678e-30f || sink == 0x12345679) ((volatile LAS unsigned*)ldsidx)[2300] = 1u; }
        if (!has_next) break;
#pragma unroll
        for (int a = 0; a < 2; ++a)
#pragma unroll
            for (int b = 0; b < 2; ++b)
#pragma unroll
                for (int m = 0; m < 4; ++m) { acc[a][b][m][0] = (f32x4){0.f, 0.f, 0.f, 0.f}; acc[a][b][m][1] = (f32x4){0.f, 0.f, 0.f, 0.f}; }
        cur = nxt; cB = nB; ++ui; ib = ibn;
        if (wr == 1) PG6_BAR;
    }
    PG6_WAIT_V(0);
    PG6_BAR;
#undef PG6_SA
#undef PG6_SB
#undef PG6_FA
#undef PG6_HA
#undef PG6_FB
#undef PG6_HB
#undef PG6_B3
#undef PG6_LDA
#undef PG6_LDB
#undef PG6_MMA
#undef PG6_LD24
#undef PG6_ROWS
#undef PG6_WAIT_V
#undef PG6_WAIT_L
#undef PG6_BAR
#undef PG6_SCHED
}
}

#define XB_TMO      128
#define XB_XCNT(j)  (256  + 64 * (j))
#define XB_XSUB(j)  (1280 + 64 * (j))
#define XB_XGEN(j)  (2304 + 64 * (j))
#define XB_TOP      3328
#define XB_TOPGEN   3392
#define XCD_BAR_WORDS 3456
#define XB_SPIN_CAP (1u << 18)

__device__ __forceinline__ unsigned xb_ld(unsigned* p)              { return __hip_atomic_load(p, __ATOMIC_RELAXED, __HIP_MEMORY_SCOPE_AGENT); }
__device__ __forceinline__ unsigned xb_add(unsigned* p, unsigned v) { return __hip_atomic_fetch_add(p, v, __ATOMIC_RELAXED, __HIP_MEMORY_SCOPE_AGENT); }
__device__ __forceinline__ unsigned xb_xcc_id() { return (unsigned)__builtin_amdgcn_s_getreg((3 << 11) | 20) & 0xFu; }
#define XB_SPIN(cond, bar) do { unsigned _sp = 0; while (cond) { __builtin_amdgcn_s_sleep(1); \
    if ((++_sp & 255u) == 0u) { if (xb_ld(&(bar)[XB_TMO])) break; if (_sp > XB_SPIN_CAP) { atomicAdd(&(bar)[XB_TMO], 1u); break; } } } } while (0)

struct XcdBarrier {
    unsigned* bar; unsigned x;
    volatile LAS unsigned* st;
};
__device__ __forceinline__ XcdBarrier xcd_barrier_post(unsigned* bar, volatile LAS unsigned* st) {
    XcdBarrier b; b.bar = bar; b.x = xb_xcc_id(); b.st = st;
    if (threadIdx.x == 0) (void)xb_add(&bar[XB_XCNT(b.x)], 1u);
    return b;
}
__device__ __forceinline__ void xcd_barrier_complete(unsigned* bar, unsigned x, unsigned& nloc, unsigned& nx) {
    const unsigned G = gridDim.x * gridDim.y * gridDim.z;
    unsigned sum, cnt, mine, sp = 0u;
    for (;;) {
        sum = 0u; cnt = 0u; mine = 0u;
#pragma unroll
        for (unsigned j = 0; j < 16; ++j) { const unsigned c = xb_ld(&bar[XB_XCNT(j)]); sum += c; cnt += (c > 0u) ? 1u : 0u; mine = (j == x) ? c : mine; }
        if (sum == G) break;
        __builtin_amdgcn_s_sleep(1);
        if ((++sp & 255u) == 0u) { if (xb_ld(&bar[XB_TMO])) break; if (sp > XB_SPIN_CAP) { atomicAdd(&bar[XB_TMO], 1u); break; } }
    }
    nloc = mine > 0u ? mine : 1u; nx = cnt > 0u ? cnt : 1u;
}
__device__ __forceinline__ void xcd_barrier(const XcdBarrier& b) {
    asm volatile("s_waitcnt vmcnt(0)" ::: "memory");
    __syncthreads();
    if (threadIdx.x == 0) {
        unsigned* bar = b.bar;
        __builtin_amdgcn_s_waitcnt(0);
        unsigned nloc = b.st[0], nx = b.st[1];
        if (nloc == 0u) { xcd_barrier_complete(bar, b.x, nloc, nx); b.st[0] = nloc; b.st[1] = nx; }
        const unsigned old = xb_add(&bar[XB_XSUB(b.x)], 1u);
        const unsigned gen = old / nloc;
        if (old + 1u == (gen + 1u) * nloc) {
            __builtin_amdgcn_fence(__ATOMIC_RELEASE, "agent");
            asm volatile("s_waitcnt vmcnt(0)" ::: "memory");
            const unsigned og = xb_add(&bar[XB_TOP], 1u);
            const unsigned tg = og / nx;
            if (og + 1u == (tg + 1u) * nx) xb_add(&bar[XB_TOPGEN], 1u);
            else XB_SPIN(xb_ld(&bar[XB_TOPGEN]) == tg, bar);
            __builtin_amdgcn_fence(__ATOMIC_ACQUIRE, "agent");
            xb_add(&bar[XB_XGEN(b.x)], 1u);
            asm volatile("s_waitcnt vmcnt(0)" ::: "memory");
        } else {
            XB_SPIN(xb_ld(&bar[XB_XGEN(b.x)]) == gen, bar);
            __builtin_amdgcn_fence(__ATOMIC_ACQUIRE, "agent");
            asm volatile("s_waitcnt vmcnt(0)" ::: "memory");
        }
    }
    __syncthreads();
}

__device__ __forceinline__ void group_barrier(unsigned* cnt, unsigned target, unsigned* tmo, bool same_xcc) {
    asm volatile("s_waitcnt vmcnt(0)" ::: "memory");
    __syncthreads();
    if (threadIdx.x == 0) {
        __builtin_amdgcn_s_waitcnt(0);
        if (!same_xcc) { __builtin_amdgcn_fence(__ATOMIC_RELEASE, "agent"); asm volatile("s_waitcnt vmcnt(0)" ::: "memory"); }
        (void)xb_add(cnt, 1u);
        { unsigned sp_ = 0; while (xb_ld(cnt) < target) { __builtin_amdgcn_s_sleep(1); if ((++sp_ & 255u) == 0u) { if (xb_ld(tmo)) break; if (sp_ > XB_SPIN_CAP) { atomicAdd(tmo, 1u); break; } } } }
        __builtin_amdgcn_fence(__ATOMIC_ACQUIRE, "agent");
        asm volatile("s_waitcnt vmcnt(0)" ::: "memory");
    }
    __syncthreads();
}

constexpr int NWAVES = 8;
constexpr int RING_OFF = 0, RING_BYTES = 139264;
constexpr int LDSCTL_OFF = RING_BYTES, MISC_OFF = LDSCTL_OFF + 320;
constexpr int MOE_OFF = LDSCTL_OFF + 512;
constexpr int IDX_OFF = LDSCTL_OFF + 4096;
constexpr int TBL_OFF = LDSCTL_OFF + 4096;
constexpr int SSQ_OFF = LDSCTL_OFF + 16384;
constexpr int LDS_BYTES = RING_BYTES + 20480;
static_assert(TBL_OFF + 8 * 384 * 4 <= SSQ_OFF && SSQ_OFF + 4096 <= LDS_BYTES && LDS_BYTES <= 160 * 1024, "LDS map");

struct Args { const float* in[25]; float* out; unsigned char* ws; int ph_lo, ph_hi, li, pad; };
enum { I_X = 0, I_MEM, I_NORM_MIX_G, I_W_IN, I_Q_G, I_K_G, I_REL_BIAS, I_CONV_W, I_ONA_G, I_ONB_G, I_W_OUT, I_NORM_X_G, I_NORM_MEM_G, I_W_XQ, I_W_XKV, I_XQ_G, I_XK_G, I_W_XO,
       I_NORM_FFN_G, I_W_ROUTER, I_B_ROUTER, I_W_GU, I_B_GU, I_W_DN, I_B_DN };

constexpr float X8SCALE = 4.0f, W8SCALE = 64.0f, A8SCALE = 8.0f, Y8SCALE = 32.0f;
constexpr float X6SCALE = 1.0f, W6SCALE = 64.0f, A6SCALE = 1.0f;
static_assert(DM == DFF, "the prologue's fp6 items use one row length");
constexpr int ROWB6 = DM / 4 * 3, ROWB6F = DFF / 4 * 3;
__device__ __forceinline__ int fresh_tid() { int t = threadIdx.x; asm volatile("" : "+v"(t)); return t; }
struct Frame {
    LAS unsigned char* lds; int tid, lane, wave, vcu, G;
};

__device__ __forceinline__ int bimg_row(int sp) { const int s5 = sp & 31; return (sp & ~31) + 16 * ((s5 >> 2) & 1) + 4 * (s5 >> 3) + (s5 & 3); }
__device__ __forceinline__ void p0_transpose_item(const float* __restrict__ W, int ldw, int K, bf16_t* __restrict__ WT, int k0, int scol0, int cstride, int drow0, const float* __restrict__ g, LAS float* scr, int lane) {
#pragma unroll 8
    for (int i = 0; i < 32; ++i) { const int kk = 2 * i + (lane >> 5); float v = W[(size_t)(k0 + kk) * ldw + scol0 + (lane & 31) * cstride]; if (g) v *= g[k0 + kk]; scr[kk * 33 + (lane & 31)] = v; }
    asm volatile("s_waitcnt lgkmcnt(0)" ::: "memory");
    const int c = lane & 7;
#pragma unroll
    for (int j = 0; j < 4; ++j) { const int n = (lane >> 3) + 8 * j; const LAS float* s = scr + (8 * c) * 33 + n;
        u32x4 o; o.x = pk2(s[0 * 33], s[1 * 33]); o.y = pk2(s[2 * 33], s[3 * 33]); o.z = pk2(s[4 * 33], s[5 * 33]); o.w = pk2(s[6 * 33], s[7 * 33]);
        *(u32x4*)(WT + (size_t)(drow0 + n) * K + k0 + 8 * c) = o; }
    asm volatile("s_waitcnt lgkmcnt(0)" ::: "memory");
}
template <int MODE>
__device__ __forceinline__ void p0_transpose64(const float* __restrict__ W, int ldw, int K, bf16_t* __restrict__ WT, int k0, int n0, int drow0, const float* __restrict__ g, LAS float* scr, int lane) {
    const int krow = lane >> 4, c4 = lane & 15;
    f32x4 v[16];
#pragma unroll
    for (int i = 0; i < 16; ++i) v[i] = *(const f32x4*)(W + (size_t)(k0 + 4 * i + krow) * ldw + n0 + 4 * c4);
    if (g) {
#pragma unroll
        for (int i = 0; i < 16; ++i) v[i] = v[i] * g[k0 + 4 * i + krow]; }
#pragma unroll
    for (int i = 0; i < 16; ++i) { LAS float* d = scr + (4 * i + krow) * 65 + 4 * c4; d[0] = v[i].x; d[1] = v[i].y; d[2] = v[i].z; d[3] = v[i].w; }
    asm volatile("s_waitcnt lgkmcnt(0)" ::: "memory");
    const int kc = lane & 7;
#pragma unroll
    for (int j = 0; j < 8; ++j) { const int n = (lane >> 3) + 8 * j; const LAS float* s = scr + (8 * kc) * 65 + n;
        u32x4 o; o.x = pk2(s[0 * 65], s[1 * 65]); o.y = pk2(s[2 * 65], s[3 * 65]); o.z = pk2(s[4 * 65], s[5 * 65]); o.w = pk2(s[6 * 65], s[7 * 65]);
        const int dr = MODE == 0 ? n : (MODE == 1 ? 128 * (n >> 5) + (n & 31) : 128 * (n & 1) + (n >> 1));
        const int drow = drow0 + dr, slot = drow & 255, R = bimg_row(slot & 127);
        *(u32x4*)((char*)WT + ((size_t)((drow >> 8) * (K / 64) + (k0 >> 6)) * 2 + (slot >> 7)) * pg8::HTB + pg8::lds_byte(R, 8 * kc)) = o; }
    asm volatile("s_waitcnt lgkmcnt(0)" ::: "memory");
}
__device__ __forceinline__ float clamp8(float v) { return fminf(fmaxf(v, -448.0f), 448.0f); }
__device__ __forceinline__ unsigned pk4_fp8(float a, float b, float c, float d) { int w = 0; w = __builtin_amdgcn_cvt_pk_fp8_f32(a, b, w, false); w = __builtin_amdgcn_cvt_pk_fp8_f32(c, d, w, true); return (unsigned)w; }
template <int MODE>
__device__ __forceinline__ void p0_transpose64_f8(const float* __restrict__ W, int ldw, int K, unsigned char* __restrict__ WT, int k0, int n0, int drow0, const float* __restrict__ g, float sc, LAS float* scr, int lane) {
    const int krow = lane >> 4, c4 = lane & 15;
    f32x4 v[16];
#pragma unroll
    for (int i = 0; i < 16; ++i) v[i] = *(const f32x4*)(W + (size_t)(k0 + 4 * i + krow) * ldw + n0 + 4 * c4);
#pragma unroll
    for (int i = 0; i < 16; ++i) v[i] = v[i] * (g ? g[k0 + 4 * i + krow] * sc : sc);
#pragma unroll
    for (int i = 0; i < 16; ++i) { LAS float* d = scr + (4 * i + krow) * 65 + 4 * c4; d[0] = v[i].x; d[1] = v[i].y; d[2] = v[i].z; d[3] = v[i].w; }
    asm volatile("s_waitcnt lgkmcnt(0)" ::: "memory");
    const int kc = lane & 3;
#pragma unroll
    for (int j = 0; j < 4; ++j) { const int n = (lane >> 2) + 16 * j; const LAS float* s = scr + (16 * kc) * 65 + n;
        u32x4 o; o.x = pk4_fp8(s[0 * 65], s[1 * 65], s[2 * 65], s[3 * 65]); o.y = pk4_fp8(s[4 * 65], s[5 * 65], s[6 * 65], s[7 * 65]);
        o.z = pk4_fp8(s[8 * 65], s[9 * 65], s[10 * 65], s[11 * 65]); o.w = pk4_fp8(s[12 * 65], s[13 * 65], s[14 * 65], s[15 * 65]);
        const int dr = MODE == 0 ? n : (MODE == 1 ? 128 * (n >> 5) + (n & 31) : 128 * (n & 1) + (n >> 1));
        *(u32x4*)(WT + (size_t)(drow0 + dr) * K + k0 + 16 * kc) = o; }
    asm volatile("s_waitcnt lgkmcnt(0)" ::: "memory");
}
struct F8Item { const float* W; unsigned char* WT; const float* g; int ldw, k0, n0, drow0, mode; };
__device__ __forceinline__ void p0_f8_load(const F8Item& I, f32x4 (&v)[16], int lane) {
    const int krow = lane >> 4, c4 = lane & 15;
#pragma unroll
    for (int i = 0; i < 16; ++i) v[i] = *(const f32x4*)(I.W + (size_t)(I.k0 + 4 * i + krow) * I.ldw + I.n0 + 4 * c4);
}
__device__ __forceinline__ void p0_f8_store(const F8Item& I, const f32x4 (&v)[16], int K, float sc, LAS float* scr, int lane) {
    const int krow = lane >> 4, c4 = lane & 15;
#pragma unroll
    for (int i = 0; i < 16; ++i) { const float s = I.g ? I.g[I.k0 + 4 * i + krow] * sc : sc; LAS float* d = scr + (4 * i + krow) * 65 + 4 * c4; d[0] = v[i].x * s; d[1] = v[i].y * s; d[2] = v[i].z * s; d[3] = v[i].w * s; }
    asm volatile("s_waitcnt lgkmcnt(0)" ::: "memory");
    const int kc = lane & 3;
#pragma unroll
    for (int j = 0; j < 4; ++j) { const int n = (lane >> 2) + 16 * j; const LAS float* s = scr + (16 * kc) * 65 + n;
        u32x4 o; o.x = pk4_fp8(s[0 * 65], s[1 * 65], s[2 * 65], s[3 * 65]); o.y = pk4_fp8(s[4 * 65], s[5 * 65], s[6 * 65], s[7 * 65]);
        o.z = pk4_fp8(s[8 * 65], s[9 * 65], s[10 * 65], s[11 * 65]); o.w = pk4_fp8(s[12 * 65], s[13 * 65], s[14 * 65], s[15 * 65]);
        const int dr = I.mode == 0 ? n : 128 * (n & 1) + (n >> 1);
        *(u32x4*)(I.WT + (size_t)(I.drow0 + dr) * K + I.k0 + 16 * kc) = o; }
    asm volatile("s_waitcnt lgkmcnt(0)" ::: "memory");
}
__device__ __forceinline__ float clamp6(float v) { return fminf(fmaxf(v, -7.5f), 7.5f); }
__device__ __forceinline__ void store_ht(unsigned char* hd, unsigned char* tl, const u32x6 w) { *(u32x4*)hd = (u32x4){w[0], w[1], w[2], w[3]}; *(u32x2*)tl = (u32x2){w[4], w[5]}; }
constexpr int TILE6 = 256 * 96, HT6B = 128 * 96;
__device__ __forceinline__ int lds_row_of_slot(int sp) { const int s5 = sp & 31; return (sp & ~31) + 16 * ((s5 >> 2) & 1) + 4 * (s5 >> 3) + (s5 & 3); }
struct F6Item { const float* W; unsigned char* T; const float* g; int ldw, k0, n0, s0, mode; };
__device__ __forceinline__ void p0_f6_load(const F6Item& I, f32x4 (&v)[16], int lane) {
    const int krow = lane >> 3, c4 = lane & 7;
#pragma unroll
    for (int i = 0; i < 16; ++i) v[i] = *(const f32x4*)(I.W + (size_t)(I.k0 + 8 * i + krow) * I.ldw + I.n0 + 4 * c4);
}
__device__ __forceinline__ void p0_f6_store(const F6Item& I, const f32x4 (&v)[16], float sc, LAS float* scr, int lane) {
    const int krow = lane >> 3, c4 = lane & 7;
#pragma unroll
    for (int i = 0; i < 16; ++i) { const float s = I.g ? I.g[I.k0 + 8 * i + krow] * sc : sc; LAS float* d = scr + (8 * i + krow) * 33 + 4 * c4; d[0] = v[i].x * s; d[1] = v[i].y * s; d[2] = v[i].z * s; d[3] = v[i].w * s; }
    asm volatile("s_waitcnt lgkmcnt(0)" ::: "memory");
    const int n = lane & 31;
    const int slot = I.mode == 2 ? 128 * (n & 1) + I.s0 + (n >> 1) : I.s0 + n;
    const int R = lds_row_of_slot(slot & 127); unsigned char* rowp = I.T + ((slot >> 7) * 128 + R) * 96; const int rot = 16 * ((R >> 3) & 1);
#pragma unroll
    for (int j = 0; j < 2; ++j) { const int kb = (lane >> 5) + 2 * j; const LAS float* sp = scr + (32 * kb) * 33 + n;
        f32x16 a, b;
#pragma unroll
        for (int t = 0; t < 16; ++t) { a[t] = clamp6(sp[t * 33]); b[t] = clamp6(sp[(16 + t) * 33]); }
        store_ht(rowp + 16 * kb, rowp + 64 + ((8 * kb + rot) & 31), __builtin_amdgcn_cvt_scalef32_2xpk16_fp6_f32(a, b, 1.0f)); }
    asm volatile("s_waitcnt lgkmcnt(0)" ::: "memory");
}
__device__ __forceinline__ void rms_row_to_bf16(const float* __restrict__ xrow, const float* __restrict__ g, bf16_t* __restrict__ orow, int lane) {
    const f32x4* xr = (const f32x4*)xrow + lane; const f32x4* gr = (const f32x4*)g + lane;
    f32x4 v[4]; float s = 0.f;
#pragma unroll
    for (int j = 0; j < 4; ++j) { v[j] = xr[64 * j]; s += (v[j].x * v[j].x + v[j].y * v[j].y) + (v[j].z * v[j].z + v[j].w * v[j].w); }
    const float rstd = 1.0f / sqrtf(wave_sum(s) * (1.0f / DM) + EPS);
    u32x2* o8 = (u32x2*)orow + lane;
#pragma unroll
    for (int j = 0; j < 4; ++j) { const f32x4 gg = gr[64 * j]; u32x2 o; o.x = pk2(v[j].x * rstd * gg.x, v[j].y * rstd * gg.y); o.y = pk2(v[j].z * rstd * gg.z, v[j].w * rstd * gg.w); o8[64 * j] = o; }
}

using pg8::Unit;
struct EpiProj { bf16_t* O; const float* qg; const float* kg; float qscale; int pad;
    __device__ __forceinline__ void operator()(const f32x4 (&acc)[2][2][4][2], const Unit& u, int wr, int wc, int fr, int fq, const LAS unsigned char*) const {
        const int row0 = u.pm * 256 + wr * 64 + fr, colb = u.pn * 256 + wc * 64 + 8 * fq;
        const int mode = u.pn < 2 ? 1 : (u.pn < 4 ? 2 : 0);
        f32x4 gv[2][2];
        if (mode) { const float* gp = (mode == 1 ? qg : kg) + 8 * fq; const float sc = mode == 1 ? qscale : 1.0f;
#pragma unroll
            for (int bj = 0; bj < 2; ++bj)
#pragma unroll
                for (int n = 0; n < 2; ++n) gv[bj][n] = *(const f32x4*)(gp + 32 * bj + 4 * n) * sc; }
#pragma unroll
        for (int ai = 0; ai < 2; ++ai)
#pragma unroll
            for (int m = 0; m < 4; ++m) {
                f32x4 v[2][2];
#pragma unroll
                for (int bj = 0; bj < 2; ++bj)
#pragma unroll
                    for (int n = 0; n < 2; ++n) v[bj][n] = acc[ai][bj][m][n];
                if (mode) { float ss = 0.f;
#pragma unroll
                    for (int bj = 0; bj < 2; ++bj)
#pragma unroll
                        for (int n = 0; n < 2; ++n) ss += (v[bj][n].x * v[bj][n].x + v[bj][n].y * v[bj][n].y) + (v[bj][n].z * v[bj][n].z + v[bj][n].w * v[bj][n].w);
                    ss += __shfl_xor(ss, 16); ss += __shfl_xor(ss, 32);
                    const float rstd = 1.0f / sqrtf(ss * (1.0f / 64.0f) + EPS);
#pragma unroll
                    for (int bj = 0; bj < 2; ++bj)
#pragma unroll
                        for (int n = 0; n < 2; ++n) v[bj][n] = v[bj][n] * rstd * gv[bj][n]; }
                bf16_t* rowp = O + (size_t)(row0 + ai * 128 + m * 16) * NPROJ + colb;
#pragma unroll
                for (int bj = 0; bj < 2; ++bj) { u32x4 w; w.x = cvt_pk_bf16(v[bj][0].x, v[bj][0].y); w.y = cvt_pk_bf16(v[bj][0].z, v[bj][0].w); w.z = cvt_pk_bf16(v[bj][1].x, v[bj][1].y); w.w = cvt_pk_bf16(v[bj][1].z, v[bj][1].w);
                    *(u32x4*)(rowp + 32 * bj) = w; }
            }
    }
};
struct EpiBf16 { bf16_t* O; int ldo; int pad;
    __device__ __forceinline__ void operator()(const f32x4 (&acc)[2][2][4][2], const Unit& u, int wr, int wc, int fr, int fq, const LAS unsigned char*) const {
        const int row0 = u.pm * 256 + wr * 64 + fr, col0 = u.pn * 256 + wc * 32 + 8 * fq;
#pragma unroll
        for (int ai = 0; ai < 2; ++ai)
#pragma unroll
            for (int m = 0; m < 4; ++m) { bf16_t* rowp = O + (size_t)(row0 + ai * 128 + m * 16) * ldo + col0;
#pragma unroll
                for (int bj = 0; bj < 2; ++bj) { const f32x4 v0 = acc[ai][bj][m][0], v1 = acc[ai][bj][m][1];
                    u32x4 w; w.x = cvt_pk_bf16(v0.x, v0.y); w.y = cvt_pk_bf16(v0.z, v0.w); w.z = cvt_pk_bf16(v1.x, v1.y); w.w = cvt_pk_bf16(v1.z, v1.w);
                    *(u32x4*)(rowp + bj * 128) = w; } }
    }
};
template <bool BASE_BF16, bool F8COPY = false> struct EpiRes { const void* base; bf16_t* outb; float* sq; unsigned char* out8;
    __device__ __forceinline__ void operator()(const f32x4 (&acc)[2][2][4][2], const Unit& u, int wr, int wc, int fr, int fq, const LAS unsigned char*) const {
        const int row0 = u.pm * 256 + wr * 64 + fr, col0 = u.pn * 256 + wc * 32 + 8 * fq;
#pragma unroll
        for (int ai = 0; ai < 2; ++ai)
#pragma unroll
            for (int m = 0; m < 4; ++m) { const int row = row0 + ai * 128 + m * 16; const size_t off = (size_t)row * DM + col0; float ss = 0.f;
#pragma unroll
                for (int bj = 0; bj < 2; ++bj) { f32x4 b0, b1;
                    if constexpr (BASE_BF16) { const u32x4 bb = *(const u32x4*)((const bf16_t*)base + off + bj * 128); b0 = (f32x4){bflo(bb.x), bfhi(bb.x), bflo(bb.y), bfhi(bb.y)}; b1 = (f32x4){bflo(bb.z), bfhi(bb.z), bflo(bb.w), bfhi(bb.w)}; }
                    else { b0 = *(const f32x4*)((const float*)base + off + bj * 128); b1 = *(const f32x4*)((const float*)base + off + bj * 128 + 4); }
                    const f32x4 v0 = acc[ai][bj][m][0] + b0, v1 = acc[ai][bj][m][1] + b1;
                    u32x4 w; w.x = cvt_pk_bf16(v0.x, v0.y); w.y = cvt_pk_bf16(v0.z, v0.w); w.z = cvt_pk_bf16(v1.x, v1.y); w.w = cvt_pk_bf16(v1.z, v1.w);
                    *(u32x4*)(outb + off + bj * 128) = w;
                    if constexpr (F8COPY) { u32x2 w8; w8.x = pk4_fp8(clamp8(v0.x * X8SCALE), clamp8(v0.y * X8SCALE), clamp8(v0.z * X8SCALE), clamp8(v0.w * X8SCALE)); w8.y = pk4_fp8(clamp8(v1.x * X8SCALE), clamp8(v1.y * X8SCALE), clamp8(v1.z * X8SCALE), clamp8(v1.w * X8SCALE)); *(u32x2*)(out8 + off + bj * 128) = w8; }
                    ss += (v0.x * v0.x + v0.y * v0.y) + (v0.z * v0.z + v0.w * v0.w) + (v1.x * v1.x + v1.y * v1.y) + (v1.z * v1.z + v1.w * v1.w); }
                ss += __shfl_xor(ss, 16); ss += __shfl_xor(ss, 32);
                if (fq == 0) sq[((size_t)u.pn * MTOK + row) * 4 + wc] = ss; }
    }
};
__device__ __forceinline__ void swap32f(float& x, float& y) { const auto p = __builtin_amdgcn_permlane32_swap(__builtin_bit_cast(unsigned, x), __builtin_bit_cast(unsigned, y), false, false); const unsigned a = p[0], b = p[1]; x = __builtin_bit_cast(float, a); y = __builtin_bit_cast(float, b); }
__device__ __forceinline__ void swap16f(float& x, float& y) { const auto p = __builtin_amdgcn_permlane16_swap(__builtin_bit_cast(unsigned, x), __builtin_bit_cast(unsigned, y), false, false); const unsigned a = p[0], b = p[1]; x = __builtin_bit_cast(float, a); y = __builtin_bit_cast(float, b); }
__device__ __forceinline__ void tr4(float& r0, float& r1, float& r2, float& r3) { swap32f(r0, r2); swap32f(r1, r3); swap16f(r0, r1); swap16f(r2, r3); }
struct EpiRes6 { bf16_t* hbp; float* sq; unsigned char* out6;
    __device__ __forceinline__ void operator()(const f32x4 (&acc)[2][2][4][2], const Unit& u, int wr, int wc, int fr, int fq, const LAS unsigned char*) const {
        const int row0 = u.pm * 256 + wr * 64 + fr, col0 = u.pn * 256 + wc * 32 + 8 * fq;
        f32x4 vv[2][4][2][2];
#pragma unroll
        for (int ai = 0; ai < 2; ++ai) {
            u32x4 bq[4][2];
#pragma unroll
            for (int m = 0; m < 4; ++m)
#pragma unroll
                for (int bj = 0; bj < 2; ++bj) bq[m][bj] = *(const u32x4*)(hbp + (size_t)(row0 + ai * 128 + m * 16) * DM + col0 + bj * 128);
#pragma unroll
            for (int m = 0; m < 4; ++m) { const int row = row0 + ai * 128 + m * 16; const size_t off = (size_t)row * DM + col0; float ss = 0.f;
#pragma unroll
                for (int bj = 0; bj < 2; ++bj) { const u32x4 bb = bq[m][bj];
                    const f32x4 v0 = acc[ai][bj][m][0] + (f32x4){bflo(bb.x), bfhi(bb.x), bflo(bb.y), bfhi(bb.y)}, v1 = acc[ai][bj][m][1] + (f32x4){bflo(bb.z), bfhi(bb.z), bflo(bb.w), bfhi(bb.w)};
                    u32x4 w; w.x = cvt_pk_bf16(v0.x, v0.y); w.y = cvt_pk_bf16(v0.z, v0.w); w.z = cvt_pk_bf16(v1.x, v1.y); w.w = cvt_pk_bf16(v1.z, v1.w);
                    *(u32x4*)(hbp + off + bj * 128) = w;
                    vv[ai][m][bj][0] = v0 * X6SCALE; vv[ai][m][bj][1] = v1 * X6SCALE;
                    ss += (v0.x * v0.x + v0.y * v0.y) + (v0.z * v0.z + v0.w * v0.w) + (v1.x * v1.x + v1.y * v1.y) + (v1.z * v1.z + v1.w * v1.w); }
                ss += __shfl_xor(ss, 16); ss += __shfl_xor(ss, 32);
                if (fq == 0) sq[((size_t)u.pn * MTOK + row) * 4 + wc] = ss; } }
#pragma unroll
        for (int b = 0; b < 2; ++b) { const int rho = 2 * fq + b; unsigned char* rowp = out6 + ((size_t)(2 * u.pn) * MTOK + (u.pm * 256 + (rho >> 2) * 128 + wr * 64 + (rho & 3) * 16 + fr)) * 128 + wc * 16;
#pragma unroll
            for (int bj = 0; bj < 2; ++bj) { f32x16 s0, s1;
#pragma unroll
                for (int n = 0; n < 2; ++n)
#pragma unroll
                    for (int k = 0; k < 4; ++k) { float r0 = vv[0][b][bj][n][k], r1 = vv[0][2 + b][bj][n][k], r2 = vv[1][b][bj][n][k], r3 = vv[1][2 + b][bj][n][k]; tr4(r0, r1, r2, r3);
                        s0[4 * n + k] = r0; s0[8 + 4 * n + k] = r1; s1[4 * n + k] = r2; s1[8 + 4 * n + k] = r3; }
                { unsigned char* rp = rowp + (size_t)bj * MTOK * 128; store_ht(rp, rp + 64 - 8 * wc, __builtin_amdgcn_cvt_scalef32_2xpk16_fp6_f32(s0, s1, 1.0f)); } } }
    }
};
struct EpiRstdBf16 { bf16_t* O; const float* sq; int ldo; int pad;
    __device__ __forceinline__ void operator()(const f32x4 (&acc)[2][2][4][2], const Unit& u, int wr, int wc, int fr, int fq, const LAS unsigned char*) const {
        const int row0 = u.pm * 256 + wr * 64 + fr, col0 = u.pn * 256 + wc * 32 + 8 * fq;
#pragma unroll
        for (int ai = 0; ai < 2; ++ai)
#pragma unroll
            for (int m = 0; m < 4; ++m) { const int row = row0 + ai * 128 + m * 16; float s = 0.f;
#pragma unroll
                for (int t = 0; t < 4; ++t) { const f32x4 p = *(const f32x4*)(sq + ((size_t)t * MTOK + row) * 4); s += (p.x + p.y) + (p.z + p.w); }
                const float rstd = 1.0f / sqrtf(s * (1.0f / DM) + EPS);
                bf16_t* rowp = O + (size_t)row * ldo + col0;
#pragma unroll
                for (int bj = 0; bj < 2; ++bj) { const f32x4 v0 = acc[ai][bj][m][0] * rstd, v1 = acc[ai][bj][m][1] * rstd;
                    u32x4 w; w.x = cvt_pk_bf16(v0.x, v0.y); w.y = cvt_pk_bf16(v0.z, v0.w); w.z = cvt_pk_bf16(v1.x, v1.y); w.w = cvt_pk_bf16(v1.z, v1.w);
                    *(u32x4*)(rowp + bj * 128) = w; } }
    }
};
constexpr int LSTRIDE = MTOK;
struct MoeSched {
    const char* A; const char* Bt; size_t estride; const int* list; const float* listv; const float* bias; const LAS unsigned* tab; int K, nN, nblk, G, c, gather, rowb, bstride, arow, akstep;
    __device__ __forceinline__ bool next(int i, Unit& u) const {
        if (!pg8::static_order(nblk, nN, G, c, i, u.pm, u.pn)) return false;
        int e = 0; while (e < NE - 1 && (int)tab[32 + e + 1] <= u.pm) ++e;
        e = __builtin_amdgcn_readfirstlane(e); u.e = e; u.rbl = u.pm - (int)__builtin_amdgcn_readfirstlane(tab[32 + e]); return true;
    }
    __device__ __forceinline__ const char* a_base(const Unit& u) const { return gather ? A : A + (size_t)u.pm * 256 * rowb; }
    __device__ __forceinline__ const char* b_base(const Unit& u) const { return Bt + (size_t)u.e * estride + (size_t)u.pn * 256 * rowb; }
    __device__ __forceinline__ unsigned a_off(const Unit& u) const { return gather ? 0u : (unsigned)u.pm * 256u * (unsigned)rowb; }
    __device__ __forceinline__ unsigned b_off(const Unit& u) const { return (unsigned)u.e * (unsigned)estride + (unsigned)u.pn * 256u * (unsigned)rowb; }
    __device__ __forceinline__ void issue_rows(const Unit& u, LAS unsigned char* buf, int wid, int lane) const {
        const size_t li = (size_t)u.e * LSTRIDE + u.rbl * 256 + (wid & 3) * 64 + lane;
        if (wid < 4) __builtin_amdgcn_global_load_lds((const unsigned*)(list + li), (LAS unsigned*)(buf + wid * 256), 4, 0, 0);
        else __builtin_amdgcn_global_load_lds((const unsigned*)(listv + li), (LAS unsigned*)(buf + 1024 + (wid - 4) * 256), 4, 0, 0);
        if (wid == 0) __builtin_amdgcn_global_load_lds((const unsigned*)(bias + (size_t)u.e * bstride + u.pn * 256 + lane * 4), (LAS unsigned*)(buf + 2048), 16, 0, 0);
    }
    __device__ __forceinline__ void read_rows(const Unit& u, const LAS unsigned char* buf, int R0, unsigned (&off)[4]) const {
        const int cnt = (int)tab[u.e] - u.rbl * 256;
#pragma unroll
        for (int q = 0; q < 4; ++q) { const int j = R0 + 64 * q; const int v = ((const LAS int*)buf)[j]; const int tok = (j < cnt) ? (v >> 2) : 0; off[q] = (unsigned)tok * (unsigned)rowb; }
    }
    __device__ __forceinline__ void read_rows2(const Unit& u, const LAS unsigned char* buf, int Ra, int Rc, unsigned (&off)[4]) const {
        const int cnt = (int)tab[u.e] - u.rbl * 256;
#pragma unroll
        for (int q = 0; q < 4; ++q) { const int j = (q & 1 ? Rc : Ra) + 128 * (q >> 1); const int v = ((const LAS int*)buf)[j]; const int tok = (j < cnt) ? (v >> 2) : 0; off[q] = (unsigned)tok * (unsigned)arow; }
    }
};
struct EpiSwiglu8 { unsigned char* act; const LAS unsigned* tab; float isc; int pad;
    __device__ __forceinline__ void operator()(const f32x4 (&acc)[2][2][4][2], const Unit& u, int wr, int wc, int fr, int fq, const LAS unsigned char* meta) const {
        const int cnt = (int)tab[u.e] - u.rbl * 256, c0 = u.pn * 128 + wc * 32 + 8 * fq;
        const LAS f32x4* bp = (const LAS f32x4*)(meta + 2048 + (64 * wc + 16 * fq) * 4); f32x4 bb[4];
#pragma unroll
        for (int i = 0; i < 4; ++i) bb[i] = bp[i];
#pragma unroll
        for (int ai = 0; ai < 2; ++ai)
#pragma unroll
            for (int m = 0; m < 4; ++m) { const int j = ai * 128 + wr * 64 + m * 16 + fr; const float rs = (j < cnt) ? ((const LAS float*)(meta + 1024))[j] * isc : 0.f;
                float o[8];
#pragma unroll
                for (int n = 0; n < 2; ++n)
#pragma unroll
                    for (int k = 0; k < 4; ++k) { const int cc = 4 * n + k; const float bg = bb[cc >> 1][(cc & 1) * 2], bl = bb[cc >> 1][(cc & 1) * 2 + 1];
                        const float g = fminf(acc[ai][0][m][n][k] * rs + bg, 7.0f), l = fminf(fmaxf(acc[ai][1][m][n][k] * rs + bl, -7.0f), 7.0f);
                        o[cc] = fminf(fmaxf(g * __builtin_amdgcn_rcpf(1.0f + __builtin_amdgcn_exp2f(-1.702f * LOG2E * g)) * (l + 1.0f) * A8SCALE, -448.0f), 448.0f); }
                u32x2 w; w.x = pk4_fp8(o[0], o[1], o[2], o[3]); w.y = pk4_fp8(o[4], o[5], o[6], o[7]);
                *(u32x2*)(act + (size_t)(u.pm * 256 + j) * DFF + c0) = w; }
    }
};
struct EpiSwiglu6 { unsigned char* act; const LAS unsigned* tab; float isc; int pad;
    __device__ __forceinline__ void operator()(const f32x4 (&acc)[2][2][4][2], const Unit& u, int wr, int wc, int fr, int fq, const LAS unsigned char* meta) const {
        const int cnt = (int)tab[u.e] - u.rbl * 256;
        const LAS f32x4* bp = (const LAS f32x4*)(meta + 2048 + (64 * wc + 16 * fq) * 4); f32x4 bb[4];
#pragma unroll
        for (int i = 0; i < 4; ++i) bb[i] = bp[i];
        float o[2][4][8];
        f32x2 bg2[4], bl2[4];
#pragma unroll
        for (int i = 0; i < 4; ++i) { bg2[i] = (f32x2){bb[i].x, bb[i].z}; bl2[i] = (f32x2){bb[i].y + 1.0f, bb[i].w + 1.0f}; }
#pragma unroll
        for (int ai = 0; ai < 2; ++ai)
#pragma unroll
            for (int m = 0; m < 4; ++m) { const int j = ai * 128 + wr * 64 + m * 16 + fr; const float rs = (j < cnt) ? ((const LAS float*)(meta + 1024))[j] * isc : 0.f; const f32x2 rs2 = (f32x2){rs, rs};
#pragma unroll
                for (int n = 0; n < 2; ++n)
#pragma unroll
                    for (int h2 = 0; h2 < 2; ++h2) { const int ci = 2 * n + h2;
                        const f32x2 ag = (f32x2){acc[ai][0][m][n][2 * h2], acc[ai][0][m][n][2 * h2 + 1]}, al = (f32x2){acc[ai][1][m][n][2 * h2], acc[ai][1][m][n][2 * h2 + 1]};
                        f32x2 g = ag * rs2 + bg2[ci], l1 = al * rs2 + bl2[ci];
                        g.x = fminf(g.x, 7.0f); g.y = fminf(g.y, 7.0f); l1.x = fminf(fmaxf(l1.x, -6.0f), 8.0f); l1.y = fminf(fmaxf(l1.y, -6.0f), 8.0f);
                        const f32x2 t = g * (f32x2){-1.702f * LOG2E, -1.702f * LOG2E};
                        const f32x2 d = (f32x2){__builtin_amdgcn_exp2f(t.x), __builtin_amdgcn_exp2f(t.y)} + (f32x2){1.0f, 1.0f};
                        f32x2 v = g * (f32x2){__builtin_amdgcn_rcpf(d.x), __builtin_amdgcn_rcpf(d.y)} * l1 * (f32x2){A6SCALE, A6SCALE};
                        o[ai][m][2 * ci] = fminf(fmaxf(v.x, -28.0f), 28.0f); o[ai][m][2 * ci + 1] = fminf(fmaxf(v.y, -28.0f), 28.0f); } }
#pragma unroll
        for (int b = 0; b < 2; ++b) { const int rho = 2 * fq + b; f32x16 s0, s1;
#pragma unroll
            for (int j = 0; j < 8; ++j) { float r0 = o[0][b][j], r1 = o[0][2 + b][j], r2 = o[1][b][j], r3 = o[1][2 + b][j]; tr4(r0, r1, r2, r3); s0[j] = r0; s0[8 + j] = r1; s1[j] = r2; s1[8 + j] = r3; }
            unsigned char* rp = act + ((size_t)(u.pm * (DFF / 128) + u.pn) * 256 + (rho >> 2) * 128 + wr * 64 + (rho & 3) * 16 + fr) * 96;
            store_ht(rp + 16 * wc, rp + 64 + ((8 * wc + 16 * ((fr >> 3) & 1)) & 31), __builtin_amdgcn_cvt_scalef32_2xpk16_bf6_f32(s0, s1, 1.0f)); }
    }
};
struct EpiDown8 { unsigned char* ybuf; const LAS unsigned* tab; float isc; int pad;
    __device__ __forceinline__ void operator()(const f32x4 (&acc)[2][2][4][2], const Unit& u, int wr, int wc, int fr, int fq, const LAS unsigned char* meta) const {
        const int cnt = (int)tab[u.e] - u.rbl * 256, col0 = u.pn * 256 + wc * 32 + 8 * fq;
        const LAS f32x4* bp = (const LAS f32x4*)(meta + 2048 + (32 * wc + 8 * fq) * 4);
        f32x4 bb[2][2];
#pragma unroll
        for (int bj = 0; bj < 2; ++bj) { bb[bj][0] = bp[bj * 32] * Y8SCALE; bb[bj][1] = bp[bj * 32 + 1] * Y8SCALE; }
#pragma unroll
        for (int ai = 0; ai < 2; ++ai)
#pragma unroll
            for (int m = 0; m < 4; ++m) { const int j = ai * 128 + wr * 64 + m * 16 + fr;
                if (j < cnt) { const int tk = ((const LAS int*)meta)[j]; const float g = ((const LAS float*)(meta + 1024))[j]; unsigned char* rowp = ybuf + (size_t)tk * DM + col0;
#pragma unroll
                    for (int bj = 0; bj < 2; ++bj) { const f32x4 v0 = (acc[ai][bj][m][0] * isc + bb[bj][0]) * g, v1 = (acc[ai][bj][m][1] * isc + bb[bj][1]) * g;
                        u32x2 w; w.x = pk4_fp8(clamp8(v0.x), clamp8(v0.y), clamp8(v0.z), clamp8(v0.w)); w.y = pk4_fp8(clamp8(v1.x), clamp8(v1.y), clamp8(v1.z), clamp8(v1.w));
                        *(u32x2*)(rowp + bj * 128) = w; } } }
    }
};
__device__ __forceinline__ void moe_tables(const unsigned* gcnt, LAS unsigned* tab) {
    const int tid = fresh_tid();
    if (tid < 64) { const unsigned c = tid < NE ? gcnt[tid] : 0u; const unsigned nb = (c + 255u) >> 8; unsigned inc = nb;
#pragma unroll
        for (int o = 1; o < 64; o <<= 1) { const unsigned t = __shfl_up(inc, o); if (tid >= o) inc += t; }
        if (tid < NE) { tab[tid] = c; tab[32 + tid] = inc - nb; } if (tid == NE) tab[32 + NE] = inc - nb; }
    __syncthreads();
}
__device__ __forceinline__ void p7_route(const Frame& F, const bf16_t* __restrict__ hb, const bf16_t* __restrict__ Wrt, const float* __restrict__ sq2, const float* __restrict__ br,
                                         unsigned* gcnt, int* __restrict__ list, float* __restrict__ listg, float* __restrict__ listr) {
    LAS unsigned* lcnt = (LAS unsigned*)(F.lds + RING_OFF); LAS unsigned* lbase = lcnt + 32;
    const int tid = fresh_tid(), lane = tid & 63, tcol = lane & 15, kq = lane >> 4;
    LAS unsigned char* Wl = F.lds + RING_OFF + 4096;
#pragma unroll
    for (int i = 0; i < 8; ++i) { const int ci = tid + 512 * i, row = ci >> 7, ch = ci & 127; *(LAS u32x4*)(Wl + row * 2064 + ch * 16) = *(const u32x4*)(Wrt + (size_t)row * DM + ch * 8); }
    __syncthreads();
    for (int round = blockIdx.x; round < MTOK / 128; round += F.G) {
        if (tid < 32) lcnt[tid] = 0u;
        __syncthreads();
        const int tok = round * 128 + F.wave * 16 + tcol;
        const bf16_t* xp = hb + (size_t)tok * DM + 8 * kq;
        bf16x8 bx[32];
#pragma unroll
        for (int ks = 0; ks < 32; ++ks) bx[ks] = *(const bf16x8*)(xp + 32 * ks);
        const LAS unsigned char* w0l = Wl + tcol * 2064 + kq * 16; const LAS unsigned char* w1l = w0l + 16 * 2064;
        f32x4 a0 = {0.f, 0.f, 0.f, 0.f}, a1 = {0.f, 0.f, 0.f, 0.f};
#pragma unroll
        for (int ks = 0; ks < 32; ++ks) { const bf16x8 w0 = *(const LAS bf16x8*)(w0l + 64 * ks), w1 = *(const LAS bf16x8*)(w1l + 64 * ks);
            a0 = __builtin_amdgcn_mfma_f32_16x16x32_bf16(w0, bx[ks], a0, 0, 0, 0); a1 = __builtin_amdgcn_mfma_f32_16x16x32_bf16(w1, bx[ks], a1, 0, 0, 0); }
        float s = 0.f;
#pragma unroll
        for (int t = 0; t < 4; ++t) { const f32x4 p = *(const f32x4*)(sq2 + ((size_t)t * MTOK + tok) * 4); s += (p.x + p.y) + (p.z + p.w); }
        const float rstd = 1.0f / sqrtf(s * (1.0f / DM) + EPS);
        float v[8]; int id[8];
#pragma unroll
        for (int r = 0; r < 4; ++r) { id[r] = 4 * kq + r; id[4 + r] = 16 + 4 * kq + r; v[r] = a0[r] * rstd + br[4 * kq + r]; v[4 + r] = a1[r] * rstd + br[16 + 4 * kq + r]; }
        float tv[4]; int ti[4];
#pragma unroll
        for (int r = 0; r < 4; ++r) { float bv = v[0]; int bi = id[0];
#pragma unroll
            for (int j = 1; j < 8; ++j) if (v[j] > bv) { bv = v[j]; bi = id[j]; }
#pragma unroll
            for (int o = 16; o < 64; o <<= 1) { const float ov = __shfl_xor(bv, o); const int oi = __shfl_xor(bi, o); if (ov > bv || (ov == bv && oi < bi)) { bv = ov; bi = oi; } }
            tv[r] = bv; ti[r] = bi;
#pragma unroll
            for (int j = 0; j < 8; ++j) if (id[j] == bi) v[j] = -3.0e38f; }
        const float e1 = __expf(tv[1] - tv[0]), e2 = __expf(tv[2] - tv[0]), e3 = __expf(tv[3] - tv[0]); const float inv = 1.0f / (1.0f + e1 + e2 + e3);
        unsigned lp[4];
        if (kq == 0) {
#pragma unroll
            for (int k = 0; k < 4; ++k) lp[k] = __hip_atomic_fetch_add(lcnt + ti[k], 1u, __ATOMIC_RELAXED, __HIP_MEMORY_SCOPE_WORKGROUP); }
        __syncthreads();
        if (tid < 32) { const unsigned c = lcnt[tid]; lbase[tid] = c ? __hip_atomic_fetch_add(gcnt + tid, c, __ATOMIC_RELAXED, __HIP_MEMORY_SCOPE_AGENT) : 0u; }
        __syncthreads();
        if (kq == 0) { const float gk[4] = {inv, e1 * inv, e2 * inv, e3 * inv};
#pragma unroll
            for (int k = 0; k < 4; ++k) { const size_t pos = (size_t)ti[k] * LSTRIDE + lbase[ti[k]] + lp[k]; list[pos] = tok * 4 + k; listg[pos] = gk[k]; listr[pos] = rstd; } }
        __syncthreads();
    }
}
__device__ __forceinline__ void p10_combine(const Frame& F, float* __restrict__ out, const bf16_t* __restrict__ x2b, const unsigned char* __restrict__ ybuf) {
    const size_t n8 = (size_t)MTOK * DM / 8;
    for (size_t i = (size_t)blockIdx.x * (NWAVES * 64) + fresh_tid(); i < n8; i += (size_t)F.G * (NWAVES * 64)) {
        const size_t tok = i / (DM / 8), c8 = i % (DM / 8);
        const u32x4 xb = *(const u32x4*)(x2b + i * 8);
        f32x4 s0 = {0.f, 0.f, 0.f, 0.f}, s1 = {0.f, 0.f, 0.f, 0.f};
#pragma unroll
        for (int k = 0; k < 4; ++k) { const u32x2 y = *(const u32x2*)(ybuf + (tok * 4 + k) * DM + c8 * 8);
            const f32x2 a = __builtin_amdgcn_cvt_pk_f32_fp8((int)y.x, false), b = __builtin_amdgcn_cvt_pk_f32_fp8((int)y.x, true), c = __builtin_amdgcn_cvt_pk_f32_fp8((int)y.y, false), d = __builtin_amdgcn_cvt_pk_f32_fp8((int)y.y, true);
            s0.x += a.x; s0.y += a.y; s0.z += b.x; s0.w += b.y; s1.x += c.x; s1.y += c.y; s1.z += d.x; s1.w += d.y; }
        const f32x4 v0 = (f32x4){bflo(xb.x), bfhi(xb.x), bflo(xb.y), bfhi(xb.y)} + s0 * (1.0f / Y8SCALE), v1 = (f32x4){bflo(xb.z), bfhi(xb.z), bflo(xb.w), bfhi(xb.w)} + s1 * (1.0f / Y8SCALE);
        *(f32x4*)(out + i * 8) = v0; *(f32x4*)(out + i * 8 + 4) = v1;
    }
}
typedef short v4i16_t __attribute__((ext_vector_type(4)));
__device__ __forceinline__ v4i16_t lds_tr16(const LAS unsigned char* p) { return __builtin_amdgcn_ds_read_tr16_b64_v4i16((LAS v4i16_t*)p); }
__device__ __forceinline__ bf16x8 cat8(v4i16_t a, v4i16_t b) { return (bf16x8){a[0], a[1], a[2], a[3], b[0], b[1], b[2], b[3]}; }
__device__ __forceinline__ int koff16(int rho) { return (rho & 3) + 8 * (rho >> 2); }

__device__ __forceinline__ void kv_knorm_row(bf16_t* __restrict__ kvmem, const float* __restrict__ xk_g, int row, int lane) {
    bf16_t* kp = kvmem + (size_t)row * (2 * DX) + 8 * lane; const u32x4 kv = *(const u32x4*)kp;
    float v[8] = {bflo(kv.x), bfhi(kv.x), bflo(kv.y), bfhi(kv.y), bflo(kv.z), bfhi(kv.z), bflo(kv.w), bfhi(kv.w)}; float ss = 0.f;
#pragma unroll
    for (int j = 0; j < 8; ++j) ss += v[j] * v[j];
    ss += __shfl_xor(ss, 1); ss += __shfl_xor(ss, 2); ss += __shfl_xor(ss, 4); ss += __shfl_xor(ss, 8);
    const float rstd = 1.0f / sqrtf(ss * (1.0f / XHD) + EPS); const float* gp = xk_g + ((8 * lane) & (XHD - 1)); const f32x4 g0 = *(const f32x4*)gp, g1 = *(const f32x4*)(gp + 4);
    u32x4 w; w.x = cvt_pk_bf16(v[0] * rstd * g0.x, v[1] * rstd * g0.y); w.y = cvt_pk_bf16(v[2] * rstd * g0.z, v[3] * rstd * g0.w); w.z = cvt_pk_bf16(v[4] * rstd * g1.x, v[5] * rstd * g1.y); w.w = cvt_pk_bf16(v[6] * rstd * g1.z, v[7] * rstd * g1.w);
    *(u32x4*)kp = w;
}
__device__ __forceinline__ void p2_attn(const Frame& F, const bf16_t* __restrict__ proj, const float* __restrict__ rel_bias, const float* __restrict__ conv_w,
                                        const float* __restrict__ ga, const float* __restrict__ gb, bf16_t* __restrict__ yb, const float* __restrict__ q_g, const float* __restrict__ k_g, float qscale) {
    LAS float* tbl = (LAS float*)(F.lds + TBL_OFF);
    for (int i = fresh_tid(); i < 8 * 384; i += NWAVES * 64) { const int h = i / 384, j = i % 384; int rel = 319 - j; rel = rel < -MAXREL ? -MAXREL : (rel > MAXREL ? MAXREL : rel); tbl[i] = rel_bias[h * NREL + rel + MAXREL] * LOG2E; }
    __syncthreads();
    int lane_ = F.lane; asm volatile("" : "+v"(lane_));
    const int lane = lane_, h = F.wave, r = lane & 31, hi = lane >> 5;
    LAS unsigned char* wbuf = F.lds + RING_OFF + h * 16384;
    LAS float* ssq = (LAS float*)(F.lds + SSQ_OFF);
    const LAS float* tblh = tbl + h * 384;
    const float far_bias = rel_bias[h * NREL + 2 * MAXREL] * LOG2E;
    float mstat;
    { float gq = __builtin_fabsf(q_g[lane_]), gk = __builtin_fabsf(k_g[lane_]), bm = far_bias;
#pragma unroll
      for (int j = 0; j < 6; ++j) bm = fmaxf(bm, tblh[lane_ + 64 * j]);
#pragma unroll
      for (int o_ = 1; o_ < 64; o_ <<= 1) { gq = fmaxf(gq, __shfl_xor(gq, o_)); gk = fmaxf(gk, __shfl_xor(gk, o_)); bm = fmaxf(bm, __shfl_xor(bm, o_)); }
      mstat = __builtin_bit_cast(float, __builtin_amdgcn_readfirstlane(__builtin_bit_cast(int, 64.0f * gq * gk * qscale * 1.01f + bm))); }
    const float ninit = -mstat;
    unsigned kso[2], vso0;
#pragma unroll
    for (int i = 0; i < 2; ++i) { const int key = 8 * i + (lane >> 3), cp = lane & 7; kso[i] = (unsigned)(key * NPROJ + (cp ^ ((key >> 1) & 7)) * 8) * 2u; }
    { const int key = lane >> 3, cp = lane & 7; vso0 = (unsigned)(key * NPROJ + DATT + (cp ^ (((key >> 1) & 1) << 2)) * 8) * 2u; }
    int kaddr[4];
#pragma unroll
    for (int s = 0; s < 4; ++s) kaddr[s] = r * 128 + (((2 * s + hi) ^ ((r >> 1) & 7)) * 16);
    const int G1 = (lane >> 4) & 1, tq = (lane & 15) >> 2, tp = lane & 3;
    int vaddr[2];
#pragma unroll
    for (int db = 0; db < 2; ++db) vaddr[db] = (4 * hi + tq) * 128 + (((4 * db + 2 * G1 + (tp >> 1)) ^ (((tq >> 1) & 1) << 2)) * 16) + (tp & 1) * 8;
#define P2_DMA_K(T_, slot_) do { const char* kp_ = (const char*)(proj + ((size_t)b * SEQ + 32 * (T_)) * NPROJ + DATT + h * 64); \
        _Pragma("unroll") for (int i_ = 0; i_ < 4; ++i_) __builtin_amdgcn_global_load_lds((const unsigned*)(kp_ + (size_t)(i_ >> 1) * (16 * NPROJ * 2) + kso[i_ & 1]), (LAS unsigned*)(wbuf + (slot_) * 4096 + i_ * 1024), 16, 0, 0); } while (0)
#define P2_DMA_V(T_, slot_) do { const char* kp_ = (const char*)(proj + ((size_t)b * SEQ + 32 * (T_)) * NPROJ + DATT + h * 64); \
        _Pragma("unroll") for (int i_ = 0; i_ < 4; ++i_) __builtin_amdgcn_global_load_lds((const unsigned*)(kp_ + (size_t)i_ * (8 * NPROJ * 2) + vso0), (LAS unsigned*)(wbuf + 8192 + (slot_) * 4096 + i_ * 1024), 16, 0, 0); } while (0)
#define P2_QK(dst, ks_, T_) do { const LAS unsigned char* Kp_ = wbuf + (ks_) * 4096; const float init_ = (((T_) >> 1) >= c - 4) ? ninit : ninit + far_bias;     \
        _Pragma("unroll") for (int qb_ = 0; qb_ < 2; ++qb_) _Pragma("unroll") for (int i_ = 0; i_ < 16; ++i_) dst[qb_][i_] = init_; \
        _Pragma("unroll") for (int s_ = 0; s_ < 4; ++s_) { const bf16x8 kf_ = *(const LAS bf16x8*)(Kp_ + kaddr[s_]); \
            dst[0] = __builtin_amdgcn_mfma_f32_32x32x16_bf16(kf_, qf[0][s_], dst[0], 0, 0, 0); dst[1] = __builtin_amdgcn_mfma_f32_32x32x16_bf16(kf_, qf[1][s_], dst[1], 0, 0, 0); } } while (0)
    const int upw = (512 + F.G - 1) / F.G;
    for (int ui = 0; ui < upw; ++ui) {
        const int unit = F.vcu * upw + ui; if (unit >= BATCH * (SEQ / CHUNK)) break;
        const int b = unit / (SEQ / CHUNK), c = unit % (SEQ / CHUNK); const size_t row0 = (size_t)b * SEQ + c * CHUNK;
        const int T0 = 2 * (c - LEFT < 0 ? 0 : c - LEFT), nT = 2 * c + 2 - T0;
        int oz = 0; asm volatile("" : "+s"(oz));
        P2_DMA_K(T0, 0); P2_DMA_V(T0, 0); P2_DMA_K(T0 + 1, 1);
        { int lane3 = lane; asm volatile("" : "+v"(lane3));
          const int ch0 = 8 * lane3; const size_t tfirst = row0 + 8 * h; const int sfirst = c * CHUNK + 8 * h;
          u32x4 bgv[8], cgv[8], xvv[8], hc[2], hx[2];
#pragma unroll
          for (int i = 0; i < 8; ++i) { const bf16_t* pr = proj + (tfirst + i) * NPROJ + 3 * DATT + ch0; bgv[i] = *(const u32x4*)pr; cgv[i] = *(const u32x4*)(pr + DCONV); xvv[i] = *(const u32x4*)(pr + 2 * DCONV); }
#pragma unroll
          for (int j = 0; j < 2; ++j) { if (sfirst >= j + 1) { const bf16_t* pr = proj + (tfirst - 1 - j) * NPROJ + 3 * DATT + ch0; hc[j] = *(const u32x4*)(pr + DCONV); hx[j] = *(const u32x4*)(pr + 2 * DCONV); }
              else { hc[j] = (u32x4){0u, 0u, 0u, 0u}; hx[j] = (u32x4){0u, 0u, 0u, 0u}; } }
          f32x4 cwv[3][2], gbq[2];
#pragma unroll
          for (int t = 0; t < 3; ++t) { cwv[t][0] = *(const f32x4*)(conv_w + t * DCONV + ch0); cwv[t][1] = *(const f32x4*)(conv_w + t * DCONV + ch0 + 4); }
          gbq[0] = *(const f32x4*)(gb + ch0); gbq[1] = *(const f32x4*)(gb + ch0 + 4);
#define P2_UNPK(dst, vv_) do { const u32x4 q_ = (vv_); dst[0] = bflo(q_.x); dst[1] = bfhi(q_.x); dst[2] = bflo(q_.y); dst[3] = bfhi(q_.y); dst[4] = bflo(q_.z); dst[5] = bfhi(q_.z); dst[6] = bflo(q_.w); dst[7] = bfhi(q_.w); } while (0)
          float u1[8], u2[8], ta[8], tb[8];
          P2_UNPK(ta, hc[0]); P2_UNPK(tb, hx[0]);
#pragma unroll
          for (int j = 0; j < 8; ++j) u1[j] = ta[j] * tb[j];
          P2_UNPK(ta, hc[1]); P2_UNPK(tb, hx[1]);
#pragma unroll
          for (int j = 0; j < 8; ++j) u2[j] = ta[j] * tb[j];
#pragma unroll
          for (int i = 0; i < 8; ++i) { float u0[8], bgf[8], y[8]; P2_UNPK(ta, cgv[i]); P2_UNPK(tb, xvv[i]); P2_UNPK(bgf, bgv[i]);
              float ss = 0.f;
#pragma unroll
              for (int j = 0; j < 8; ++j) { u0[j] = ta[j] * tb[j]; y[j] = bgf[j] * (cwv[0][j >> 2][j & 3] * u2[j] + cwv[1][j >> 2][j & 3] * u1[j] + cwv[2][j >> 2][j & 3] * u0[j]); ss += y[j] * y[j]; u2[j] = u1[j]; u1[j] = u0[j]; }
              const float rstd = 1.0f / sqrtf(wave_sum(ss) * (1.0f / DCONV) + EPS);
              u32x4 w; w.x = cvt_pk_bf16(y[0] * rstd * gbq[0].x, y[1] * rstd * gbq[0].y); w.y = cvt_pk_bf16(y[2] * rstd * gbq[0].z, y[3] * rstd * gbq[0].w); w.z = cvt_pk_bf16(y[4] * rstd * gbq[1].x, y[5] * rstd * gbq[1].y); w.w = cvt_pk_bf16(y[6] * rstd * gbq[1].z, y[7] * rstd * gbq[1].w);
              *(u32x4*)(yb + (tfirst + i) * DM + DATT + ch0) = w; }
#undef P2_UNPK
        }
        asm volatile("" ::: "memory");
        bf16x8 qf[2][4];
#pragma unroll
        for (int qb = 0; qb < 2; ++qb)
#pragma unroll
            for (int s = 0; s < 4; ++s) qf[qb][s] = *(const bf16x8*)(proj + (row0 + 32 * qb + r) * NPROJ + h * 64 + 16 * s + 8 * hi);
        f32x16 o[2][2];
#pragma unroll
        for (int db = 0; db < 2; ++db)
#pragma unroll
            for (int qb = 0; qb < 2; ++qb)
#pragma unroll
                for (int i = 0; i < 16; ++i) o[db][qb][i] = 0.f;
        float lrun[2] = {0.f, 0.f};
        f32x16 scur[2];
        asm volatile("s_waitcnt vmcnt(0)" ::: "memory");
        P2_QK(scur, 0, T0);
        for (int t = 0; t < nT; ++t) {
            const int T = T0 + t;
            if (t + 2 < nT) { P2_DMA_K(T + 2, t & 1); P2_DMA_V(T + 1, (t + 1) & 1); }
            else if (t + 1 < nT) { P2_DMA_V(T + 1, (t + 1) & 1); }
            if ((T >> 1) >= c - 4) {
#pragma unroll
                for (int qb = 0; qb < 2; ++qb) { const LAS float* tp0 = tblh + (319 - 64 * c - 32 * qb - r + 32 * T + 4 * hi);
#pragma unroll
                    for (int i = 0; i < 16; ++i) scur[qb][i] += tp0[koff16(i)];
                    __builtin_amdgcn_sched_barrier(0); }
            }
            bf16x8 pf[2][2];
#pragma unroll
            for (int qb = 0; qb < 2; ++qb) { float ls = 0.f; float p[16];
#pragma unroll
                for (int i = 0; i < 16; ++i) { p[i] = __builtin_amdgcn_exp2f(scur[qb][i]); ls += p[i]; }
                lrun[qb] += ls;
#pragma unroll
                for (int ks = 0; ks < 2; ++ks) { u32x4 w; w.x = cvt_pk_bf16(p[8 * ks + 0], p[8 * ks + 1]); w.y = cvt_pk_bf16(p[8 * ks + 2], p[8 * ks + 3]); w.z = cvt_pk_bf16(p[8 * ks + 4], p[8 * ks + 5]); w.w = cvt_pk_bf16(p[8 * ks + 6], p[8 * ks + 7]);
                    pf[qb][ks] = __builtin_bit_cast(bf16x8, w); } }
            __builtin_amdgcn_sched_barrier(0);
            if (t + 2 < nT) asm volatile("s_waitcnt vmcnt(8)" ::: "memory"); else if (t + 1 < nT) asm volatile("s_waitcnt vmcnt(4)" ::: "memory"); else asm volatile("s_waitcnt vmcnt(0)" ::: "memory");
            if (t + 1 < nT) P2_QK(scur, (t + 1) & 1, T + 1);
            { const LAS unsigned char* Vp = wbuf + 8192 + (t & 1) * 4096;
#pragma unroll
              for (int db = 0; db < 2; ++db)
#pragma unroll
                  for (int ks = 0; ks < 2; ++ks) {
                      const v4i16_t t0 = lds_tr16(Vp + vaddr[db] + (16 * ks) * 128), t1 = lds_tr16(Vp + vaddr[db] + (16 * ks + 8) * 128);
                      const bf16x8 vf = cat8(t0, t1);
                      o[db][0] = __builtin_amdgcn_mfma_f32_32x32x16_bf16(vf, pf[0][ks], o[db][0], 0, 0, 0); o[db][1] = __builtin_amdgcn_mfma_f32_32x32x16_bf16(vf, pf[1][ks], o[db][1], 0, 0, 0);
                      if (ks == 1 && db == 0) __builtin_amdgcn_sched_barrier(0);
                  } }
        }
        int oz2 = 0; asm volatile("" : "+v"(oz2));
        const int r2 = r + oz2;

        LAS float* sq = ssq + (ui & 1) * 512;
#pragma unroll
        for (int qb = 0; qb < 2; ++qb) { const float lt = lrun[qb] + __shfl_xor(lrun[qb], 32); const float inv = 1.0f / lt; float ss = 0.f;
#pragma unroll
            for (int db = 0; db < 2; ++db)
#pragma unroll
                for (int i = 0; i < 16; ++i) { o[db][qb][i] *= inv; ss += o[db][qb][i] * o[db][qb][i]; }
            ss += __shfl_xor(ss, 32);
            if (hi == 0) sq[h * 64 + 32 * qb + r] = ss; }
        f32x4 gg[2][4];
#pragma unroll
        for (int db = 0; db < 2; ++db)
#pragma unroll
            for (int g4 = 0; g4 < 4; ++g4) gg[db][g4] = *(const f32x4*)(ga + oz2 + h * 64 + 32 * db + 8 * g4 + 4 * hi);
        __syncthreads();
#pragma unroll
        for (int qb = 0; qb < 2; ++qb) { float tot = 0.f;
#pragma unroll
            for (int hh = 0; hh < 8; ++hh) tot += sq[hh * 64 + 32 * qb + r];
            const float rstd = 1.0f / sqrtf(tot * (1.0f / DATT) + EPS);
            bf16_t* orow = yb + (row0 + 32 * qb + r2) * DM + h * 64;
#pragma unroll
            for (int db = 0; db < 2; ++db)
#pragma unroll
                for (int g4 = 0; g4 < 4; ++g4) { const int d0 = 32 * db + 8 * g4 + 4 * hi; const f32x4 g_ = gg[db][g4];
                    u32x2 w; w.x = cvt_pk_bf16(o[db][qb][4 * g4 + 0] * rstd * g_.x, o[db][qb][4 * g4 + 1] * rstd * g_.y); w.y = cvt_pk_bf16(o[db][qb][4 * g4 + 2] * rstd * g_.z, o[db][qb][4 * g4 + 3] * rstd * g_.w);
                    *(u32x2*)(orow + d0) = w; } }
    }
#undef P2_DMA_K
#undef P2_DMA_V
#undef P2_QK
    __syncthreads();
}
__device__ __forceinline__ void p5_xattn(const Frame& F, const bf16_t* __restrict__ qx, const bf16_t* __restrict__ kvmem, const float* __restrict__ xq_g, bf16_t* __restrict__ ox, const float* __restrict__ xk_g) {
    const int ptid = fresh_tid(), lane = ptid & 63, r = lane & 31, hi = lane >> 5;
    LAS unsigned char* Kl = F.lds + RING_OFF; LAS unsigned char* Vl = Kl + 256 * 272;
    const int G1 = (lane >> 4) & 1, tq = (lane & 15) >> 2, tp = lane & 3;
    const float XS = 0.08838834764831845f * LOG2E;
    float mstat;
    { float gq = fmaxf(__builtin_fabsf(xq_g[lane]), __builtin_fabsf(xq_g[lane + 64])), gk = fmaxf(__builtin_fabsf(xk_g[lane]), __builtin_fabsf(xk_g[lane + 64]));
#pragma unroll
      for (int o_ = 1; o_ < 64; o_ <<= 1) { gq = fmaxf(gq, __shfl_xor(gq, o_)); gk = fmaxf(gk, __shfl_xor(gk, o_)); }
      mstat = __builtin_bit_cast(float, __builtin_amdgcn_readfirstlane(__builtin_bit_cast(int, 128.0f * gq * gk * XS * 1.01f))); }
    const float ninit = -mstat;
    const int upw = (512 + F.G - 1) / F.G; int cur_bh = -1;
    for (int ui = 0; ui < upw; ++ui) {
        const int unit = F.vcu * upw + ui; if (unit >= BATCH * XH * 8) break;
        const int bh = unit >> 3, qt = unit & 7, b = bh >> 2, h = bh & 3;
        if (bh != cur_bh) {
            __syncthreads();
            const bf16_t* src = kvmem + (size_t)b * NMEM * (2 * DX) + h * XHD;
#pragma unroll
            for (int i = 0; i < 8; ++i) { const int ci = ptid + 512 * i, key = ci >> 4, ch = ci & 15;
                const u32x4 kv = *(const u32x4*)(src + (size_t)key * (2 * DX) + ch * 8), vv = *(const u32x4*)(src + (size_t)key * (2 * DX) + DX + ch * 8);
                *(LAS u32x4*)(Kl + key * 272 + ch * 16) = kv; *(LAS u32x4*)(Vl + key * 256 + ((ch ^ ((key & 3) << 2)) * 16)) = vv; }
            __syncthreads();
            cur_bh = bh;
        }
        const size_t qrow = (size_t)b * SEQ + qt * 256 + F.wave * 32 + r;
        bf16x8 qf[8];
        { u32x4 raw[8]; float ss = 0.f;
#pragma unroll
          for (int s = 0; s < 8; ++s) { raw[s] = *(const u32x4*)(qx + qrow * DX + h * XHD + 16 * s + 8 * hi);
              const float a0 = bflo(raw[s].x), a1 = bfhi(raw[s].x), a2 = bflo(raw[s].y), a3 = bfhi(raw[s].y), a4 = bflo(raw[s].z), a5 = bfhi(raw[s].z), a6 = bflo(raw[s].w), a7 = bfhi(raw[s].w);
              ss += (a0 * a0 + a1 * a1) + (a2 * a2 + a3 * a3) + (a4 * a4 + a5 * a5) + (a6 * a6 + a7 * a7); }
          ss += __shfl_xor(ss, 32);
          const float rs = XS / sqrtf(ss * (1.0f / XHD) + EPS);
#pragma unroll
          for (int s = 0; s < 8; ++s) { const f32x4 g0 = *(const f32x4*)(xq_g + 16 * s + 8 * hi), g1 = *(const f32x4*)(xq_g + 16 * s + 8 * hi + 4);
              u32x4 w; w.x = cvt_pk_bf16(bflo(raw[s].x) * rs * g0.x, bfhi(raw[s].x) * rs * g0.y); w.y = cvt_pk_bf16(bflo(raw[s].y) * rs * g0.z, bfhi(raw[s].y) * rs * g0.w);
              w.z = cvt_pk_bf16(bflo(raw[s].z) * rs * g1.x, bfhi(raw[s].z) * rs * g1.y); w.w = cvt_pk_bf16(bflo(raw[s].w) * rs * g1.z, bfhi(raw[s].w) * rs * g1.w);
              qf[s] = __builtin_bit_cast(bf16x8, w); } }
        f32x16 o[4];
#pragma unroll
        for (int db = 0; db < 4; ++db)
#pragma unroll
            for (int i = 0; i < 16; ++i) o[db][i] = 0.f;
        float lrun = 0.f;
        const LAS unsigned char* kbase = Kl + r * 272 + hi * 16;
        const LAS unsigned char* vbase[4];
#pragma unroll
        for (int db = 0; db < 4; ++db) vbase[db] = Vl + (4 * hi + tq) * 256 + ((4 * (db ^ tq) + 2 * G1 + (tp >> 1)) * 16) + (tp & 1) * 8;
#pragma unroll 1
        for (int t = 0; t < 4; ++t) {
            f32x16 sacc[2];
#pragma unroll
            for (int kb = 0; kb < 2; ++kb) {
#pragma unroll
                for (int i = 0; i < 16; ++i) sacc[kb][i] = ninit;
#pragma unroll
                for (int s = 0; s < 8; ++s) { const bf16x8 kf = *(const LAS bf16x8*)(kbase + (64 * t + 32 * kb) * 272 + 32 * s);
                    sacc[kb] = __builtin_amdgcn_mfma_f32_32x32x16_bf16(kf, qf[s], sacc[kb], 0, 0, 0); } }
            float ls = 0.f; bf16x8 pf[2][2];
#pragma unroll
            for (int kb = 0; kb < 2; ++kb) { float p[16];
#pragma unroll
                for (int i = 0; i < 16; ++i) { p[i] = __builtin_amdgcn_exp2f(sacc[kb][i]); ls += p[i]; }
#pragma unroll
                for (int ks = 0; ks < 2; ++ks) { u32x4 w; w.x = cvt_pk_bf16(p[8 * ks + 0], p[8 * ks + 1]); w.y = cvt_pk_bf16(p[8 * ks + 2], p[8 * ks + 3]); w.z = cvt_pk_bf16(p[8 * ks + 4], p[8 * ks + 5]); w.w = cvt_pk_bf16(p[8 * ks + 6], p[8 * ks + 7]);
                    pf[kb][ks] = __builtin_bit_cast(bf16x8, w); } }
            lrun += ls;
#pragma unroll
            for (int db = 0; db < 4; ++db)
#pragma unroll
                for (int kb = 0; kb < 2; ++kb)
#pragma unroll
                    for (int ks = 0; ks < 2; ++ks) { const int ko = (64 * t + 32 * kb + 16 * ks) * 256;
                        const v4i16_t t0 = lds_tr16(vbase[db] + ko), t1 = lds_tr16(vbase[db] + ko + 8 * 256);
                        o[db] = __builtin_amdgcn_mfma_f32_32x32x16_bf16(cat8(t0, t1), pf[kb][ks], o[db], 0, 0, 0); }
        }
        const float lt = lrun + __shfl_xor(lrun, 32); const float inv = 1.0f / lt;
        bf16_t* orow = ox + qrow * DX + h * XHD;
#pragma unroll
        for (int db = 0; db < 4; ++db)
#pragma unroll
            for (int g4 = 0; g4 < 4; ++g4) { const int d0 = 32 * db + 8 * g4 + 4 * hi;
                u32x2 w; w.x = cvt_pk_bf16(o[db][4 * g4 + 0] * inv, o[db][4 * g4 + 1] * inv); w.y = cvt_pk_bf16(o[db][4 * g4 + 2] * inv, o[db][4 * g4 + 3] * inv);
                *(u32x2*)(orow + d0) = w; }
    }
    __syncthreads();
}

#ifndef QSCALE_V
#define QSCALE_V (0.125f * LOG2E)
#endif
typedef __attribute__((address_space(4))) const Args* KArgP;
__device__ __forceinline__ KArgP kargs() { KArgP p = (KArgP)__builtin_amdgcn_kernarg_segment_ptr(); asm volatile("" : "+s"(p)); return p; }
#define AIN(k) (kargs()->in[k])
__global__ void __launch_bounds__(NWAVES * 64, 2) mk_fwd(Args args) {
    extern __shared__ __attribute__((aligned(16))) unsigned char lds_raw[];
    Frame F; F.lds = (LAS unsigned char*)lds_raw; F.tid = threadIdx.x; F.lane = F.tid & 63; F.wave = __builtin_amdgcn_readfirstlane(F.tid >> 6); F.G = gridDim.x;
    { const int bx = blockIdx.x; F.vcu = (F.G % 8 == 0) ? (bx % 8) * (F.G / 8) + bx / 8 : bx; }

    for (int u = F.tid; u < (LDS_BYTES - LDSCTL_OFF) / 4; u += NWAVES * 64) ((LAS unsigned*)(F.lds + LDSCTL_OFF))[u] = 0u;
    __syncthreads();
    volatile LAS unsigned* MISC = (volatile LAS unsigned*)(F.lds + MISC_OFF);
    (void)xcd_barrier_post((unsigned*)(kargs()->ws + WS_CTL) + CW_BAR + kargs()->li * XCD_BAR_WORDS, MISC + 8);
    if (F.tid == 0) atomicOr((unsigned*)(kargs()->ws + WS_CTL) + CW_GMASK + 64 * (blockIdx.x & 7), 1u << xb_xcc_id());
#define GRID_BARRIER() do { XcdBarrier bar_; bar_.bar = (unsigned*)(kargs()->ws + WS_CTL) + CW_BAR + kargs()->li * XCD_BAR_WORDS; bar_.x = xb_xcc_id(); bar_.st = (volatile LAS unsigned*)(F.lds + MISC_OFF) + 8; xcd_barrier(bar_); } while (0)
    const int lo = kargs()->ph_lo, hi = kargs()->ph_hi;
#define IN(k) (lo <= (k) && (k) < hi)
#define BOTH(k) (IN(k) && IN((k) + 1))
    const bool grouped = (F.G == 256); int gbk = 0;
    const int cvpos = grouped ? (int)(blockIdx.x & 7) : 0;
#define PHASE_BARRIER() do { if (grouped) { ++gbk; unsigned* gb_ = (unsigned*)(kargs()->ws + WS_CTL); const unsigned mk_ = xb_ld(gb_ + CW_GMASK + 64 * (blockIdx.x & 7)); \
        group_barrier(gb_ + CW_GBAR + 64 * (blockIdx.x & 7), (unsigned)(gbk * (F.G >> 3)), gb_ + CW_BAR + kargs()->li * XCD_BAR_WORDS + XB_TMO, (mk_ & (mk_ - 1u)) == 0u); } else GRID_BARRIER(); } while (0)
#define WSP(T, off) ((T*)(kargs()->ws + (off)))
#define Win WSP(bf16_t, WS_WIN)
#define Wxkv WSP(bf16_t, WS_WXKV)
#define Wout WSP(bf16_t, WS_WOUT)
#define Wxq WSP(bf16_t, WS_WXQ)
#define Wxo WSP(bf16_t, WS_WXO)
#define yb WSP(bf16_t, WS_YB)
#define qx WSP(bf16_t, WS_QX)
#define ox WSP(bf16_t, WS_OX)
#define sq1 WSP(float, WS_SQ1)
#define sq2 WSP(float, WS_SQ2)
#define listr WSP(float, WS_LISTR)
#define listg WSP(float, WS_LISTG)
#define Wrt WSP(bf16_t, WS_WRT)
#define ybuf WSP(bf16_t, WS_YBUF)
#define Wgu8 WSP(unsigned char, WS_WGU)
#define Wdn8 WSP(unsigned char, WS_WDN)
#define x2f8 WSP(unsigned char, WS_X2F6)
#define act8 WSP(unsigned char, WS_ACT)
#define list WSP(int, WS_LIST)
#define hb WSP(bf16_t, WS_HB)
#define hmb WSP(bf16_t, WS_HMB)
#define proj WSP(bf16_t, WS_PROJ)
#define kvmem WSP(bf16_t, WS_KVMEM)
    LAS unsigned* mtab = (LAS unsigned*)(F.lds + MOE_OFF);
    const int gw = F.vcu * NWAVES + F.wave, NGW = F.G * NWAVES;

    constexpr int CV_ALL = NE * (DM / 128) * (2 * DFF / 32) + NE * (DFF / 128) * (DM / 32);
    auto expert_convert = [&](int lo, int hi) {
        const int plane = fresh_tid() & 63; LAS float* scr = (LAS float*)(F.lds + RING_OFF + F.wave * 17408);
        {
            constexpr int GU6_PER_E = (DM / 128) * (2 * DFF / 32), DN6_PER_E = (DFF / 128) * (DM / 32), IT_GU6 = NE * GU6_PER_E, IT_DN6 = NE * DN6_PER_E;
            auto decode = [&](int r) -> F6Item { F6Item I;
                if (r < IT_GU6) { const int e = r / GU6_PER_E, rr = r % GU6_PER_E, kt = rr / (2 * DFF / 32), nb = rr % (2 * DFF / 32), c0 = 16 * nb, pn = c0 >> 7;
                    I.W = AIN(I_W_GU) + (size_t)e * DM * 2 * DFF; I.T = Wgu8 + ((size_t)(e * (2 * DFF / 256) + pn) * (DM / 128) + kt) * TILE6; I.g = AIN(I_NORM_FFN_G); I.ldw = 2 * DFF; I.k0 = 128 * kt; I.n0 = 32 * nb; I.s0 = c0 & 127; I.mode = 2; }
                else { r -= IT_GU6; const int e = r / DN6_PER_E, rr = r % DN6_PER_E, kt = rr / (DM / 32), nb = rr % (DM / 32), pn = nb >> 3;
                    I.W = AIN(I_W_DN) + (size_t)e * DFF * DM; I.T = Wdn8 + ((size_t)(e * (DM / 256) + pn) * (DFF / 128) + kt) * TILE6; I.g = nullptr; I.ldw = DM; I.k0 = 128 * kt; I.n0 = 32 * nb; I.s0 = (32 * nb) & 255; I.mode = 0; }
                return I; };
            int it = lo + gw; F6Item A{}, B{}; f32x4 va[16], vb[16];
            if (it < hi) { A = decode(it); p0_f6_load(A, va, plane); }
            while (it < hi) { const int nit = it + NGW;
                if (nit < hi) { B = decode(nit); p0_f6_load(B, vb, plane); }
                p0_f6_store(A, va, W6SCALE, scr, plane);
                A = B; it = nit;
#pragma unroll
                for (int i = 0; i < 16; ++i) va[i] = vb[i]; }
        }
    };
    if (IN(0)) {
        const int plane = fresh_tid() & 63;
        LAS float* scr = (LAS float*)(F.lds + RING_OFF + F.wave * 17408);
        constexpr int IT_IN = (DM / 64) * (NPROJ / 64), IT_XKV = (DM / 64) * (2 * DX / 64), IT_OUT = (DM / 64) * (DM / 64), IT_XQ = (DM / 64) * (DX / 64), IT_XO = (DX / 64) * (DM / 64), IT_RT = DM / 64;
        for (int it = gw; it < IT_IN + IT_XKV + IT_OUT + IT_XQ + IT_XO + IT_RT; it += NGW) {
            int r = it;
            if (r < IT_IN) { const int kb = r / (NPROJ / 64), nb = r % (NPROJ / 64); const int pn = nb >> 2, wc = nb & 3;
                p0_transpose64<1>(AIN(I_W_IN), NPROJ, DM, Win, 64 * kb, 64 * nb, 256 * pn + 32 * wc, nullptr, scr, plane); continue; }
            r -= IT_IN;
            if (r < IT_XKV) { const int kb = r / (2 * DX / 64), nb = r % (2 * DX / 64);
                p0_transpose64<0>(AIN(I_W_XKV), 2 * DX, DM, Wxkv, 64 * kb, 64 * nb, 64 * nb, nullptr, scr, plane); continue; }
            r -= IT_XKV;
            if (r < IT_OUT) { const int kb = r / (DM / 64), nb = r % (DM / 64);
                p0_transpose64<0>(AIN(I_W_OUT), DM, DM, Wout, 64 * kb, 64 * nb, 64 * nb, nullptr, scr, plane); continue; }
            r -= IT_OUT;
            if (r < IT_XQ) { const int kb = r / (DX / 64), nb = r % (DX / 64);
                p0_transpose64<0>(AIN(I_W_XQ), DX, DM, Wxq, 64 * kb, 64 * nb, 64 * nb, AIN(I_NORM_X_G), scr, plane); continue; }
            r -= IT_XQ;
            if (r < IT_XO) { const int kb = r / (DM / 64), nb = r % (DM / 64);
                p0_transpose64<0>(AIN(I_W_XO), DM, DX, Wxo, 64 * kb, 64 * nb, 64 * nb, nullptr, scr, plane); continue; }
            r -= IT_XO;
            p0_transpose_item(AIN(I_W_ROUTER), NE, DM, Wrt, 64 * r, 0, 1, 0, AIN(I_NORM_FFN_G), scr, plane);
        }
        for (int m = gw; m < MTOK; m += NGW) rms_row_to_bf16(AIN(I_X) + (size_t)m * DM, AIN(I_NORM_MIX_G), hb + (size_t)m * DM, plane);
        for (int m = gw; m < MMEM; m += NGW) rms_row_to_bf16(AIN(I_MEM) + (size_t)m * DM, AIN(I_NORM_MEM_G), hmb + (size_t)m * DM, plane);
        if (BOTH(0)) GRID_BARRIER();
    }
    if (IN(1)) {
        const int nrnd = (MTOK / 256) * (NPROJ / 256) / (F.G > 0 ? F.G : 1), ksplit = !grouped ? 0 : (cvpos * nrnd) / 7;
        { pg8::DenseSched S; S.init(hb, Win, MTOK, NPROJ, DM, F.G, (int)blockIdx.x); S.cnt = ksplit; EpiProj E{proj, AIN(I_Q_G), AIN(I_K_G), QSCALE_V, 0};
          if (ksplit > 0) pg8::gemm_phase<EpiProj, pg8::DenseSched, 0>(F.lds + RING_OFF, F.lds + IDX_OFF, S, E); }
        expert_convert(0, CV_ALL);
        __syncthreads();
        { pg8::DenseSched S; S.init(hb, Win, MTOK, NPROJ, DM, F.G, (int)blockIdx.x); S.i0 = ksplit; EpiProj E{proj, AIN(I_Q_G), AIN(I_K_G), QSCALE_V, 0};
          pg8::gemm_phase<EpiProj, pg8::DenseSched, 0>(F.lds + RING_OFF, F.lds + IDX_OFF, S, E); }
        if (F.G != 256) { pg8::DenseSched S; S.init(hmb, Wxkv, MMEM, 2 * DX, DM, F.G, (int)blockIdx.x); EpiBf16 E{kvmem, 2 * DX, 0};
          pg8::gemm_phase<EpiBf16, pg8::DenseSched, 0>(F.lds + RING_OFF, F.lds + IDX_OFF, S, E); }
        if (BOTH(1)) PHASE_BARRIER();
    }
    if (IN(2)) {
        if (F.G == 256) {
            const int bq = F.vcu >> 4, cls = F.vcu & 15;
            if (cls < 3) { pg8::ListSched S{(const char*)hmb, (const char*)Wxkv, DM, 2 * DX / 256, cls == 0 ? 4 * bq : 4 * bq + 1 + cls, cls == 0 ? 2 : 1};     EpiBf16 E{kvmem, 2 * DX, 0};
                pg8::gemm_phase<EpiBf16, pg8::ListSched, 0>(F.lds + RING_OFF, F.lds + IDX_OFF, S, E); }
        }
        p2_attn(F, proj, AIN(I_REL_BIAS), AIN(I_CONV_W), AIN(I_ONA_G), AIN(I_ONB_G), yb, AIN(I_Q_G), AIN(I_K_G), QSCALE_V);
        if (BOTH(2)) PHASE_BARRIER();
    }
    if (IN(3)) {
        { if (grouped) { for (int j = 0; j < 2; ++j) kv_knorm_row(kvmem, AIN(I_XK_G), (F.vcu >> 4) * (MMEM / BATCH) + (F.vcu & 15) * 16 + F.wave * 2 + j, fresh_tid() & 63); }
                          else for (int m = gw; m < MMEM; m += NGW) kv_knorm_row(kvmem, AIN(I_XK_G), m, fresh_tid() & 63); }
        pg8::DenseSched S; S.init(yb, Wout, MTOK, DM, DM, F.G, (int)blockIdx.x); EpiRes<false> E{AIN(I_X), hb, sq1, nullptr};
        pg8::gemm_phase<EpiRes<false>, pg8::DenseSched, 0>(F.lds + RING_OFF, F.lds + IDX_OFF, S, E);
        if (BOTH(3)) PHASE_BARRIER();
    }
    if (IN(4)) {
        pg8::DenseSched S; S.init(hb, Wxq, MTOK, DX, DM, F.G, (int)blockIdx.x); EpiRstdBf16 E{qx, sq1, DX, 0};
        pg8::gemm_phase<EpiRstdBf16, pg8::DenseSched, 0>(F.lds + RING_OFF, F.lds + IDX_OFF, S, E);
        if (BOTH(4)) PHASE_BARRIER();
    }
    if (IN(5)) {
        p5_xattn(F, qx, kvmem, AIN(I_XQ_G), ox, AIN(I_XK_G));
        if (BOTH(5)) PHASE_BARRIER();
    }
    if (IN(6)) {
        pg8::DenseSched S; S.init(ox, Wxo, MTOK, DM, DX, F.G, (int)blockIdx.x); EpiRes6 E{hb, sq2, x2f8};
        pg8::gemm_phase<EpiRes6, pg8::DenseSched, 0>(F.lds + RING_OFF, F.lds + IDX_OFF, S, E);
        if (BOTH(6)) GRID_BARRIER();
    }
    if (IN(7)) {
        p7_route(F, hb, Wrt, sq2, AIN(I_B_ROUTER), (unsigned*)(kargs()->ws + WS_CTL) + CW_CNT, list, listg, listr);
        if (BOTH(7)) GRID_BARRIER();
    }
    if (IN(8)) {
        moe_tables((unsigned*)(kargs()->ws + WS_CTL) + CW_CNT, mtab);
        MoeSched S{(const char*)x2f8, (const char*)Wgu8, (size_t)2 * DFF * ROWB6, list, listr, AIN(I_B_GU), mtab, DM, 2 * DFF / 256, (int)mtab[32 + NE], F.G, (int)blockIdx.x, 1, ROWB6, 2 * DFF, 128, MTOK * 128};
        EpiSwiglu6 E{act8, mtab, 1.0f / (X6SCALE * W6SCALE), 0};
        pg8::gemm_phase_f6<EpiSwiglu6, MoeSched, 2, 2>(F.lds + RING_OFF, F.lds + IDX_OFF, S, E);
        if (BOTH(8)) GRID_BARRIER();
    }
    if (IN(9)) {
        moe_tables((unsigned*)(kargs()->ws + WS_CTL) + CW_CNT, mtab);
        MoeSched S{(const char*)act8, (const char*)Wdn8, (size_t)DM * ROWB6F, list, listg, AIN(I_B_DN), mtab, DFF, DM / 256, (int)mtab[32 + NE], F.G, (int)blockIdx.x, 0, ROWB6F, DM, 0, TILE6};
        EpiDown8 E{(unsigned char*)ybuf, mtab, Y8SCALE / (A6SCALE * W6SCALE), 0};
        pg8::gemm_phase_f6<EpiDown8, MoeSched, 1, 3>(F.lds + RING_OFF, F.lds + IDX_OFF, S, E);
        if (BOTH(9)) GRID_BARRIER();
    }
    if (IN(10)) p10_combine(F, kargs()->out, hb, (const unsigned char*)ybuf);
#undef IN
#undef BOTH
#undef GRID_BARRIER
#undef PHASE_BARRIER
#undef WSP
#undef Win
#undef Wxkv
#undef Wout
#undef Wxq
#undef Wxo
#undef yb
#undef qx
#undef ox
#undef sq1
#undef sq2
#undef listr
#undef listg
#undef Wrt
#undef ybuf
#undef Wgu8
#undef Wdn8
#undef x2f8
#undef act8
#undef list
#undef hb
#undef hmb
#undef proj
#undef kvmem
}

static int g_grid = 0;
static void launch_mk(Args& a, int lo, int hi, int li, hipStream_t stream) {
    a.ph_lo = lo; a.ph_hi = hi; a.li = li; a.pad = 0;
    hipLaunchKernelGGL(mk_fwd, dim3(g_grid), dim3(NWAVES * 64), LDS_BYTES, stream, a);
}
extern "C" void kernel_launch(void* const* d_in, const int* in_sizes, int n_in, void* d_out, int out_size, void* d_ws, size_t ws_size, hipStream_t stream) {
    if (n_in != 25 || ws_size < WS_END || out_size != MTOK * DM) { fprintf(stderr, "kernel_launch: unexpected problem (n_in %d ws %zu out %d)\n", n_in, ws_size, out_size); return; }
    if (g_grid == 0) {
        int dev = 0, cus = 0;
        if (hipGetDevice(&dev) != hipSuccess || hipDeviceGetAttribute(&cus, hipDeviceAttributeMultiprocessorCount, dev) != hipSuccess) { g_grid = -1; return; }
        if (hipFuncSetAttribute((const void*)mk_fwd, hipFuncAttributeMaxDynamicSharedMemorySize, LDS_BYTES) != hipSuccess) { g_grid = -1; return; }
        int per_cu = 0; (void)hipOccupancyMaxActiveBlocksPerMultiprocessor(&per_cu, (const void*)mk_fwd, NWAVES * 64, LDS_BYTES); (void)hipGetLastError();
        g_grid = (per_cu >= 1) ? cus : -1;
    }
    if (g_grid < 0) return;
    unsigned char* ws = (unsigned char*)d_ws; float* out = (float*)d_out; unsigned* ctl = (unsigned*)(ws + WS_CTL);
    (void)hipMemsetAsync(ctl, 0, CTL_ZERO_BYTES, stream);
    Args a{}; for (int i = 0; i < 25; ++i) a.in[i] = (const float*)d_in[i]; a.out = out; a.ws = ws;
    launch_mk(a, 0, 11, 0, stream);
}
```

```cpp
#include <hip/hip_runtime.h>
#include <stdint.h>
#include <stdio.h>

#define LAS __attribute__((address_space(3)))
#define GAS __attribute__((address_space(1)))
typedef unsigned short bf16_t;
typedef short bf16x8 __attribute__((ext_vector_type(8)));
typedef float f32x4 __attribute__((ext_vector_type(4)));
typedef float f32x2 __attribute__((ext_vector_type(2)));
typedef float f32x16 __attribute__((ext_vector_type(16)));
typedef float f32x8 __attribute__((ext_vector_type(8)));
typedef unsigned u32x4 __attribute__((ext_vector_type(4)));
typedef unsigned u32x2 __attribute__((ext_vector_type(2)));
typedef int v8i32 __attribute__((ext_vector_type(8)));
typedef int v4i32 __attribute__((ext_vector_type(4)));
typedef int v2i32 __attribute__((ext_vector_type(2)));

constexpr int DM = 1024, BATCH = 16, SEQ = 2048, MTOK = BATCH * SEQ;
constexpr int CHUNK = 64, LEFT = 8, NMEM = 256, MMEM = BATCH * NMEM;
constexpr int DATT = 512, DCONV = 512, NPROJ = 3072, NPROJ_O = 3 * 512 + 2 * 512;
constexpr int XH = 4, XHD = 128, DX = 512;
constexpr int NE = 32, TOPK = 4, DFF = 1024;
constexpr int NREL = 513, MAXREL = 256;
constexpr int NASSIGN = MTOK * TOPK;
constexpr int MAXSLOT = NASSIGN + NE * 256;
constexpr float EPS = 1e-6f;
constexpr float LOG2E = 1.4426950408889634f;

constexpr size_t MiB = 1u << 20;
constexpr size_t WS_CTL = 0, CTL_ZERO_BYTES = 256 * 1024;
constexpr size_t WS_WIN = 1 * MiB, WS_WOUT = 7 * MiB, WS_WXQ = 9 * MiB, WS_WXKV = 10 * MiB, WS_WXO = 12 * MiB, WS_WGU = 13 * MiB, WS_WDN = 141 * MiB;
constexpr size_t WS_HB = 205 * MiB, WS_HMB = 269 * MiB;
constexpr size_t WS_LIST = 277 * MiB, WS_GATE = 281 * MiB, WS_SLOTTK = 282 * MiB, WS_SLOTSRC = 283 * MiB, WS_BLKE = 284 * MiB;
constexpr size_t WS_PROJ = 285 * MiB, WS_KVMEM = 477 * MiB, WS_YA = 485 * MiB, WS_YB = 549 * MiB, WS_X1 = 613 * MiB, WS_QX = 741 * MiB, WS_OX = 773 * MiB;
constexpr size_t WS_ACT = 285 * MiB, WS_YBUF = 557 * MiB, WS_X2F6 = 700 * MiB;
constexpr size_t WS_SQ1 = 813 * MiB, WS_SQ2 = 815 * MiB, WS_RSTD2 = 817 * MiB, WS_WRT = 818 * MiB, WS_LISTR = 819 * MiB, WS_LISTG = 824 * MiB, WS_END = 829 * MiB;
constexpr int CW_CNT = 0, CW_NBLK = 64, CW_PSTART = 128;
constexpr int CW_GMASK = 512;
constexpr int CW_GBAR = 1024;
constexpr int CW_BAR = 4096;

__device__ __forceinline__ unsigned f2bf(float f) { unsigned u = __builtin_bit_cast(unsigned, f); return (u + 0x7fffu + ((u >> 16) & 1u)) >> 16; }
__device__ __forceinline__ float bf2f(bf16_t b) { return __builtin_bit_cast(float, ((unsigned)b) << 16); }
__device__ __forceinline__ unsigned pk2(float lo, float hi) { return f2bf(lo) | (f2bf(hi) << 16); }
__device__ __forceinline__ float bflo(unsigned w) { return __builtin_bit_cast(float, w << 16); }
__device__ __forceinline__ float bfhi(unsigned w) { return __builtin_bit_cast(float, w & 0xffff0000u); }
template <int CTRL> __device__ __forceinline__ float dpp_f(float v) { return __builtin_bit_cast(float, __builtin_amdgcn_update_dpp(0, __builtin_bit_cast(int, v), CTRL, 0xF, 0xF, true)); }
__device__ __forceinline__ float wave_sum(float v) {
    v += dpp_f<0xB1>(v); v += dpp_f<0x4E>(v); v += dpp_f<0x141>(v); v += dpp_f<0x140>(v);
    { const auto p = __builtin_amdgcn_permlane32_swap(__builtin_bit_cast(unsigned, v), __builtin_bit_cast(unsigned, v), false, false); const unsigned a = p[0], b = p[1]; v = __builtin_bit_cast(float, a) + __builtin_bit_cast(float, b); }
    { const auto p = __builtin_amdgcn_permlane16_swap(__builtin_bit_cast(unsigned, v), __builtin_bit_cast(unsigned, v), false, false); const unsigned a = p[0], b = p[1]; v = __builtin_bit_cast(float, a) + __builtin_bit_cast(float, b); }
    return v;
}
__device__ __forceinline__ unsigned cvt_pk_bf16(float lo, float hi) { unsigned r; asm volatile("v_cvt_pk_bf16_f32 %0, %1, %2" : "=v"(r) : "v"(lo), "v"(hi)); return r; }
__device__ __forceinline__ v8i32 cat6(v2i32 a, v2i32 b, v2i32 c) { return (v8i32){a.x, a.y, b.x, b.y, c.x, c.y, 0, 0}; }
__device__ __forceinline__ v8i32 cat6h(v4i32 h, v2i32 t) { return (v8i32){h.x, h.y, h.z, h.w, t.x, t.y, 0, 0}; }
typedef unsigned u32x6 __attribute__((ext_vector_type(6)));

namespace pg8 {
constexpr int BM = 256, BK = 64, HALF = 128, HTB = HALF * BK * 2  , STAGE_BYTES = 8 * HTB, NXCD = 8, WGM = 8;
__host__ __device__ __forceinline__ int lds_byte(int r, int c) { const int st = (r >> 4) * 2 + (c >> 5), rr = r & 15, cc = c & 31, ob = rr * 64 + cc * 2; return st * 1024 + (ob ^ (((ob >> 9) & 1) << 5)); }
__host__ __device__ __forceinline__ void stage_rc(int b, int& R, int& C) { const int st = b / 1024, sb = b % 1024, swz = sb ^ (((sb >> 9) & 1) << 5); R = (st >> 1) * 16 + swz / 64; C = (st & 1) * 32 + (swz % 64) / 2; }
__host__ __device__ __forceinline__ int perm32(int rho) { const int n = rho >> 4, i = rho & 15; return 8 * (i >> 2) + 4 * n + (i & 3); }

struct Unit { int pm, pn, e, rbl; };

__device__ __forceinline__ bool static_order(int nM, int nN, int G, int c, int i, int& pm, int& pn) {
    const int nwg = nM * nN; const long L = (long)i * G + c; if (L >= nwg) return false;
    int wgid = (int)L; { const int q = nwg / NXCD, r = nwg % NXCD, xcd = wgid % NXCD, off = wgid / NXCD; wgid = (xcd < r ? xcd * (q + 1) : r * (q + 1) + (xcd - r) * q) + off; }
    const int nig = WGM * nN, gid = wgid / nig, fm = gid * WGM, gsz = (nM - fm) < WGM ? (nM - fm) : WGM;
    pm = fm + ((wgid % nig) % gsz); pn = (wgid % nig) / gsz; return true;
}
struct DenseSched {
    const char* A; const char* Bt; int K, nM, nN, G, c, i0, cnt;
    __device__ __forceinline__ void init(const void* A_, const void* Bt_, int M, int N, int K_, int G_, int c_) { A = (const char*)A_; Bt = (const char*)Bt_; K = K_; nM = M / BM; nN = N / BM; G = G_; c = c_; i0 = 0; cnt = 1 << 30; }
    __device__ __forceinline__ bool next(int i, Unit& u) const { u.e = 0; u.rbl = 0; if (i >= cnt) return false; return static_order(nM, nN, G, c, i0 + i, u.pm, u.pn); }
    __device__ __forceinline__ const char* a_base(const Unit& u) const { return A + (size_t)u.pm * BM * K * 2; }
    __device__ __forceinline__ const char* b_base(const Unit& u) const { return Bt + (size_t)u.pn * BM * K * 2; }
    __device__ __forceinline__ unsigned a_off(const Unit& u) const { return (unsigned)u.pm * BM * K; }
    __device__ __forceinline__ unsigned b_off(const Unit& u) const { return (unsigned)u.pn * BM * K; }
    __device__ __forceinline__ void issue_rows(const Unit&, LAS unsigned char*, int, int) const {}
    __device__ __forceinline__ void read_rows(const Unit&, const LAS unsigned char*, int, unsigned (&)[4]) const {}
};

struct ListSched {
    const char* A; const char* Bt; int K, nN, id0, cnt;
    __device__ __forceinline__ bool next(int i, Unit& u) const { if (i >= cnt) return false; const int id = id0 + i; u.pm = id / nN; u.pn = id % nN; u.e = 0; u.rbl = 0; return true; }
    __device__ __forceinline__ const char* a_base(const Unit& u) const { return A + (size_t)u.pm * BM * K * 2; }
    __device__ __forceinline__ const char* b_base(const Unit& u) const { return Bt + (size_t)u.pn * BM * K * 2; }
    __device__ __forceinline__ void issue_rows(const Unit&, LAS unsigned char*, int, int) const {}
    __device__ __forceinline__ void read_rows(const Unit&, const LAS unsigned char*, int, unsigned (&)[4]) const {}
};

template <class Epi, class Sched, int MODE>
__device__ __forceinline__ void gemm_phase(LAS unsigned char* lds, LAS unsigned char* ldsidx, const Sched& S, const Epi& E) {
    int tid_ = threadIdx.x; asm volatile("" : "+v"(tid_));
    const int tid = tid_, wid = __builtin_amdgcn_readfirstlane(tid >> 6), lane = tid & 63, wr = wid >> 2, wc = wid & 3, fr = lane & 15, fq = lane >> 4;
    const int K = S.K, nt = K / BK;
    int R0, C0; stage_rc(tid * 16, R0, C0);
    const int Rb = (R0 & ~31) + perm32(R0 & 31);
    const unsigned voffB0 = (unsigned)tid * 16u, voffB1 = voffB0 + 8192u;
    const size_t kstep = (size_t)(BK * 2), kstepB = (size_t)(2 * HTB);
    const size_t hstep = (size_t)HTB;
    (void)Rb;
    const unsigned ldsw = (unsigned)wid * 1024u;
    const int aoff = lds_byte(wr * 64 + fr, fq * 8), boff = lds_byte(wc * 32 + fr, fq * 8);
#define PG8_SA(b, h) (((b) * 2 + (h)) * HTB)
#define PG8_SB(b, h) ((4 + (b) * 2 + (h)) * HTB)
#define PG8_STAGE(bufoff, gbase, o0, o1) do { \
        __builtin_amdgcn_global_load_lds((const unsigned*)((const char*)(gbase) + (o0)), (LAS unsigned*)(lds + (bufoff) + ldsw), 16, 0, 0); \
        __builtin_amdgcn_global_load_lds((const unsigned*)((const char*)(gbase) + (o1)), (LAS unsigned*)(lds + (bufoff) + ldsw + 8192), 16, 0, 0); } while (0)
#define PG8_LDA(dst, b, h) do { _Pragma("unroll") for (int m = 0; m < 4; ++m) _Pragma("unroll") for (int k = 0; k < 2; ++k) dst[m][k] = *(const LAS bf16x8*)(lds + PG8_SA(b, h) + aoff + m * 2048 + k * 1024); } while (0)
#define PG8_LDB(dst, b, h) do { _Pragma("unroll") for (int n = 0; n < 2; ++n) _Pragma("unroll") for (int k = 0; k < 2; ++k) dst[n][k] = *(const LAS bf16x8*)(lds + PG8_SB(b, h) + boff + n * 2048 + k * 1024); } while (0)
#define PG8_MMA(ai, bj, At, Bt) do { __builtin_amdgcn_s_setprio(1); _Pragma("unroll") for (int m = 0; m < 4; ++m) _Pragma("unroll") for (int n = 0; n < 2; ++n) _Pragma("unroll") for (int k = 0; k < 2; ++k) \
        acc[ai][bj][m][n] = __builtin_amdgcn_mfma_f32_16x16x32_bf16(Bt[n][k], At[m][k], acc[ai][bj][m][n], 0, 0, 0); __builtin_amdgcn_s_setprio(0); } while (0)
#define PG8_WAIT_V(n) asm volatile("s_waitcnt vmcnt(" #n ")" ::: "memory")
#define PG8_WAIT_L(n) asm volatile("s_waitcnt lgkmcnt(" #n ")" ::: "memory")
#define PG8_BAR __builtin_amdgcn_s_barrier()
#define PG8_SCHED __builtin_amdgcn_sched_barrier(0)
    Unit cur, nxt; int ui = 0, ib = 0;
    if (!S.next(0, cur)) return;
    unsigned vc[4], vn[4];
    constexpr bool GATHER = (MODE == 2);
    if constexpr (MODE >= 1) { S.issue_rows(cur, ldsidx, wid, lane); asm volatile("s_waitcnt vmcnt(0)" ::: "memory"); __builtin_amdgcn_s_barrier(); asm volatile("" ::: "memory"); }
    if constexpr (GATHER) { S.read_rows(cur, ldsidx, R0, vc); _Pragma("unroll") for (int q = 0; q < 4; ++q) vc[q] += (unsigned)C0 * 2u; }
    else { _Pragma("unroll") for (int q = 0; q < 4; ++q) vc[q] = (unsigned)((R0 + 64 * q) * K + C0) * 2u; }
#pragma unroll
    for (int q = 0; q < 4; ++q) vn[q] = vc[q];
    f32x4 acc[2][2][4][2];
#pragma unroll
    for (int a = 0; a < 2; ++a)
#pragma unroll
        for (int b = 0; b < 2; ++b)
#pragma unroll
            for (int m = 0; m < 4; ++m)
#pragma unroll
                for (int n = 0; n < 2; ++n) acc[a][b][m][n] = (f32x4){0.f, 0.f, 0.f, 0.f};
    bf16x8 At[4][2], B0[2][2], B1[2][2];
    const char* cA = S.a_base(cur); const char* cB = S.b_base(cur);
    PG8_STAGE(PG8_SB(0, 0), cB, voffB0, voffB1); PG8_STAGE(PG8_SB(0, 1), cB + hstep, voffB0, voffB1); PG8_STAGE(PG8_SA(0, 0), cA, vc[0], vc[1]); PG8_STAGE(PG8_SA(0, 1), cA, vc[2], vc[3]);
    if (wr == 1) PG8_BAR;
    PG8_WAIT_V(2); PG8_BAR;
    PG8_STAGE(PG8_SB(1, 0), cB + kstepB, voffB0, voffB1); PG8_STAGE(PG8_SA(1, 0), cA + kstep, vc[0], vc[1]); PG8_STAGE(PG8_SB(1, 1), cB + hstep + kstepB, voffB0, voffB1);
    PG8_WAIT_V(6); PG8_BAR;
    for (;;) {
        const bool has_next = S.next(ui + 1, nxt);
        if constexpr (MODE >= 1) { if (has_next) S.issue_rows(nxt, ldsidx + (ib == 2 ? 0 : ib + 1) * 3072, wid, lane); }
        const char* nA = has_next ? S.a_base(nxt) : cA; const char* nB = has_next ? S.b_base(nxt) : cB;
        for (int t = 0; t < nt; t += 2) {
            const bool last = (t == nt - 2);
            const char* a1 = cA + (size_t)(t + 1) * kstep;
            const char* a2 = last ? nA : cA + (size_t)(t + 2) * kstep; const char* b2 = last ? nB : cB + (size_t)(t + 2) * kstepB;
            const char* a3 = a2 + kstep; const char* b3 = b2 + kstepB;
            unsigned w0 = vc[0], w1 = vc[1], w2 = vc[2], w3 = vc[3];
            if constexpr (GATHER) { if (last && has_next) { S.read_rows(nxt, ldsidx + (ib == 2 ? 0 : ib + 1) * 3072, R0, vn); _Pragma("unroll") for (int q = 0; q < 4; ++q) vn[q] += (unsigned)C0 * 2u;
                w0 = vn[0]; w1 = vn[1]; w2 = vn[2]; w3 = vn[3]; } }
            PG8_LDB(B0, 0, 0); PG8_LDB(B1, 0, 1); PG8_SCHED; PG8_LDA(At, 0, 0); PG8_STAGE(PG8_SA(1, 1), a1, vc[2], vc[3]);
            PG8_WAIT_V(8); PG8_WAIT_L(0); PG8_BAR; PG8_MMA(0, 0, At, B0); PG8_MMA(0, 1, At, B1); PG8_BAR; PG8_SCHED;
            PG8_LDA(At, 0, 1); PG8_STAGE(PG8_SB(0, 0), b2, voffB0, voffB1); PG8_STAGE(PG8_SB(0, 1), b2 + hstep, voffB0, voffB1); PG8_STAGE(PG8_SA(0, 0), a2, w0, w1);
            PG8_WAIT_V(8); PG8_WAIT_L(0); PG8_BAR; PG8_MMA(1, 0, At, B0); PG8_MMA(1, 1, At, B1); PG8_BAR; PG8_SCHED;
            PG8_LDB(B0, 1, 0); PG8_LDB(B1, 1, 1); PG8_SCHED; PG8_LDA(At, 1, 0); PG8_STAGE(PG8_SA(0, 1), a2, w2, w3);
            PG8_WAIT_V(8); PG8_WAIT_L(0); PG8_BAR; PG8_MMA(0, 0, At, B0); PG8_MMA(0, 1, At, B1); PG8_BAR; PG8_SCHED;
            PG8_LDA(At, 1, 1); PG8_STAGE(PG8_SB(1, 0), b3, voffB0, voffB1); PG8_STAGE(PG8_SB(1, 1), b3 + hstep, voffB0, voffB1); PG8_STAGE(PG8_SA(1, 0), a3, w0, w1);
            PG8_WAIT_V(8); PG8_WAIT_L(0); PG8_BAR; PG8_MMA(1, 0, At, B0); PG8_MMA(1, 1, At, B1); PG8_BAR; PG8_SCHED;
        }
        if (wr == 0) PG8_BAR;
        E(acc, cur, wr, wc, fr, fq, (const LAS unsigned char*)(ldsidx + ib * 3072));
        if (!has_next) break;
#pragma unroll
        for (int a = 0; a < 2; ++a)
#pragma unroll
            for (int b = 0; b < 2; ++b)
#pragma unroll
                for (int m = 0; m < 4; ++m)
#pragma unroll
                    for (int n = 0; n < 2; ++n) acc[a][b][m][n] = (f32x4){0.f, 0.f, 0.f, 0.f};
        cur = nxt; cA = nA; cB = nB; ++ui; ib = (ib == 2 ? 0 : ib + 1);
#pragma unroll
        for (int q = 0; q < 4; ++q) vc[q] = vn[q];
        if (wr == 1) PG8_BAR;
    }
    PG8_WAIT_V(0);
    PG8_BAR;
#undef PG8_SA
#undef PG8_SB
#undef PG8_STAGE
#undef PG8_LDA
#undef PG8_LDB
#undef PG8_MMA
#undef PG8_WAIT_V
#undef PG8_WAIT_L
#undef PG8_BAR
#undef PG8_SCHED
}
template <class Epi, class Sched, int MODE>
__device__ __forceinline__ void gemm_phase_f8(LAS unsigned char* lds, LAS unsigned char* ldsidx, const Sched& S, const Epi& E) {
    int tid_ = threadIdx.x; asm volatile("" : "+v"(tid_));
    const int tid = tid_, wid = __builtin_amdgcn_readfirstlane(tid >> 6), lane = tid & 63, wr = wid >> 2, wc = wid & 3, fr = lane & 15, fq = lane >> 4;
    constexpr bool GATHER = (MODE == 2);
    const int K = S.K, nt = K / 128;
    const int R0 = tid >> 3, C0 = ((tid & 7) ^ (((R0 >> 1) & 1) | (((R0 >> 3) & 1) << 2))) * 16;
    const int Rb = (R0 & ~31) + perm32(R0 & 31);
    const unsigned voffB0 = (unsigned)(Rb * K + C0), r64 = 64u * (unsigned)K;
    const unsigned kstep = 128u;
    const unsigned hstep = (unsigned)(HALF * K);
    const char* const Abase = S.A; const char* const Bbase = S.Bt;
    const unsigned ldsw = (unsigned)wid * 1024u;
    const int sg = ((fr >> 1) & 1) | (((fr >> 3) & 1) << 2);
    const LAS unsigned char* a0p = lds + (wr * 64 + fr) * 128 + (((2 * fq) ^ sg) * 16); const LAS unsigned char* a1p = lds + (wr * 64 + fr) * 128 + (((2 * fq + 1) ^ sg) * 16);
    const LAS unsigned char* b0p = lds + 4 * HTB + (wc * 32 + fr) * 128 + (((2 * fq) ^ sg) * 16); const LAS unsigned char* b1p = lds + 4 * HTB + (wc * 32 + fr) * 128 + (((2 * fq + 1) ^ sg) * 16);
#define PG8_SA(b, h) (((b) * 2 + (h)) * HTB)
#define PG8_SB(b, h) ((4 + (b) * 2 + (h)) * HTB)
#define PG8_STAGE(bufoff, gbase, o0, o1) do { \
        __builtin_amdgcn_global_load_lds((const unsigned*)((const char*)(gbase) + (o0)), (LAS unsigned*)(lds + (bufoff) + ldsw), 16, 0, 0); \
        __builtin_amdgcn_global_load_lds((const unsigned*)((const char*)(gbase) + (o1)), (LAS unsigned*)(lds + (bufoff) + ldsw + 8192), 16, 0, 0); } while (0)
#define PG8_STAGEA(bufoff, uo, hh) do { \
        __builtin_amdgcn_global_load_lds((const unsigned*)(Abase + (unsigned)((uo) + vc[2 * (hh)])), (LAS unsigned*)(lds + (bufoff) + ldsw), 16, 0, 0); \
        __builtin_amdgcn_global_load_lds((const unsigned*)(Abase + (unsigned)((uo) + vc[2 * (hh) + 1])), (LAS unsigned*)(lds + (bufoff) + ldsw + 8192), 16, 0, 0); } while (0)
#define PG8_STAGEB(bufoff, uo) do { \
        __builtin_amdgcn_global_load_lds((const unsigned*)(Bbase + (unsigned)((uo) + voffB0)), (LAS unsigned*)(lds + (bufoff) + ldsw), 16, 0, 0); \
        __builtin_amdgcn_global_load_lds((const unsigned*)(Bbase + (unsigned)((uo) + r64 + voffB0)), (LAS unsigned*)(lds + (bufoff) + ldsw + 8192), 16, 0, 0); } while (0)
#define PG8_LD32(p0, p1, off) __builtin_shufflevector(*(const LAS v4i32*)((p0) + (off)), *(const LAS v4i32*)((p1) + (off)), 0, 1, 2, 3, 4, 5, 6, 7)
#define PG8_LDA(dst, b, h) do { _Pragma("unroll") for (int m = 0; m < 4; ++m) dst[m] = PG8_LD32(a0p, a1p, PG8_SA(b, h) + m * 2048); } while (0)
#define PG8_LDB(dst, b, h) do { _Pragma("unroll") for (int n = 0; n < 2; ++n) dst[n] = PG8_LD32(b0p, b1p, PG8_SB(b, h) - 4 * HTB + n * 2048); } while (0)
#define PG8_MMA(ai, bj, At, Bt) do { __builtin_amdgcn_s_setprio(1); _Pragma("unroll") for (int m = 0; m < 4; ++m) _Pragma("unroll") for (int n = 0; n < 2; ++n) \
        acc[ai][bj][m][n] = __builtin_amdgcn_mfma_scale_f32_16x16x128_f8f6f4(Bt[n], At[m], acc[ai][bj][m][n], 0, 0, 0, 0, 0, 0); __builtin_amdgcn_s_setprio(0); } while (0)
#define PG8_WAIT_V(n) asm volatile("s_waitcnt vmcnt(" #n ")" ::: "memory")
#define PG8_WAIT_L(n) asm volatile("s_waitcnt lgkmcnt(" #n ")" ::: "memory")
#define PG8_BAR __builtin_amdgcn_s_barrier()
#define PG8_SCHED __builtin_amdgcn_sched_barrier(0)
    Unit cur, nxt; int ui = 0, ib = 0;
    if (!S.next(0, cur)) return;
    unsigned vc[4];
    if constexpr (MODE >= 1) { S.issue_rows(cur, ldsidx, wid, lane); asm volatile("s_waitcnt vmcnt(0)" ::: "memory"); __builtin_amdgcn_s_barrier(); asm volatile("" ::: "memory"); }
    if constexpr (GATHER) { S.read_rows(cur, ldsidx, R0, vc); _Pragma("unroll") for (int q = 0; q < 4; ++q) vc[q] += (unsigned)C0; }
    else { const unsigned ua = S.a_off(cur); _Pragma("unroll") for (int q = 0; q < 4; ++q) vc[q] = ua + (unsigned)((R0 + 64 * q) * K + C0); }
    f32x4 acc[2][2][4][2];
#pragma unroll
    for (int a = 0; a < 2; ++a)
#pragma unroll
        for (int b = 0; b < 2; ++b)
#pragma unroll
            for (int m = 0; m < 4; ++m)
#pragma unroll
                for (int n = 0; n < 2; ++n) acc[a][b][m][n] = (f32x4){0.f, 0.f, 0.f, 0.f};
    v8i32 At[4], B0[2], B1[2];
    unsigned cB = S.b_off(cur);
    PG8_STAGEB(PG8_SB(0, 0), cB); PG8_STAGEB(PG8_SB(0, 1), cB + hstep); PG8_STAGEA(PG8_SA(0, 0), 0u, 0); PG8_STAGEA(PG8_SA(0, 1), 0u, 1);
    if (wr == 1) PG8_BAR;
    PG8_WAIT_V(2); PG8_BAR;
    PG8_STAGEB(PG8_SB(1, 0), cB + kstep); PG8_STAGEA(PG8_SA(1, 0), kstep, 0); PG8_STAGEB(PG8_SB(1, 1), cB + hstep + kstep);
    PG8_WAIT_V(6); PG8_BAR;
    for (;;) {
        const bool has_next = S.next(ui + 1, nxt);
        if constexpr (MODE >= 1) { if (has_next) S.issue_rows(nxt, ldsidx + (ib == 2 ? 0 : ib + 1) * 3072, wid, lane); }
        const unsigned nB = has_next ? S.b_off(nxt) : cB;
        for (int t = 0; t < nt; t += 2) {
            const bool last = (t == nt - 2);
            const unsigned a1 = (unsigned)(t + 1) * kstep;
            const unsigned a2 = last ? 0u : (unsigned)(t + 2) * kstep, b2 = last ? nB : cB + (unsigned)(t + 2) * kstep;
            const unsigned a3 = a2 + kstep, b3 = b2 + kstep;
            PG8_LDB(B0, 0, 0); PG8_LDB(B1, 0, 1); PG8_SCHED; PG8_LDA(At, 0, 0); PG8_STAGEA(PG8_SA(1, 1), a1, 1);
            if (last && has_next) {
                if constexpr (GATHER) { S.read_rows(nxt, ldsidx + (ib == 2 ? 0 : ib + 1) * 3072, R0, vc); _Pragma("unroll") for (int q = 0; q < 4; ++q) vc[q] += (unsigned)C0; }
                else { const unsigned ua = S.a_off(nxt); _Pragma("unroll") for (int q = 0; q < 4; ++q) vc[q] = ua + (unsigned)((R0 + 64 * q) * K + C0); } }
            PG8_WAIT_V(8); PG8_WAIT_L(0); PG8_BAR; PG8_MMA(0, 0, At, B0); PG8_MMA(0, 1, At, B1); PG8_BAR; PG8_SCHED;
            PG8_LDA(At, 0, 1); PG8_STAGEB(PG8_SB(0, 0), b2); PG8_STAGEB(PG8_SB(0, 1), b2 + hstep); PG8_STAGEA(PG8_SA(0, 0), a2, 0);
            PG8_WAIT_V(8); PG8_WAIT_L(0); PG8_BAR; PG8_MMA(1, 0, At, B0); PG8_MMA(1, 1, At, B1); PG8_BAR; PG8_SCHED;
            PG8_LDB(B0, 1, 0); PG8_LDB(B1, 1, 1); PG8_SCHED; PG8_LDA(At, 1, 0); PG8_STAGEA(PG8_SA(0, 1), a2, 1);
            PG8_WAIT_V(8); PG8_WAIT_L(0); PG8_BAR; PG8_MMA(0, 0, At, B0); PG8_MMA(0, 1, At, B1); PG8_BAR; PG8_SCHED;
            PG8_LDA(At, 1, 1); PG8_STAGEB(PG8_SB(1, 0), b3); PG8_STAGEB(PG8_SB(1, 1), b3 + hstep); PG8_STAGEA(PG8_SA(1, 0), a3, 0);
            PG8_WAIT_V(8); PG8_WAIT_L(0); PG8_BAR; PG8_MMA(1, 0, At, B0); PG8_MMA(1, 1, At, B1); PG8_BAR; PG8_SCHED;
        }
        if (wr == 0) PG8_BAR;
        E(acc, cur, wr, wc, fr, fq, (const LAS unsigned char*)(ldsidx + ib * 3072));
        if (!has_next) break;
#pragma unroll
        for (int a = 0; a < 2; ++a)
#pragma unroll
            for (int b = 0; b < 2; ++b)
#pragma unroll
                for (int m = 0; m < 4; ++m) { acc[a][b][m][0] = (f32x4){0.f, 0.f, 0.f, 0.f}; acc[a][b][m][1] = (f32x4){0.f, 0.f, 0.f, 0.f}; }
        cur = nxt; cB = nB; ++ui; ib = (ib == 2 ? 0 : ib + 1);
        if (wr == 1) PG8_BAR;
    }
    PG8_WAIT_V(0);
    PG8_BAR;
#undef PG8_SA
#undef PG8_SB
#undef PG8_STAGE
#undef PG8_STAGEB
#undef PG8_STAGEA
#undef PG8_LDA
#undef PG8_LDB
#undef PG8_MMA
#undef PG8_LD32
#undef PG8_WAIT_V
#undef PG8_WAIT_L
#undef PG8_BAR
#undef PG8_SCHED
}
template <class Epi, class Sched, int MODE, int AFMT, int PM = 0>
__device__ __forceinline__ void gemm_phase_f6(LAS unsigned char* lds, LAS unsigned char* ldsidx, const Sched& S, const Epi& E) {
    int tid_ = threadIdx.x; asm volatile("" : "+v"(tid_));
    const int tid = tid_, wid = __builtin_amdgcn_readfirstlane(tid >> 6), lane = tid & 63, wr = wid >> 2, wc = wid & 3, fr = lane & 15, fq = lane >> 4;
    constexpr bool GATHER = (MODE == 2);
    constexpr int HT6 = HALF * 96;
    const int K = S.K, nt = K / 128, KB = (K >> 2) * 3;
    const int s0 = tid, s1 = 512 + wid * 32 + (lane & 31);
    const int Ra = s0 / 6, Rc = s1 / 6;
    const int pa = s0 - Ra * 6, pc = s1 - Rc * 6;
    const int ca = (pa < 4 ? pa : 4 + ((pa - 4) ^ ((Ra >> 3) & 1))) * 16, cc = (pc < 4 ? pc : 4 + ((pc - 4) ^ ((Rc >> 3) & 1))) * 16;
    const bool lo32 = lane < 32;
    const unsigned voffBa = (unsigned)s0 * 16u, voffBc = (unsigned)s1 * 16u;
    const unsigned kstep = 2u * HT6, kstepA = (unsigned)S.akstep;
    const unsigned hstep = (unsigned)HT6;
    const char* const Abase = S.A; const char* const Bbase = S.Bt;
    const unsigned ldsw = (unsigned)wid * 1024u, ldsw2 = 8192u + (unsigned)wid * 512u;
    const int hd6 = 16 * fq, tl6 = 64 + ((8 * fq + 16 * ((fr >> 3) & 1)) & 31);
    const LAS unsigned char* aP = lds + (wr * 64 + fr) * 96 + hd6; const LAS unsigned char* aT = lds + (wr * 64 + fr) * 96 + tl6;
    const LAS unsigned char* bP = lds + 4 * HT6 + (wc * 32 + fr) * 96 + hd6; const LAS unsigned char* bT = lds + 4 * HT6 + (wc * 32 + fr) * 96 + tl6;
#define PG6_SA(b, h) (((b) * 2 + (h)) * HT6)
#define PG6_SB(b, h) ((4 + (b) * 2 + (h)) * HT6)
#define PG6_FA(bufoff, uo, hh) if constexpr (PM != 2) __builtin_amdgcn_global_load_lds((const unsigned*)(Abase + (unsigned)((uo) + vc[2 * (hh)])), (LAS unsigned*)(lds + (bufoff) + ldsw), 16, 0, 0)
#define PG6_HA(bufoff, uo, hh) if constexpr (PM != 2) __builtin_amdgcn_global_load_lds((const unsigned*)(Abase + (unsigned)((uo) + vc[2 * (hh) + 1])), (LAS unsigned*)(lds + (bufoff) + ldsw2), 16, 0, 0)
#define PG6_FB(bufoff, uo) __builtin_amdgcn_global_load_lds((const unsigned*)(Bbase + (unsigned)((uo) + voffBa)), (LAS unsigned*)(lds + (bufoff) + ldsw), 16, 0, 0)
#define PG6_HB(bufoff, uo) __builtin_amdgcn_global_load_lds((const unsigned*)(Bbase + (unsigned)((uo) + voffBc)), (LAS unsigned*)(lds + (bufoff) + ldsw2), 16, 0, 0)
#define PG6_B3(b, uo) do { if constexpr (PM != 2) _Pragma("unroll") for (int i3 = 0; i3 < 3; ++i3) __builtin_amdgcn_global_load_lds((const unsigned*)(Bbase + (unsigned)((uo) + i3 * 8192u + voffBa)), (LAS unsigned*)(lds + PG6_SB(b, 0) + i3 * 8192 + ldsw), 16, 0, 0); } while (0)
#define PG6_LD24(ph, pt, off) cat6h(*(const LAS v4i32*)((ph) + (off)), *(const volatile LAS v2i32*)((pt) + (off)))
#define PG6_LDA(dst, b, h) do { if constexpr (PM != 3) _Pragma("unroll") for (int m = 0; m < 4; ++m) dst[m] = PG6_LD24(aP, aT, PG6_SA(b, h) + m * 1536); } while (0)
#define PG6_LDB(dst, b, h) do { if constexpr (PM != 3) _Pragma("unroll") for (int n = 0; n < 2; ++n) dst[n] = PG6_LD24(bP, bT, PG6_SB(b, h) - 4 * HT6 + n * 1536); } while (0)
#define PG6_MMA(ai, bj, At, Bt) do { __builtin_amdgcn_s_setprio(1); if constexpr (PM < 3) { _Pragma("unroll") for (int m = 0; m < 4; ++m) _Pragma("unroll") for (int n = 0; n < 2; ++n) \
        acc[ai][bj][m][n] = __builtin_amdgcn_mfma_scale_f32_16x16x128_f8f6f4(Bt[n], At[m], acc[ai][bj][m][n], 2, AFMT, 0, 0, 0, 0); } \
        else if constexpr (PM == 4) { _Pragma("unroll") for (int m = 0; m < 4; ++m) _Pragma("unroll") for (int i6 = 0; i6 < 6; ++i6) sink ^= At[m][i6]; _Pragma("unroll") for (int n = 0; n < 2; ++n) _Pragma("unroll") for (int i6 = 0; i6 < 6; ++i6) sink ^= Bt[n][i6]; } \
        __builtin_amdgcn_s_setprio(0); } while (0)
#define PG6_WAIT_V(n) asm volatile("s_waitcnt vmcnt(" #n ")" ::: "memory")
#define PG6_WAIT_L(n) asm volatile("s_waitcnt lgkmcnt(" #n ")" ::: "memory")
#define PG6_BAR __builtin_amdgcn_s_barrier()
#define PG6_SCHED __builtin_amdgcn_sched_barrier(0)
#define PG6_ROWS(u) do { if constexpr (GATHER) { S.read_rows2(u, ldsidx + ibn * 3072, Ra, Rc, vc); vc[0] += (unsigned)ca; vc[2] += (unsigned)ca; vc[1] += (unsigned)cc; vc[3] += (unsigned)cc; } \
        else { const unsigned ua = S.a_off(u); vc[0] = ua + voffBa; vc[1] = ua + voffBc; vc[2] = vc[0] + hstep; vc[3] = vc[1] + hstep; } } while (0)
    Unit cur, nxt; int ui = 0, ib = 0;
    if (!S.next(0, cur)) return;
    unsigned vc[4];
    if constexpr (MODE >= 1) { S.issue_rows(cur, ldsidx, wid, lane); asm volatile("s_waitcnt vmcnt(0)" ::: "memory"); __builtin_amdgcn_s_barrier(); asm volatile("" ::: "memory"); }
    { const int ibn = 0; PG6_ROWS(cur); }
    f32x4 acc[2][2][4][2];
#pragma unroll
    for (int a = 0; a < 2; ++a)
#pragma unroll
        for (int b = 0; b < 2; ++b)
#pragma unroll
            for (int m = 0; m < 4; ++m)
#pragma unroll
                for (int n = 0; n < 2; ++n) acc[a][b][m][n] = (f32x4){0.f, 0.f, 0.f, 0.f};
    v8i32 At[4], B0[2], B1[2]; int sink = 0; (void)sink;
    unsigned cB = S.b_off(cur);
    PG6_B3(0, cB); PG6_FA(PG6_SA(0, 0), 0u, 0); if (lo32) { PG6_HA(PG6_SA(0, 0), 0u, 0); }
    PG6_SCHED; PG6_FA(PG6_SA(0, 1), 0u, 1); if (lo32) { PG6_HA(PG6_SA(0, 1), 0u, 1); }
    if (wr == 1) PG6_BAR;
    PG6_WAIT_V(2); PG6_BAR;
    PG6_B3(1, cB + kstep); PG6_FA(PG6_SA(1, 0), kstepA, 0); if (lo32) { PG6_HA(PG6_SA(1, 0), kstepA, 0); }
    PG6_WAIT_V(5); PG6_BAR;
    for (;;) {
        const bool has_next = S.next(ui + 1, nxt);
        const int ibn = (ib == 2 ? 0 : ib + 1);
        if constexpr (MODE >= 1) { if (has_next) S.issue_rows(nxt, ldsidx + ibn * 3072, wid, lane); }
        const unsigned nB = has_next ? S.b_off(nxt) : cB;
        for (int t = 0; t < nt; t += 2) {
            const bool last = (t == nt - 2);
            const unsigned a1 = (unsigned)(t + 1) * kstepA;
            const unsigned a2 = last ? 0u : (unsigned)(t + 2) * kstepA, b2 = last ? nB : cB + (unsigned)(t + 2) * kstep;
            const unsigned a3 = a2 + kstepA, b3 = b2 + kstep;
            PG6_LDB(B0, 0, 0); PG6_LDB(B1, 0, 1); PG6_SCHED; PG6_LDA(At, 0, 0); PG6_FA(PG6_SA(1, 1), a1, 1); if (lo32) { PG6_HA(PG6_SA(1, 1), a1, 1); }
            if (last && has_next) PG6_ROWS(nxt);
            PG6_WAIT_V(7); PG6_WAIT_L(0); PG6_BAR; PG6_MMA(0, 0, At, B0); PG6_MMA(0, 1, At, B1); PG6_BAR; PG6_SCHED;
            PG6_LDA(At, 0, 1); PG6_B3(0, b2); PG6_FA(PG6_SA(0, 0), a2, 0); if (lo32) { PG6_HA(PG6_SA(0, 0), a2, 0); }
            PG6_WAIT_V(7); PG6_WAIT_L(0); PG6_BAR; PG6_MMA(1, 0, At, B0); PG6_MMA(1, 1, At, B1); PG6_BAR; PG6_SCHED;
            PG6_LDB(B0, 1, 0); PG6_LDB(B1, 1, 1); PG6_SCHED; PG6_LDA(At, 1, 0); PG6_FA(PG6_SA(0, 1), a2, 1); if (lo32) { PG6_HA(PG6_SA(0, 1), a2, 1); }
            PG6_WAIT_V(7); PG6_WAIT_L(0); PG6_BAR; PG6_MMA(0, 0, At, B0); PG6_MMA(0, 1, At, B1); PG6_BAR; PG6_SCHED;
            PG6_LDA(At, 1, 1); PG6_B3(1, b3); PG6_FA(PG6_SA(1, 0), a3, 0); if (lo32) { PG6_HA(PG6_SA(1, 0), a3, 0); }
            PG6_WAIT_V(7); PG6_WAIT_L(0); PG6_BAR; PG6_MMA(1, 0, At, B0); PG6_MMA(1, 1, At, B1); PG6_BAR; PG6_SCHED;
        }
        if (wr == 0) PG6_BAR;
        if constexpr (PM == 0) E(acc, cur, wr, wc, fr, fq, (const LAS unsigned char*)(ldsidx + ib * 3072));
        else { float sm = 0.f;
#pragma unroll
            for (int a = 0; a < 2; ++a)
#pragma unroll
                for (int b2 = 0; b2 < 2; ++b2)
#pragma unroll
                    for (int m = 0; m < 4; ++m)
#pragma unroll
                        for (int n = 0; n < 2; ++n) sm += (acc[a][b2][m][n].x + acc[a][b2][m][n].y) + (acc[a][b2][m][n].z + acc[a][b2][m][n].w);
            if (sm == 1.2345678e-30f || sink == 0x12345679) ((volatile LAS unsigned*)ldsidx)[2300] = 1u; }
        if (!has_next) break;
#pragma unroll
        for (int a = 0; a < 2; ++a)
#pragma unroll
            for (int b = 0; b < 2; ++b)
#pragma unroll
                for (int m = 0; m < 4; ++m) { acc[a][b][m][0] = (f32x4){0.f, 0.f, 0.f, 0.f}; acc[a][b][m][1] = (f32x4){0.f, 0.f, 0.f, 0.f}; }
        cur = nxt; cB = nB; ++ui; ib = ibn;
        if (wr == 1) PG6_BAR;
    }
    PG6_WAIT_V(0);
    PG6_BAR;
#undef PG6_SA
#undef PG6_SB
#undef PG6_FA
#undef PG6_HA
#undef PG6_FB
#undef PG6_HB
#undef PG6_B3
#undef PG6_LDA
#undef PG6_LDB
#undef PG6_MMA
#undef PG6_LD24
#undef PG6_ROWS
#undef PG6_WAIT_V
#undef PG6_WAIT_L
#undef PG6_BAR
#undef PG6_SCHED
}
}

#define XB_TMO      128
#define XB_XCNT(j)  (256  + 64 * (j))
#define XB_XSUB(j)  (1280 + 64 * (j))
#define XB_XGEN(j)  (2304 + 64 * (j))
#define XB_TOP      3328
#define XB_TOPGEN   3392
#define XCD_BAR_WORDS 3456
#define XB_SPIN_CAP (1u << 18)

__device__ __forceinline__ unsigned xb_ld(unsigned* p)              { return __hip_atomic_load(p, __ATOMIC_RELAXED, __HIP_MEMORY_SCOPE_AGENT); }
__device__ __forceinline__ unsigned xb_add(unsigned* p, unsigned v) { return __hip_atomic_fetch_add(p, v, __ATOMIC_RELAXED, __HIP_MEMORY_SCOPE_AGENT); }
__device__ __forceinline__ unsigned xb_xcc_id() { return (unsigned)__builtin_amdgcn_s_getreg((3 << 11) | 20) & 0xFu; }
#define XB_SPIN(cond, bar) do { unsigned _sp = 0; while (cond) { __builtin_amdgcn_s_sleep(1); \
    if ((++_sp & 255u) == 0u) { if (xb_ld(&(bar)[XB_TMO])) break; if (_sp > XB_SPIN_CAP) { atomicAdd(&(bar)[XB_TMO], 1u); break; } } } } while (0)

struct XcdBarrier {
    unsigned* bar; unsigned x;
    volatile LAS unsigned* st;
};
__device__ __forceinline__ XcdBarrier xcd_barrier_post(unsigned* bar, volatile LAS unsigned* st) {
    XcdBarrier b; b.bar = bar; b.x = xb_xcc_id(); b.st = st;
    if (threadIdx.x == 0) (void)xb_add(&bar[XB_XCNT(b.x)], 1u);
    return b;
}
__device__ __forceinline__ void xcd_barrier_complete(unsigned* bar, unsigned x, unsigned& nloc, unsigned& nx) {
    const unsigned G = gridDim.x * gridDim.y * gridDim.z;
    unsigned sum, cnt, mine, sp = 0u;
    for (;;) {
        sum = 0u; cnt = 0u; mine = 0u;
#pragma unroll
        for (unsigned j = 0; j < 16; ++j) { const unsigned c = xb_ld(&bar[XB_XCNT(j)]); sum += c; cnt += (c > 0u) ? 1u : 0u; mine = (j == x) ? c : mine; }
        if (sum == G) break;
        __builtin_amdgcn_s_sleep(1);
        if ((++sp & 255u) == 0u) { if (xb_ld(&bar[XB_TMO])) break; if (sp > XB_SPIN_CAP) { atomicAdd(&bar[XB_TMO], 1u); break; } }
    }
    nloc = mine > 0u ? mine : 1u; nx = cnt > 0u ? cnt : 1u;
}
__device__ __forceinline__ void xcd_barrier(const XcdBarrier& b) {
    asm volatile("s_waitcnt vmcnt(0)" ::: "memory");
    __syncthreads();
    if (threadIdx.x == 0) {
        unsigned* bar = b.bar;
        __builtin_amdgcn_s_waitcnt(0);
        unsigned nloc = b.st[0], nx = b.st[1];
        if (nloc == 0u) { xcd_barrier_complete(bar, b.x, nloc, nx); b.st[0] = nloc; b.st[1] = nx; }
        const unsigned old = xb_add(&bar[XB_XSUB(b.x)], 1u);
        const unsigned gen = old / nloc;
        if (old + 1u == (gen + 1u) * nloc) {
            __builtin_amdgcn_fence(__ATOMIC_RELEASE, "agent");
            asm volatile("s_waitcnt vmcnt(0)" ::: "memory");
            const unsigned og = xb_add(&bar[XB_TOP], 1u);
            const unsigned tg = og / nx;
            if (og + 1u == (tg + 1u) * nx) xb_add(&bar[XB_TOPGEN], 1u);
            else XB_SPIN(xb_ld(&bar[XB_TOPGEN]) == tg, bar);
            __builtin_amdgcn_fence(__ATOMIC_ACQUIRE, "agent");
            xb_add(&bar[XB_XGEN(b.x)], 1u);
            asm volatile("s_waitcnt vmcnt(0)" ::: "memory");
        } else {
            XB_SPIN(xb_ld(&bar[XB_XGEN(b.x)]) == gen, bar);
            __builtin_amdgcn_fence(__ATOMIC_ACQUIRE, "agent");
            asm volatile("s_waitcnt vmcnt(0)" ::: "memory");
        }
    }
    __syncthreads();
}

__device__ __forceinline__ void group_barrier(unsigned* cnt, unsigned target, unsigned* tmo, bool same_xcc) {
    asm volatile("s_waitcnt vmcnt(0)" ::: "memory");
    __syncthreads();
    if (threadIdx.x == 0) {
        __builtin_amdgcn_s_waitcnt(0);
        if (!same_xcc) { __builtin_amdgcn_fence(__ATOMIC_RELEASE, "agent"); asm volatile("s_waitcnt vmcnt(0)" ::: "memory"); }
        (void)xb_add(cnt, 1u);
        { unsigned sp_ = 0; while (xb_ld(cnt) < target) { __builtin_amdgcn_s_sleep(1); if ((++sp_ & 255u) == 0u) { if (xb_ld(tmo)) break; if (sp_ > XB_SPIN_CAP) { atomicAdd(tmo, 1u); break; } } } }
        __builtin_amdgcn_fence(__ATOMIC_ACQUIRE, "agent");
        asm volatile("s_waitcnt vmcnt(0)" ::: "memory");
    }
    __syncthreads();
}

constexpr int NWAVES = 8;
constexpr int RING_OFF = 0, RING_BYTES = 139264;
constexpr int LDSCTL_OFF = RING_BYTES, MISC_OFF = LDSCTL_OFF + 320;
constexpr int MOE_OFF = LDSCTL_OFF + 512;
constexpr int IDX_OFF = LDSCTL_OFF + 4096;
constexpr int TBL_OFF = LDSCTL_OFF + 4096;
constexpr int SSQ_OFF = LDSCTL_OFF + 16384;
constexpr int LDS_BYTES = RING_BYTES + 20480;
static_assert(TBL_OFF + 8 * 384 * 4 <= SSQ_OFF && SSQ_OFF + 4096 <= LDS_BYTES && LDS_BYTES <= 160 * 1024, "LDS map");

struct Args { const float* in[25]; float* out; unsigned char* ws; int ph_lo, ph_hi, li, pad; };
enum { I_X = 0, I_MEM, I_NORM_MIX_G, I_W_IN, I_Q_G, I_K_G, I_REL_BIAS, I_CONV_W, I_ONA_G, I_ONB_G, I_W_OUT, I_NORM_X_G, I_NORM_MEM_G, I_W_XQ, I_W_XKV, I_XQ_G, I_XK_G, I_W_XO,
       I_NORM_FFN_G, I_W_ROUTER, I_B_ROUTER, I_W_GU, I_B_GU, I_W_DN, I_B_DN };

constexpr float X8SCALE = 4.0f, W8SCALE = 64.0f, A8SCALE = 8.0f, Y8SCALE = 32.0f;
constexpr float X6SCALE = 1.0f, W6SCALE = 64.0f, A6SCALE = 1.0f;
static_assert(DM == DFF, "the prologue's fp6 items use one row length");
constexpr int ROWB6 = DM / 4 * 3, ROWB6F = DFF / 4 * 3;
__device__ __forceinline__ int fresh_tid() { int t = threadIdx.x; asm volatile("" : "+v"(t)); return t; }
struct Frame {
    LAS unsigned char* lds; int tid, lane, wave, vcu, G;
};

__device__ __forceinline__ int bimg_row(int sp) { const int s5 = sp & 31; return (sp & ~31) + 16 * ((s5 >> 2) & 1) + 4 * (s5 >> 3) + (s5 & 3); }
__device__ __forceinline__ void p0_transpose_item(const float* __restrict__ W, int ldw, int K, bf16_t* __restrict__ WT, int k0, int scol0, int cstride, int drow0, const float* __restrict__ g, LAS float* scr, int lane) {
#pragma unroll 8
    for (int i = 0; i < 32; ++i) { const int kk = 2 * i + (lane >> 5); float v = W[(size_t)(k0 + kk) * ldw + scol0 + (lane & 31) * cstride]; if (g) v *= g[k0 + kk]; scr[kk * 33 + (lane & 31)] = v; }
    asm volatile("s_waitcnt lgkmcnt(0)" ::: "memory");
    const int c = lane & 7;
#pragma unroll
    for (int j = 0; j < 4; ++j) { const int n = (lane >> 3) + 8 * j; const LAS float* s = scr + (8 * c) * 33 + n;
        u32x4 o; o.x = pk2(s[0 * 33], s[1 * 33]); o.y = pk2(s[2 * 33], s[3 * 33]); o.z = pk2(s[4 * 33], s[5 * 33]); o.w = pk2(s[6 * 33], s[7 * 33]);
        *(u32x4*)(WT + (size_t)(drow0 + n) * K + k0 + 8 * c) = o; }
    asm volatile("s_waitcnt lgkmcnt(0)" ::: "memory");
}
template <int MODE>
__device__ __forceinline__ void p0_transpose64(const float* __restrict__ W, int ldw, int K, bf16_t* __restrict__ WT, int k0, int n0, int drow0, const float* __restrict__ g, LAS float* scr, int lane) {
    const int krow = lane >> 4, c4 = lane & 15;
    f32x4 v[16];
#pragma unroll
    for (int i = 0; i < 16; ++i) v[i] = *(const f32x4*)(W + (size_t)(k0 + 4 * i + krow) * ldw + n0 + 4 * c4);
    if (g) {
#pragma unroll
        for (int i = 0; i < 16; ++i) v[i] = v[i] * g[k0 + 4 * i + krow]; }
#pragma unroll
    for (int i = 0; i < 16; ++i) { LAS float* d = scr + (4 * i + krow) * 65 + 4 * c4; d[0] = v[i].x; d[1] = v[i].y; d[2] = v[i].z; d[3] = v[i].w; }
    asm volatile("s_waitcnt lgkmcnt(0)" ::: "memory");
    const int kc = lane & 7;
#pragma unroll
    for (int j = 0; j < 8; ++j) { const int n = (lane >> 3) + 8 * j; const LAS float* s = scr + (8 * kc) * 65 + n;
        u32x4 o; o.x = pk2(s[0 * 65], s[1 * 65]); o.y = pk2(s[2 * 65], s[3 * 65]); o.z = pk2(s[4 * 65], s[5 * 65]); o.w = pk2(s[6 * 65], s[7 * 65]);
        const int dr = MODE == 0 ? n : (MODE == 1 ? 128 * (n >> 5) + (n & 31) : 128 * (n & 1) + (n >> 1));
        const int drow = drow0 + dr, slot = drow & 255, R = bimg_row(slot & 127);
        *(u32x4*)((char*)WT + ((size_t)((drow >> 8) * (K / 64) + (k0 >> 6)) * 2 + (slot >> 7)) * pg8::HTB + pg8::lds_byte(R, 8 * kc)) = o; }
    asm volatile("s_waitcnt lgkmcnt(0)" ::: "memory");
}
__device__ __forceinline__ float clamp8(float v) { return fminf(fmaxf(v, -448.0f), 448.0f); }
__device__ __forceinline__ unsigned pk4_fp8(float a, float b, float c, float d) { int w = 0; w = __builtin_amdgcn_cvt_pk_fp8_f32(a, b, w, false); w = __builtin_amdgcn_cvt_pk_fp8_f32(c, d, w, true); return (unsigned)w; }
template <int MODE>
__device__ __forceinline__ void p0_transpose64_f8(const float* __restrict__ W, int ldw, int K, unsigned char* __restrict__ WT, int k0, int n0, int drow0, const float* __restrict__ g, float sc, LAS float* scr, int lane) {
    const int krow = lane >> 4, c4 = lane & 15;
    f32x4 v[16];
#pragma unroll
    for (int i = 0; i < 16; ++i) v[i] = *(const f32x4*)(W + (size_t)(k0 + 4 * i + krow) * ldw + n0 + 4 * c4);
#pragma unroll
    for (int i = 0; i < 16; ++i) v[i] = v[i] * (g ? g[k0 + 4 * i + krow] * sc : sc);
#pragma unroll
    for (int i = 0; i < 16; ++i) { LAS float* d = scr + (4 * i + krow) * 65 + 4 * c4; d[0] = v[i].x; d[1] = v[i].y; d[2] = v[i].z; d[3] = v[i].w; }
    asm volatile("s_waitcnt lgkmcnt(0)" ::: "memory");
    const int kc = lane & 3;
#pragma unroll
    for (int j = 0; j < 4; ++j) { const int n = (lane >> 2) + 16 * j; const LAS float* s = scr + (16 * kc) * 65 + n;
        u32x4 o; o.x = pk4_fp8(s[0 * 65], s[1 * 65], s[2 * 65], s[3 * 65]); o.y = pk4_fp8(s[4 * 65], s[5 * 65], s[6 * 65], s[7 * 65]);
        o.z = pk4_fp8(s[8 * 65], s[9 * 65], s[10 * 65], s[11 * 65]); o.w = pk4_fp8(s[12 * 65], s[13 * 65], s[14 * 65], s[15 * 65]);
        const int dr = MODE == 0 ? n : (MODE == 1 ? 128 * (n >> 5) + (n & 31) : 128 * (n & 1) + (n >> 1));
        *(u32x4*)(WT + (size_t)(drow0 + dr) * K + k0 + 16 * kc) = o; }
    asm volatile("s_waitcnt lgkmcnt(0)" ::: "memory");
}
struct F8Item { const float* W; unsigned char* WT; const float* g; int ldw, k0, n0, drow0, mode; };
__device__ __forceinline__ void p0_f8_load(const F8Item& I, f32x4 (&v)[16], int lane) {
    const int krow = lane >> 4, c4 = lane & 15;
#pragma unroll
    for (int i = 0; i < 16; ++i) v[i] = *(const f32x4*)(I.W + (size_t)(I.k0 + 4 * i + krow) * I.ldw + I.n0 + 4 * c4);
}
__device__ __forceinline__ void p0_f8_store(const F8Item& I, const f32x4 (&v)[16], int K, float sc, LAS float* scr, int lane) {
    const int krow = lane >> 4, c4 = lane & 15;
#pragma unroll
    for (int i = 0; i < 16; ++i) { const float s = I.g ? I.g[I.k0 + 4 * i + krow] * sc : sc; LAS float* d = scr + (4 * i + krow) * 65 + 4 * c4; d[0] = v[i].x * s; d[1] = v[i].y * s; d[2] = v[i].z * s; d[3] = v[i].w * s; }
    asm volatile("s_waitcnt lgkmcnt(0)" ::: "memory");
    const int kc = lane & 3;
#pragma unroll
    for (int j = 0; j < 4; ++j) { const int n = (lane >> 2) + 16 * j; const LAS float* s = scr + (16 * kc) * 65 + n;
        u32x4 o; o.x = pk4_fp8(s[0 * 65], s[1 * 65], s[2 * 65], s[3 * 65]); o.y = pk4_fp8(s[4 * 65], s[5 * 65], s[6 * 65], s[7 * 65]);
        o.z = pk4_fp8(s[8 * 65], s[9 * 65], s[10 * 65], s[11 * 65]); o.w = pk4_fp8(s[12 * 65], s[13 * 65], s[14 * 65], s[15 * 65]);
        const int dr = I.mode == 0 ? n : 128 * (n & 1) + (n >> 1);
        *(u32x4*)(I.WT + (size_t)(I.drow0 + dr) * K + I.k0 + 16 * kc) = o; }
    asm volatile("s_waitcnt lgkmcnt(0)" ::: "memory");
}
__device__ __forceinline__ float clamp6(float v) { return fminf(fmaxf(v, -7.5f), 7.5f); }
__device__ __forceinline__ void store_ht(unsigned char* hd, unsigned char* tl, const u32x6 w) { *(u32x4*)hd = (u32x4){w[0], w[1], w[2], w[3]}; *(u32x2*)tl = (u32x2){w[4], w[5]}; }
constexpr int TILE6 = 256 * 96, HT6B = 128 * 96;
__device__ __forceinline__ int lds_row_of_slot(int sp) { const int s5 = sp & 31; return (sp & ~31) + 16 * ((s5 >> 2) & 1) + 4 * (s5 >> 3) + (s5 & 3); }
struct F6Item { const float* W; unsigned char* T; const float* g; int ldw, k0, n0, s0, mode; };
__device__ __forceinline__ void p0_f6_load(const F6Item& I, f32x4 (&v)[16], int lane) {
    const int krow = lane >> 3, c4 = lane & 7;
#pragma unroll
    for (int i = 0; i < 16; ++i) v[i] = *(const f32x4*)(I.W + (size_t)(I.k0 + 8 * i + krow) * I.ldw + I.n0 + 4 * c4);
}
__device__ __forceinline__ void p0_f6_store(const F6Item& I, const f32x4 (&v)[16], float sc, LAS float* scr, int lane) {
    const int krow = lane >> 3, c4 = lane & 7;
#pragma unroll
    for (int i = 0; i < 16; ++i) { const float s = I.g ? I.g[I.k0 + 8 * i + krow] * sc : sc; LAS float* d = scr + (8 * i + krow) * 33 + 4 * c4; d[0] = v[i].x * s; d[1] = v[i].y * s; d[2] = v[i].z * s; d[3] = v[i].w * s; }
    asm volatile("s_waitcnt lgkmcnt(0)" ::: "memory");
    const int n = lane & 31;
    const int slot = I.mode == 2 ? 128 * (n & 1) + I.s0 + (n >> 1) : I.s0 + n;
    const int R = lds_row_of_slot(slot & 127); unsigned char* rowp = I.T + ((slot >> 7) * 128 + R) * 96; const int rot = 16 * ((R >> 3) & 1);
#pragma unroll
    for (int j = 0; j < 2; ++j) { const int kb = (lane >> 5) + 2 * j; const LAS float* sp = scr + (32 * kb) * 33 + n;
        f32x16 a, b;
#pragma unroll
        for (int t = 0; t < 16; ++t) { a[t] = clamp6(sp[t * 33]); b[t] = clamp6(sp[(16 + t) * 33]); }
        store_ht(rowp + 16 * kb, rowp + 64 + ((8 * kb + rot) & 31), __builtin_amdgcn_cvt_scalef32_2xpk16_fp6_f32(a, b, 1.0f)); }
    asm volatile("s_waitcnt lgkmcnt(0)" ::: "memory");
}
__device__ __forceinline__ void rms_row_to_bf16(const float* __restrict__ xrow, const float* __restrict__ g, bf16_t* __restrict__ orow, int lane) {
    const f32x4* xr = (const f32x4*)xrow + lane; const f32x4* gr = (const f32x4*)g + lane;
    f32x4 v[4]; float s = 0.f;
#pragma unroll
    for (int j = 0; j < 4; ++j) { v[j] = xr[64 * j]; s += (v[j].x * v[j].x + v[j].y * v[j].y) + (v[j].z * v[j].z + v[j].w * v[j].w); }
    const float rstd = __builtin_amdgcn_rsqf(wave_sum(s) * (1.0f / DM) + EPS);
    u32x2* o8 = (u32x2*)orow + lane;
#pragma unroll
    for (int j = 0; j < 4; ++j) { const f32x4 gg = gr[64 * j]; u32x2 o; o.x = pk2(v[j].x * rstd * gg.x, v[j].y * rstd * gg.y); o.y = pk2(v[j].z * rstd * gg.z, v[j].w * rstd * gg.w); o8[64 * j] = o; }
}

__device__ __forceinline__ void row_to_bf16_rstd(const float* __restrict__ xrow, bf16_t* __restrict__ orow, float* __restrict__ rs, int lane) {
    const f32x4* xr = (const f32x4*)xrow + lane;
    f32x4 v[4]; float s = 0.f;
#pragma unroll
    for (int j = 0; j < 4; ++j) { v[j] = __builtin_nontemporal_load(xr + 64 * j); s += (v[j].x * v[j].x + v[j].y * v[j].y) + (v[j].z * v[j].z + v[j].w * v[j].w); }
    const float rstd = __builtin_amdgcn_rsqf(wave_sum(s) * (1.0f / DM) + EPS);
    if (lane == 0) *rs = rstd;
    u32x2* o8 = (u32x2*)orow + lane;
#pragma unroll
    for (int j = 0; j < 4; ++j) { u32x2 o; o.x = pk2(v[j].x, v[j].y); o.y = pk2(v[j].z, v[j].w); __builtin_nontemporal_store(o, o8 + 64 * j); }
}

using pg8::Unit;
struct EpiProj { bf16_t* O; const float* qg; const float* kg; float qscale; int pad; const float* rstd0;
    __device__ __forceinline__ void operator()(const f32x4 (&acc)[2][2][4][2], const Unit& u, int wr, int wc, int fr, int fq, const LAS unsigned char*) const {
        const int row0 = u.pm * 256 + wr * 64 + fr, colb = u.pn * 256 + wc * 64 + 8 * fq;
        const int mode = u.pn < 2 ? 1 : (u.pn < 4 ? 2 : 0);
        const bool utile = u.pn >= 8;
        f32x4 gv[2][2];
        if (mode) { const float* gp = (mode == 1 ? qg : kg) + 8 * fq; const float sc = mode == 1 ? qscale : 1.0f;
#pragma unroll
            for (int bj = 0; bj < 2; ++bj)
#pragma unroll
                for (int n = 0; n < 2; ++n) gv[bj][n] = *(const f32x4*)(gp + 32 * bj + 4 * n) * sc; }
        float rs0v[2][4];
#pragma unroll
        for (int ai = 0; ai < 2; ++ai)
#pragma unroll
            for (int m = 0; m < 4; ++m) rs0v[ai][m] = rstd0[row0 + ai * 128 + m * 16];
#pragma unroll
        for (int ai = 0; ai < 2; ++ai)
#pragma unroll
            for (int m = 0; m < 4; ++m) { const float rs0 = rs0v[ai][m];
                f32x4 v[2][2];
#pragma unroll
                for (int bj = 0; bj < 2; ++bj)
#pragma unroll
                    for (int n = 0; n < 2; ++n) v[bj][n] = acc[ai][bj][m][n] * rs0;
                if (mode) { float ss = 0.f;
#pragma unroll
                    for (int bj = 0; bj < 2; ++bj)
#pragma unroll
                        for (int n = 0; n < 2; ++n) ss += (v[bj][n].x * v[bj][n].x + v[bj][n].y * v[bj][n].y) + (v[bj][n].z * v[bj][n].z + v[bj][n].w * v[bj][n].w);
                    ss += __shfl_xor(ss, 16); ss += __shfl_xor(ss, 32);
                    const float rstd = __builtin_amdgcn_rsqf(ss * (1.0f / 64.0f) + EPS);
#pragma unroll
                    for (int bj = 0; bj < 2; ++bj)
#pragma unroll
                        for (int n = 0; n < 2; ++n) v[bj][n] = v[bj][n] * rstd * gv[bj][n]; }
                if (utile) { const f32x4 p0 = v[0][0] * v[1][0], p1 = v[0][1] * v[1][1];
                    u32x4 w; w.x = cvt_pk_bf16(p0.x, p0.y); w.y = cvt_pk_bf16(p0.z, p0.w); w.z = cvt_pk_bf16(p1.x, p1.y); w.w = cvt_pk_bf16(p1.z, p1.w);
                    *(u32x4*)(O + (size_t)(row0 + ai * 128 + m * 16) * NPROJ_O + 4 * 512 + 128 * (u.pn - 8) + 32 * wc + 8 * fq) = w; continue; }
                bf16_t* rowp = O + (size_t)(row0 + ai * 128 + m * 16) * NPROJ_O + colb;
#pragma unroll
                for (int bj = 0; bj < 2; ++bj) { u32x4 w; w.x = cvt_pk_bf16(v[bj][0].x, v[bj][0].y); w.y = cvt_pk_bf16(v[bj][0].z, v[bj][0].w); w.z = cvt_pk_bf16(v[bj][1].x, v[bj][1].y); w.w = cvt_pk_bf16(v[bj][1].z, v[bj][1].w);
                    *(u32x4*)(rowp + 32 * bj) = w; }
            }
    }
};
struct EpiBf16 { bf16_t* O; int ldo; int pad;
    __device__ __forceinline__ void operator()(const f32x4 (&acc)[2][2][4][2], const Unit& u, int wr, int wc, int fr, int fq, const LAS unsigned char*) const {
        const int row0 = u.pm * 256 + wr * 64 + fr, col0 = u.pn * 256 + wc * 32 + 8 * fq;
#pragma unroll
        for (int ai = 0; ai < 2; ++ai)
#pragma unroll
            for (int m = 0; m < 4; ++m) { bf16_t* rowp = O + (size_t)(row0 + ai * 128 + m * 16) * ldo + col0;
#pragma unroll
                for (int bj = 0; bj < 2; ++bj) { const f32x4 v0 = acc[ai][bj][m][0], v1 = acc[ai][bj][m][1];
                    u32x4 w; w.x = cvt_pk_bf16(v0.x, v0.y); w.y = cvt_pk_bf16(v0.z, v0.w); w.z = cvt_pk_bf16(v1.x, v1.y); w.w = cvt_pk_bf16(v1.z, v1.w);
                    *(u32x4*)(rowp + bj * 128) = w; } }
    }
};
template <bool BASE_BF16, bool F8COPY = false> struct EpiRes { const void* base; bf16_t* outb; float* sq; unsigned char* out8;
    __device__ __forceinline__ void operator()(const f32x4 (&acc)[2][2][4][2], const Unit& u, int wr, int wc, int fr, int fq, const LAS unsigned char*) const {
        const int row0 = u.pm * 256 + wr * 64 + fr, col0 = u.pn * 256 + wc * 32 + 8 * fq;
        u32x4 bq[2][4][2];
        if constexpr (BASE_BF16) { const unsigned bo = (unsigned)(row0 * DM + col0) * 2u;
#pragma unroll
            for (int ai = 0; ai < 2; ++ai)
#pragma unroll
                for (int m = 0; m < 4; ++m)
#pragma unroll
                    for (int bj = 0; bj < 2; ++bj) bq[ai][m][bj] = *(const u32x4*)((const char*)base + (bo + (unsigned)((ai * 128 + m * 16) * DM + bj * 128) * 2u));
        }
#pragma unroll
        for (int ai = 0; ai < 2; ++ai) {
#pragma unroll
            for (int m = 0; m < 4; ++m) { const int row = row0 + ai * 128 + m * 16; const size_t off = (size_t)row * DM + col0; float ss = 0.f;
#pragma unroll
                for (int bj = 0; bj < 2; ++bj) { f32x4 b0, b1;
                    if constexpr (BASE_BF16) { const u32x4 bb = bq[ai][m][bj]; b0 = (f32x4){bflo(bb.x), bfhi(bb.x), bflo(bb.y), bfhi(bb.y)}; b1 = (f32x4){bflo(bb.z), bfhi(bb.z), bflo(bb.w), bfhi(bb.w)}; }
                    else { b0 = *(const f32x4*)((const float*)base + off + bj * 128); b1 = *(const f32x4*)((const float*)base + off + bj * 128 + 4); }
                    const f32x4 v0 = acc[ai][bj][m][0] + b0, v1 = acc[ai][bj][m][1] + b1;
                    u32x4 w; w.x = cvt_pk_bf16(v0.x, v0.y); w.y = cvt_pk_bf16(v0.z, v0.w); w.z = cvt_pk_bf16(v1.x, v1.y); w.w = cvt_pk_bf16(v1.z, v1.w);
                    *(u32x4*)(outb + off + bj * 128) = w;
                    if constexpr (F8COPY) { u32x2 w8; w8.x = pk4_fp8(clamp8(v0.x * X8SCALE), clamp8(v0.y * X8SCALE), clamp8(v0.z * X8SCALE), clamp8(v0.w * X8SCALE)); w8.y = pk4_fp8(clamp8(v1.x * X8SCALE), clamp8(v1.y * X8SCALE), clamp8(v1.z * X8SCALE), clamp8(v1.w * X8SCALE)); *(u32x2*)(out8 + off + bj * 128) = w8; }
                    ss += (v0.x * v0.x + v0.y * v0.y) + (v0.z * v0.z + v0.w * v0.w) + (v1.x * v1.x + v1.y * v1.y) + (v1.z * v1.z + v1.w * v1.w); }
                ss += __shfl_xor(ss, 16); ss += __shfl_xor(ss, 32);
                if (fq == 0) sq[((size_t)u.pn * MTOK + row) * 4 + wc] = ss; } }
    }
};
__device__ __forceinline__ void swap32f(float& x, float& y) { const auto p = __builtin_amdgcn_permlane32_swap(__builtin_bit_cast(unsigned, x), __builtin_bit_cast(unsigned, y), false, false); const unsigned a = p[0], b = p[1]; x = __builtin_bit_cast(float, a); y = __builtin_bit_cast(float, b); }
__device__ __forceinline__ void swap16f(float& x, float& y) { const auto p = __builtin_amdgcn_permlane16_swap(__builtin_bit_cast(unsigned, x), __builtin_bit_cast(unsigned, y), false, false); const unsigned a = p[0], b = p[1]; x = __builtin_bit_cast(float, a); y = __builtin_bit_cast(float, b); }
__device__ __forceinline__ void tr4(float& r0, float& r1, float& r2, float& r3) { swap32f(r0, r2); swap32f(r1, r3); swap16f(r0, r1); swap16f(r2, r3); }
struct EpiRes6 { bf16_t* hbp; float* sq; unsigned char* out6;
    __device__ __forceinline__ void operator()(const f32x4 (&acc)[2][2][4][2], const Unit& u, int wr, int wc, int fr, int fq, const LAS unsigned char*) const {
        const int row0 = u.pm * 256 + wr * 64 + fr, col0 = u.pn * 256 + wc * 32 + 8 * fq;
        f32x4 vv[2][4][2][2];
#pragma unroll
        for (int ai = 0; ai < 2; ++ai) {
            u32x4 bq[4][2];
#pragma unroll
            for (int m = 0; m < 4; ++m)
#pragma unroll
                for (int bj = 0; bj < 2; ++bj) bq[m][bj] = *(const u32x4*)(hbp + (size_t)(row0 + ai * 128 + m * 16) * DM + col0 + bj * 128);
#pragma unroll
            for (int m = 0; m < 4; ++m) { const int row = row0 + ai * 128 + m * 16; const size_t off = (size_t)row * DM + col0; float ss = 0.f;
#pragma unroll
                for (int bj = 0; bj < 2; ++bj) { const u32x4 bb = bq[m][bj];
                    const f32x4 v0 = acc[ai][bj][m][0] + (f32x4){bflo(bb.x), bfhi(bb.x), bflo(bb.y), bfhi(bb.y)}, v1 = acc[ai][bj][m][1] + (f32x4){bflo(bb.z), bfhi(bb.z), bflo(bb.w), bfhi(bb.w)};
                    u32x4 w; w.x = cvt_pk_bf16(v0.x, v0.y); w.y = cvt_pk_bf16(v0.z, v0.w); w.z = cvt_pk_bf16(v1.x, v1.y); w.w = cvt_pk_bf16(v1.z, v1.w);
                    *(u32x4*)(hbp + off + bj * 128) = w;
                    vv[ai][m][bj][0] = v0 * X6SCALE; vv[ai][m][bj][1] = v1 * X6SCALE;
                    ss += (v0.x * v0.x + v0.y * v0.y) + (v0.z * v0.z + v0.w * v0.w) + (v1.x * v1.x + v1.y * v1.y) + (v1.z * v1.z + v1.w * v1.w); }
                ss += __shfl_xor(ss, 16); ss += __shfl_xor(ss, 32);
                if (fq == 0) sq[((size_t)u.pn * MTOK + row) * 4 + wc] = ss; } }
#pragma unroll
        for (int b = 0; b < 2; ++b) { const int rho = 2 * fq + b; unsigned char* rowp = out6 + ((size_t)(2 * u.pn) * MTOK + (u.pm * 256 + (rho >> 2) * 128 + wr * 64 + (rho & 3) * 16 + fr)) * 128 + wc * 16;
#pragma unroll
            for (int bj = 0; bj < 2; ++bj) { f32x16 s0, s1;
#pragma unroll
                for (int n = 0; n < 2; ++n)
#pragma unroll
                    for (int k = 0; k < 4; ++k) { float r0 = vv[0][b][bj][n][k], r1 = vv[0][2 + b][bj][n][k], r2 = vv[1][b][bj][n][k], r3 = vv[1][2 + b][bj][n][k]; tr4(r0, r1, r2, r3);
                        s0[4 * n + k] = r0; s0[8 + 4 * n + k] = r1; s1[4 * n + k] = r2; s1[8 + 4 * n + k] = r3; }
                { unsigned char* rp = rowp + (size_t)bj * MTOK * 128; store_ht(rp, rp + 64 - 8 * wc, __builtin_amdgcn_cvt_scalef32_2xpk16_fp6_f32(s0, s1, 1.0f)); } } }
    }
};
struct EpiRstdBf16 { bf16_t* O; const float* sq; int ldo; int pad;
    __device__ __forceinline__ void operator()(const f32x4 (&acc)[2][2][4][2], const Unit& u, int wr, int wc, int fr, int fq, const LAS unsigned char*) const {
        const int row0 = u.pm * 256 + wr * 64 + fr, col0 = u.pn * 256 + wc * 32 + 8 * fq;
        float rsv[2][4];
#pragma unroll
        for (int ai = 0; ai < 2; ++ai)
#pragma unroll
            for (int m = 0; m < 4; ++m) { const int row = row0 + ai * 128 + m * 16; float s = 0.f;
#pragma unroll
                for (int t = 0; t < 4; ++t) { const f32x4 p = *(const f32x4*)(sq + ((size_t)t * MTOK + row) * 4); s += (p.x + p.y) + (p.z + p.w); }
                rsv[ai][m] = __builtin_amdgcn_rsqf(s * (1.0f / DM) + EPS); }
#pragma unroll
        for (int ai = 0; ai < 2; ++ai)
#pragma unroll
            for (int m = 0; m < 4; ++m) { const int row = row0 + ai * 128 + m * 16; const float rstd = rsv[ai][m];
                bf16_t* rowp = O + (size_t)row * ldo + col0;
#pragma unroll
                for (int bj = 0; bj < 2; ++bj) { const f32x4 v0 = acc[ai][bj][m][0] * rstd, v1 = acc[ai][bj][m][1] * rstd;
                    u32x4 w; w.x = cvt_pk_bf16(v0.x, v0.y); w.y = cvt_pk_bf16(v0.z, v0.w); w.z = cvt_pk_bf16(v1.x, v1.y); w.w = cvt_pk_bf16(v1.z, v1.w);
                    *(u32x4*)(rowp + bj * 128) = w; } }
    }
};
constexpr int LSTRIDE = MTOK;
struct MoeSched {
    const char* A; const char* Bt; size_t estride; const int* list; const float* listv; const float* bias; const LAS unsigned* tab; int K, nN, nblk, G, c, gather, rowb, bstride, arow, akstep;
    __device__ __forceinline__ bool next(int i, Unit& u) const {
        if (!pg8::static_order(nblk, nN, G, c, i, u.pm, u.pn)) return false;
        int e = 0; while (e < NE - 1 && (int)tab[32 + e + 1] <= u.pm) ++e;
        e = __builtin_amdgcn_readfirstlane(e); u.e = e; u.rbl = u.pm - (int)__builtin_amdgcn_readfirstlane(tab[32 + e]); return true;
    }
    __device__ __forceinline__ const char* a_base(const Unit& u) const { return gather ? A : A + (size_t)u.pm * 256 * rowb; }
    __device__ __forceinline__ const char* b_base(const Unit& u) const { return Bt + (size_t)u.e * estride + (size_t)u.pn * 256 * rowb; }
    __device__ __forceinline__ unsigned a_off(const Unit& u) const { return gather ? 0u : (unsigned)u.pm * 256u * (unsigned)rowb; }
    __device__ __forceinline__ unsigned b_off(const Unit& u) const { return (unsigned)u.e * (unsigned)estride + (unsigned)u.pn * 256u * (unsigned)rowb; }
    __device__ __forceinline__ void issue_rows(const Unit& u, LAS unsigned char* buf, int wid, int lane) const {
        const size_t li = (size_t)u.e * LSTRIDE + u.rbl * 256 + (wid & 3) * 64 + lane;
        if (wid < 4) __builtin_amdgcn_global_load_lds((const unsigned*)(list + li), (LAS unsigned*)(buf + wid * 256), 4, 0, 0);
        else __builtin_amdgcn_global_load_lds((const unsigned*)(listv + li), (LAS unsigned*)(buf + 1024 + (wid - 4) * 256), 4, 0, 0);
        if (wid == 0) __builtin_amdgcn_global_load_lds((const unsigned*)(bias + (size_t)u.e * bstride + u.pn * 256 + lane * 4), (LAS unsigned*)(buf + 2048), 16, 0, 0);
    }
    __device__ __forceinline__ void read_rows(const Unit& u, const LAS unsigned char* buf, int R0, unsigned (&off)[4]) const {
        const int cnt = (int)tab[u.e] - u.rbl * 256;
#pragma unroll
        for (int q = 0; q < 4; ++q) { const int j = R0 + 64 * q; const int v = ((const LAS int*)buf)[j]; const int tok = (j < cnt) ? (v >> 2) : 0; off[q] = (unsigned)tok * (unsigned)rowb; }
    }
    __device__ __forceinline__ void read_rows2(const Unit& u, const LAS unsigned char* buf, int Ra, int Rc, unsigned (&off)[4]) const {
        const int cnt = (int)tab[u.e] - u.rbl * 256;
#pragma unroll
        for (int q = 0; q < 4; ++q) { const int j = (q & 1 ? Rc : Ra) + 128 * (q >> 1); const int v = ((const LAS int*)buf)[j]; const int tok = (j < cnt) ? (v >> 2) : 0; off[q] = (unsigned)tok * (unsigned)arow; }
    }
};
struct EpiSwiglu8 { unsigned char* act; const LAS unsigned* tab; float isc; int pad;
    __device__ __forceinline__ void operator()(const f32x4 (&acc)[2][2][4][2], const Unit& u, int wr, int wc, int fr, int fq, const LAS unsigned char* meta) const {
        const int cnt = (int)tab[u.e] - u.rbl * 256, c0 = u.pn * 128 + wc * 32 + 8 * fq;
        const LAS f32x4* bp = (const LAS f32x4*)(meta + 2048 + (64 * wc + 16 * fq) * 4); f32x4 bb[4];
#pragma unroll
        for (int i = 0; i < 4; ++i) bb[i] = bp[i];
#pragma unroll
        for (int ai = 0; ai < 2; ++ai)
#pragma unroll
            for (int m = 0; m < 4; ++m) { const int j = ai * 128 + wr * 64 + m * 16 + fr; const float rs = (j < cnt) ? ((const LAS float*)(meta + 1024))[j] * isc : 0.f;
                float o[8];
#pragma unroll
                for (int n = 0; n < 2; ++n)
#pragma unroll
                    for (int k = 0; k < 4; ++k) { const int cc = 4 * n + k; const float bg = bb[cc >> 1][(cc & 1) * 2], bl = bb[cc >> 1][(cc & 1) * 2 + 1];
                        const float g = fminf(acc[ai][0][m][n][k] * rs + bg, 7.0f), l = fminf(fmaxf(acc[ai][1][m][n][k] * rs + bl, -7.0f), 7.0f);
                        o[cc] = fminf(fmaxf(g * __builtin_amdgcn_rcpf(1.0f + __builtin_amdgcn_exp2f(-1.702f * LOG2E * g)) * (l + 1.0f) * A8SCALE, -448.0f), 448.0f); }
                u32x2 w; w.x = pk4_fp8(o[0], o[1], o[2], o[3]); w.y = pk4_fp8(o[4], o[5], o[6], o[7]);
                *(u32x2*)(act + (size_t)(u.pm * 256 + j) * DFF + c0) = w; }
    }
};
struct EpiSwiglu6 { unsigned char* act; const LAS unsigned* tab; float isc; int pad;
    __device__ __forceinline__ void operator()(const f32x4 (&acc)[2][2][4][2], const Unit& u, int wr, int wc, int fr, int fq, const LAS unsigned char* meta) const {
        const int cnt = (int)tab[u.e] - u.rbl * 256;
        const LAS f32x4* bp = (const LAS f32x4*)(meta + 2048 + (64 * wc + 16 * fq) * 4); f32x4 bb[4];
#pragma unroll
        for (int i = 0; i < 4; ++i) bb[i] = bp[i];
        float o[2][4][8];
        f32x2 bg2[4], bl2[4];
#pragma unroll
        for (int i = 0; i < 4; ++i) { bg2[i] = (f32x2){bb[i].x, bb[i].z}; bl2[i] = (f32x2){bb[i].y + 1.0f, bb[i].w + 1.0f}; }
#pragma unroll
        for (int ai = 0; ai < 2; ++ai)
#pragma unroll
            for (int m = 0; m < 4; ++m) { const int j = ai * 128 + wr * 64 + m * 16 + fr; const float rs = (j < cnt) ? ((const LAS float*)(meta + 1024))[j] * isc : 0.f; const f32x2 rs2 = (f32x2){rs, rs};
#pragma unroll
                for (int n = 0; n < 2; ++n)
#pragma unroll
                    for (int h2 = 0; h2 < 2; ++h2) { const int ci = 2 * n + h2;
                        const f32x2 ag = (f32x2){acc[ai][0][m][n][2 * h2], acc[ai][0][m][n][2 * h2 + 1]}, al = (f32x2){acc[ai][1][m][n][2 * h2], acc[ai][1][m][n][2 * h2 + 1]};
                        f32x2 g = ag * rs2 + bg2[ci], l1 = al * rs2 + bl2[ci];
                        g.x = fminf(g.x, 7.0f); g.y = fminf(g.y, 7.0f); l1.x = fminf(fmaxf(l1.x, -6.0f), 8.0f); l1.y = fminf(fmaxf(l1.y, -6.0f), 8.0f);
                        const f32x2 t = g * (f32x2){-1.702f * LOG2E, -1.702f * LOG2E};
                        const f32x2 d = (f32x2){__builtin_amdgcn_exp2f(t.x), __builtin_amdgcn_exp2f(t.y)} + (f32x2){1.0f, 1.0f};
                        f32x2 v = g * (f32x2){__builtin_amdgcn_rcpf(d.x), __builtin_amdgcn_rcpf(d.y)} * l1 * (f32x2){A6SCALE, A6SCALE};
                        o[ai][m][2 * ci] = fminf(fmaxf(v.x, -28.0f), 28.0f); o[ai][m][2 * ci + 1] = fminf(fmaxf(v.y, -28.0f), 28.0f); } }
#pragma unroll
        for (int b = 0; b < 2; ++b) { const int rho = 2 * fq + b; f32x16 s0, s1;
#pragma unroll
            for (int j = 0; j < 8; ++j) { float r0 = o[0][b][j], r1 = o[0][2 + b][j], r2 = o[1][b][j], r3 = o[1][2 + b][j]; tr4(r0, r1, r2, r3); s0[j] = r0; s0[8 + j] = r1; s1[j] = r2; s1[8 + j] = r3; }
            unsigned char* rp = act + ((size_t)(u.pm * (DFF / 128) + u.pn) * 256 + (rho >> 2) * 128 + wr * 64 + (rho & 3) * 16 + fr) * 96;
            store_ht(rp + 16 * wc, rp + 64 + ((8 * wc + 16 * ((fr >> 3) & 1)) & 31), __builtin_amdgcn_cvt_scalef32_2xpk16_bf6_f32(s0, s1, 1.0f)); }
    }
};
struct EpiDown8 { unsigned char* ybuf; const LAS unsigned* tab; float isc; int pad;
    __device__ __forceinline__ void operator()(const f32x4 (&acc)[2][2][4][2], const Unit& u, int wr, int wc, int fr, int fq, const LAS unsigned char* meta) const {
        const int cnt = (int)tab[u.e] - u.rbl * 256, col0 = u.pn * 256 + wc * 32 + 8 * fq;
        const LAS f32x4* bp = (const LAS f32x4*)(meta + 2048 + (32 * wc + 8 * fq) * 4);
        f32x4 bb[2][2];
#pragma unroll
        for (int bj = 0; bj < 2; ++bj) { bb[bj][0] = bp[bj * 32] * Y8SCALE; bb[bj][1] = bp[bj * 32 + 1] * Y8SCALE; }
#pragma unroll
        for (int ai = 0; ai < 2; ++ai) {
            float wx[2][4], wy[2][4];
#pragma unroll
            for (int m = 0; m < 4; ++m) { const int j = ai * 128 + wr * 64 + m * 16 + fr; const float g = (j < cnt) ? ((const LAS float*)(meta + 1024))[j] : 0.f;
#pragma unroll
                for (int bj = 0; bj < 2; ++bj) { const f32x4 v0 = (acc[ai][bj][m][0] * isc + bb[bj][0]) * g, v1 = (acc[ai][bj][m][1] * isc + bb[bj][1]) * g;
                    wx[bj][m] = __builtin_bit_cast(float, pk4_fp8(clamp8(v0.x), clamp8(v0.y), clamp8(v0.z), clamp8(v0.w))); wy[bj][m] = __builtin_bit_cast(float, pk4_fp8(clamp8(v1.x), clamp8(v1.y), clamp8(v1.z), clamp8(v1.w))); } }
            const int jr = ai * 128 + wr * 64 + fq * 16 + fr;
#pragma unroll
            for (int bj = 0; bj < 2; ++bj) { tr4(wx[bj][0], wx[bj][1], wx[bj][2], wx[bj][3]); tr4(wy[bj][0], wy[bj][1], wy[bj][2], wy[bj][3]); }
            if (jr < cnt) { const int tk = ((const LAS int*)meta)[jr]; unsigned char* rowp = ybuf + (size_t)tk * DM + u.pn * 256 + wc * 32;
#pragma unroll
                for (int bj = 0; bj < 2; ++bj) {
                    *(u32x4*)(rowp + bj * 128) = (u32x4){__builtin_bit_cast(unsigned, wx[bj][0]), __builtin_bit_cast(unsigned, wy[bj][0]), __builtin_bit_cast(unsigned, wx[bj][1]), __builtin_bit_cast(unsigned, wy[bj][1])};
                    *(u32x4*)(rowp + bj * 128 + 16) = (u32x4){__builtin_bit_cast(unsigned, wx[bj][2]), __builtin_bit_cast(unsigned, wy[bj][2]), __builtin_bit_cast(unsigned, wx[bj][3]), __builtin_bit_cast(unsigned, wy[bj][3])}; } } }
    }
};
__device__ __forceinline__ void moe_tables(const unsigned* gcnt, LAS unsigned* tab) {
    const int tid = fresh_tid();
    if (tid < 64) { const unsigned c = tid < NE ? gcnt[tid] : 0u; const unsigned nb = (c + 255u) >> 8; unsigned inc = nb;
#pragma unroll
        for (int o = 1; o < 64; o <<= 1) { const unsigned t = __shfl_up(inc, o); if (tid >= o) inc += t; }
        if (tid < NE) { tab[tid] = c; tab[32 + tid] = inc - nb; } if (tid == NE) tab[32 + NE] = inc - nb; }
    __syncthreads();
}
__device__ __forceinline__ void p7_route(const Frame& F, const bf16_t* __restrict__ hb, const bf16_t* __restrict__ Wrt, const float* __restrict__ sq2, const float* __restrict__ br,
                                         unsigned* gcnt, int* __restrict__ list, float* __restrict__ listg, float* __restrict__ listr) {
    LAS unsigned* lcnt = (LAS unsigned*)(F.lds + RING_OFF); LAS unsigned* lbase = lcnt + 32;
    const int tid = fresh_tid(), lane = tid & 63, tcol = lane & 15, kq = lane >> 4;
    LAS unsigned char* Wl = F.lds + RING_OFF + 4096;
#pragma unroll
    for (int i = 0; i < 8; ++i) { const int ci = tid + 512 * i, row = ci >> 7, ch = ci & 127; *(LAS u32x4*)(Wl + row * 2064 + ch * 16) = *(const u32x4*)(Wrt + (size_t)row * DM + ch * 8); }
    __syncthreads();
    for (int round = (F.G == 256 ? F.vcu : (int)blockIdx.x); round < MTOK / 128; round += F.G) {
        if (tid < 32) lcnt[tid] = 0u;
        __syncthreads();
        const int tok = round * 128 + F.wave * 16 + tcol;
        const bf16_t* xp = hb + (size_t)tok * DM + 8 * kq;
        bf16x8 bx[32];
#pragma unroll
        for (int ks = 0; ks < 32; ++ks) bx[ks] = *(const bf16x8*)(xp + 32 * ks);
        const LAS unsigned char* w0l = Wl + tcol * 2064 + kq * 16; const LAS unsigned char* w1l = w0l + 16 * 2064;
        f32x4 a0 = {0.f, 0.f, 0.f, 0.f}, a1 = {0.f, 0.f, 0.f, 0.f};
#pragma unroll
        for (int ks = 0; ks < 32; ++ks) { const bf16x8 w0 = *(const LAS bf16x8*)(w0l + 64 * ks), w1 = *(const LAS bf16x8*)(w1l + 64 * ks);
            a0 = __builtin_amdgcn_mfma_f32_16x16x32_bf16(w0, bx[ks], a0, 0, 0, 0); a1 = __builtin_amdgcn_mfma_f32_16x16x32_bf16(w1, bx[ks], a1, 0, 0, 0); }
        float s = 0.f;
#pragma unroll
        for (int t = 0; t < 4; ++t) { const f32x4 p = *(const f32x4*)(sq2 + ((size_t)t * MTOK + tok) * 4); s += (p.x + p.y) + (p.z + p.w); }
        const float rstd = __builtin_amdgcn_rsqf(s * (1.0f / DM) + EPS);
        float v[8]; int id[8];
#pragma unroll
        for (int r = 0; r < 4; ++r) { id[r] = 4 * kq + r; id[4 + r] = 16 + 4 * kq + r; v[r] = a0[r] * rstd + br[4 * kq + r]; v[4 + r] = a1[r] * rstd + br[16 + 4 * kq + r]; }
        float tv[4]; int ti[4];
#pragma unroll
        for (int r = 0; r < 4; ++r) { float bv = v[0]; int bi = id[0];
#pragma unroll
            for (int j = 1; j < 8; ++j) if (v[j] > bv) { bv = v[j]; bi = id[j]; }
#pragma unroll
            for (int o = 16; o < 64; o <<= 1) { const float ov = __shfl_xor(bv, o); const int oi = __shfl_xor(bi, o); if (ov > bv || (ov == bv && oi < bi)) { bv = ov; bi = oi; } }
            tv[r] = bv; ti[r] = bi;
#pragma unroll
            for (int j = 0; j < 8; ++j) if (id[j] == bi) v[j] = -3.0e38f; }
        const float e1 = __expf(tv[1] - tv[0]), e2 = __expf(tv[2] - tv[0]), e3 = __expf(tv[3] - tv[0]); const float inv = __builtin_amdgcn_rcpf(1.0f + e1 + e2 + e3);
        unsigned lp[4];
        if (kq == 0) {
#pragma unroll
            for (int k = 0; k < 4; ++k) lp[k] = __hip_atomic_fetch_add(lcnt + ti[k], 1u, __ATOMIC_RELAXED, __HIP_MEMORY_SCOPE_WORKGROUP); }
        __syncthreads();
        if (tid < 32) { const unsigned c = lcnt[tid]; lbase[tid] = c ? __hip_atomic_fetch_add(gcnt + tid, c, __ATOMIC_RELAXED, __HIP_MEMORY_SCOPE_AGENT) : 0u; }
        __syncthreads();
        if (kq == 0) { const float gk[4] = {inv, e1 * inv, e2 * inv, e3 * inv};
#pragma unroll
            for (int k = 0; k < 4; ++k) { const size_t pos = (size_t)ti[k] * LSTRIDE + lbase[ti[k]] + lp[k]; list[pos] = tok * 4 + k; listg[pos] = gk[k]; listr[pos] = rstd; } }
        __syncthreads();
    }
}
__device__ __forceinline__ void p10_combine(const Frame& F, float* __restrict__ out, const bf16_t* __restrict__ x2b, const unsigned char* __restrict__ ybuf) {
    const size_t n8 = (size_t)MTOK * DM / 8, step = (size_t)F.G * (NWAVES * 64);
    for (size_t i = (size_t)blockIdx.x * (NWAVES * 64) + fresh_tid(); i < n8; i += 2 * step) {
        const size_t i1 = i + step; const bool two = i1 < n8;
        const size_t tok0 = i / (DM / 8), c80 = i % (DM / 8), tok1 = two ? i1 / (DM / 8) : tok0, c81 = two ? i1 % (DM / 8) : c80;
        const u32x4 xb0 = *(const u32x4*)(x2b + i * 8), xb1 = *(const u32x4*)(x2b + (two ? i1 : i) * 8);
        u32x2 y0[4], y1[4];
#pragma unroll
        for (int k = 0; k < 4; ++k) { y0[k] = *(const u32x2*)(ybuf + (tok0 * 4 + k) * DM + c80 * 8); y1[k] = *(const u32x2*)(ybuf + (tok1 * 4 + k) * DM + c81 * 8); }
#pragma unroll
        for (int it = 0; it < 2; ++it) { if (it == 1 && !two) break;
            const u32x4 xb = it ? xb1 : xb0; const size_t ii = it ? i1 : i;
            f32x4 s0 = {0.f, 0.f, 0.f, 0.f}, s1 = {0.f, 0.f, 0.f, 0.f};
#pragma unroll
            for (int k = 0; k < 4; ++k) { const u32x2 y = it ? y1[k] : y0[k];
                const f32x2 a = __builtin_amdgcn_cvt_pk_f32_fp8((int)y.x, false), b = __builtin_amdgcn_cvt_pk_f32_fp8((int)y.x, true), c = __builtin_amdgcn_cvt_pk_f32_fp8((int)y.y, false), d = __builtin_amdgcn_cvt_pk_f32_fp8((int)y.y, true);
                s0.x += a.x; s0.y += a.y; s0.z += b.x; s0.w += b.y; s1.x += c.x; s1.y += c.y; s1.z += d.x; s1.w += d.y; }
            const f32x4 v0 = (f32x4){bflo(xb.x), bfhi(xb.x), bflo(xb.y), bfhi(xb.y)} + s0 * (1.0f / Y8SCALE), v1 = (f32x4){bflo(xb.z), bfhi(xb.z), bflo(xb.w), bfhi(xb.w)} + s1 * (1.0f / Y8SCALE);
            *(f32x4*)(out + ii * 8) = v0; *(f32x4*)(out + ii * 8 + 4) = v1; }
    }
}
typedef short v4i16_t __attribute__((ext_vector_type(4)));
__device__ __forceinline__ v4i16_t lds_tr16(const LAS unsigned char* p) { return __builtin_amdgcn_ds_read_tr16_b64_v4i16((LAS v4i16_t*)p); }
__device__ __forceinline__ bf16x8 cat8(v4i16_t a, v4i16_t b) { return (bf16x8){a[0], a[1], a[2], a[3], b[0], b[1], b[2], b[3]}; }
__device__ __forceinline__ int koff16(int rho) { return (rho & 3) + 8 * (rho >> 2); }

__device__ __forceinline__ void kv_knorm_row(bf16_t* __restrict__ kvmem, const float* __restrict__ xk_g, int row, int lane) {
    bf16_t* kp = kvmem + (size_t)row * (2 * DX) + 8 * lane; const u32x4 kv = *(const u32x4*)kp;
    float v[8] = {bflo(kv.x), bfhi(kv.x), bflo(kv.y), bfhi(kv.y), bflo(kv.z), bfhi(kv.z), bflo(kv.w), bfhi(kv.w)}; float ss = 0.f;
#pragma unroll
    for (int j = 0; j < 8; ++j) ss += v[j] * v[j];
    ss += __shfl_xor(ss, 1); ss += __shfl_xor(ss, 2); ss += __shfl_xor(ss, 4); ss += __shfl_xor(ss, 8);
    const float rstd = __builtin_amdgcn_rsqf(ss * (1.0f / XHD) + EPS); const float* gp = xk_g + ((8 * lane) & (XHD - 1)); const f32x4 g0 = *(const f32x4*)gp, g1 = *(const f32x4*)(gp + 4);
    u32x4 w; w.x = cvt_pk_bf16(v[0] * rstd * g0.x, v[1] * rstd * g0.y); w.y = cvt_pk_bf16(v[2] * rstd * g0.z, v[3] * rstd * g0.w); w.z = cvt_pk_bf16(v[4] * rstd * g1.x, v[5] * rstd * g1.y); w.w = cvt_pk_bf16(v[6] * rstd * g1.z, v[7] * rstd * g1.w);
    *(u32x4*)kp = w;
}
__device__ __forceinline__ void p2_attn(const Frame& F, const bf16_t* __restrict__ proj, const float* __restrict__ rel_bias, const float* __restrict__ conv_w,
                                        const float* __restrict__ ga, const float* __restrict__ gb, bf16_t* __restrict__ yb, const float* __restrict__ q_g, const float* __restrict__ k_g, float qscale) {
    LAS float* tbl = (LAS float*)(F.lds + TBL_OFF);
    for (int i = fresh_tid(); i < 8 * 384; i += NWAVES * 64) { const int h = i / 384, j = i % 384; int rel = 319 - j; rel = rel < -MAXREL ? -MAXREL : (rel > MAXREL ? MAXREL : rel); tbl[i] = rel_bias[h * NREL + rel + MAXREL] * LOG2E; }
    __syncthreads();
    int lane_ = F.lane; asm volatile("" : "+v"(lane_));
    const int lane = lane_, h = F.wave, r = lane & 31, hi = lane >> 5;
    LAS unsigned char* wbuf = F.lds + RING_OFF + h * 16384;
    LAS float* ssq = (LAS float*)(F.lds + SSQ_OFF);
    const LAS float* tblh = tbl + h * 384;
    const float far_bias = rel_bias[h * NREL + 2 * MAXREL] * LOG2E;
    float mstat;
    { float gq = __builtin_fabsf(q_g[lane_]), gk = __builtin_fabsf(k_g[lane_]), bm = far_bias;
#pragma unroll
      for (int j = 0; j < 6; ++j) bm = fmaxf(bm, tblh[lane_ + 64 * j]);
#pragma unroll
      for (int o_ = 1; o_ < 64; o_ <<= 1) { gq = fmaxf(gq, __shfl_xor(gq, o_)); gk = fmaxf(gk, __shfl_xor(gk, o_)); bm = fmaxf(bm, __shfl_xor(bm, o_)); }
      mstat = __builtin_bit_cast(float, __builtin_amdgcn_readfirstlane(__builtin_bit_cast(int, 64.0f * gq * gk * qscale * 1.01f + bm))); }
    { LAS float* tw_ = tbl + h * 384;
#pragma unroll
      for (int j = 0; j < 6; ++j) tw_[lane_ + 64 * j] -= mstat; }
    const float far_bias_s = far_bias - mstat;
    unsigned kso[2], vso0;
#pragma unroll
    for (int i = 0; i < 2; ++i) { const int key = 8 * i + (lane >> 3), cp = lane & 7; kso[i] = (unsigned)(key * NPROJ_O + (cp ^ ((key >> 1) & 7)) * 8) * 2u; }
    { const int key = lane >> 3, cp = lane & 7; vso0 = (unsigned)(key * NPROJ_O + DATT + (cp ^ (((key >> 1) & 1) << 2)) * 8) * 2u; }
#define P2_DMA_K(T_, slot_) do { const char* kp_ = (const char*)(proj + ((size_t)b * SEQ + 32 * (T_)) * NPROJ_O + DATT + h * 64); \
        _Pragma("unroll") for (int i_ = 0; i_ < 4; ++i_) __builtin_amdgcn_global_load_lds((const unsigned*)(kp_ + (size_t)(i_ >> 1) * (16 * NPROJ_O * 2) + kso[i_ & 1]), (LAS unsigned*)(wbuf + (slot_) * 4096 + i_ * 1024), 16, 0, 0); } while (0)
#define P2_DMA_V(T_, slot_) do { const char* kp_ = (const char*)(proj + ((size_t)b * SEQ + 32 * (T_)) * NPROJ_O + DATT + h * 64); \
        _Pragma("unroll") for (int i_ = 0; i_ < 4; ++i_) __builtin_amdgcn_global_load_lds((const unsigned*)(kp_ + (size_t)i_ * (8 * NPROJ_O * 2) + vso0), (LAS unsigned*)(wbuf + 8192 + (slot_) * 4096 + i_ * 1024), 16, 0, 0); } while (0)
#define P2_QK(dst, ks_) do { const LAS unsigned char* Kp_ = wbuf + (ks_) * 4096; \
        _Pragma("unroll") for (int qb_ = 0; qb_ < 2; ++qb_) _Pragma("unroll") for (int i_ = 0; i_ < 16; ++i_) dst[qb_][i_] = 0.f; \
        _Pragma("unroll") for (int s_ = 0; s_ < 4; ++s_) { const bf16x8 kf_ = *(const LAS bf16x8*)(Kp_ + kaddr[s_]); \
            dst[0] = __builtin_amdgcn_mfma_f32_32x32x16_bf16(kf_, qf[0][s_], dst[0], 0, 0, 0); dst[1] = __builtin_amdgcn_mfma_f32_32x32x16_bf16(kf_, qf[1][s_], dst[1], 0, 0, 0); } } while (0)
    const int upw = (512 + F.G - 1) / F.G;
    for (int ui = 0; ui < upw; ++ui) {
        const int cw_ = F.vcu & 31; const int unit = F.G == 256 ? (cw_ >= 8 ? (2 * (F.vcu >> 5) + ui) * (SEQ / CHUNK) + cw_ : (2 * (F.vcu >> 5) + (cw_ >> 2)) * (SEQ / CHUNK) + (ui == 0 ? (cw_ & 3) : 7 - (cw_ & 3))) : F.vcu * upw + ui; if (unit >= BATCH * (SEQ / CHUNK)) break;
        const int b = unit / (SEQ / CHUNK), c = unit % (SEQ / CHUNK); const size_t row0 = (size_t)b * SEQ + c * CHUNK;
        const int T0 = 2 * (c - LEFT < 0 ? 0 : c - LEFT), nT = 2 * c + 2 - T0;
        int oz = 0; asm volatile("" : "+s"(oz));
        const int rot = (nT == 18) ? (2 * c) % 18 : 0;
#define P2_TT(t_) (T0 + ((t_) + rot >= nT ? (t_) + rot - nT : (t_) + rot))
        P2_DMA_K(P2_TT(0), 0); P2_DMA_V(P2_TT(0), 0); P2_DMA_K(P2_TT(1), 1);
        int lq_ = lane; asm volatile("" : "+v"(lq_));
        bf16x8 qf[2][4];
#pragma unroll
        for (int qb = 0; qb < 2; ++qb)
#pragma unroll
            for (int s = 0; s < 4; ++s) qf[qb][s] = *(const bf16x8*)(proj + (row0 + 32 * qb + (lq_ & 31)) * NPROJ_O + h * 64 + 16 * s + 8 * (lq_ >> 5));
        { int lane3 = lane; asm volatile("" : "+v"(lane3));
          const int ch0 = 8 * lane3; const size_t tfirst = row0 + 8 * h; const int sfirst = c * CHUNK + 8 * h;
          u32x4 bgv[8], uv[8], hu[2];
#pragma unroll
          for (int i = 0; i < 8; ++i) { const bf16_t* pr = proj + (tfirst + i) * NPROJ_O + 3 * DATT + ch0; bgv[i] = *(const u32x4*)pr; uv[i] = *(const u32x4*)(pr + DCONV); }
#pragma unroll
          for (int j = 0; j < 2; ++j) { if (sfirst >= j + 1) { const bf16_t* pr = proj + (tfirst - 1 - j) * NPROJ_O + 3 * DATT + ch0; hu[j] = *(const u32x4*)(pr + DCONV); }
              else hu[j] = (u32x4){0u, 0u, 0u, 0u}; }
          f32x4 cwv[3][2], gbq[2];
#pragma unroll
          for (int t = 0; t < 3; ++t) { cwv[t][0] = *(const f32x4*)(conv_w + t * DCONV + ch0); cwv[t][1] = *(const f32x4*)(conv_w + t * DCONV + ch0 + 4); }
          gbq[0] = *(const f32x4*)(gb + ch0); gbq[1] = *(const f32x4*)(gb + ch0 + 4);
#define P2_UNPK(dst, vv_) do { const u32x4 q_ = (vv_); dst[0] = bflo(q_.x); dst[1] = bfhi(q_.x); dst[2] = bflo(q_.y); dst[3] = bfhi(q_.y); dst[4] = bflo(q_.z); dst[5] = bfhi(q_.z); dst[6] = bflo(q_.w); dst[7] = bfhi(q_.w); } while (0)
          float u1[8], u2[8];
          P2_UNPK(u1, hu[0]); P2_UNPK(u2, hu[1]);
#pragma unroll
          for (int i = 0; i < 8; ++i) { float u0[8], bgf[8], y[8]; P2_UNPK(u0, uv[i]); P2_UNPK(bgf, bgv[i]);
              float ss = 0.f;
#pragma unroll
              for (int j = 0; j < 8; ++j) { y[j] = bgf[j] * (cwv[0][j >> 2][j & 3] * u2[j] + cwv[1][j >> 2][j & 3] * u1[j] + cwv[2][j >> 2][j & 3] * u0[j]); ss += y[j] * y[j]; u2[j] = u1[j]; u1[j] = u0[j]; }
              const float rstd = __builtin_amdgcn_rsqf(wave_sum(ss) * (1.0f / DCONV) + EPS);
              u32x4 w; w.x = cvt_pk_bf16(y[0] * rstd * gbq[0].x, y[1] * rstd * gbq[0].y); w.y = cvt_pk_bf16(y[2] * rstd * gbq[0].z, y[3] * rstd * gbq[0].w); w.z = cvt_pk_bf16(y[4] * rstd * gbq[1].x, y[5] * rstd * gbq[1].y); w.w = cvt_pk_bf16(y[6] * rstd * gbq[1].z, y[7] * rstd * gbq[1].w);
              *(u32x4*)(yb + (tfirst + i) * DM + DATT + ch0) = w; }
#undef P2_UNPK
        }
        asm volatile("" ::: "memory");
        int lane4 = lane; asm volatile("" : "+v"(lane4));
        int kaddr[4];
        { const int r4 = lane4 & 31, hi4 = lane4 >> 5;
#pragma unroll
          for (int s = 0; s < 4; ++s) kaddr[s] = r4 * 128 + (((2 * s + hi4) ^ ((r4 >> 1) & 7)) * 16); }
        int vaddr[2];
        { const int hi4 = lane4 >> 5, G1 = (lane4 >> 4) & 1, tq = (lane4 & 15) >> 2, tp = lane4 & 3;
#pragma unroll
          for (int db = 0; db < 2; ++db) vaddr[db] = (4 * hi4 + tq) * 128 + (((4 * db + 2 * G1 + (tp >> 1)) ^ (((tq >> 1) & 1) << 2)) * 16) + (tp & 1) * 8; }
        f32x16 o[2][2];
#pragma unroll
        for (int db = 0; db < 2; ++db)
#pragma unroll
            for (int qb = 0; qb < 2; ++qb)
#pragma unroll
                for (int i = 0; i < 16; ++i) o[db][qb][i] = 0.f;
        float lrun[2] = {0.f, 0.f};
        f32x16 scA[2];
        asm volatile("s_waitcnt vmcnt(0)" ::: "memory");
        P2_QK(scA, 0);
#define P2_ITER(t_, SC, SN, PAR) do { const int T = P2_TT(t_); const bool more_ = (t_) + 1 < nT; \
              \
            if ((t_) + 2 < nT) { P2_DMA_K(P2_TT((t_) + 2), PAR); P2_DMA_V(P2_TT((t_) + 1), 1 - (PAR)); } \
            else if (more_) { P2_DMA_V(P2_TT((t_) + 1), 1 - (PAR)); } \
            if ((T >> 1) >= c - 4) { \
                _Pragma("unroll") for (int qb = 0; qb < 2; ++qb) { const LAS float* tp0 = tblh + (319 - 64 * c - 32 * qb - r + 32 * T + 4 * hi); \
                    _Pragma("unroll") for (int i = 0; i < 16; ++i) SC[qb][i] += tp0[koff16(i)]; \
                    __builtin_amdgcn_sched_barrier(0); } \
            } else { \
                _Pragma("unroll") for (int qb = 0; qb < 2; ++qb) _Pragma("unroll") for (int i = 0; i < 16; ++i) SC[qb][i] += far_bias_s; \
            } \
              \
            bf16x8 pf[2][2]; \
            _Pragma("unroll") for (int qb = 0; qb < 2; ++qb) { float l4[4] = {0.f, 0.f, 0.f, 0.f}; float p[16]; \
                _Pragma("unroll") for (int i = 0; i < 16; ++i) { p[i] = __builtin_amdgcn_exp2f(SC[qb][i]); l4[i & 3] += p[i]; } \
                lrun[qb] += (l4[0] + l4[1]) + (l4[2] + l4[3]); \
                _Pragma("unroll") for (int ks = 0; ks < 2; ++ks) { u32x4 w; w.x = cvt_pk_bf16(p[8 * ks + 0], p[8 * ks + 1]); w.y = cvt_pk_bf16(p[8 * ks + 2], p[8 * ks + 3]); w.z = cvt_pk_bf16(p[8 * ks + 4], p[8 * ks + 5]); w.w = cvt_pk_bf16(p[8 * ks + 6], p[8 * ks + 7]); \
                    pf[qb][ks] = __builtin_bit_cast(bf16x8, w); } } \
            asm volatile("" : "+v"(lrun[0]), "+v"(lrun[1]));     \
            __builtin_amdgcn_sched_barrier(0); \
              \
            if ((t_) + 2 < nT) asm volatile("s_waitcnt vmcnt(8)" ::: "memory"); else if (more_) asm volatile("s_waitcnt vmcnt(4)" ::: "memory"); else asm volatile("s_waitcnt vmcnt(0)" ::: "memory"); \
            bf16x8 kf_[4]; const LAS unsigned char* Vp = wbuf + 8192 + (PAR) * 4096; \
            { const LAS unsigned char* Kp_ = wbuf + (1 - (PAR)) * 4096; \
              _Pragma("unroll") for (int s_ = 0; s_ < 4; ++s_) kf_[s_] = *(const LAS bf16x8*)(Kp_ + kaddr[s_]); } \
            __builtin_amdgcn_sched_barrier(0); \
              \
            { _Pragma("unroll") for (int qb_ = 0; qb_ < 2; ++qb_) _Pragma("unroll") for (int i_ = 0; i_ < 16; ++i_) SN[qb_][i_] = 0.f; \
                _Pragma("unroll") for (int s_ = 0; s_ < 4; ++s_) { SN[0] = __builtin_amdgcn_mfma_f32_32x32x16_bf16(kf_[s_], qf[0][s_], SN[0], 0, 0, 0); SN[1] = __builtin_amdgcn_mfma_f32_32x32x16_bf16(kf_[s_], qf[1][s_], SN[1], 0, 0, 0); } } \
            __builtin_amdgcn_sched_barrier(0); \
              \
            bf16x8 vf_[2][2]; \
            _Pragma("unroll") for (int db = 0; db < 2; ++db) _Pragma("unroll") for (int ks = 0; ks < 2; ++ks) { \
                const v4i16_t t0 = lds_tr16(Vp + vaddr[db] + (16 * ks) * 128), t1 = lds_tr16(Vp + vaddr[db] + (16 * ks + 8) * 128); vf_[db][ks] = cat8(t0, t1); } \
            __builtin_amdgcn_sched_barrier(0); \
            _Pragma("unroll") for (int db = 0; db < 2; ++db) _Pragma("unroll") for (int ks = 0; ks < 2; ++ks) { \
                o[db][0] = __builtin_amdgcn_mfma_f32_32x32x16_bf16(vf_[db][ks], pf[0][ks], o[db][0], 0, 0, 0); o[db][1] = __builtin_amdgcn_mfma_f32_32x32x16_bf16(vf_[db][ks], pf[1][ks], o[db][1], 0, 0, 0); } \
            __builtin_amdgcn_sched_barrier(0); \
        } while (0)
        for (int t = 0; t < nT; ++t) { const int par_ = t & 1; P2_ITER(t, scA, scA, par_); }
#undef P2_ITER
#undef P2_TT
        int oz2 = 0; asm volatile("" : "+v"(oz2));
        const int r2 = r + oz2, hi2 = hi + oz2;

        LAS float* sq = ssq + (ui & 1) * 512;
#pragma unroll
        for (int qb = 0; qb < 2; ++qb) { const float lt = lrun[qb] + __shfl_xor(lrun[qb], 32); const float inv = __builtin_amdgcn_rcpf(lt); float ss = 0.f;
#pragma unroll
            for (int db = 0; db < 2; ++db)
#pragma unroll
                for (int i = 0; i < 16; ++i) { o[db][qb][i] *= inv; ss += o[db][qb][i] * o[db][qb][i]; }
            ss += __shfl_xor(ss, 32);
            if (hi == 0) sq[h * 64 + 32 * qb + r] = ss; }
        f32x4 gg[2][4];
#pragma unroll
        for (int db = 0; db < 2; ++db)
#pragma unroll
            for (int g4 = 0; g4 < 4; ++g4) gg[db][g4] = *(const f32x4*)(ga + h * 64 + 32 * db + 8 * g4 + 4 * hi2);
        __syncthreads();
#pragma unroll
        for (int qb = 0; qb < 2; ++qb) { float tot = 0.f;
#pragma unroll
            for (int hh = 0; hh < 8; ++hh) tot += sq[hh * 64 + 32 * qb + r];
            const float rstd = __builtin_amdgcn_rsqf(tot * (1.0f / DATT) + EPS);
            bf16_t* orow = yb + (row0 + 32 * qb + r2) * DM + h * 64;
#pragma unroll
            for (int db = 0; db < 2; ++db)
#pragma unroll
                for (int g4 = 0; g4 < 4; ++g4) { const int d0 = 32 * db + 8 * g4 + 4 * hi2; const f32x4 g_ = gg[db][g4];
                    u32x2 w; w.x = cvt_pk_bf16(o[db][qb][4 * g4 + 0] * rstd * g_.x, o[db][qb][4 * g4 + 1] * rstd * g_.y); w.y = cvt_pk_bf16(o[db][qb][4 * g4 + 2] * rstd * g_.z, o[db][qb][4 * g4 + 3] * rstd * g_.w);
                    *(u32x2*)(orow + d0) = w; } }
    }
#undef P2_DMA_K
#undef P2_DMA_V
#undef P2_QK
    __syncthreads();
}
__device__ __forceinline__ void p5_xattn(const Frame& F, const bf16_t* __restrict__ qx, const bf16_t* __restrict__ kvmem, const float* __restrict__ xq_g, bf16_t* __restrict__ ox, const float* __restrict__ xk_g) {
    const int ptid = fresh_tid(), lane = ptid & 63, r = lane & 31, hi = lane >> 5;
    LAS unsigned char* Kl = F.lds + RING_OFF; LAS unsigned char* Vl = Kl + 256 * 272;
    const int G1 = (lane >> 4) & 1, tq = (lane & 15) >> 2, tp = lane & 3;
    const float XS = 0.08838834764831845f * LOG2E;
    float mstat;
    { float gq = fmaxf(__builtin_fabsf(xq_g[lane]), __builtin_fabsf(xq_g[lane + 64])), gk = fmaxf(__builtin_fabsf(xk_g[lane]), __builtin_fabsf(xk_g[lane + 64]));
#pragma unroll
      for (int o_ = 1; o_ < 64; o_ <<= 1) { gq = fmaxf(gq, __shfl_xor(gq, o_)); gk = fmaxf(gk, __shfl_xor(gk, o_)); }
      mstat = __builtin_bit_cast(float, __builtin_amdgcn_readfirstlane(__builtin_bit_cast(int, 128.0f * gq * gk * XS * 1.01f))); }
    const float ninit = -mstat;
    const int upw = (512 + F.G - 1) / F.G; int cur_bh = -1;
    for (int ui = 0; ui < upw; ++ui) {
        const int unit = F.vcu * upw + ui; if (unit >= BATCH * XH * 8) break;
        const int bh = unit >> 3, qt = unit & 7, b = bh >> 2, h = bh & 3;
        if (bh != cur_bh) {
            __syncthreads();
            const bf16_t* src = kvmem + (size_t)b * NMEM * (2 * DX) + h * XHD;
#pragma unroll
            for (int i = 0; i < 8; ++i) { const int ci = ptid + 512 * i, key = ci >> 4, ch = ci & 15;
                const u32x4 kv = *(const u32x4*)(src + (size_t)key * (2 * DX) + ch * 8), vv = *(const u32x4*)(src + (size_t)key * (2 * DX) + DX + ch * 8);
                *(LAS u32x4*)(Kl + key * 272 + ch * 16) = kv; *(LAS u32x4*)(Vl + key * 256 + ((ch ^ ((key & 3) << 2)) * 16)) = vv; }
            __syncthreads();
            cur_bh = bh;
        }
        const size_t qrow = (size_t)b * SEQ + qt * 256 + F.wave * 32 + r;
        bf16x8 qf[8];
        { u32x4 raw[8]; float ss = 0.f;
#pragma unroll
          for (int s = 0; s < 8; ++s) { raw[s] = *(const u32x4*)(qx + qrow * DX + h * XHD + 16 * s + 8 * hi);
              const float a0 = bflo(raw[s].x), a1 = bfhi(raw[s].x), a2 = bflo(raw[s].y), a3 = bfhi(raw[s].y), a4 = bflo(raw[s].z), a5 = bfhi(raw[s].z), a6 = bflo(raw[s].w), a7 = bfhi(raw[s].w);
              ss += (a0 * a0 + a1 * a1) + (a2 * a2 + a3 * a3) + (a4 * a4 + a5 * a5) + (a6 * a6 + a7 * a7); }
          ss += __shfl_xor(ss, 32);
          const float rs = XS * __builtin_amdgcn_rsqf(ss * (1.0f / XHD) + EPS);
#pragma unroll
          for (int s = 0; s < 8; ++s) { const f32x4 g0 = *(const f32x4*)(xq_g + 16 * s + 8 * hi), g1 = *(const f32x4*)(xq_g + 16 * s + 8 * hi + 4);
              u32x4 w; w.x = cvt_pk_bf16(bflo(raw[s].x) * rs * g0.x, bfhi(raw[s].x) * rs * g0.y); w.y = cvt_pk_bf16(bflo(raw[s].y) * rs * g0.z, bfhi(raw[s].y) * rs * g0.w);
              w.z = cvt_pk_bf16(bflo(raw[s].z) * rs * g1.x, bfhi(raw[s].z) * rs * g1.y); w.w = cvt_pk_bf16(bflo(raw[s].w) * rs * g1.z, bfhi(raw[s].w) * rs * g1.w);
              qf[s] = __builtin_bit_cast(bf16x8, w); } }
        f32x16 o[4];
#pragma unroll
        for (int db = 0; db < 4; ++db)
#pragma unroll
            for (int i = 0; i < 16; ++i) o[db][i] = 0.f;
        float lrun = 0.f;
        const LAS unsigned char* kbase = Kl + r * 272 + hi * 16;
        const LAS unsigned char* vbase[4];
#pragma unroll
        for (int db = 0; db < 4; ++db) vbase[db] = Vl + (4 * hi + tq) * 256 + ((4 * (db ^ tq) + 2 * G1 + (tp >> 1)) * 16) + (tp & 1) * 8;
#pragma unroll 1
        for (int t = 0; t < 4; ++t) {
            f32x16 sacc[2];
#pragma unroll
            for (int kb = 0; kb < 2; ++kb) {
#pragma unroll
                for (int i = 0; i < 16; ++i) sacc[kb][i] = ninit;
#pragma unroll
                for (int s = 0; s < 8; ++s) { const bf16x8 kf = *(const LAS bf16x8*)(kbase + (64 * t + 32 * kb) * 272 + 32 * s);
                    sacc[kb] = __builtin_amdgcn_mfma_f32_32x32x16_bf16(kf, qf[s], sacc[kb], 0, 0, 0); } }
            float ls = 0.f; bf16x8 pf[2][2];
#pragma unroll
            for (int kb = 0; kb < 2; ++kb) { float p[16];
#pragma unroll
                for (int i = 0; i < 16; ++i) { p[i] = __builtin_amdgcn_exp2f(sacc[kb][i]); ls += p[i]; }
#pragma unroll
                for (int ks = 0; ks < 2; ++ks) { u32x4 w; w.x = cvt_pk_bf16(p[8 * ks + 0], p[8 * ks + 1]); w.y = cvt_pk_bf16(p[8 * ks + 2], p[8 * ks + 3]); w.z = cvt_pk_bf16(p[8 * ks + 4], p[8 * ks + 5]); w.w = cvt_pk_bf16(p[8 * ks + 6], p[8 * ks + 7]);
                    pf[kb][ks] = __builtin_bit_cast(bf16x8, w); } }
            lrun += ls;
#pragma unroll
            for (int db = 0; db < 4; ++db)
#pragma unroll
                for (int kb = 0; kb < 2; ++kb)
#pragma unroll
                    for (int ks = 0; ks < 2; ++ks) { const int ko = (64 * t + 32 * kb + 16 * ks) * 256;
                        const v4i16_t t0 = lds_tr16(vbase[db] + ko), t1 = lds_tr16(vbase[db] + ko + 8 * 256);
                        o[db] = __builtin_amdgcn_mfma_f32_32x32x16_bf16(cat8(t0, t1), pf[kb][ks], o[db], 0, 0, 0); }
        }
        const float lt = lrun + __shfl_xor(lrun, 32); const float inv = __builtin_amdgcn_rcpf(lt);
        bf16_t* orow = ox + qrow * DX + h * XHD;
#pragma unroll
        for (int db = 0; db < 4; ++db)
#pragma unroll
            for (int g4 = 0; g4 < 4; ++g4) { const int d0 = 32 * db + 8 * g4 + 4 * hi;
                u32x2 w; w.x = cvt_pk_bf16(o[db][4 * g4 + 0] * inv, o[db][4 * g4 + 1] * inv); w.y = cvt_pk_bf16(o[db][4 * g4 + 2] * inv, o[db][4 * g4 + 3] * inv);
                *(u32x2*)(orow + d0) = w; }
    }
    __syncthreads();
}

#ifndef QSCALE_V
#define QSCALE_V (0.125f * LOG2E)
#endif
typedef __attribute__((address_space(4))) const Args* KArgP;
__device__ __forceinline__ KArgP kargs() { KArgP p = (KArgP)__builtin_amdgcn_kernarg_segment_ptr(); asm volatile("" : "+s"(p)); return p; }
#define AIN(k) (kargs()->in[k])
__global__ void __launch_bounds__(NWAVES * 64, 2) mk_fwd(Args args) {
    extern __shared__ __attribute__((aligned(16))) unsigned char lds_raw[];
    Frame F; F.lds = (LAS unsigned char*)lds_raw; F.tid = threadIdx.x; F.lane = F.tid & 63; F.wave = __builtin_amdgcn_readfirstlane(F.tid >> 6); F.G = gridDim.x;
    { const int bx = blockIdx.x; F.vcu = (F.G % 8 == 0) ? (bx % 8) * (F.G / 8) + bx / 8 : bx; }

    for (int u = F.tid; u < (LDS_BYTES - LDSCTL_OFF) / 4; u += NWAVES * 64) ((LAS unsigned*)(F.lds + LDSCTL_OFF))[u] = 0u;
    __syncthreads();
    volatile LAS unsigned* MISC = (volatile LAS unsigned*)(F.lds + MISC_OFF);
    (void)xcd_barrier_post((unsigned*)(kargs()->ws + WS_CTL) + CW_BAR + kargs()->li * XCD_BAR_WORDS, MISC + 8);
    if (F.tid == 0) atomicOr((unsigned*)(kargs()->ws + WS_CTL) + CW_GMASK + 64 * (blockIdx.x & 7), 1u << xb_xcc_id());
#define GRID_BARRIER() do { XcdBarrier bar_; bar_.bar = (unsigned*)(kargs()->ws + WS_CTL) + CW_BAR + kargs()->li * XCD_BAR_WORDS; bar_.x = xb_xcc_id(); bar_.st = (volatile LAS unsigned*)(F.lds + MISC_OFF) + 8; xcd_barrier(bar_); } while (0)
    const int lo = kargs()->ph_lo, hi = kargs()->ph_hi;
#define IN(k) (lo <= (k) && (k) < hi)
#define BOTH(k) (IN(k) && IN((k) + 1))
    const bool grouped = (F.G == 256); int gbk = 0;
    const int cvpos = grouped ? (int)(blockIdx.x & 7) : 0;
#define PHASE_BARRIER() do { if (grouped) { ++gbk; unsigned* gb_ = (unsigned*)(kargs()->ws + WS_CTL); const unsigned mk_ = xb_ld(gb_ + CW_GMASK + 64 * (blockIdx.x & 7)); \
        group_barrier(gb_ + CW_GBAR + 64 * (blockIdx.x & 7), (unsigned)(gbk * (F.G >> 3)), gb_ + CW_BAR + kargs()->li * XCD_BAR_WORDS + XB_TMO, (mk_ & (mk_ - 1u)) == 0u); } else GRID_BARRIER(); } while (0)
#define WSP(T, off) ((T*)(kargs()->ws + (off)))
#define Win WSP(bf16_t, WS_WIN)
#define Wxkv WSP(bf16_t, WS_WXKV)
#define Wout WSP(bf16_t, WS_WOUT)
#define Wxq WSP(bf16_t, WS_WXQ)
#define Wxo WSP(bf16_t, WS_WXO)
#define yb WSP(bf16_t, WS_YB)
#define qx WSP(bf16_t, WS_QX)
#define ox WSP(bf16_t, WS_OX)
#define sq1 WSP(float, WS_SQ1)
#define sq2 WSP(float, WS_SQ2)
#define listr WSP(float, WS_LISTR)
#define listg WSP(float, WS_LISTG)
#define Wrt WSP(bf16_t, WS_WRT)
#define ybuf WSP(bf16_t, WS_YBUF)
#define Wgu8 WSP(unsigned char, WS_WGU)
#define Wdn8 WSP(unsigned char, WS_WDN)
#define x2f8 WSP(unsigned char, WS_X2F6)
#define act8 WSP(unsigned char, WS_ACT)
#define list WSP(int, WS_LIST)
#define hb WSP(bf16_t, WS_HB)
#define hmb WSP(bf16_t, WS_HMB)
#define proj WSP(bf16_t, WS_PROJ)
#define kvmem WSP(bf16_t, WS_KVMEM)
    LAS unsigned* mtab = (LAS unsigned*)(F.lds + MOE_OFF);
    const int gw = F.vcu * NWAVES + F.wave, NGW = F.G * NWAVES;

    constexpr int CV_ALL = NE * (DM / 128) * (2 * DFF / 32) + NE * (DFF / 128) * (DM / 32);
    auto expert_convert = [&](int lo, int hi) {
        const int plane = fresh_tid() & 63; LAS float* scr = (LAS float*)(F.lds + RING_OFF + F.wave * 17408);
        {
            constexpr int GU6_PER_E = (DM / 128) * (2 * DFF / 32), DN6_PER_E = (DFF / 128) * (DM / 32), IT_GU6 = NE * GU6_PER_E, IT_DN6 = NE * DN6_PER_E;
            auto decode = [&](int r) -> F6Item { F6Item I;
                if (r < IT_GU6) { const int e = r / GU6_PER_E, rr = r % GU6_PER_E, kt = rr / (2 * DFF / 32), nb = rr % (2 * DFF / 32), c0 = 16 * nb, pn = c0 >> 7;
                    I.W = AIN(I_W_GU) + (size_t)e * DM * 2 * DFF; I.T = Wgu8 + ((size_t)(e * (2 * DFF / 256) + pn) * (DM / 128) + kt) * TILE6; I.g = AIN(I_NORM_FFN_G); I.ldw = 2 * DFF; I.k0 = 128 * kt; I.n0 = 32 * nb; I.s0 = c0 & 127; I.mode = 2; }
                else { r -= IT_GU6; const int e = r / DN6_PER_E, rr = r % DN6_PER_E, kt = rr / (DM / 32), nb = rr % (DM / 32), pn = nb >> 3;
                    I.W = AIN(I_W_DN) + (size_t)e * DFF * DM; I.T = Wdn8 + ((size_t)(e * (DM / 256) + pn) * (DFF / 128) + kt) * TILE6; I.g = nullptr; I.ldw = DM; I.k0 = 128 * kt; I.n0 = 32 * nb; I.s0 = (32 * nb) & 255; I.mode = 0; }
                return I; };
            int it = lo + gw; F6Item A{}, B{}; f32x4 va[16], vb[16];
            if (it < hi) { A = decode(it); p0_f6_load(A, va, plane); }
            while (it < hi) { const int nit = it + NGW;
                if (nit < hi) { B = decode(nit); p0_f6_load(B, vb, plane); }
                p0_f6_store(A, va, W6SCALE, scr, plane);
                A = B; it = nit;
#pragma unroll
                for (int i = 0; i < 16; ++i) va[i] = vb[i]; }
        }
    };
    if (IN(0)) {
        const int plane = fresh_tid() & 63;
        LAS float* scr = (LAS float*)(F.lds + RING_OFF + F.wave * 17408);
        constexpr int IT_IN = (DM / 64) * (NPROJ / 64), IT_XKV = (DM / 64) * (2 * DX / 64), IT_OUT = (DM / 64) * (DM / 64), IT_XQ = (DM / 64) * (DX / 64), IT_XO = (DX / 64) * (DM / 64), IT_RT = DM / 64;
        for (int m = gw; m < MTOK; m += NGW) row_to_bf16_rstd(AIN(I_X) + (size_t)m * DM, hb + (size_t)m * DM, WSP(float, WS_RSTD2) + m, plane);
        for (int it = gw; it < IT_IN + IT_XKV + IT_OUT + IT_XQ + IT_XO + IT_RT; it += NGW) {
            int r = it;
            if (r < IT_IN) { const int kb = r / (NPROJ / 64), nb = r % (NPROJ / 64); const int pn = nb >> 2, wc = nb & 3;
                if (nb < 32) p0_transpose64<1>(AIN(I_W_IN), NPROJ, DM, Win, 64 * kb, 64 * nb, 256 * pn + 32 * wc, AIN(I_NORM_MIX_G), scr, plane);
                else { const int isx = nb >= 40, ci = nb - (isx ? 40 : 32);
                    p0_transpose64<0>(AIN(I_W_IN), NPROJ, DM, Win, 64 * kb, 64 * nb, 256 * (8 + (ci >> 1)) + 128 * isx + 64 * (ci & 1), AIN(I_NORM_MIX_G), scr, plane); }
                continue; }
            r -= IT_IN;
            if (r < IT_XKV) { const int kb = r / (2 * DX / 64), nb = r % (2 * DX / 64);
                p0_transpose64<0>(AIN(I_W_XKV), 2 * DX, DM, Wxkv, 64 * kb, 64 * nb, 64 * nb, nullptr, scr, plane); continue; }
            r -= IT_XKV;
            if (r < IT_OUT) { const int kb = r / (DM / 64), nb = r % (DM / 64);
                p0_transpose64<0>(AIN(I_W_OUT), DM, DM, Wout, 64 * kb, 64 * nb, 64 * nb, nullptr, scr, plane); continue; }
            r -= IT_OUT;
            if (r < IT_XQ) { const int kb = r / (DX / 64), nb = r % (DX / 64);
                p0_transpose64<0>(AIN(I_W_XQ), DX, DM, Wxq, 64 * kb, 64 * nb, 64 * nb, AIN(I_NORM_X_G), scr, plane); continue; }
            r -= IT_XQ;
            if (r < IT_XO) { const int kb = r / (DM / 64), nb = r % (DM / 64);
                p0_transpose64<0>(AIN(I_W_XO), DM, DX, Wxo, 64 * kb, 64 * nb, 64 * nb, nullptr, scr, plane); continue; }
            r -= IT_XO;
            p0_transpose_item(AIN(I_W_ROUTER), NE, DM, Wrt, 64 * r, 0, 1, 0, AIN(I_NORM_FFN_G), scr, plane);
        }
        for (int m = gw; m < MMEM; m += NGW) rms_row_to_bf16(AIN(I_MEM) + (size_t)m * DM, AIN(I_NORM_MEM_G), hmb + (size_t)m * DM, plane);
        if (BOTH(0)) GRID_BARRIER();
    }
    if (IN(1)) {
        const int nrnd = (MTOK / 256) * (NPROJ / 256) / (F.G > 0 ? F.G : 1), ksplit = !grouped ? 0 : (cvpos * nrnd) / 7;
        { pg8::DenseSched S; S.init(hb, Win, MTOK, NPROJ, DM, F.G, (int)blockIdx.x); S.cnt = ksplit; EpiProj E{proj, AIN(I_Q_G), AIN(I_K_G), QSCALE_V, 0, WSP(float, WS_RSTD2)};
          if (ksplit > 0) pg8::gemm_phase<EpiProj, pg8::DenseSched, 0>(F.lds + RING_OFF, F.lds + IDX_OFF, S, E); }
        expert_convert(0, CV_ALL);
        __syncthreads();
        { pg8::DenseSched S; S.init(hb, Win, MTOK, NPROJ, DM, F.G, (int)blockIdx.x); S.i0 = ksplit; EpiProj E{proj, AIN(I_Q_G), AIN(I_K_G), QSCALE_V, 0, WSP(float, WS_RSTD2)};
          pg8::gemm_phase<EpiProj, pg8::DenseSched, 0>(F.lds + RING_OFF, F.lds + IDX_OFF, S, E); }
        if (F.G != 256) { pg8::DenseSched S; S.init(hmb, Wxkv, MMEM, 2 * DX, DM, F.G, (int)blockIdx.x); EpiBf16 E{kvmem, 2 * DX, 0};
          pg8::gemm_phase<EpiBf16, pg8::DenseSched, 0>(F.lds + RING_OFF, F.lds + IDX_OFF, S, E); }
        if (BOTH(1)) PHASE_BARRIER();
    }
    if (IN(2)) {
        if (F.G == 256) {
            const int gq = F.vcu >> 5, cls = F.vcu & 31;
            if (cls < 8) { pg8::ListSched S{(const char*)hmb, (const char*)Wxkv, DM, 2 * DX / 256, 8 * gq + cls, 1};     EpiBf16 E{kvmem, 2 * DX, 0};
                pg8::gemm_phase<EpiBf16, pg8::ListSched, 0>(F.lds + RING_OFF, F.lds + IDX_OFF, S, E); }
        }
        p2_attn(F, proj, AIN(I_REL_BIAS), AIN(I_CONV_W), AIN(I_ONA_G), AIN(I_ONB_G), yb, AIN(I_Q_G), AIN(I_K_G), QSCALE_V);
        if (BOTH(2)) PHASE_BARRIER();
    }
    if (IN(3)) {
        pg8::DenseSched S; S.init(yb, Wout, MTOK, DM, DM, F.G, (int)blockIdx.x); EpiRes<true> E{hb, hb, sq1, nullptr};
        pg8::gemm_phase<EpiRes<true>, pg8::DenseSched, 0>(F.lds + RING_OFF, F.lds + IDX_OFF, S, E);
        { if (grouped) { for (int j = 0; j < 2; ++j) kv_knorm_row(kvmem, AIN(I_XK_G), (F.vcu >> 4) * (MMEM / BATCH) + (F.vcu & 15) * 16 + F.wave * 2 + j, fresh_tid() & 63); }
                          else for (int m = gw; m < MMEM; m += NGW) kv_knorm_row(kvmem, AIN(I_XK_G), m, fresh_tid() & 63); }
        if (BOTH(3)) PHASE_BARRIER();
    }
    if (IN(4)) {
        pg8::DenseSched S; S.init(hb, Wxq, MTOK, DX, DM, F.G, (int)blockIdx.x); EpiRstdBf16 E{qx, sq1, DX, 0};
        pg8::gemm_phase<EpiRstdBf16, pg8::DenseSched, 0>(F.lds + RING_OFF, F.lds + IDX_OFF, S, E);
        if (BOTH(4)) PHASE_BARRIER();
    }
    if (IN(5)) {
        p5_xattn(F, qx, kvmem, AIN(I_XQ_G), ox, AIN(I_XK_G));
        if (BOTH(5)) PHASE_BARRIER();
    }
    if (IN(6)) {
        pg8::DenseSched S; S.init(ox, Wxo, MTOK, DM, DX, F.G, (int)blockIdx.x); EpiRes6 E{hb, sq2, x2f8};
        pg8::gemm_phase<EpiRes6, pg8::DenseSched, 0>(F.lds + RING_OFF, F.lds + IDX_OFF, S, E);
        if (BOTH(6)) PHASE_BARRIER();
    }
    if (IN(7)) {
        p7_route(F, hb, Wrt, sq2, AIN(I_B_ROUTER), (unsigned*)(kargs()->ws + WS_CTL) + CW_CNT, list, listg, listr);
        if (BOTH(7)) GRID_BARRIER();
    }
    if (IN(8)) {
        moe_tables((unsigned*)(kargs()->ws + WS_CTL) + CW_CNT, mtab);
        MoeSched S{(const char*)x2f8, (const char*)Wgu8, (size_t)2 * DFF * ROWB6, list, listr, AIN(I_B_GU), mtab, DM, 2 * DFF / 256, (int)mtab[32 + NE], F.G, (int)blockIdx.x, 1, ROWB6, 2 * DFF, 128, MTOK * 128};
        EpiSwiglu6 E{act8, mtab, 1.0f / (X6SCALE * W6SCALE), 0};
        pg8::gemm_phase_f6<EpiSwiglu6, MoeSched, 2, 2>(F.lds + RING_OFF, F.lds + IDX_OFF, S, E);
        if (BOTH(8)) GRID_BARRIER();
    }
    if (IN(9)) {
        moe_tables((unsigned*)(kargs()->ws + WS_CTL) + CW_CNT, mtab);
        MoeSched S{(const char*)act8, (const char*)Wdn8, (size_t)DM * ROWB6F, list, listg, AIN(I_B_DN), mtab, DFF, DM / 256, (int)mtab[32 + NE], F.G, (int)blockIdx.x, 0, ROWB6F, DM, 0, TILE6};
        EpiDown8 E{(unsigned char*)ybuf, mtab, Y8SCALE / (A6SCALE * W6SCALE), 0};
        pg8::gemm_phase_f6<EpiDown8, MoeSched, 1, 3>(F.lds + RING_OFF, F.lds + IDX_OFF, S, E);
        if (BOTH(9)) GRID_BARRIER();
    }
    if (IN(10)) p10_combine(F, kargs()->out, hb, (const unsigned char*)ybuf);
#undef IN
#undef BOTH
#undef GRID_BARRIER
#undef PHASE_BARRIER
#undef WSP
#undef Win
#undef Wxkv
#undef Wout
#undef Wxq
#undef Wxo
#undef yb
#undef qx
#undef ox
#undef sq1
#undef sq2
#undef listr
#undef listg
#undef Wrt
#undef ybuf
#undef Wgu8
#undef Wdn8
#undef x2f8
#undef act8
#undef list
#undef hb
#undef hmb
#undef proj
#undef kvmem
}

static int g_grid = 0;
static void launch_mk(Args& a, int lo, int hi, int li, hipStream_t stream) {
    a.ph_lo = lo; a.ph_hi = hi; a.li = li; a.pad = 0;
    hipLaunchKernelGGL(mk_fwd, dim3(g_grid), dim3(NWAVES * 64), LDS_BYTES, stream, a);
}
extern "C" void kernel_launch(void* const* d_in, const int* in_sizes, int n_in, void* d_out, int out_size, void* d_ws, size_t ws_size, hipStream_t stream) {
    if (n_in != 25 || ws_size < WS_END || out_size != MTOK * DM) { fprintf(stderr, "kernel_launch: unexpected problem (n_in %d ws %zu out %d)\n", n_in, ws_size, out_size); return; }
    if (g_grid == 0) {
        int dev = 0, cus = 0;
        if (hipGetDevice(&dev) != hipSuccess || hipDeviceGetAttribute(&cus, hipDeviceAttributeMultiprocessorCount, dev) != hipSuccess) { g_grid = -1; return; }
        if (hipFuncSetAttribute((const void*)mk_fwd, hipFuncAttributeMaxDynamicSharedMemorySize, LDS_BYTES) != hipSuccess) { g_grid = -1; return; }
        int per_cu = 0; (void)hipOccupancyMaxActiveBlocksPerMultiprocessor(&per_cu, (const void*)mk_fwd, NWAVES * 64, LDS_BYTES); (void)hipGetLastError();
        g_grid = (per_cu >= 1) ? cus : -1;
    }
    if (g_grid < 0) return;
    unsigned char* ws = (unsigned char*)d_ws; float* out = (float*)d_out; unsigned* ctl = (unsigned*)(ws + WS_CTL);
    (void)hipMemsetAsync(ctl, 0, CTL_ZERO_BYTES, stream);
    Args a{}; for (int i = 0; i < 25; ++i) a.in[i] = (const float*)d_in[i]; a.out = out; a.ws = ws;
    launch_mk(a, 0, 11, 0, stream);
}
```
